# Optimizing an MI355X kernel written in HIP

```python
import math
import jax
import jax.numpy as jnp
from jax import lax
import numpy as np

D_MODEL = 1024
BATCH = 32
SEQ = 256
DEPTH = 2
DEC_BATCH = 2
DEC_SEQ = 2048
PAST_LEN = 256

GRID_W = 64
HEAD_DIM = 64
H_NA = D_MODEL // 128
H_DIFF = D_MODEL // 256
H_RET = D_MODEL // 128
H_RWKV = D_MODEL // 128
WIN_R_MAX = 8
WIN_W = 16
Q_BLOCK = 128
RET_CHUNK = 128
D_LORA_W = 64
D_LORA_A = 64
D_LORA_G = 128
FF_RAW = -(-8 * D_MODEL // 3)
D_FF = -(-FF_RAW // 256) * 256
N_ATTN_LAYERS = (DEPTH + 1) // 2
N_REC_LAYERS = DEPTH // 2
D_NA = H_NA * HEAD_DIM
D_DIFF = H_DIFF * 2 * HEAD_DIM
D_RET = H_RET * HEAD_DIM
D_RWKV = H_RWKV * HEAD_DIM
ATTN_IN_SIZES = (D_NA, D_NA, D_NA, D_DIFF, D_DIFF, D_DIFF)
REC_IN_SIZES = (D_RET, D_RET, D_RET, D_RET, D_RWKV, D_RWKV, D_RWKV, D_LORA_W, D_LORA_A, D_LORA_G)
D_IN_ATTN = 3 * D_NA + 3 * D_DIFF
D_MIX_ATTN = D_NA + D_DIFF
D_IN_REC = 4 * D_RET + 3 * D_RWKV + D_LORA_W + D_LORA_A + D_LORA_G
D_MIX_REC = D_RET + D_RWKV
ROPE_BASE = 10000.0
RMS_EPS = 1e-6
RWKV_GN_EPS = 64e-5
NEG_INF = -1e30

kernel_name = 'hybrid_diffusion_prefix_step'


def rms_norm(x, gain=None, eps=RMS_EPS):
    xf = x.astype(jnp.float32)
    y = xf * lax.rsqrt(jnp.mean(xf * xf, axis=-1, keepdims=True) + eps)
    if gain is not None:
        y = y * gain.astype(jnp.float32)
    return y.astype(x.dtype)


def ada_modulation(cond, w, b):
    m = (jax.nn.silu(cond) @ w + b)[..., None, :]
    return jnp.split(m, 6, axis=-1)


def modulate(h, shift, scale):
    return h * (1.0 + scale) + shift


def split_cols(x, sizes):
    out, start = [], 0
    for s in sizes:
        out.append(x[..., start:start + s])
        start += s
    return out


def axial_rope(x):
    n = x.shape[1]
    pos = jnp.arange(n)
    half = HEAD_DIM // 2
    quarter = half // 2
    inv_freq = ROPE_BASE ** (-jnp.arange(quarter, dtype=jnp.float32) / quarter)
    bshape = (n,) + (1,) * (x.ndim - 3) + (quarter,)

    def rot(xh, p):
        ang = (p.astype(jnp.float32)[:, None] * inv_freq[None, :]).reshape(bshape)
        cos, sin = jnp.cos(ang), jnp.sin(ang)
        x1, x2 = xh[..., :quarter], xh[..., quarter:]
        return jnp.concatenate([x1 * cos - x2 * sin, x1 * sin + x2 * cos], axis=-1)

    xf = x.astype(jnp.float32)
    out = jnp.concatenate([rot(xf[..., :half], pos // GRID_W), rot(xf[..., half:], pos % GRID_W)], axis=-1)
    return out.astype(x.dtype)


def sweep_query_blocks(fn, q):
    b, n = q.shape[0], q.shape[1]
    nb = n // Q_BLOCK
    qb = jnp.moveaxis(q.reshape((b, nb, Q_BLOCK) + q.shape[2:]), 1, 0)
    o = jnp.moveaxis(lax.map(fn, qb), 0, 1)
    return o.reshape((b, n) + o.shape[3:])


def softmax_attention(q, k, v):
    scale = HEAD_DIM ** -0.5

    def block(qb):
        s = jnp.einsum('bqhd,bkhd->bhqk', qb, k).astype(jnp.float32) * scale
        p = jax.nn.softmax(s, axis=-1).astype(v.dtype)
        return jnp.einsum('bhqk,bkhd->bqhd', p, v)

    return sweep_query_blocks(block, q)


def neighbourhood_attention(q, k, v, k_ctx, v_ctx, rpb):
    b, n, h, d = q.shape
    rows = n // GRID_W
    win_r = min(WIN_R_MAX, rows)
    r_idx = jnp.arange(rows)
    r_start = jnp.clip(r_idx - win_r // 2, 0, rows - win_r)
    key_rows = r_start[:, None] + jnp.arange(win_r)[None, :]
    col = jnp.arange(GRID_W)
    c_start = jnp.clip(col - WIN_W // 2, 0, GRID_W - WIN_W)
    col_in = (col[None, :] >= c_start[:, None]) & (col[None, :] < c_start[:, None] + WIN_W)
    dr_idx = key_rows - r_idx[:, None] + (WIN_R_MAX - 1)
    dc_idx = jnp.clip(col[None, :] - col[:, None] + (WIN_W - 1), 0, 2 * WIN_W - 2)
    bias = rpb[:, dr_idx[:, None, :, None], dc_idx[None, :, None, :]]
    qg = q.reshape(b, rows, GRID_W, h, d)
    kg = k.reshape(b, rows, GRID_W, h, d)[:, key_rows]
    vg = v.reshape(b, rows, GRID_W, h, d)[:, key_rows]
    scale = d ** -0.5
    s_win = jnp.einsum('brqhd,brikhd->bhrqik', qg, kg).astype(jnp.float32) * scale + bias.astype(jnp.float32)
    s_win = jnp.where(col_in[:, None, :], s_win, NEG_INF).reshape(b, h, rows, GRID_W, win_r * GRID_W)
    s_ctx = jnp.einsum('brqhd,blhd->bhrql', qg, k_ctx).astype(jnp.float32) * scale
    p = jax.nn.softmax(jnp.concatenate([s_win, s_ctx], axis=-1), axis=-1).astype(v.dtype)
    p_win = p[..., :win_r * GRID_W].reshape(b, h, rows, GRID_W, win_r, GRID_W)
    p_ctx = p[..., win_r * GRID_W:]
    o = jnp.einsum('bhrqik,brikhd->brqhd', p_win, vg) + jnp.einsum('bhrql,blhd->brqhd', p_ctx, v_ctx)
    return o.reshape(b, n, h, d)


def diff_attention(q, k, v, lam, lam_init):
    scale = HEAD_DIM ** -0.5

    def block(qb):
        s = jnp.einsum('bqhcd,bkhcd->bhcqk', qb, k).astype(jnp.float32) * scale
        p = jax.nn.softmax(s, axis=-1)
        p = (p[:, :, 0] - lam * p[:, :, 1]).astype(v.dtype)
        return jnp.einsum('bhqk,bkhe->bqhe', p, v)

    o = sweep_query_blocks(block, q)
    return rms_norm(o) * (1.0 - lam_init)


def attn_projections(h, w_in):
    b, n, _ = h.shape
    nq, nk, nv, dq, dk, dv = split_cols(h @ w_in, ATTN_IN_SIZES)
    na = lambda t: t.reshape(b, n, H_NA, HEAD_DIM)
    dqk = lambda t: t.reshape(b, n, H_DIFF, 2, HEAD_DIM)
    return na(nq), na(nk), na(nv), dqk(dq), dqk(dk), dv.reshape(b, n, H_DIFF, 2 * HEAD_DIM)


def retention_scan(q, k, v, log_g, r0):
    b, n, h, d = q.shape
    nc = n // RET_CHUNK
    idx = jnp.arange(RET_CHUNK, dtype=jnp.float32)
    diff = idx[:, None] - idx[None, :]
    decay_mask = jnp.where(diff[None] >= 0, jnp.exp(jnp.maximum(diff, 0.0)[None] * log_g[:, None, None]), 0.0)
    q_decay = jnp.exp((idx[:, None] + 1.0) * log_g[None, :])
    k_decay = jnp.exp((RET_CHUNK - 1.0 - idx)[:, None] * log_g[None, :])
    chunk_decay = jnp.exp(RET_CHUNK * log_g)

    def to_chunks(x):
        return jnp.moveaxis(x.reshape(b, nc, RET_CHUNK, h, d), 1, 0)

    def step(state, qkv):
        qc, kc, vc = qkv
        s = jnp.einsum('bihd,bjhd->bhij', qc, kc) * decay_mask[None]
        inner = jnp.einsum('bhij,bjhe->bihe', s, vc)
        cross = jnp.einsum('bihd,bhde->bihe', qc, state) * q_decay[None, :, :, None]
        new_state = state * chunk_decay[None, :, None, None] + jnp.einsum('bjhd,bjhe->bhde', kc * k_decay[None, :, :, None], vc)
        return new_state, inner + cross

    final, out = lax.scan(step, r0, (to_chunks(q), to_chunks(k), to_chunks(v)))
    return jnp.moveaxis(out, 0, 1).reshape(b, n, h, d), final


def retention_mixer(x_q, x_k, x_v, x_g, decay_logit, state0):
    b, n, _ = x_q.shape
    heads = lambda t: t.reshape(b, n, H_RET, HEAD_DIM).astype(jnp.float32)
    q, k, v = heads(x_q), heads(x_k) * (HEAD_DIM ** -0.5), heads(x_v)
    log_g = jax.nn.log_sigmoid(decay_logit.astype(jnp.float32))
    s0 = state0.astype(jnp.float32)
    o_f, s_f = retention_scan(q, k, v, log_g[0], s0[:, 0])
    o_b, s_b = retention_scan(q[:, ::-1], k[:, ::-1], v[:, ::-1], log_g[1], s0[:, 1])
    o = rms_norm(o_f + o_b[:, ::-1]).reshape(b, n, D_RET)
    out = jax.nn.silu(x_g.astype(jnp.float32)) * o
    return out.astype(x_q.dtype), jnp.stack([s_f, s_b], axis=1).astype(x_q.dtype)


def rwkv7_scan(r, w, k, v, a_vec, b_vec, s0):
    def step(S, inp):
        rt, wt, kt, vt, at, bt = inp
        sa = jnp.einsum('bhvk,bhk->bhv', S, at)
        S = S * wt[:, :, None, :] + sa[..., None] * bt[:, :, None, :] + vt[..., None] * kt[:, :, None, :]
        return S, jnp.einsum('bhvk,bhk->bhv', S, rt)

    xs = tuple(jnp.moveaxis(t, 1, 0) for t in (r, w, k, v, a_vec, b_vec))
    S, ys = lax.scan(step, s0, xs)
    return jnp.moveaxis(ys, 0, 1), S


def rwkv7_mixer(x_r, x_k, x_v, x_wd, x_ad, x_gd, w0, w_up, a0, a_up, g_up, k_k, k_a, r_k, ln_g, ln_b, state0):
    b, n, _ = x_r.shape
    heads = lambda t: t.reshape(b, n, H_RWKV, HEAD_DIM).astype(jnp.float32)
    r, k, v = heads(x_r), heads(x_k), heads(x_v)
    kk = heads(x_k * k_k)
    kk = kk * lax.rsqrt(jnp.sum(kk * kk, axis=-1, keepdims=True) + 1e-12)
    k_a_h = k_a.reshape(H_RWKV, HEAD_DIM).astype(jnp.float32)
    s0 = state0.astype(jnp.float32)
    ys, states = [], []
    for d in range(2):
        w_log = -math.exp(-0.5) * jax.nn.sigmoid(w0[d] + jnp.tanh(x_wd) @ w_up[d])
        decay = heads(jnp.exp(w_log))
        a = heads(jax.nn.sigmoid(a0[d] + x_ad @ a_up[d]))
        k_eff = k * (1.0 + (a - 1.0) * k_a_h)
        seq = (r, decay, k_eff, v, -kk, kk * a)
        if d == 1:
            seq = tuple(t[:, ::-1] for t in seq)
        y, s = rwkv7_scan(*seq, s0[:, d])
        if d == 1:
            y = y[:, ::-1]
        ys.append(y)
        states.append(s)
    y = ys[0] + ys[1]
    mu = jnp.mean(y, axis=-1, keepdims=True)
    var = jnp.mean(jnp.square(y - mu), axis=-1, keepdims=True)
    y = ((y - mu) * lax.rsqrt(var + RWKV_GN_EPS)).reshape(b, n, D_RWKV) * ln_g.astype(jnp.float32) + ln_b.astype(jnp.float32)
    bonus = (jnp.sum(r * r_k.astype(jnp.float32) * k, axis=-1, keepdims=True) * v).reshape(b, n, D_RWKV)
    g = (jax.nn.sigmoid(x_gd) @ g_up).astype(jnp.float32)
    out = (y + bonus) * g
    return out.astype(x_r.dtype), jnp.stack(states, axis=1).astype(x_r.dtype)


def rec_mixer(h, w_in, w_out, decay_logit, w0, w_up, a0, a_up, g_up, k_k, k_a, r_k, ln_g, ln_b, ret_state0, rwkv_state0):
    rq, rk, rv, rg, wr, wk, wv, wd, ad, gd = split_cols(h @ w_in, REC_IN_SIZES)
    o_ret, s_ret = retention_mixer(rq, rk, rv, rg, decay_logit, ret_state0)
    o_rw, s_rw = rwkv7_mixer(wr, wk, wv, wd, ad, gd, w0, w_up, a0, a_up, g_up, k_k, k_a, r_k, ln_g, ln_b, rwkv_state0)
    return jnp.concatenate([o_ret, o_rw], axis=-1) @ w_out, s_ret, s_rw


def swiglu(h, w_in, w_out):
    g, u = jnp.split(h @ w_in, 2, axis=-1)
    return (jax.nn.silu(g) * u) @ w_out


def setup_inputs(seed: int = 0) -> dict:
    key = jax.random.key(seed)
    ks = iter(jax.random.split(key, 48))
    nrm = lambda shape, scale: jax.random.normal(next(ks), shape, jnp.float32) * scale
    base_logit = jnp.log(2.0 ** (5.0 + jnp.arange(H_RET, dtype=jnp.float32)) - 1.0)
    return {
        'x_prompt': nrm((BATCH, SEQ, D_MODEL), 1.0),
        'x_sample': nrm((DEC_BATCH, DEC_SEQ, D_MODEL), 1.0),
        'cache_na_k': nrm((DEC_BATCH, N_ATTN_LAYERS, PAST_LEN, H_NA, HEAD_DIM), 1.0),
        'cache_na_v': nrm((DEC_BATCH, N_ATTN_LAYERS, PAST_LEN, H_NA, HEAD_DIM), 1.0),
        'cache_diff_k': nrm((DEC_BATCH, N_ATTN_LAYERS, PAST_LEN, H_DIFF, 2, HEAD_DIM), 1.0),
        'cache_diff_v': nrm((DEC_BATCH, N_ATTN_LAYERS, PAST_LEN, H_DIFF, 2 * HEAD_DIM), 1.0),
        'state_ret': nrm((DEC_BATCH, N_REC_LAYERS, 2, H_RET, HEAD_DIM, HEAD_DIM), 0.5),
        'state_rwkv': nrm((DEC_BATCH, N_REC_LAYERS, 2, H_RWKV, HEAD_DIM, HEAD_DIM), 0.5),
        'c': nrm((DEC_BATCH, D_MODEL), 1.0),
        'c_ctx': nrm((D_MODEL,), 1.0),
        'norm_mix_g': 1.0 + nrm((DEPTH, D_MODEL), 0.05),
        'norm_ffn_g': 1.0 + nrm((DEPTH, D_MODEL), 0.05),
        'norm_final_g': 1.0 + nrm((D_MODEL,), 0.05),
        'w_ada': nrm((DEPTH, D_MODEL, 6 * D_MODEL), 0.5 * D_MODEL ** -0.5),
        'b_ada': nrm((DEPTH, 6 * D_MODEL), 0.02),
        'w_in_attn': nrm((N_ATTN_LAYERS, D_MODEL, D_IN_ATTN), D_MODEL ** -0.5),
        'w_out_attn': nrm((N_ATTN_LAYERS, D_MIX_ATTN, D_MODEL), D_MIX_ATTN ** -0.5),
        'na_rpb': nrm((N_ATTN_LAYERS, H_NA, 2 * WIN_R_MAX - 1, 2 * WIN_W - 1), 0.1),
        'diff_lq1': nrm((N_ATTN_LAYERS, HEAD_DIM), 0.1),
        'diff_lk1': nrm((N_ATTN_LAYERS, HEAD_DIM), 0.1),
        'diff_lq2': nrm((N_ATTN_LAYERS, HEAD_DIM), 0.1),
        'diff_lk2': nrm((N_ATTN_LAYERS, HEAD_DIM), 0.1),
        'w_in_rec': nrm((N_REC_LAYERS, D_MODEL, D_IN_REC), D_MODEL ** -0.5),
        'w_out_rec': nrm((N_REC_LAYERS, D_MIX_REC, D_MODEL), D_MIX_REC ** -0.5),
        'ret_decay_logit': jnp.broadcast_to(base_logit, (N_REC_LAYERS, 2, H_RET)) + nrm((N_REC_LAYERS, 2, H_RET), 0.05),
        'rw_w0': nrm((N_REC_LAYERS, 2, D_RWKV), 0.5),
        'rw_w_up': nrm((N_REC_LAYERS, 2, D_LORA_W, D_RWKV), 0.5 * D_LORA_W ** -0.5),
        'rw_a0': nrm((N_REC_LAYERS, 2, D_RWKV), 0.5),
        'rw_a_up': nrm((N_REC_LAYERS, 2, D_LORA_A, D_RWKV), 0.5 * D_LORA_A ** -0.5),
        'rw_g_up': nrm((N_REC_LAYERS, D_LORA_G, D_RWKV), D_LORA_G ** -0.5),
        'rw_k_k': 0.85 + nrm((N_REC_LAYERS, D_RWKV), 0.05),
        'rw_k_a': 1.0 + nrm((N_REC_LAYERS, D_RWKV), 0.05),
        'rw_r_k': nrm((N_REC_LAYERS, H_RWKV, HEAD_DIM), 0.1),
        'rw_ln_g': 1.0 + nrm((N_REC_LAYERS, D_RWKV), 0.05),
        'rw_ln_b': nrm((N_REC_LAYERS, D_RWKV), 0.02),
        'w_ffn_in': nrm((DEPTH, D_MODEL, 2 * D_FF), D_MODEL ** -0.5),
        'w_ffn_out': nrm((DEPTH, D_FF, D_MODEL), D_FF ** -0.5),
    }


def reference(x_prompt, x_sample, cache_na_k, cache_na_v, cache_diff_k, cache_diff_v, state_ret, state_rwkv,
              c, c_ctx, norm_mix_g, norm_ffn_g, norm_final_g, w_ada, b_ada,
              w_in_attn, w_out_attn, na_rpb, diff_lq1, diff_lk1, diff_lq2, diff_lk2,
              w_in_rec, w_out_rec, ret_decay_logit, rw_w0, rw_w_up, rw_a0, rw_a_up, rw_g_up,
              rw_k_k, rw_k_a, rw_r_k, rw_ln_g, rw_ln_b, w_ffn_in, w_ffn_out):
    ctx, lat = x_prompt, x_sample
    bp = ctx.shape[0]
    na_k_list, na_v_list, df_k_list, df_v_list, ret_list, rwkv_list = [], [], [], [], [], []
    for layer in range(DEPTH):
        m_ctx = ada_modulation(c_ctx, w_ada[layer], b_ada[layer])
        m_lat = ada_modulation(c, w_ada[layer], b_ada[layer])
        h_ctx = modulate(rms_norm(ctx, norm_mix_g[layer]), m_ctx[0], m_ctx[1])
        h_lat = modulate(rms_norm(lat, norm_mix_g[layer]), m_lat[0], m_lat[1])
        if layer % 2 == 0:
            i = layer // 2
            lam_init = 0.8 - 0.6 * math.exp(-0.3 * layer)
            lam = (jnp.exp(jnp.sum(diff_lq1[i].astype(jnp.float32) * diff_lk1[i].astype(jnp.float32)))
                   - jnp.exp(jnp.sum(diff_lq2[i].astype(jnp.float32) * diff_lk2[i].astype(jnp.float32))) + lam_init)
            nq, nk, nv, dq, dk, dv = attn_projections(h_ctx, w_in_attn[i])
            o_na = softmax_attention(nq, nk, nv)
            o_df = diff_attention(dq, dk, dv, lam, lam_init)
            mix_ctx = jnp.concatenate([o_na.reshape(o_na.shape[:2] + (D_NA,)), o_df.reshape(o_df.shape[:2] + (D_DIFF,))], axis=-1) @ w_out_attn[i]
            na_k_list.append(nk)
            na_v_list.append(nv)
            df_k_list.append(dk)
            df_v_list.append(dv)
            nq, nk, nv, dq, dk, dv = attn_projections(h_lat, w_in_attn[i])
            dq, dk = axial_rope(dq), axial_rope(dk)
            o_na = neighbourhood_attention(nq, nk, nv, cache_na_k[:, i], cache_na_v[:, i], na_rpb[i])
            k_all = jnp.concatenate([dk, cache_diff_k[:, i]], axis=1)
            v_all = jnp.concatenate([dv, cache_diff_v[:, i]], axis=1)
            o_df = diff_attention(dq, k_all, v_all, lam, lam_init)
            mix_lat = jnp.concatenate([o_na.reshape(o_na.shape[:2] + (D_NA,)), o_df.reshape(o_df.shape[:2] + (D_DIFF,))], axis=-1) @ w_out_attn[i]
        else:
            j = layer // 2
            params = (w_in_rec[j], w_out_rec[j], ret_decay_logit[j], rw_w0[j], rw_w_up[j], rw_a0[j], rw_a_up[j],
                      rw_g_up[j], rw_k_k[j], rw_k_a[j], rw_r_k[j], rw_ln_g[j], rw_ln_b[j])
            zero_ret = jnp.zeros((bp, 2, H_RET, HEAD_DIM, HEAD_DIM), ctx.dtype)
            zero_rwkv = jnp.zeros((bp, 2, H_RWKV, HEAD_DIM, HEAD_DIM), ctx.dtype)
            mix_ctx, s_ret, s_rw = rec_mixer(h_ctx, *params, zero_ret, zero_rwkv)
            ret_list.append(s_ret)
            rwkv_list.append(s_rw)
            mix_lat, _, _ = rec_mixer(h_lat, *params, state_ret[:, j], state_rwkv[:, j])
        ctx = ctx + m_ctx[2] * mix_ctx
        lat = lat + m_lat[2] * mix_lat
        ctx = ctx + m_ctx[5] * swiglu(modulate(rms_norm(ctx, norm_ffn_g[layer]), m_ctx[3], m_ctx[4]), w_ffn_in[layer], w_ffn_out[layer])
        lat = lat + m_lat[5] * swiglu(modulate(rms_norm(lat, norm_ffn_g[layer]), m_lat[3], m_lat[4]), w_ffn_in[layer], w_ffn_out[layer])
    y_prompt = rms_norm(ctx, norm_final_g)
    y_sample = rms_norm(lat, norm_final_g)
    new_cache_na_k = jnp.stack(na_k_list, axis=1)
    new_cache_na_v = jnp.stack(na_v_list, axis=1)
    new_cache_diff_k = jnp.stack(df_k_list, axis=1)
    new_cache_diff_v = jnp.stack(df_v_list, axis=1)
    new_state_ret = jnp.stack(ret_list, axis=1)
    new_state_rwkv = jnp.stack(rwkv_list, axis=1)
    return (y_prompt, y_sample, new_cache_na_k, new_cache_na_v, new_cache_diff_k, new_cache_diff_v, new_state_ret, new_state_rwkv)
```

```cpp
#include <hip/hip_runtime.h>
#include <hip/hip_cooperative_groups.h>
#include <cstdio>
#include <cstdint>
namespace pg8 {
#define PG8_LAS __attribute__((address_space(3)))
typedef unsigned short bf16_t;
typedef short bf16x8 __attribute__((ext_vector_type(8)));
typedef float f32x4 __attribute__((ext_vector_type(4)));
typedef unsigned u32x4 __attribute__((ext_vector_type(4)));
constexpr int BM = 256, BK = 64, HALF = 128, HTB = HALF * BK * 2  , STAGE_BYTES = 8 * HTB, NXCD = 8, WGM = 8;

__host__ __device__ __forceinline__ int lds_byte(int r, int c) { const int st = (r >> 4) * 2 + (c >> 5), rr = r & 15, cc = c & 31, ob = rr * 64 + cc * 2; return st * 1024 + (ob ^ (((ob >> 9) & 1) << 5)); }
__host__ __device__ __forceinline__ void stage_rc(int b, int& R, int& C) { const int st = b / 1024, sb = b % 1024, swz = sb ^ (((sb >> 9) & 1) << 5); R = (st >> 1) * 16 + swz / 64; C = (st & 1) * 32 + (swz % 64) / 2; }
__host__ __device__ __forceinline__ int perm32(int rho) { const int n = rho >> 4, i = rho & 15; return 8 * (i >> 2) + 4 * n + (i & 3); }

struct Unit { int pm, pn; };
struct Gemm { const bf16_t* A; const bf16_t* Bt; int M, N, K; };

struct StaticOrder {
    int nM, nN, nwg, G, c;
    __host__ __device__ void init(int M, int N, int G_, int c_) { nM = M / BM; nN = N / BM; nwg = nM * nN; G = G_; c = c_; }
    __host__ __device__ bool next(int i, Unit& u) const {
        const long L = (long)i * G + c; if (L >= nwg) return false;
        int wgid = (int)L; { const int q = nwg / NXCD, r = nwg % NXCD, xcd = wgid % NXCD, off = wgid / NXCD; wgid = (xcd < r ? xcd * (q + 1) : r * (q + 1) + (xcd - r) * q) + off; }
        const int nig = WGM * nN, gid = wgid / nig, fm = gid * WGM, gsz = (nM - fm) < WGM ? (nM - fm) : WGM;
        u.pm = fm + ((wgid % nig) % gsz); u.pn = (wgid % nig) / gsz; return true;
    }
    __device__ __forceinline__ void a_ready(const Unit&) const {}
    __device__ __forceinline__ void done(const Unit&) const {}
};
__device__ __forceinline__ unsigned cvt_pk_bf16(float lo, float hi) { unsigned r; asm volatile("v_cvt_pk_bf16_f32 %0, %1, %2" : "=v"(r) : "v"(lo), "v"(hi)); return r; }
typedef float f32x2 __attribute__((ext_vector_type(2)));
template <class Epi, class Sched, bool ALIGN_EPI = false, bool SP2 = false>
__device__ __forceinline__ void gemm_phase(PG8_LAS unsigned char* lds, const Gemm g, const Sched& S, const Epi& E) {
    const int tid = threadIdx.x, wid = __builtin_amdgcn_readfirstlane(tid >> 6), lane = tid & 63, wr = wid >> 2, wc = wid & 3, fr = lane & 15, fq = lane >> 4;
    const int K = g.K, nt = K / BK;
    unsigned voffA[2], voffB[2];
#pragma unroll
    for (int i = 0; i < 2; ++i) { int R, C; stage_rc(tid * 16 + i * 8192, R, C); const int Rb = Epi::PERM ? ((R & ~31) + perm32(R & 31)) : R;
        voffA[i] = (unsigned)(R * K + C) * 2u; voffB[i] = (unsigned)(Rb * K + C) * 2u; }
    const size_t kstep = (size_t)(BK * 2);
    const size_t hstep = (size_t)HALF * K * 2;
    const size_t tstep = 2 * hstep;
    const unsigned ldsw = (unsigned)wid * 1024u;
    const int aoff = lds_byte(wr * 64 + fr, fq * 8), boff = lds_byte(wc * 32 + fr, fq * 8);
#define PG8_SA(b, h) (((b) * 2 + (h)) * HTB)
#define PG8_SB(b, h) ((4 + (b) * 2 + (h)) * HTB)
#define PG8_STAGE(bufoff, gbase, voff) do { _Pragma("unroll") for (int _i = 0; _i < 2; ++_i) \
        __builtin_amdgcn_global_load_lds((const unsigned*)((const char*)(gbase) + (voff)[_i]), (PG8_LAS unsigned*)(lds + (bufoff) + ldsw + _i * 8192), 16, 0, 0); } while (0)
#define PG8_LDA(dst, b, h) do { _Pragma("unroll") for (int m = 0; m < 4; ++m) _Pragma("unroll") for (int k = 0; k < 2; ++k) dst[m][k] = *(const PG8_LAS bf16x8*)(lds + PG8_SA(b, h) + aoff + m * 2048 + k * 1024); } while (0)
#define PG8_LDB(dst, b, h) do { _Pragma("unroll") for (int n = 0; n < 2; ++n) _Pragma("unroll") for (int k = 0; k < 2; ++k) dst[n][k] = *(const PG8_LAS bf16x8*)(lds + PG8_SB(b, h) + boff + n * 2048 + k * 1024); } while (0)
#define PG8_MMA(ai, bj, At, Bt) do { __builtin_amdgcn_s_setprio(1); _Pragma("unroll") for (int m = 0; m < 4; ++m) _Pragma("unroll") for (int n = 0; n < 2; ++n) _Pragma("unroll") for (int k = 0; k < 2; ++k) \
        acc[ai][bj][m][n] = __builtin_amdgcn_mfma_f32_16x16x32_bf16(Bt[n][k], At[m][k], acc[ai][bj][m][n], 0, 0, 0); __builtin_amdgcn_s_setprio(0); } while (0)
#define PG8_WAIT_V(n) asm volatile("s_waitcnt vmcnt(" #n ")" ::: "memory")
#define PG8_WAIT_L(n) asm volatile("s_waitcnt lgkmcnt(" #n ")" ::: "memory")
#define PG8_BAR __builtin_amdgcn_s_barrier()
#define PG8_SCHED __builtin_amdgcn_sched_barrier(0)
    Unit cur, nxt; int ui = 0;
    if (!S.next(0, cur)) return;
    f32x4 acc[2][2][4][2];
#pragma unroll
    for (int a = 0; a < 2; ++a)
#pragma unroll
        for (int b = 0; b < 2; ++b)
#pragma unroll
            for (int m = 0; m < 4; ++m)
#pragma unroll
                for (int n = 0; n < 2; ++n) acc[a][b][m][n] = (f32x4){0.f, 0.f, 0.f, 0.f};
    bf16x8 At[4][2], B0[2][2], B1[2][2];
    const char* cA = (const char*)g.A + (size_t)cur.pm * tstep; const char* cB = (const char*)g.Bt + (size_t)cur.pn * tstep;
    S.a_ready(cur);
    if constexpr (SP2) {
        PG8_STAGE(PG8_SB(0, 0), cB, voffB); PG8_STAGE(PG8_SB(0, 1), cB + hstep, voffB); PG8_STAGE(PG8_SA(0, 0), cA, voffA); PG8_STAGE(PG8_SA(0, 1), cA + hstep, voffA);
        if (wr == 1) PG8_BAR;
        PG8_WAIT_V(2); PG8_BAR;
        PG8_STAGE(PG8_SB(1, 0), cB + kstep, voffB); PG8_STAGE(PG8_SA(1, 0), cA + kstep, voffA); PG8_STAGE(PG8_SB(1, 1), cB + hstep + kstep, voffB);
        PG8_WAIT_V(6); PG8_BAR;
    } else {
        PG8_STAGE(PG8_SB(0, 0), cB, voffB); PG8_STAGE(PG8_SA(0, 0), cA, voffA); PG8_STAGE(PG8_SB(0, 1), cB + hstep, voffB); PG8_STAGE(PG8_SA(0, 1), cA + hstep, voffA);
        if (wr == 1) PG8_BAR;
        PG8_WAIT_V(4); PG8_BAR;
        PG8_STAGE(PG8_SB(1, 0), cB + kstep, voffB); PG8_STAGE(PG8_SA(1, 0), cA + kstep, voffA); PG8_STAGE(PG8_SB(1, 1), cB + hstep + kstep, voffB);
        PG8_WAIT_V(6); PG8_BAR;
    }
    for (;;) {
        const bool has_next = S.next(ui + 1, nxt);
        const char* nA = has_next ? (const char*)g.A + (size_t)nxt.pm * tstep : cA; const char* nB = has_next ? (const char*)g.Bt + (size_t)nxt.pn * tstep : cB;
        for (int t = 0; t < nt; t += 2) {
            const bool last = (t == nt - 2);
            const char* a1 = cA + (size_t)(t + 1) * kstep;
            const char* a2 = last ? nA : cA + (size_t)(t + 2) * kstep; const char* b2 = last ? nB : cB + (size_t)(t + 2) * kstep;
            const char* a3 = a2 + kstep; const char* b3 = b2 + kstep;
            if (last && has_next) S.a_ready(nxt);
            if constexpr (SP2) {
            PG8_LDB(B0, 0, 0); PG8_LDB(B1, 0, 1); PG8_SCHED; PG8_LDA(At, 0, 0); PG8_STAGE(PG8_SA(1, 1), a1 + hstep, voffA);
            PG8_WAIT_V(8); PG8_WAIT_L(0); PG8_BAR; PG8_MMA(0, 0, At, B0); PG8_MMA(0, 1, At, B1); PG8_BAR; PG8_SCHED;
            PG8_LDA(At, 0, 1); PG8_STAGE(PG8_SB(0, 0), b2, voffB); PG8_STAGE(PG8_SB(0, 1), b2 + hstep, voffB); PG8_STAGE(PG8_SA(0, 0), a2, voffA);
            PG8_WAIT_V(8); PG8_WAIT_L(0); PG8_BAR; PG8_MMA(1, 0, At, B0); PG8_MMA(1, 1, At, B1); PG8_BAR; PG8_SCHED;
            PG8_LDB(B0, 1, 0); PG8_LDB(B1, 1, 1); PG8_SCHED; PG8_LDA(At, 1, 0); PG8_STAGE(PG8_SA(0, 1), a2 + hstep, voffA);
            PG8_WAIT_V(8); PG8_WAIT_L(0); PG8_BAR; PG8_MMA(0, 0, At, B0); PG8_MMA(0, 1, At, B1); PG8_BAR; PG8_SCHED;
            PG8_LDA(At, 1, 1); PG8_STAGE(PG8_SB(1, 0), b3, voffB); PG8_STAGE(PG8_SB(1, 1), b3 + hstep, voffB); PG8_STAGE(PG8_SA(1, 0), a3, voffA);
            PG8_WAIT_V(8); PG8_WAIT_L(0); PG8_BAR; PG8_MMA(1, 0, At, B0); PG8_MMA(1, 1, At, B1); PG8_BAR; PG8_SCHED;
            } else {
            PG8_LDB(B0, 0, 0); PG8_SCHED; PG8_LDA(At, 0, 0); PG8_STAGE(PG8_SA(1, 1), a1 + hstep, voffA);
            PG8_WAIT_L(8); PG8_BAR; PG8_WAIT_L(0); PG8_MMA(0, 0, At, B0); PG8_BAR; PG8_SCHED;
            PG8_LDB(B1, 0, 1); PG8_STAGE(PG8_SB(0, 0), b2, voffB);
            PG8_BAR; PG8_WAIT_L(0); PG8_MMA(0, 1, At, B1); PG8_BAR;
            PG8_LDA(At, 0, 1); PG8_STAGE(PG8_SA(0, 0), a2, voffA);
            PG8_BAR; PG8_WAIT_L(0); PG8_MMA(1, 0, At, B0); PG8_BAR; PG8_SCHED;
            PG8_STAGE(PG8_SB(0, 1), b2 + hstep, voffB);
            PG8_WAIT_V(6); PG8_BAR; PG8_MMA(1, 1, At, B1); PG8_BAR;
            PG8_LDB(B0, 1, 0); PG8_SCHED; PG8_LDA(At, 1, 0); PG8_STAGE(PG8_SA(0, 1), a2 + hstep, voffA);
            PG8_WAIT_L(8); PG8_BAR; PG8_WAIT_L(0); PG8_MMA(0, 0, At, B0); PG8_BAR; PG8_SCHED;
            PG8_LDB(B1, 1, 1); PG8_STAGE(PG8_SB(1, 0), b3, voffB);
            PG8_BAR; PG8_WAIT_L(0); PG8_MMA(0, 1, At, B1); PG8_BAR;
            PG8_LDA(At, 1, 1); PG8_STAGE(PG8_SA(1, 0), a3, voffA);
            PG8_BAR; PG8_WAIT_L(0); PG8_MMA(1, 0, At, B0); PG8_BAR; PG8_SCHED;
            PG8_STAGE(PG8_SB(1, 1), b3 + hstep, voffB);
            PG8_WAIT_V(6); PG8_BAR; PG8_MMA(1, 1, At, B1); PG8_BAR;
            }
        }
        if constexpr (ALIGN_EPI) { if (wr == 0) PG8_BAR; }
        if constexpr (!Epi::AFTER_DRAIN) { E(acc, cur, wr, wc, fr, fq); S.done(cur); }
        if (!has_next) break;
#pragma unroll
        for (int a = 0; a < 2; ++a)
#pragma unroll
            for (int b = 0; b < 2; ++b)
#pragma unroll
                for (int m = 0; m < 4; ++m)
#pragma unroll
                    for (int n = 0; n < 2; ++n) acc[a][b][m][n] = (f32x4){0.f, 0.f, 0.f, 0.f};
        cur = nxt; cA = nA; cB = nB; ++ui;
        if constexpr (ALIGN_EPI) { if (wr == 1) PG8_BAR; }
    }
    PG8_WAIT_V(0);
    if constexpr (!ALIGN_EPI) { if (wr == 0) PG8_BAR; }
    PG8_BAR;
    if constexpr (Epi::AFTER_DRAIN) { E.fused(acc, cur, wr, wc, fr, fq, lds, wid, lane); S.done(cur); }
#undef PG8_SA
#undef PG8_SB
#undef PG8_STAGE
#undef PG8_LDA
#undef PG8_LDB
#undef PG8_MMA
#undef PG8_WAIT_V
#undef PG8_WAIT_L
#undef PG8_BAR
#undef PG8_SCHED
}
}

#define GAS __attribute__((address_space(1)))
#define LAS __attribute__((address_space(3)))
typedef unsigned short bf16;
typedef unsigned v4u __attribute__((ext_vector_type(4)));
typedef unsigned v2u __attribute__((ext_vector_type(2)));
typedef float f32x4 __attribute__((ext_vector_type(4)));
typedef float f32x2v __attribute__((ext_vector_type(2)));

constexpr int NWAVES = 8, NTHR = 512;
constexpr int D = 1024, TCX = 8192, TLT = 4096, T = 12288;
constexpr int NATT = 3072, NREC = 3840, DFF = 2816, NFF = 5632;
constexpr int QLD = NATT;
constexpr size_t MiB = 1u << 20;
constexpr size_t WS_CTL = 0, WS_MOD = 1 * MiB, WS_WATT = 2 * MiB, WS_WOA = 8 * MiB, WS_WREC = 10 * MiB, WS_WOR = 18 * MiB, WS_WF1 = 20 * MiB, WS_WF2 = 42 * MiB,
                 WS_H = 54 * MiB, WS_MIX = 78 * MiB, WS_P = 102 * MiB, WS_S = 192 * MiB, WS_END = 256 * MiB;
constexpr size_t MOD_ROPE = 160 * 1024, MOD_LAM = 176 * 1024;
constexpr size_t WF1_STRIDE = (size_t)NFF * D;
constexpr size_t WF2_STRIDE = (size_t)D * DFF;
constexpr size_t O_YP = 0, O_YS = 8388608, O_NAK = 12582912, O_NAV = 16777216, O_DFK = 20971520, O_DFV = 25165824, O_SRET = 29360128, O_SRW = 31457280;
constexpr int LDS_BYTES = 147456;

__device__ __forceinline__ float bflo(unsigned u) { return __uint_as_float(u << 16); }
__device__ __forceinline__ float bfhi(unsigned u) { return __uint_as_float(u & 0xffff0000u); }
__device__ __forceinline__ float bf1(bf16 b) { return __uint_as_float(((unsigned)b) << 16); }
__device__ __forceinline__ unsigned f2bf(float f) { unsigned u = __float_as_uint(f); return (u + 0x7fffu + ((u >> 16) & 1u)) >> 16; }
__device__ __forceinline__ unsigned pk2(float lo, float hi) { return f2bf(lo) | (f2bf(hi) << 16); }
__device__ __forceinline__ float wave_sum(float v) {
#pragma unroll
    for (int o = 1; o < 64; o <<= 1) v += __shfl_xor(v, o);
    return v;
}
__device__ __forceinline__ float sigmoidf_(float x) { return 1.f / (1.f + __expf(-x)); }

struct Frame {
    LAS unsigned char* lds;
    int tid, lane, wave, G, bid;
    const float* in[37];
    float* out; unsigned char* ws;
    bf16 *Watt, *Woa, *Wrec, *Wor, *Wf1, *Wf2, *H, *MIX, *P;
    float *MOD, *S;
};

__device__ __forceinline__ void transpose_item(const float* W, int K, int N, bf16* WT, int k0, int n0, int drow0, LAS float* scr, int lane) {
#pragma unroll 8
    for (int i = 0; i < 32; ++i) { const int kk = 2 * i + (lane >> 5); scr[kk * 33 + (lane & 31)] = W[(size_t)(k0 + kk) * N + n0 + (lane & 31)]; }
    asm volatile("s_waitcnt lgkmcnt(0)" ::: "memory");
    const int c = lane & 7;
#pragma unroll
    for (int j = 0; j < 4; ++j) { const int n = (lane >> 3) + 8 * j; const LAS float* s = scr + (8 * c) * 33 + n;
        v4u o; o.x = pk2(s[0 * 33], s[1 * 33]); o.y = pk2(s[2 * 33], s[3 * 33]); o.z = pk2(s[4 * 33], s[5 * 33]); o.w = pk2(s[6 * 33], s[7 * 33]);
        *(v4u*)(WT + (size_t)(drow0 + n) * K + k0 + 8 * c) = o; }
    asm volatile("s_waitcnt lgkmcnt(0)" ::: "memory");
}

__device__ __forceinline__ void p0_prologue(Frame& F) {
    {
        LAS float* sc = (LAS float*)F.lds;
        LAS float* red = sc + 3072;
        for (int idx = F.tid; idx < 3072; idx += NTHR) { const int j = idx >> 10, k = idx & 1023; const float c = (j == 0) ? F.in[9][k] : F.in[8][(j - 1) * 1024 + k]; sc[idx] = c * sigmoidf_(c); }
        __syncthreads();
        for (int item = F.bid; item < 192; item += F.G) {
            const int layer = item / 96, col = (item % 96) * 64 + (F.tid & 63), kg = F.tid >> 6;
            const float* w = F.in[13] + (size_t)layer * 1024 * 6144 + col;
            float a0 = 0.f, a1 = 0.f, a2 = 0.f;
#pragma unroll 8
            for (int k = kg * 128; k < kg * 128 + 128; ++k) { const float wv = w[(size_t)k * 6144]; a0 += sc[k] * wv; a1 += sc[1024 + k] * wv; a2 += sc[2048 + k] * wv; }
            red[(kg * 3 + 0) * 64 + (F.tid & 63)] = a0; red[(kg * 3 + 1) * 64 + (F.tid & 63)] = a1; red[(kg * 3 + 2) * 64 + (F.tid & 63)] = a2;
            __syncthreads();
            if (F.tid < 192) { const int j = F.tid >> 6, c = F.tid & 63; float s = 0.f;
#pragma unroll
                for (int g = 0; g < 8; ++g) s += red[(g * 3 + j) * 64 + c];
                const int cc = (item % 96) * 64 + c; F.MOD[(layer * 3 + j) * 6144 + cc] = s + F.in[14][layer * 6144 + cc]; }
            __syncthreads();
        }
    }
    if (F.bid == F.G - 1) {
        f32x2v* rope = (f32x2v*)((unsigned char*)F.MOD + MOD_ROPE);
        for (int idx = F.tid; idx < 1024; idx += NTHR) { const int pos = idx >> 4, i = idx & 15; const float inv = powf(10000.0f, -(float)i / 16.0f); const float ang = (float)pos * inv; rope[idx] = (f32x2v){cosf(ang), sinf(ang)}; }
        if (F.wave == 0) { const float s1 = wave_sum(F.in[18][F.lane] * F.in[19][F.lane]), s2 = wave_sum(F.in[20][F.lane] * F.in[21][F.lane]);
            if (F.lane == 0) *(float*)((unsigned char*)F.MOD + MOD_LAM) = expf(s1) - expf(s2) + 0.2f; }
    }
    {
        const int gt = F.bid * NTHR + F.tid, NG = F.G * NTHR;
        for (int idx = gt; idx < 4 * 512 * 64; idx += NG) { const int t = idx / (512 * 64), r = (idx / 64) % 512, c8 = idx % 64;
            const float* srcb = (t == 0) ? F.in[2] : (t == 1) ? F.in[3] : (t == 2) ? F.in[4] : F.in[5]; const float* src = srcb + (size_t)r * 512 + c8 * 8; const int colb = (t == 0) ? 512 : (t == 1) ? 1024 : (t == 2) ? 2048 : 2560;
            const f32x4 a = *(const f32x4*)src, b = *(const f32x4*)(src + 4);
            v4u o; o.x = pk2(a[0], a[1]); o.y = pk2(a[2], a[3]); o.z = pk2(b[0], b[1]); o.w = pk2(b[2], b[3]);
            *(v4u*)(F.P + (size_t)(T + r) * QLD + colb + c8 * 8) = o; }
    }
    {
        LAS float* scr = (LAS float*)(F.lds + 20480 + F.wave * 8448);
        __syncthreads();
        const int gw = F.bid * NWAVES + F.wave, NGW = F.G * NWAVES;
        constexpr int I0 = 16 * 96, I1 = 16 * 32, I2 = 16 * 120, I3 = 16 * 32, I4 = 16 * 176, I6 = 44 * 32;
        constexpr int NIT = I0 + I1 + I2 + I3 + 2 * I4 + 2 * I6;
        for (int it = gw; it < NIT; it += NGW) {
            int r = it;
            if (r < I0) { const int nb = 96; transpose_item(F.in[15], 1024, 3072, F.Watt, 64 * (r / nb), 32 * (r % nb), 32 * (r % nb), scr, F.lane); continue; } r -= I0;
            if (r < I1) { const int nb = 32; transpose_item(F.in[16], 1024, 1024, F.Woa, 64 * (r / nb), 32 * (r % nb), 32 * (r % nb), scr, F.lane); continue; } r -= I1;
            if (r < I2) { const int nb = 120; transpose_item(F.in[22], 1024, 3840, F.Wrec, 64 * (r / nb), 32 * (r % nb), 32 * (r % nb), scr, F.lane); continue; } r -= I2;
            if (r < I3) { const int nb = 32; transpose_item(F.in[23], 1024, 1024, F.Wor, 64 * (r / nb), 32 * (r % nb), 32 * (r % nb), scr, F.lane); continue; } r -= I3;
            if (r < 2 * I4) { const int l = r / I4; r -= l * I4; const int nb = 176, n0 = 32 * (r % nb);
                const int drow = (n0 < DFF) ? ((n0 / 128) * 256 + (n0 % 128)) : (((n0 - DFF) / 128) * 256 + 128 + ((n0 - DFF) % 128));
                transpose_item(F.in[35] + (size_t)l * 1024 * NFF, 1024, NFF, F.Wf1 + (size_t)l * WF1_STRIDE, 64 * (r / nb), n0, drow, scr, F.lane); continue; } r -= 2 * I4;
            { const int l = r / I6; r -= l * I6; const int nb = 32;
                transpose_item(F.in[36] + (size_t)l * DFF * 1024, DFF, 1024, F.Wf2 + (size_t)l * WF2_STRIDE, 64 * (r / nb), 32 * (r % nb), 32 * (r % nb), scr, F.lane); }
        }
    }
}

__device__ __forceinline__ void norm_phase(Frame& F, const float* xc, const float* xl, const float* g, const float* mod  , int shift_i, int scale_i, bool zero_s) {
    const int gw = F.bid * NWAVES + F.wave, NGW = F.G * NWAVES;
    for (int row = gw; row < T; row += NGW) {
        const float* xr = (row < TCX) ? xc + (size_t)row * D : xl + (size_t)(row - TCX) * D;
        const int cond = (row < TCX) ? 0 : 1 + ((row - TCX) >> 11);
        const float* sh = mod + cond * 6144 + shift_i * 1024; const float* sc = mod + cond * 6144 + scale_i * 1024;
        f32x4 v[4]; float ss = 0.f;
#pragma unroll
        for (int j = 0; j < 4; ++j) { v[j] = *(const f32x4*)(xr + 4 * F.lane + 256 * j); ss += (v[j][0] * v[j][0] + v[j][1] * v[j][1]) + (v[j][2] * v[j][2] + v[j][3] * v[j][3]); }
        const float rstd = rsqrtf(wave_sum(ss) * (1.f / D) + 1e-6f);
#pragma unroll
        for (int j = 0; j < 4; ++j) { const int c = 4 * F.lane + 256 * j; const f32x4 gg = *(const f32x4*)(g + c), s1 = *(const f32x4*)(sc + c), s0 = *(const f32x4*)(sh + c);
            f32x4 h;
#pragma unroll
            for (int e = 0; e < 4; ++e) h[e] = v[j][e] * rstd * gg[e] * (1.f + s1[e]) + s0[e];
            v2u o; o.x = pk2(h[0], h[1]); o.y = pk2(h[2], h[3]); *(v2u*)(F.H + (size_t)row * D + c) = o; }
    }
    if (zero_s) {
        const size_t n16 = (size_t)48 * MiB / 16; f32x4* p = (f32x4*)F.S;
        for (size_t i = (size_t)F.bid * NTHR + F.tid; i < n16; i += (size_t)F.G * NTHR) p[i] = (f32x4){0.f, 0.f, 0.f, 0.f};
    }
}
__device__ __forceinline__ void final_norm_phase(Frame& F) {
    const int gw = F.bid * NWAVES + F.wave, NGW = F.G * NWAVES; const float* g = F.in[12];
    for (int row = gw; row < T; row += NGW) {
        float* xr = F.out + (size_t)row * D;
        f32x4 v[4]; float ss = 0.f;
#pragma unroll
        for (int j = 0; j < 4; ++j) { v[j] = *(const f32x4*)(xr + 4 * F.lane + 256 * j); ss += (v[j][0] * v[j][0] + v[j][1] * v[j][1]) + (v[j][2] * v[j][2] + v[j][3] * v[j][3]); }
        const float rstd = rsqrtf(wave_sum(ss) * (1.f / D) + 1e-6f);
#pragma unroll
        for (int j = 0; j < 4; ++j) { const int c = 4 * F.lane + 256 * j; const f32x4 gg = *(const f32x4*)(g + c); *(f32x4*)(xr + c) = v[j] * rstd * gg; }
    }
}

struct EpiAttnIn {
    static constexpr bool PERM = true, AFTER_DRAIN = false;
    bf16* QKV; float* out; const f32x2v* rope;
    __device__ __forceinline__ void operator()(const f32x4 (&acc)[2][2][4][2], const pg8::Unit& u, int wr, int wc, int fr, int fq) const {
        const int pn = u.pn; const bool ctx = u.pm < 32;
        float* cdst = nullptr; int cbase = 0;
        if (ctx) { if (pn == 2 || pn == 3) { cdst = out + O_NAK; cbase = 512; } else if (pn == 4 || pn == 5) { cdst = out + O_NAV; cbase = 1024; }
                   else if (pn == 8 || pn == 9) { cdst = out + O_DFK; cbase = 2048; } else if (pn == 10 || pn == 11) { cdst = out + O_DFV; cbase = 2560; } }
        const bool rope_on = (!ctx) && pn >= 6 && pn <= 9;
        const float sgn = (fq < 2) ? -1.f : 1.f;
#pragma unroll
        for (int ai = 0; ai < 2; ++ai)
#pragma unroll
            for (int m = 0; m < 4; ++m) { const int row = u.pm * 256 + ai * 128 + wr * 64 + m * 16 + fr;
#pragma unroll
                for (int bj = 0; bj < 2; ++bj) { const int col = pn * 256 + bj * 128 + wc * 32 + 8 * fq;
                    f32x4 v0 = acc[ai][bj][m][0], v1 = acc[ai][bj][m][1];
                    if (rope_on) { const int n = (row - TCX) & 2047; const int p = (wc & 1) ? (n & 63) : (n >> 6); const f32x2v* tb = rope + p * 16 + 8 * (fq & 1);
#pragma unroll
                        for (int e = 0; e < 4; ++e) { const float p0 = __shfl_xor(v0[e], 32), p1 = __shfl_xor(v1[e], 32); const f32x2v c0 = tb[e], c1 = tb[4 + e];
                            v0[e] = v0[e] * c0.x + sgn * p0 * c0.y; v1[e] = v1[e] * c1.x + sgn * p1 * c1.y; } }
                    v4u w; w.x = pg8::cvt_pk_bf16(v0[0], v0[1]); w.y = pg8::cvt_pk_bf16(v0[2], v0[3]); w.z = pg8::cvt_pk_bf16(v1[0], v1[1]); w.w = pg8::cvt_pk_bf16(v1[2], v1[3]);
                    *(v4u*)(QKV + (size_t)row * QLD + col) = w;
                    if (cdst) { float* cp = cdst + (size_t)row * 512 + (col - cbase); *(f32x4*)cp = v0; *(f32x4*)(cp + 4) = v1; } } }
    }
};
struct EpiBf16Plain {
    static constexpr bool PERM = true, AFTER_DRAIN = false;
    bf16* O; int ldc;
    __device__ __forceinline__ void operator()(const f32x4 (&acc)[2][2][4][2], const pg8::Unit& u, int wr, int wc, int fr, int fq) const {
#pragma unroll
        for (int ai = 0; ai < 2; ++ai)
#pragma unroll
            for (int m = 0; m < 4; ++m) { const int row = u.pm * 256 + ai * 128 + wr * 64 + m * 16 + fr;
#pragma unroll
                for (int bj = 0; bj < 2; ++bj) { const int col = u.pn * 256 + bj * 128 + wc * 32 + 8 * fq; const f32x4 v0 = acc[ai][bj][m][0], v1 = acc[ai][bj][m][1];
                    v4u w; w.x = pg8::cvt_pk_bf16(v0[0], v0[1]); w.y = pg8::cvt_pk_bf16(v0[2], v0[3]); w.z = pg8::cvt_pk_bf16(v1[0], v1[1]); w.w = pg8::cvt_pk_bf16(v1[2], v1[3]);
                    *(v4u*)(O + (size_t)row * ldc + col) = w; } }
    }
};
struct EpiSwiglu {
    static constexpr bool PERM = true, AFTER_DRAIN = false;
    bf16* O;
    __device__ __forceinline__ void operator()(const f32x4 (&acc)[2][2][4][2], const pg8::Unit& u, int wr, int wc, int fr, int fq) const {
#pragma unroll
        for (int ai = 0; ai < 2; ++ai)
#pragma unroll
            for (int m = 0; m < 4; ++m) { const int row = u.pm * 256 + ai * 128 + wr * 64 + m * 16 + fr; const int col = u.pn * 128 + wc * 32 + 8 * fq;
                float r[8];
#pragma unroll
                for (int n = 0; n < 2; ++n)
#pragma unroll
                    for (int e = 0; e < 4; ++e) { const float g = acc[ai][0][m][n][e], up = acc[ai][1][m][n][e]; r[4 * n + e] = g * __builtin_amdgcn_rcpf(1.f + __expf(-g)) * up; }
                v4u w; w.x = pg8::cvt_pk_bf16(r[0], r[1]); w.y = pg8::cvt_pk_bf16(r[2], r[3]); w.z = pg8::cvt_pk_bf16(r[4], r[5]); w.w = pg8::cvt_pk_bf16(r[6], r[7]);
                *(v4u*)(O + (size_t)row * DFF + col) = w; }
    }
};
struct EpiResid {
    static constexpr bool PERM = false, AFTER_DRAIN = false;
    const float* bc; const float* bl; float* X; const float* mod; int gate_i;
    __device__ __forceinline__ void operator()(const f32x4 (&acc)[2][2][4][2], const pg8::Unit& u, int wr, int wc, int fr, int fq) const {
        const int cond = (u.pm < 32) ? 0 : ((u.pm < 40) ? 1 : 2);
        const float* gate = mod + cond * 6144 + gate_i * 1024;
        const float* base = (u.pm < 32) ? bc : bl - (size_t)TCX * D;
        const int col0 = u.pn * 256 + wc * 32 + 4 * fq;
        f32x4 gv[2][2];
#pragma unroll
        for (int bj = 0; bj < 2; ++bj)
#pragma unroll
            for (int n = 0; n < 2; ++n) gv[bj][n] = *(const f32x4*)(gate + col0 + bj * 128 + n * 16);
#pragma unroll
        for (int ai = 0; ai < 2; ++ai)
#pragma unroll
            for (int m = 0; m < 4; ++m) { const size_t off = (size_t)(u.pm * 256 + ai * 128 + wr * 64 + m * 16 + fr) * D + col0;
#pragma unroll
                for (int bj = 0; bj < 2; ++bj)
#pragma unroll
                    for (int n = 0; n < 2; ++n) { const f32x4 b = *(const f32x4*)(base + off + bj * 128 + n * 16); *(f32x4*)(X + off + bj * 128 + n * 16) = b + gv[bj][n] * acc[ai][bj][m][n]; } }
    }
};

#define KEY_STEP(kp, vp, biasv) do { \
    float s_ = 0.f; \
    _Pragma("unroll") for (int c_ = 0; c_ < 8; ++c_) { const v4u kv_ = *(const v4u*)((kp) + 8 * c_); \
        s_ += q[8 * c_ + 0] * bflo(kv_.x) + q[8 * c_ + 1] * bfhi(kv_.x) + q[8 * c_ + 2] * bflo(kv_.y) + q[8 * c_ + 3] * bfhi(kv_.y) \
            + q[8 * c_ + 4] * bflo(kv_.z) + q[8 * c_ + 5] * bfhi(kv_.z) + q[8 * c_ + 6] * bflo(kv_.w) + q[8 * c_ + 7] * bfhi(kv_.w); } \
    s_ = s_ * 0.125f + (biasv); \
    const float mn_ = fmaxf(m, s_), al_ = __expf(m - mn_), p_ = __expf(s_ - mn_); l = l * al_ + p_; m = mn_; \
    _Pragma("unroll") for (int c_ = 0; c_ < 8; ++c_) { const v4u vv_ = *(const v4u*)((vp) + 8 * c_); \
        o[8 * c_ + 0] = o[8 * c_ + 0] * al_ + p_ * bflo(vv_.x); o[8 * c_ + 1] = o[8 * c_ + 1] * al_ + p_ * bfhi(vv_.x); \
        o[8 * c_ + 2] = o[8 * c_ + 2] * al_ + p_ * bflo(vv_.y); o[8 * c_ + 3] = o[8 * c_ + 3] * al_ + p_ * bfhi(vv_.y); \
        o[8 * c_ + 4] = o[8 * c_ + 4] * al_ + p_ * bflo(vv_.z); o[8 * c_ + 5] = o[8 * c_ + 5] * al_ + p_ * bfhi(vv_.z); \
        o[8 * c_ + 6] = o[8 * c_ + 6] * al_ + p_ * bflo(vv_.w); o[8 * c_ + 7] = o[8 * c_ + 7] * al_ + p_ * bfhi(vv_.w); } } while (0)
#define LOAD_Q(qp) do { _Pragma("unroll") for (int c_ = 0; c_ < 8; ++c_) { const v4u qv_ = *(const v4u*)((qp) + 8 * c_); \
        q[8 * c_ + 0] = bflo(qv_.x); q[8 * c_ + 1] = bfhi(qv_.x); q[8 * c_ + 2] = bflo(qv_.y); q[8 * c_ + 3] = bfhi(qv_.y); \
        q[8 * c_ + 4] = bflo(qv_.z); q[8 * c_ + 5] = bfhi(qv_.z); q[8 * c_ + 6] = bflo(qv_.w); q[8 * c_ + 7] = bfhi(qv_.w); } } while (0)

__device__ __forceinline__ void attn_naive_phase(Frame& F) {
    const bf16* QKV = F.P; const float lam = *(const float*)((unsigned char*)F.MOD + MOD_LAM);
    float* DIFFO = F.S; const float* rpb = F.in[17];
    constexpr int ND = 32768, NC = 32768, NB = 65536, NA = 65536, NTASK = ND + NC + NB + NA;
    for (int task = F.bid * NTHR + F.tid; task < NTASK; task += F.G * NTHR) {
        float q[64], o[64]; float m, l;
        if (task < ND || (task >= ND + NC && task < ND + NC + NB)) {
            const bool lat = task < ND; int idx = lat ? task : task - ND - NC;
            int n, b, h, vh;
            if (lat) { n = idx & 2047; idx >>= 11; b = idx & 1; idx >>= 1; h = idx & 3; vh = idx >> 2; }
            else { n = idx & 255; idx >>= 8; b = idx & 31; idx >>= 5; h = idx & 3; vh = idx >> 2; }
            const int row = lat ? TCX + b * 2048 + n : b * 256 + n;
            const int krow0 = lat ? TCX + b * 2048 : b * 256, nk0 = lat ? 2048 : 256, krow1 = T + b * 256, nk1 = lat ? 256 : 0;
            const int vcol = 2560 + h * 128 + vh * 64;
            float o1[64];
#pragma unroll
            for (int c = 0; c < 2; ++c) {
                const int qcol = 1536 + h * 128 + c * 64, kcol = 2048 + h * 128 + c * 64;
                LOAD_Q(QKV + (size_t)row * QLD + qcol);
#pragma unroll
                for (int d = 0; d < 64; ++d) o[d] = 0.f;
                m = -INFINITY; l = 0.f;
                for (int j = 0; j < nk0; ++j) { const bf16* kr = QKV + (size_t)(krow0 + j) * QLD; KEY_STEP(kr + kcol, kr + vcol, 0.f); }
                for (int j = 0; j < nk1; ++j) { const bf16* kr = QKV + (size_t)(krow1 + j) * QLD; KEY_STEP(kr + kcol, kr + vcol, 0.f); }
                const float il = 1.f / l;
                if (c == 0) {
#pragma unroll
                    for (int d = 0; d < 64; ++d) o1[d] = o[d] * il;
                } else {
                    float* dst = DIFFO + (size_t)row * 512 + h * 128 + vh * 64;
#pragma unroll
                    for (int d = 0; d < 64; d += 4) *(f32x4*)(dst + d) = (f32x4){o1[d] - lam * o[d] * il, o1[d + 1] - lam * o[d + 1] * il, o1[d + 2] - lam * o[d + 2] * il, o1[d + 3] - lam * o[d + 3] * il};
                }
            }
        } else {
            const bool lat = task < ND + NC; int idx = lat ? task - ND : task - ND - NC - NB;
            int n, b, h;
            if (lat) { n = idx & 2047; idx >>= 11; b = idx & 1; h = idx >> 1; } else { n = idx & 255; idx >>= 8; b = idx & 31; h = idx >> 5; }
            const int row = lat ? TCX + b * 2048 + n : b * 256 + n;
            const int kcol = 512 + h * 64, vcol = 1024 + h * 64;
            LOAD_Q(QKV + (size_t)row * QLD + h * 64);
#pragma unroll
            for (int d = 0; d < 64; ++d) o[d] = 0.f;
            m = -INFINITY; l = 0.f;
            if (lat) {
                const int r = n >> 6, qc = n & 63; const int rs = min(max(r - 4, 0), 24), cs = min(max(qc - 8, 0), 48);
                for (int i = 0; i < 8; ++i) for (int cc = 0; cc < 16; ++cc) { const int kr_ = rs + i, kc = cs + cc;
                    const bf16* kr = QKV + (size_t)(TCX + b * 2048 + kr_ * 64 + kc) * QLD; const float bias = rpb[h * 465 + (kr_ - r + 7) * 31 + (kc - qc + 15)];
                    KEY_STEP(kr + kcol, kr + vcol, bias); }
                for (int j = 0; j < 256; ++j) { const bf16* kr = QKV + (size_t)(T + b * 256 + j) * QLD; KEY_STEP(kr + kcol, kr + vcol, 0.f); }
            } else {
                for (int j = 0; j < 256; ++j) { const bf16* kr = QKV + (size_t)(b * 256 + j) * QLD; KEY_STEP(kr + kcol, kr + vcol, 0.f); }
            }
            const float il = 1.f / l; bf16* dst = F.MIX + (size_t)row * D + h * 64;
#pragma unroll
            for (int d = 0; d < 64; d += 8) { v4u w; w.x = pk2(o[d] * il, o[d + 1] * il); w.y = pk2(o[d + 2] * il, o[d + 3] * il); w.z = pk2(o[d + 4] * il, o[d + 5] * il); w.w = pk2(o[d + 6] * il, o[d + 7] * il); *(v4u*)(dst + d) = w; }
        }
    }
}
__device__ __forceinline__ void diff_post_phase(Frame& F) {
    const int gw = F.bid * NWAVES + F.wave, NGW = F.G * NWAVES; const float* DIFFO = F.S;
    for (int it = gw; it < T * 4; it += NGW) { const int row = it >> 2, h = it & 3;
        const f32x2v v = *(const f32x2v*)(DIFFO + (size_t)row * 512 + h * 128 + 2 * F.lane);
        const float r = rsqrtf(wave_sum(v.x * v.x + v.y * v.y) * (1.f / 128.f) + 1e-6f) * 0.8f;
        *(unsigned*)(F.MIX + (size_t)row * D + 512 + h * 128 + 2 * F.lane) = pk2(v.x * r, v.y * r); }
}

__device__ __forceinline__ void rwkv_job(Frame& F, int seq, int h, int dir) {
    LAS float* L = (LAS float*)F.lds;
    LAS float *WUP = L, *AUP = L + 4096, *Lr = L + 8192, *Lk = Lr + 1024, *Lv = Lk + 1024, *Lwd = Lv + 1024, *Lad = Lwd + 1024, *Lw = Lad + 1024, *La = Lw + 1024, *Lkk = La + 1024, *Lkef = Lkk + 1024, *Lb = Lkef + 1024, *Ly = Lb + 1024;
    const int tid = F.tid, lane = F.lane, w = F.wave;
    const bool lat = seq >= 32; const int b = lat ? seq - 32 : seq, N = lat ? 2048 : 256, R0 = lat ? TCX + b * 2048 : b * 256;
    const bf16* PROJ = F.P; float* Y = F.S;
    __syncthreads();
    for (int idx = tid; idx < 4096; idx += NTHR) { const int j = idx >> 6, k = idx & 63; WUP[idx] = F.in[26][(size_t)(dir * 64 + j) * 512 + h * 64 + k]; AUP[idx] = F.in[28][(size_t)(dir * 64 + j) * 512 + h * 64 + k]; }
    const int i = 8 * w + (lane >> 3), s = lane & 7;
    float S[8];
    {
        const float* st = F.in[7] + (size_t)((b * 2 + dir) * 8 + h) * 4096 + i * 64 + 8 * s;
#pragma unroll
        for (int kk = 0; kk < 8; ++kk) S[kk] = lat ? st[kk] : 0.f;
    }
    for (int t0 = 0; t0 < N; t0 += 16) {
#pragma unroll
        for (int rep = 0; rep < 2; ++rep) { const int idx = tid + NTHR * rep, j = idx >> 6, k = idx & 63; const int n = dir ? N - 1 - (t0 + j) : t0 + j;
            const bf16* pr = PROJ + (size_t)(R0 + n) * NREC;
            Lr[idx] = bf1(pr[2048 + h * 64 + k]); Lk[idx] = bf1(pr[2560 + h * 64 + k]); Lv[idx] = bf1(pr[3072 + h * 64 + k]); Lwd[idx] = tanhf(bf1(pr[3584 + k])); Lad[idx] = bf1(pr[3648 + k]); }
        __syncthreads();
#pragma unroll
        for (int rep = 0; rep < 2; ++rep) { const int idx = tid + NTHR * rep, j = idx >> 6, k = idx & 63;
            float zw = F.in[25][dir * 512 + h * 64 + k], za = F.in[27][dir * 512 + h * 64 + k];
#pragma unroll 8
            for (int jj = 0; jj < 64; ++jj) { zw += Lwd[j * 64 + jj] * WUP[jj * 64 + k]; za += Lad[j * 64 + jj] * AUP[jj * 64 + k]; }
            Lw[idx] = __expf(-0.6065306597f * sigmoidf_(zw)); La[idx] = sigmoidf_(za); }
        if (tid < 256) { const int j = tid >> 4, p = tid & 15; float v[4]; float ss = 0.f;
#pragma unroll
            for (int e = 0; e < 4; ++e) { v[e] = Lk[j * 64 + 4 * p + e] * F.in[30][h * 64 + 4 * p + e]; ss += v[e] * v[e]; }
            ss += __shfl_xor(ss, 1); ss += __shfl_xor(ss, 2); ss += __shfl_xor(ss, 4); ss += __shfl_xor(ss, 8);
            const float rs = rsqrtf(ss + 1e-12f);
#pragma unroll
            for (int e = 0; e < 4; ++e) Lkk[j * 64 + 4 * p + e] = v[e] * rs; }
        __syncthreads();
#pragma unroll
        for (int rep = 0; rep < 2; ++rep) { const int idx = tid + NTHR * rep, k = idx & 63; const float a = La[idx];
            Lkef[idx] = Lk[idx] * (1.f + (a - 1.f) * F.in[31][h * 64 + k]); Lb[idx] = Lkk[idx] * a; }
        __syncthreads();
        for (int j = 0; j < 16; ++j) {
            const int o8 = j * 64 + 8 * s;
            float sa = 0.f;
#pragma unroll
            for (int kk = 0; kk < 8; ++kk) sa -= S[kk] * Lkk[o8 + kk];
            sa += __shfl_xor(sa, 1); sa += __shfl_xor(sa, 2); sa += __shfl_xor(sa, 4);
            const float vi = Lv[j * 64 + i];
            float y = 0.f;
#pragma unroll
            for (int kk = 0; kk < 8; ++kk) { S[kk] = S[kk] * Lw[o8 + kk] + sa * Lb[o8 + kk] + vi * Lkef[o8 + kk]; y += S[kk] * Lr[o8 + kk]; }
            y += __shfl_xor(y, 1); y += __shfl_xor(y, 2); y += __shfl_xor(y, 4);
            if (s == 0) Ly[j * 64 + i] = y;
        }
        __syncthreads();
#pragma unroll
        for (int rep = 0; rep < 2; ++rep) { const int idx = tid + NTHR * rep, j = idx >> 6, k = idx & 63; const int n = dir ? N - 1 - (t0 + j) : t0 + j;
            atomicAdd(Y + (size_t)(R0 + n) * 512 + h * 64 + k, Ly[idx]); }
    }
    if (!lat) { float* so = F.out + O_SRW + (size_t)((b * 2 + dir) * 8 + h) * 4096 + i * 64 + 8 * s;
#pragma unroll
        for (int kk = 0; kk < 8; ++kk) so[kk] = S[kk]; }
}
__device__ __forceinline__ void ret_job(Frame& F, int seq, int h, int dir) {
    LAS float* L = (LAS float*)F.lds;
    LAS float *Lq = L, *Lk = L + 1024, *Lv = L + 2048, *Lo = L + 3072;
    const int tid = F.tid, lane = F.lane, w = F.wave;
    const bool lat = seq >= 32; const int b = lat ? seq - 32 : seq, N = lat ? 2048 : 256, R0 = lat ? TCX + b * 2048 : b * 256;
    const bf16* PROJ = F.P; float* O = F.S + (size_t)T * 512;
    const float g = sigmoidf_(F.in[24][dir * 8 + h]);
    const int e = 8 * w + (lane >> 3), s = lane & 7;
    float S[8];
    {
        const float* st = F.in[6] + (size_t)((b * 2 + dir) * 8 + h) * 4096;
#pragma unroll
        for (int dd = 0; dd < 8; ++dd) S[dd] = lat ? st[(8 * s + dd) * 64 + e] : 0.f;
    }
    __syncthreads();
    for (int t0 = 0; t0 < N; t0 += 16) {
#pragma unroll
        for (int rep = 0; rep < 2; ++rep) { const int idx = tid + NTHR * rep, j = idx >> 6, k = idx & 63; const int n = dir ? N - 1 - (t0 + j) : t0 + j;
            const bf16* pr = PROJ + (size_t)(R0 + n) * NREC;
            Lq[idx] = bf1(pr[h * 64 + k]); Lk[idx] = bf1(pr[512 + h * 64 + k]) * 0.125f; Lv[idx] = bf1(pr[1024 + h * 64 + k]); }
        __syncthreads();
        for (int j = 0; j < 16; ++j) {
            const int o8 = j * 64 + 8 * s; const float ve = Lv[j * 64 + e];
            float o = 0.f;
#pragma unroll
            for (int dd = 0; dd < 8; ++dd) { S[dd] = g * S[dd] + Lk[o8 + dd] * ve; o += Lq[o8 + dd] * S[dd]; }
            o += __shfl_xor(o, 1); o += __shfl_xor(o, 2); o += __shfl_xor(o, 4);
            if (s == 0) Lo[j * 64 + e] = o;
        }
        __syncthreads();
#pragma unroll
        for (int rep = 0; rep < 2; ++rep) { const int idx = tid + NTHR * rep, j = idx >> 6, k = idx & 63; const int n = dir ? N - 1 - (t0 + j) : t0 + j;
            atomicAdd(O + (size_t)(R0 + n) * 512 + h * 64 + k, Lo[idx]); }
        __syncthreads();
    }
    if (!lat) { float* so = F.out + O_SRET + (size_t)((b * 2 + dir) * 8 + h) * 4096;
#pragma unroll
        for (int dd = 0; dd < 8; ++dd) so[(8 * s + dd) * 64 + e] = S[dd]; }
}
__device__ __forceinline__ void run_job(Frame& F, int J) {
    int type, seq, h, dir;
    if (J < 64) { type = J >> 5; const int r = J & 31; seq = 32 + (r >> 4); h = (r >> 1) & 7; dir = r & 1; }
    else { const int r = J - 64; type = r >> 9; const int q = r & 511; seq = q >> 4; h = (q >> 1) & 7; dir = q & 1; }
    if (type == 0) rwkv_job(F, seq, h, dir); else ret_job(F, seq, h, dir);
}
__device__ __forceinline__ void scan_phase(Frame& F) {
    if (F.G > 128) { if (F.bid < 64) run_job(F, F.bid); else for (int J = 64 + (F.bid - 64); J < 1088; J += F.G - 64) run_job(F, J); }
    else for (int J = F.bid; J < 1088; J += F.G) run_job(F, J);
}
__device__ __forceinline__ void rec_post_phase(Frame& F) {
    LAS float* sg = (LAS float*)F.lds + F.wave * 128;
    const int gw = F.bid * NWAVES + F.wave, NGW = F.G * NWAVES, lane = F.lane;
    const bf16* PROJ = F.P; const float* Y = F.S; const float* O = F.S + (size_t)T * 512;
    for (int row = gw; row < T; row += NGW) {
        const bf16* pr = PROJ + (size_t)row * NREC;
        sg[lane] = sigmoidf_(bf1(pr[3712 + lane])); sg[64 + lane] = sigmoidf_(bf1(pr[3776 + lane]));
        asm volatile("s_waitcnt lgkmcnt(0)" ::: "memory");
        for (int h = 0; h < 8; ++h) {
            const int c = h * 64 + lane;
            const float y = Y[(size_t)row * 512 + c];
            const float mu = wave_sum(y) * (1.f / 64.f), dl = y - mu, var = wave_sum(dl * dl) * (1.f / 64.f);
            const float yn = dl * rsqrtf(var + 64e-5f) * F.in[33][c] + F.in[34][c];
            const float r = bf1(pr[2048 + c]), k = bf1(pr[2560 + c]), v = bf1(pr[3072 + c]);
            const float bonus = wave_sum(r * F.in[32][c] * k) * v;
            float g = 0.f;
#pragma unroll 8
            for (int j = 0; j < 128; ++j) g += sg[j] * F.in[29][(size_t)j * 512 + c];
            F.MIX[(size_t)row * D + 512 + c] = (bf16)f2bf((yn + bonus) * g);
        }
        for (int h = 0; h < 8; ++h) {
            const int c = h * 64 + lane;
            const float o = O[(size_t)row * 512 + c];
            const float on = o * rsqrtf(wave_sum(o * o) * (1.f / 64.f) + 1e-6f);
            const float xg = bf1(pr[1536 + c]);
            F.MIX[(size_t)row * D + c] = (bf16)f2bf(xg * sigmoidf_(xg) * on);
        }
        asm volatile("s_waitcnt lgkmcnt(0)" ::: "memory");
    }
}

constexpr int NPHASE = 18;
struct Args { const float* in[37]; float* out; unsigned char* ws; int ph_lo, ph_hi; };

template <bool COOP>
__global__ void __launch_bounds__(NTHR, 2) mk_fwd(Args args) {
    extern __shared__ __attribute__((aligned(16))) unsigned char lds[];
    Frame F;
    F.lds = (LAS unsigned char*)lds;
    F.tid = threadIdx.x; F.lane = F.tid & 63; F.wave = __builtin_amdgcn_readfirstlane(F.tid >> 6); F.G = gridDim.x; F.bid = blockIdx.x;
#pragma unroll
    for (int i = 0; i < 37; ++i) F.in[i] = args.in[i];
    F.out = args.out; F.ws = args.ws;
    unsigned char* ws = args.ws;
    F.Watt = (bf16*)(ws + WS_WATT); F.Woa = (bf16*)(ws + WS_WOA); F.Wrec = (bf16*)(ws + WS_WREC); F.Wor = (bf16*)(ws + WS_WOR); F.Wf1 = (bf16*)(ws + WS_WF1); F.Wf2 = (bf16*)(ws + WS_WF2);
    F.H = (bf16*)(ws + WS_H); F.MIX = (bf16*)(ws + WS_MIX); F.P = (bf16*)(ws + WS_P); F.MOD = (float*)(ws + WS_MOD); F.S = (float*)(ws + WS_S);
    const int lo = args.ph_lo, hi = args.ph_hi;
#define IN(k) (lo <= (k) && (k) < hi)
#define SEAM(k) do { if (COOP && IN((k) + 1)) { cooperative_groups::this_grid().sync(); } } while (0)
    const f32x2v* rope = (const f32x2v*)((unsigned char*)F.MOD + MOD_ROPE);

    if (IN(0)) { p0_prologue(F); SEAM(0); }
    if (IN(1)) { norm_phase(F, F.in[0], F.in[1], F.in[10], F.MOD, 0, 1, false); SEAM(1); }
    if (IN(2)) { pg8::Gemm g{F.H, F.Watt, T, NATT, D}; pg8::StaticOrder S; S.init(T, NATT, F.G, F.bid); EpiAttnIn E{F.P, F.out, rope};
        pg8::gemm_phase<EpiAttnIn, pg8::StaticOrder, true, true>(F.lds, g, S, E); SEAM(2); }
    if (IN(3)) { attn_naive_phase(F); SEAM(3); }
    if (IN(4)) { diff_post_phase(F); SEAM(4); }
    if (IN(5)) { pg8::Gemm g{F.MIX, F.Woa, T, D, D}; pg8::StaticOrder S; S.init(T, D, F.G, F.bid); EpiResid E{F.in[0], F.in[1], F.out, F.MOD, 2};
        pg8::gemm_phase<EpiResid, pg8::StaticOrder, true, true>(F.lds, g, S, E); SEAM(5); }
    if (IN(6)) { norm_phase(F, F.out, F.out + (size_t)TCX * D, F.in[11], F.MOD, 3, 4, false); SEAM(6); }
    if (IN(7)) { pg8::Gemm g{F.H, F.Wf1, T, NFF, D}; pg8::StaticOrder S; S.init(T, NFF, F.G, F.bid); EpiSwiglu E{F.P};
        pg8::gemm_phase<EpiSwiglu, pg8::StaticOrder, true, true>(F.lds, g, S, E); SEAM(7); }
    if (IN(8)) { pg8::Gemm g{F.P, F.Wf2, T, D, DFF}; pg8::StaticOrder S; S.init(T, D, F.G, F.bid); EpiResid E{F.out, F.out + (size_t)TCX * D, F.out, F.MOD, 5};
        pg8::gemm_phase<EpiResid, pg8::StaticOrder, true, true>(F.lds, g, S, E); SEAM(8); }
    if (IN(9)) { norm_phase(F, F.out, F.out + (size_t)TCX * D, F.in[10] + D, F.MOD + 3 * 6144, 0, 1, true); SEAM(9); }
    if (IN(10)) { pg8::Gemm g{F.H, F.Wrec, T, NREC, D}; pg8::StaticOrder S; S.init(T, NREC, F.G, F.bid); EpiBf16Plain E{F.P, NREC};
        pg8::gemm_phase<EpiBf16Plain, pg8::StaticOrder, true, true>(F.lds, g, S, E); SEAM(10); }
    if (IN(11)) { scan_phase(F); SEAM(11); }
    if (IN(12)) { rec_post_phase(F); SEAM(12); }
    if (IN(13)) { pg8::Gemm g{F.MIX, F.Wor, T, D, D}; pg8::StaticOrder S; S.init(T, D, F.G, F.bid); EpiResid E{F.out, F.out + (size_t)TCX * D, F.out, F.MOD + 3 * 6144, 2};
        pg8::gemm_phase<EpiResid, pg8::StaticOrder, true, true>(F.lds, g, S, E); SEAM(13); }
    if (IN(14)) { norm_phase(F, F.out, F.out + (size_t)TCX * D, F.in[11] + D, F.MOD + 3 * 6144, 3, 4, false); SEAM(14); }
    if (IN(15)) { pg8::Gemm g{F.H, F.Wf1 + WF1_STRIDE, T, NFF, D}; pg8::StaticOrder S; S.init(T, NFF, F.G, F.bid); EpiSwiglu E{F.P};
        pg8::gemm_phase<EpiSwiglu, pg8::StaticOrder, true, true>(F.lds, g, S, E); SEAM(15); }
    if (IN(16)) { pg8::Gemm g{F.P, F.Wf2 + WF2_STRIDE, T, D, DFF}; pg8::StaticOrder S; S.init(T, D, F.G, F.bid); EpiResid E{F.out, F.out + (size_t)TCX * D, F.out, F.MOD + 3 * 6144, 5};
        pg8::gemm_phase<EpiResid, pg8::StaticOrder, true, true>(F.lds, g, S, E); SEAM(16); }
    if (IN(17)) { final_norm_phase(F); }
#undef IN
#undef SEAM
}

#ifndef MK_N_LAUNCHES
#define MK_N_LAUNCHES 18
#endif
extern "C" void kernel_launch(void* const* d_in, const int* in_sizes, int n_in, void* d_out, int out_size, void* d_ws, size_t ws_size, hipStream_t stream) {
    static int grid = 0;
    if (grid == 0) {
        if (n_in != 37 || out_size != 33554432 || ws_size < WS_END) { fprintf(stderr, "kernel_launch: unexpected problem (n_in %d out %d ws %zu)\n", n_in, out_size, ws_size); grid = -1; return; }
        int dev = 0, cus = 0, per_cu = 0;
        if (hipGetDevice(&dev) != hipSuccess || hipDeviceGetAttribute(&cus, hipDeviceAttributeMultiprocessorCount, dev) != hipSuccess) { grid = -1; return; }
        (void)hipFuncSetAttribute((const void*)mk_fwd<false>, hipFuncAttributeMaxDynamicSharedMemorySize, LDS_BYTES);
        (void)hipFuncSetAttribute((const void*)mk_fwd<true>, hipFuncAttributeMaxDynamicSharedMemorySize, LDS_BYTES);
        if (hipOccupancyMaxActiveBlocksPerMultiprocessor(&per_cu, (const void*)mk_fwd<true>, NTHR, LDS_BYTES) != hipSuccess || per_cu < 1) per_cu = 1;
        (void)hipGetLastError();
        grid = cus;
    }
    if (grid < 0) return;
    Args a{};
    for (int i = 0; i < 37; ++i) a.in[i] = (const float*)d_in[i];
    a.out = (float*)d_out; a.ws = (unsigned char*)d_ws;
#if MK_N_LAUNCHES == 1
    a.ph_lo = 0; a.ph_hi = NPHASE;
    void* kargs[] = {&a};
    hipError_t e = hipLaunchCooperativeKernel((const void*)mk_fwd<true>, dim3(grid), dim3(NTHR), kargs, LDS_BYTES, stream);
    if (e != hipSuccess) fprintf(stderr, "cooperative launch failed: %s (grid %d)\n", hipGetErrorString(e), grid);
#else
    for (int ph = 0; ph < NPHASE; ++ph) { a.ph_lo = ph; a.ph_hi = ph + 1; hipLaunchKernelGGL(mk_fwd<false>, dim3(grid), dim3(NTHR), LDS_BYTES, stream, a); }
#endif
}
```

```cpp
#include <hip/hip_runtime.h>
#include <hip/hip_cooperative_groups.h>
#include <cstdio>
#include <cstdint>
namespace pg8 {
#define PG8_LAS __attribute__((address_space(3)))
typedef unsigned short bf16_t;
typedef short bf16x8 __attribute__((ext_vector_type(8)));
typedef float f32x4 __attribute__((ext_vector_type(4)));
typedef unsigned u32x4 __attribute__((ext_vector_type(4)));
constexpr int BM = 256, BK = 64, HALF = 128, HTB = HALF * BK * 2  , STAGE_BYTES = 8 * HTB, NXCD = 8, WGM = 8;

__host__ __device__ __forceinline__ int lds_byte(int r, int c) { const int st = (r >> 4) * 2 + (c >> 5), rr = r & 15, cc = c & 31, ob = rr * 64 + cc * 2; return st * 1024 + (ob ^ (((ob >> 9) & 1) << 5)); }
__host__ __device__ __forceinline__ void stage_rc(int b, int& R, int& C) { const int st = b / 1024, sb = b % 1024, swz = sb ^ (((sb >> 9) & 1) << 5); R = (st >> 1) * 16 + swz / 64; C = (st & 1) * 32 + (swz % 64) / 2; }
__host__ __device__ __forceinline__ int perm32(int rho) { const int n = rho >> 4, i = rho & 15; return 8 * (i >> 2) + 4 * n + (i & 3); }

struct Unit { int pm, pn; };
struct Gemm { const bf16_t* A; const bf16_t* Bt; int M, N, K; };

struct StaticOrder {
    int nM, nN, nwg, G, c;
    __host__ __device__ void init(int M, int N, int G_, int c_) { nM = M / BM; nN = N / BM; nwg = nM * nN; G = G_; c = c_; }
    __host__ __device__ bool next(int i, Unit& u) const {
        const long L = (long)i * G + c; if (L >= nwg) return false;
        int wgid = (int)L; { const int q = nwg / NXCD, r = nwg % NXCD, xcd = wgid % NXCD, off = wgid / NXCD; wgid = (xcd < r ? xcd * (q + 1) : r * (q + 1) + (xcd - r) * q) + off; }
        const int nig = WGM * nN, gid = wgid / nig, fm = gid * WGM, gsz = (nM - fm) < WGM ? (nM - fm) : WGM;
        u.pm = fm + ((wgid % nig) % gsz); u.pn = (wgid % nig) / gsz; return true;
    }
    __device__ __forceinline__ void a_ready(const Unit&) const {}
    __device__ __forceinline__ void done(const Unit&) const {}
};
__device__ __forceinline__ unsigned cvt_pk_bf16(float lo, float hi) { unsigned r; asm volatile("v_cvt_pk_bf16_f32 %0, %1, %2" : "=v"(r) : "v"(lo), "v"(hi)); return r; }
typedef float f32x2 __attribute__((ext_vector_type(2)));
template <class Epi, class Sched, bool ALIGN_EPI = false, bool SP2 = false>
__device__ __forceinline__ void gemm_phase(PG8_LAS unsigned char* lds, const Gemm g, const Sched& S, const Epi& E) {
    const int tid = threadIdx.x, wid = __builtin_amdgcn_readfirstlane(tid >> 6), lane = tid & 63, wr = wid >> 2, wc = wid & 3, fr = lane & 15, fq = lane >> 4;
    const int K = g.K, nt = K / BK;
    unsigned voffA[2], voffB[2];
#pragma unroll
    for (int i = 0; i < 2; ++i) { int R, C; stage_rc(tid * 16 + i * 8192, R, C); const int Rb = Epi::PERM ? ((R & ~31) + perm32(R & 31)) : R;
        voffA[i] = (unsigned)(R * K + C) * 2u; voffB[i] = (unsigned)(Rb * K + C) * 2u; }
    const size_t kstep = (size_t)(BK * 2);
    const size_t hstep = (size_t)HALF * K * 2;
    const size_t tstep = 2 * hstep;
    const unsigned ldsw = (unsigned)wid * 1024u;
    const int aoff = lds_byte(wr * 64 + fr, fq * 8), boff = lds_byte(wc * 32 + fr, fq * 8);
#define PG8_SA(b, h) (((b) * 2 + (h)) * HTB)
#define PG8_SB(b, h) ((4 + (b) * 2 + (h)) * HTB)
#define PG8_STAGE(bufoff, gbase, voff) do { _Pragma("unroll") for (int _i = 0; _i < 2; ++_i) \
        __builtin_amdgcn_global_load_lds((const unsigned*)((const char*)(gbase) + (voff)[_i]), (PG8_LAS unsigned*)(lds + (bufoff) + ldsw + _i * 8192), 16, 0, 0); } while (0)
#define PG8_LDA(dst, b, h) do { _Pragma("unroll") for (int m = 0; m < 4; ++m) _Pragma("unroll") for (int k = 0; k < 2; ++k) dst[m][k] = *(const PG8_LAS bf16x8*)(lds + PG8_SA(b, h) + aoff + m * 2048 + k * 1024); } while (0)
#define PG8_LDB(dst, b, h) do { _Pragma("unroll") for (int n = 0; n < 2; ++n) _Pragma("unroll") for (int k = 0; k < 2; ++k) dst[n][k] = *(const PG8_LAS bf16x8*)(lds + PG8_SB(b, h) + boff + n * 2048 + k * 1024); } while (0)
#define PG8_MMA(ai, bj, At, Bt) do { __builtin_amdgcn_s_setprio(1); _Pragma("unroll") for (int m = 0; m < 4; ++m) _Pragma("unroll") for (int n = 0; n < 2; ++n) _Pragma("unroll") for (int k = 0; k < 2; ++k) \
        acc[ai][bj][m][n] = __builtin_amdgcn_mfma_f32_16x16x32_bf16(Bt[n][k], At[m][k], acc[ai][bj][m][n], 0, 0, 0); __builtin_amdgcn_s_setprio(0); } while (0)
#define PG8_WAIT_V(n) asm volatile("s_waitcnt vmcnt(" #n ")" ::: "memory")
#define PG8_WAIT_L(n) asm volatile("s_waitcnt lgkmcnt(" #n ")" ::: "memory")
#define PG8_BAR __builtin_amdgcn_s_barrier()
#define PG8_SCHED __builtin_amdgcn_sched_barrier(0)
    Unit cur, nxt; int ui = 0;
    if (!S.next(0, cur)) return;
    f32x4 acc[2][2][4][2];
#pragma unroll
    for (int a = 0; a < 2; ++a)
#pragma unroll
        for (int b = 0; b < 2; ++b)
#pragma unroll
            for (int m = 0; m < 4; ++m)
#pragma unroll
                for (int n = 0; n < 2; ++n) acc[a][b][m][n] = (f32x4){0.f, 0.f, 0.f, 0.f};
    bf16x8 At[4][2], B0[2][2], B1[2][2];
    const char* cA = (const char*)g.A + (size_t)cur.pm * tstep; const char* cB = (const char*)g.Bt + (size_t)cur.pn * tstep;
    S.a_ready(cur);
    if constexpr (SP2) {
        PG8_STAGE(PG8_SB(0, 0), cB, voffB); PG8_STAGE(PG8_SB(0, 1), cB + hstep, voffB); PG8_STAGE(PG8_SA(0, 0), cA, voffA); PG8_STAGE(PG8_SA(0, 1), cA + hstep, voffA);
        if (wr == 1) PG8_BAR;
        PG8_WAIT_V(2); PG8_BAR;
        PG8_STAGE(PG8_SB(1, 0), cB + kstep, voffB); PG8_STAGE(PG8_SA(1, 0), cA + kstep, voffA); PG8_STAGE(PG8_SB(1, 1), cB + hstep + kstep, voffB);
        PG8_WAIT_V(6); PG8_BAR;
    } else {
        PG8_STAGE(PG8_SB(0, 0), cB, voffB); PG8_STAGE(PG8_SA(0, 0), cA, voffA); PG8_STAGE(PG8_SB(0, 1), cB + hstep, voffB); PG8_STAGE(PG8_SA(0, 1), cA + hstep, voffA);
        if (wr == 1) PG8_BAR;
        PG8_WAIT_V(4); PG8_BAR;
        PG8_STAGE(PG8_SB(1, 0), cB + kstep, voffB); PG8_STAGE(PG8_SA(1, 0), cA + kstep, voffA); PG8_STAGE(PG8_SB(1, 1), cB + hstep + kstep, voffB);
        PG8_WAIT_V(6); PG8_BAR;
    }
    for (;;) {
        const bool has_next = S.next(ui + 1, nxt);
        const char* nA = has_next ? (const char*)g.A + (size_t)nxt.pm * tstep : cA; const char* nB = has_next ? (const char*)g.Bt + (size_t)nxt.pn * tstep : cB;
        for (int t = 0; t < nt; t += 2) {
            const bool last = (t == nt - 2);
            const char* a1 = cA + (size_t)(t + 1) * kstep;
            const char* a2 = last ? nA : cA + (size_t)(t + 2) * kstep; const char* b2 = last ? nB : cB + (size_t)(t + 2) * kstep;
            const char* a3 = a2 + kstep; const char* b3 = b2 + kstep;
            if (last && has_next) S.a_ready(nxt);
            if constexpr (SP2) {
            PG8_LDB(B0, 0, 0); PG8_LDB(B1, 0, 1); PG8_SCHED; PG8_LDA(At, 0, 0); PG8_STAGE(PG8_SA(1, 1), a1 + hstep, voffA);
            PG8_WAIT_V(8); PG8_WAIT_L(0); PG8_BAR; PG8_MMA(0, 0, At, B0); PG8_MMA(0, 1, At, B1); PG8_BAR; PG8_SCHED;
            PG8_LDA(At, 0, 1); PG8_STAGE(PG8_SB(0, 0), b2, voffB); PG8_STAGE(PG8_SB(0, 1), b2 + hstep, voffB); PG8_STAGE(PG8_SA(0, 0), a2, voffA);
            PG8_WAIT_V(8); PG8_WAIT_L(0); PG8_BAR; PG8_MMA(1, 0, At, B0); PG8_MMA(1, 1, At, B1); PG8_BAR; PG8_SCHED;
            PG8_LDB(B0, 1, 0); PG8_LDB(B1, 1, 1); PG8_SCHED; PG8_LDA(At, 1, 0); PG8_STAGE(PG8_SA(0, 1), a2 + hstep, voffA);
            PG8_WAIT_V(8); PG8_WAIT_L(0); PG8_BAR; PG8_MMA(0, 0, At, B0); PG8_MMA(0, 1, At, B1); PG8_BAR; PG8_SCHED;
            PG8_LDA(At, 1, 1); PG8_STAGE(PG8_SB(1, 0), b3, voffB); PG8_STAGE(PG8_SB(1, 1), b3 + hstep, voffB); PG8_STAGE(PG8_SA(1, 0), a3, voffA);
            PG8_WAIT_V(8); PG8_WAIT_L(0); PG8_BAR; PG8_MMA(1, 0, At, B0); PG8_MMA(1, 1, At, B1); PG8_BAR; PG8_SCHED;
            } else {
            PG8_LDB(B0, 0, 0); PG8_SCHED; PG8_LDA(At, 0, 0); PG8_STAGE(PG8_SA(1, 1), a1 + hstep, voffA);
            PG8_WAIT_L(8); PG8_BAR; PG8_WAIT_L(0); PG8_MMA(0, 0, At, B0); PG8_BAR; PG8_SCHED;
            PG8_LDB(B1, 0, 1); PG8_STAGE(PG8_SB(0, 0), b2, voffB);
            PG8_BAR; PG8_WAIT_L(0); PG8_MMA(0, 1, At, B1); PG8_BAR;
            PG8_LDA(At, 0, 1); PG8_STAGE(PG8_SA(0, 0), a2, voffA);
            PG8_BAR; PG8_WAIT_L(0); PG8_MMA(1, 0, At, B0); PG8_BAR; PG8_SCHED;
            PG8_STAGE(PG8_SB(0, 1), b2 + hstep, voffB);
            PG8_WAIT_V(6); PG8_BAR; PG8_MMA(1, 1, At, B1); PG8_BAR;
            PG8_LDB(B0, 1, 0); PG8_SCHED; PG8_LDA(At, 1, 0); PG8_STAGE(PG8_SA(0, 1), a2 + hstep, voffA);
            PG8_WAIT_L(8); PG8_BAR; PG8_WAIT_L(0); PG8_MMA(0, 0, At, B0); PG8_BAR; PG8_SCHED;
            PG8_LDB(B1, 1, 1); PG8_STAGE(PG8_SB(1, 0), b3, voffB);
            PG8_BAR; PG8_WAIT_L(0); PG8_MMA(0, 1, At, B1); PG8_BAR;
            PG8_LDA(At, 1, 1); PG8_STAGE(PG8_SA(1, 0), a3, voffA);
            PG8_BAR; PG8_WAIT_L(0); PG8_MMA(1, 0, At, B0); PG8_BAR; PG8_SCHED;
            PG8_STAGE(PG8_SB(1, 1), b3 + hstep, voffB);
            PG8_WAIT_V(6); PG8_BAR; PG8_MMA(1, 1, At, B1); PG8_BAR;
            }
        }
        if constexpr (ALIGN_EPI) { if (wr == 0) PG8_BAR; }
        if constexpr (!Epi::AFTER_DRAIN) { E(acc, cur, wr, wc, fr, fq); S.done(cur); }
        if (!has_next) break;
#pragma unroll
        for (int a = 0; a < 2; ++a)
#pragma unroll
            for (int b = 0; b < 2; ++b)
#pragma unroll
                for (int m = 0; m < 4; ++m)
#pragma unroll
                    for (int n = 0; n < 2; ++n) acc[a][b][m][n] = (f32x4){0.f, 0.f, 0.f, 0.f};
        cur = nxt; cA = nA; cB = nB; ++ui;
        if constexpr (ALIGN_EPI) { if (wr == 1) PG8_BAR; }
    }
    PG8_WAIT_V(0);
    if constexpr (!ALIGN_EPI) { if (wr == 0) PG8_BAR; }
    PG8_BAR;
    if constexpr (Epi::AFTER_DRAIN) { E.fused(acc, cur, wr, wc, fr, fq, lds, wid, lane); S.done(cur); }
#undef PG8_SA
#undef PG8_SB
#undef PG8_STAGE
#undef PG8_LDA
#undef PG8_LDB
#undef PG8_MMA
#undef PG8_WAIT_V
#undef PG8_WAIT_L
#undef PG8_BAR
#undef PG8_SCHED
}
}

#define GAS __attribute__((address_space(1)))
#define LAS __attribute__((address_space(3)))
typedef unsigned short bf16;
typedef unsigned v4u __attribute__((ext_vector_type(4)));
typedef unsigned v2u __attribute__((ext_vector_type(2)));
typedef float f32x4 __attribute__((ext_vector_type(4)));
typedef float f32x2v __attribute__((ext_vector_type(2)));

constexpr int NWAVES = 8, NTHR = 512;
constexpr int D = 1024, TCX = 8192, TLT = 4096, T = 12288;
constexpr int NATT = 3072, NREC = 3840, DFF = 2816, NFF = 5632;
constexpr int QLD = NATT;
constexpr size_t MiB = 1u << 20;
constexpr size_t WS_CTL = 0, WS_MOD = 1 * MiB, WS_WATT = 2 * MiB, WS_WOA = 8 * MiB, WS_WREC = 10 * MiB, WS_WOR = 18 * MiB, WS_WF1 = 20 * MiB, WS_WF2 = 42 * MiB,
                 WS_H = 54 * MiB, WS_MIX = 78 * MiB, WS_P = 102 * MiB, WS_S = 192 * MiB, WS_END = 256 * MiB;
constexpr size_t MOD_ROPE = 160 * 1024, MOD_LAM = 176 * 1024;
constexpr size_t WF1_STRIDE = (size_t)NFF * D;
constexpr size_t WF2_STRIDE = (size_t)D * DFF;
constexpr size_t O_YP = 0, O_YS = 8388608, O_NAK = 12582912, O_NAV = 16777216, O_DFK = 20971520, O_DFV = 25165824, O_SRET = 29360128, O_SRW = 31457280;
constexpr int LDS_BYTES = 147456;

__device__ __forceinline__ float bflo(unsigned u) { return __uint_as_float(u << 16); }
__device__ __forceinline__ float bfhi(unsigned u) { return __uint_as_float(u & 0xffff0000u); }
__device__ __forceinline__ float bf1(bf16 b) { return __uint_as_float(((unsigned)b) << 16); }
__device__ __forceinline__ unsigned f2bf(float f) { unsigned u = __float_as_uint(f); return (u + 0x7fffu + ((u >> 16) & 1u)) >> 16; }
__device__ __forceinline__ unsigned pk2(float lo, float hi) { return f2bf(lo) | (f2bf(hi) << 16); }
__device__ __forceinline__ float wave_sum(float v) {
#pragma unroll
    for (int o = 1; o < 64; o <<= 1) v += __shfl_xor(v, o);
    return v;
}
__device__ __forceinline__ float sigmoidf_(float x) { return 1.f / (1.f + __expf(-x)); }

struct Frame {
    LAS unsigned char* lds;
    int tid, lane, wave, G, bid;
    const float* in[37];
    float* out; unsigned char* ws;
    bf16 *Watt, *Woa, *Wrec, *Wor, *Wf1, *Wf2, *H, *MIX, *P;
    float *MOD, *S;
};

__device__ __forceinline__ void transpose_item(const float* W, int K, int N, bf16* WT, int k0, int n0, int drow0, LAS float* scr, int lane) {
#pragma unroll 8
    for (int i = 0; i < 32; ++i) { const int kk = 2 * i + (lane >> 5); scr[kk * 33 + (lane & 31)] = W[(size_t)(k0 + kk) * N + n0 + (lane & 31)]; }
    asm volatile("s_waitcnt lgkmcnt(0)" ::: "memory");
    const int c = lane & 7;
#pragma unroll
    for (int j = 0; j < 4; ++j) { const int n = (lane >> 3) + 8 * j; const LAS float* s = scr + (8 * c) * 33 + n;
        v4u o; o.x = pk2(s[0 * 33], s[1 * 33]); o.y = pk2(s[2 * 33], s[3 * 33]); o.z = pk2(s[4 * 33], s[5 * 33]); o.w = pk2(s[6 * 33], s[7 * 33]);
        *(v4u*)(WT + (size_t)(drow0 + n) * K + k0 + 8 * c) = o; }
    asm volatile("s_waitcnt lgkmcnt(0)" ::: "memory");
}

__device__ __forceinline__ void p0_prologue(Frame& F) {
    {
        LAS float* sc = (LAS float*)F.lds;
        LAS float* red = sc + 3072;
        for (int idx = F.tid; idx < 3072; idx += NTHR) { const int j = idx >> 10, k = idx & 1023; const float c = (j == 0) ? F.in[9][k] : F.in[8][(j - 1) * 1024 + k]; sc[idx] = c * sigmoidf_(c); }
        __syncthreads();
        for (int item = F.bid; item < 192; item += F.G) {
            const int layer = item / 96, col = (item % 96) * 64 + (F.tid & 63), kg = F.tid >> 6;
            const float* w = F.in[13] + (size_t)layer * 1024 * 6144 + col;
            float a0 = 0.f, a1 = 0.f, a2 = 0.f;
#pragma unroll 8
            for (int k = kg * 128; k < kg * 128 + 128; ++k) { const float wv = w[(size_t)k * 6144]; a0 += sc[k] * wv; a1 += sc[1024 + k] * wv; a2 += sc[2048 + k] * wv; }
            red[(kg * 3 + 0) * 64 + (F.tid & 63)] = a0; red[(kg * 3 + 1) * 64 + (F.tid & 63)] = a1; red[(kg * 3 + 2) * 64 + (F.tid & 63)] = a2;
            __syncthreads();
            if (F.tid < 192) { const int j = F.tid >> 6, c = F.tid & 63; float s = 0.f;
#pragma unroll
                for (int g = 0; g < 8; ++g) s += red[(g * 3 + j) * 64 + c];
                const int cc = (item % 96) * 64 + c; F.MOD[(layer * 3 + j) * 6144 + cc] = s + F.in[14][layer * 6144 + cc]; }
            __syncthreads();
        }
    }
    if (F.bid == F.G - 1) {
        f32x2v* rope = (f32x2v*)((unsigned char*)F.MOD + MOD_ROPE);
        for (int idx = F.tid; idx < 1024; idx += NTHR) { const int pos = idx >> 4, i = idx & 15; const float inv = powf(10000.0f, -(float)i / 16.0f); const float ang = (float)pos * inv; rope[idx] = (f32x2v){cosf(ang), sinf(ang)}; }
        if (F.wave == 0) { const float s1 = wave_sum(F.in[18][F.lane] * F.in[19][F.lane]), s2 = wave_sum(F.in[20][F.lane] * F.in[21][F.lane]);
            if (F.lane == 0) *(float*)((unsigned char*)F.MOD + MOD_LAM) = expf(s1) - expf(s2) + 0.2f; }
    }
    {
        const int gt = F.bid * NTHR + F.tid, NG = F.G * NTHR;
        for (int idx = gt; idx < 4 * 512 * 64; idx += NG) { const int t = idx / (512 * 64), r = (idx / 64) % 512, c8 = idx % 64;
            const float* srcb = (t == 0) ? F.in[2] : (t == 1) ? F.in[3] : (t == 2) ? F.in[4] : F.in[5]; const float* src = srcb + (size_t)r * 512 + c8 * 8; const int colb = (t == 0) ? 512 : (t == 1) ? 1024 : (t == 2) ? 2048 : 2560;
            const f32x4 a = *(const f32x4*)src, b = *(const f32x4*)(src + 4);
            v4u o; o.x = pk2(a[0], a[1]); o.y = pk2(a[2], a[3]); o.z = pk2(b[0], b[1]); o.w = pk2(b[2], b[3]);
            *(v4u*)(F.P + (size_t)(T + r) * QLD + colb + c8 * 8) = o; }
    }
    {
        LAS float* scr = (LAS float*)(F.lds + 20480 + F.wave * 8448);
        __syncthreads();
        const int gw = F.bid * NWAVES + F.wave, NGW = F.G * NWAVES;
        constexpr int I0 = 16 * 96, I1 = 16 * 32, I2 = 16 * 120, I3 = 16 * 32, I4 = 16 * 176, I6 = 44 * 32;
        constexpr int NIT = I0 + I1 + I2 + I3 + 2 * I4 + 2 * I6;
        for (int it = gw; it < NIT; it += NGW) {
            int r = it;
            if (r < I0) { const int nb = 96; transpose_item(F.in[15], 1024, 3072, F.Watt, 64 * (r / nb), 32 * (r % nb), 32 * (r % nb), scr, F.lane); continue; } r -= I0;
            if (r < I1) { const int nb = 32; transpose_item(F.in[16], 1024, 1024, F.Woa, 64 * (r / nb), 32 * (r % nb), 32 * (r % nb), scr, F.lane); continue; } r -= I1;
            if (r < I2) { const int nb = 120; transpose_item(F.in[22], 1024, 3840, F.Wrec, 64 * (r / nb), 32 * (r % nb), 32 * (r % nb), scr, F.lane); continue; } r -= I2;
            if (r < I3) { const int nb = 32; transpose_item(F.in[23], 1024, 1024, F.Wor, 64 * (r / nb), 32 * (r % nb), 32 * (r % nb), scr, F.lane); continue; } r -= I3;
            if (r < 2 * I4) { const int l = r / I4; r -= l * I4; const int nb = 176, n0 = 32 * (r % nb);
                const int drow = (n0 < DFF) ? ((n0 / 128) * 256 + (n0 % 128)) : (((n0 - DFF) / 128) * 256 + 128 + ((n0 - DFF) % 128));
                transpose_item(F.in[35] + (size_t)l * 1024 * NFF, 1024, NFF, F.Wf1 + (size_t)l * WF1_STRIDE, 64 * (r / nb), n0, drow, scr, F.lane); continue; } r -= 2 * I4;
            { const int l = r / I6; r -= l * I6; const int nb = 32;
                transpose_item(F.in[36] + (size_t)l * DFF * 1024, DFF, 1024, F.Wf2 + (size_t)l * WF2_STRIDE, 64 * (r / nb), 32 * (r % nb), 32 * (r % nb), scr, F.lane); }
        }
    }
}

__device__ __forceinline__ void norm_phase(Frame& F, const float* xc, const float* xl, const float* g, const float* mod  , int shift_i, int scale_i, bool zero_s) {
    const int gw = F.bid * NWAVES + F.wave, NGW = F.G * NWAVES;
    for (int row = gw; row < T; row += NGW) {
        const float* xr = (row < TCX) ? xc + (size_t)row * D : xl + (size_t)(row - TCX) * D;
        const int cond = (row < TCX) ? 0 : 1 + ((row - TCX) >> 11);
        const float* sh = mod + cond * 6144 + shift_i * 1024; const float* sc = mod + cond * 6144 + scale_i * 1024;
        f32x4 v[4]; float ss = 0.f;
#pragma unroll
        for (int j = 0; j < 4; ++j) { v[j] = *(const f32x4*)(xr + 4 * F.lane + 256 * j); ss += (v[j][0] * v[j][0] + v[j][1] * v[j][1]) + (v[j][2] * v[j][2] + v[j][3] * v[j][3]); }
        const float rstd = rsqrtf(wave_sum(ss) * (1.f / D) + 1e-6f);
#pragma unroll
        for (int j = 0; j < 4; ++j) { const int c = 4 * F.lane + 256 * j; const f32x4 gg = *(const f32x4*)(g + c), s1 = *(const f32x4*)(sc + c), s0 = *(const f32x4*)(sh + c);
            f32x4 h;
#pragma unroll
            for (int e = 0; e < 4; ++e) h[e] = v[j][e] * rstd * gg[e] * (1.f + s1[e]) + s0[e];
            v2u o; o.x = pk2(h[0], h[1]); o.y = pk2(h[2], h[3]); *(v2u*)(F.H + (size_t)row * D + c) = o; }
    }
    if (zero_s) {
        const size_t n16 = (size_t)48 * MiB / 16; f32x4* p = (f32x4*)F.S;
        for (size_t i = (size_t)F.bid * NTHR + F.tid; i < n16; i += (size_t)F.G * NTHR) p[i] = (f32x4){0.f, 0.f, 0.f, 0.f};
    }
}
__device__ __forceinline__ void final_norm_phase(Frame& F) {
    const int gw = F.bid * NWAVES + F.wave, NGW = F.G * NWAVES; const float* g = F.in[12];
    for (int row = gw; row < T; row += NGW) {
        float* xr = F.out + (size_t)row * D;
        f32x4 v[4]; float ss = 0.f;
#pragma unroll
        for (int j = 0; j < 4; ++j) { v[j] = *(const f32x4*)(xr + 4 * F.lane + 256 * j); ss += (v[j][0] * v[j][0] + v[j][1] * v[j][1]) + (v[j][2] * v[j][2] + v[j][3] * v[j][3]); }
        const float rstd = rsqrtf(wave_sum(ss) * (1.f / D) + 1e-6f);
#pragma unroll
        for (int j = 0; j < 4; ++j) { const int c = 4 * F.lane + 256 * j; const f32x4 gg = *(const f32x4*)(g + c); *(f32x4*)(xr + c) = v[j] * rstd * gg; }
    }
}

struct EpiAttnIn {
    static constexpr bool PERM = true, AFTER_DRAIN = false;
    bf16* QKV; float* out; const f32x2v* rope;
    __device__ __forceinline__ void operator()(const f32x4 (&acc)[2][2][4][2], const pg8::Unit& u, int wr, int wc, int fr, int fq) const {
        const int pn = u.pn; const bool ctx = u.pm < 32;
        float* cdst = nullptr; int cbase = 0;
        if (ctx) { if (pn == 2 || pn == 3) { cdst = out + O_NAK; cbase = 512; } else if (pn == 4 || pn == 5) { cdst = out + O_NAV; cbase = 1024; }
                   else if (pn == 8 || pn == 9) { cdst = out + O_DFK; cbase = 2048; } else if (pn == 10 || pn == 11) { cdst = out + O_DFV; cbase = 2560; } }
        const bool rope_on = (!ctx) && pn >= 6 && pn <= 9;
        const float sgn = (fq < 2) ? -1.f : 1.f;
#pragma unroll
        for (int ai = 0; ai < 2; ++ai)
#pragma unroll
            for (int m = 0; m < 4; ++m) { const int row = u.pm * 256 + ai * 128 + wr * 64 + m * 16 + fr;
#pragma unroll
                for (int bj = 0; bj < 2; ++bj) { const int col = pn * 256 + bj * 128 + wc * 32 + 8 * fq;
                    f32x4 v0 = acc[ai][bj][m][0], v1 = acc[ai][bj][m][1];
                    if (rope_on) { const int n = (row - TCX) & 2047; const int p = (wc & 1) ? (n & 63) : (n >> 6); const f32x2v* tb = rope + p * 16 + 8 * (fq & 1);
#pragma unroll
                        for (int e = 0; e < 4; ++e) { const float p0 = __shfl_xor(v0[e], 32), p1 = __shfl_xor(v1[e], 32); const f32x2v c0 = tb[e], c1 = tb[4 + e];
                            v0[e] = v0[e] * c0.x + sgn * p0 * c0.y; v1[e] = v1[e] * c1.x + sgn * p1 * c1.y; } }
                    v4u w; w.x = pg8::cvt_pk_bf16(v0[0], v0[1]); w.y = pg8::cvt_pk_bf16(v0[2], v0[3]); w.z = pg8::cvt_pk_bf16(v1[0], v1[1]); w.w = pg8::cvt_pk_bf16(v1[2], v1[3]);
                    *(v4u*)(QKV + (size_t)row * QLD + col) = w;
                    if (cdst) { float* cp = cdst + (size_t)row * 512 + (col - cbase); *(f32x4*)cp = v0; *(f32x4*)(cp + 4) = v1; } } }
    }
};
struct EpiBf16Plain {
    static constexpr bool PERM = true, AFTER_DRAIN = false;
    bf16* O; int ldc;
    __device__ __forceinline__ void operator()(const f32x4 (&acc)[2][2][4][2], const pg8::Unit& u, int wr, int wc, int fr, int fq) const {
#pragma unroll
        for (int ai = 0; ai < 2; ++ai)
#pragma unroll
            for (int m = 0; m < 4; ++m) { const int row = u.pm * 256 + ai * 128 + wr * 64 + m * 16 + fr;
#pragma unroll
                for (int bj = 0; bj < 2; ++bj) { const int col = u.pn * 256 + bj * 128 + wc * 32 + 8 * fq; const f32x4 v0 = acc[ai][bj][m][0], v1 = acc[ai][bj][m][1];
                    v4u w; w.x = pg8::cvt_pk_bf16(v0[0], v0[1]); w.y = pg8::cvt_pk_bf16(v0[2], v0[3]); w.z = pg8::cvt_pk_bf16(v1[0], v1[1]); w.w = pg8::cvt_pk_bf16(v1[2], v1[3]);
                    *(v4u*)(O + (size_t)row * ldc + col) = w; } }
    }
};
struct EpiSwiglu {
    static constexpr bool PERM = true, AFTER_DRAIN = false;
    bf16* O;
    __device__ __forceinline__ void operator()(const f32x4 (&acc)[2][2][4][2], const pg8::Unit& u, int wr, int wc, int fr, int fq) const {
#pragma unroll
        for (int ai = 0; ai < 2; ++ai)
#pragma unroll
            for (int m = 0; m < 4; ++m) { const int row = u.pm * 256 + ai * 128 + wr * 64 + m * 16 + fr; const int col = u.pn * 128 + wc * 32 + 8 * fq;
                float r[8];
#pragma unroll
                for (int n = 0; n < 2; ++n)
#pragma unroll
                    for (int e = 0; e < 4; ++e) { const float g = acc[ai][0][m][n][e], up = acc[ai][1][m][n][e]; r[4 * n + e] = g * __builtin_amdgcn_rcpf(1.f + __expf(-g)) * up; }
                v4u w; w.x = pg8::cvt_pk_bf16(r[0], r[1]); w.y = pg8::cvt_pk_bf16(r[2], r[3]); w.z = pg8::cvt_pk_bf16(r[4], r[5]); w.w = pg8::cvt_pk_bf16(r[6], r[7]);
                *(v4u*)(O + (size_t)row * DFF + col) = w; }
    }
};
struct EpiResid {
    static constexpr bool PERM = false, AFTER_DRAIN = false;
    const float* bc; const float* bl; float* X; const float* mod; int gate_i;
    __device__ __forceinline__ void operator()(const f32x4 (&acc)[2][2][4][2], const pg8::Unit& u, int wr, int wc, int fr, int fq) const {
        const int cond = (u.pm < 32) ? 0 : ((u.pm < 40) ? 1 : 2);
        const float* gate = mod + cond * 6144 + gate_i * 1024;
        const float* base = (u.pm < 32) ? bc : bl - (size_t)TCX * D;
        const int col0 = u.pn * 256 + wc * 32 + 4 * fq;
        f32x4 gv[2][2];
#pragma unroll
        for (int bj = 0; bj < 2; ++bj)
#pragma unroll
            for (int n = 0; n < 2; ++n) gv[bj][n] = *(const f32x4*)(gate + col0 + bj * 128 + n * 16);
#pragma unroll
        for (int ai = 0; ai < 2; ++ai)
#pragma unroll
            for (int m = 0; m < 4; ++m) { const size_t off = (size_t)(u.pm * 256 + ai * 128 + wr * 64 + m * 16 + fr) * D + col0;
#pragma unroll
                for (int bj = 0; bj < 2; ++bj)
#pragma unroll
                    for (int n = 0; n < 2; ++n) { const f32x4 b = *(const f32x4*)(base + off + bj * 128 + n * 16); *(f32x4*)(X + off + bj * 128 + n * 16) = b + gv[bj][n] * acc[ai][bj][m][n]; } }
    }
};

#define KEY_STEP(kp, vp, biasv) do { \
    float s_ = 0.f; \
    _Pragma("unroll") for (int c_ = 0; c_ < 8; ++c_) { const v4u kv_ = *(const v4u*)((kp) + 8 * c_); \
        s_ += q[8 * c_ + 0] * bflo(kv_.x) + q[8 * c_ + 1] * bfhi(kv_.x) + q[8 * c_ + 2] * bflo(kv_.y) + q[8 * c_ + 3] * bfhi(kv_.y) \
            + q[8 * c_ + 4] * bflo(kv_.z) + q[8 * c_ + 5] * bfhi(kv_.z) + q[8 * c_ + 6] * bflo(kv_.w) + q[8 * c_ + 7] * bfhi(kv_.w); } \
    s_ = s_ * 0.125f + (biasv); \
    const float mn_ = fmaxf(m, s_), al_ = __expf(m - mn_), p_ = __expf(s_ - mn_); l = l * al_ + p_; m = mn_; \
    _Pragma("unroll") for (int c_ = 0; c_ < 8; ++c_) { const v4u vv_ = *(const v4u*)((vp) + 8 * c_); \
        o[8 * c_ + 0] = o[8 * c_ + 0] * al_ + p_ * bflo(vv_.x); o[8 * c_ + 1] = o[8 * c_ + 1] * al_ + p_ * bfhi(vv_.x); \
        o[8 * c_ + 2] = o[8 * c_ + 2] * al_ + p_ * bflo(vv_.y); o[8 * c_ + 3] = o[8 * c_ + 3] * al_ + p_ * bfhi(vv_.y); \
        o[8 * c_ + 4] = o[8 * c_ + 4] * al_ + p_ * bflo(vv_.z); o[8 * c_ + 5] = o[8 * c_ + 5] * al_ + p_ * bfhi(vv_.z); \
        o[8 * c_ + 6] = o[8 * c_ + 6] * al_ + p_ * bflo(vv_.w); o[8 * c_ + 7] = o[8 * c_ + 7] * al_ + p_ * bfhi(vv_.w); } } while (0)
#define LOAD_Q(qp) do { _Pragma("unroll") for (int c_ = 0; c_ < 8; ++c_) { const v4u qv_ = *(const v4u*)((qp) + 8 * c_); \
        q[8 * c_ + 0] = bflo(qv_.x); q[8 * c_ + 1] = bfhi(qv_.x); q[8 * c_ + 2] = bflo(qv_.y); q[8 * c_ + 3] = bfhi(qv_.y); \
        q[8 * c_ + 4] = bflo(qv_.z); q[8 * c_ + 5] = bfhi(qv_.z); q[8 * c_ + 6] = bflo(qv_.w); q[8 * c_ + 7] = bfhi(qv_.w); } } while (0)

__device__ __forceinline__ void attn_naive_phase(Frame& F) {
    const bf16* QKV = F.P; const float lam = *(const float*)((unsigned char*)F.MOD + MOD_LAM);
    float* DIFFO = F.S; const float* rpb = F.in[17];
    constexpr int ND = 32768, NC = 32768, NB = 65536, NA = 65536, NTASK = ND + NC + NB + NA;
    for (int task = F.bid * NTHR + F.tid; task < NTASK; task += F.G * NTHR) {
        float q[64], o[64]; float m, l;
        if (task < ND || (task >= ND + NC && task < ND + NC + NB)) {
            const bool lat = task < ND; int idx = lat ? task : task - ND - NC;
            int n, b, h, vh;
            if (lat) { n = idx & 2047; idx >>= 11; b = idx & 1; idx >>= 1; h = idx & 3; vh = idx >> 2; }
            else { n = idx & 255; idx >>= 8; b = idx & 31; idx >>= 5; h = idx & 3; vh = idx >> 2; }
            const int row = lat ? TCX + b * 2048 + n : b * 256 + n;
            const int krow0 = lat ? TCX + b * 2048 : b * 256, nk0 = lat ? 2048 : 256, krow1 = T + b * 256, nk1 = lat ? 256 : 0;
            const int vcol = 2560 + h * 128 + vh * 64;
            float o1[64];
#pragma unroll
            for (int c = 0; c < 2; ++c) {
                const int qcol = 1536 + h * 128 + c * 64, kcol = 2048 + h * 128 + c * 64;
                LOAD_Q(QKV + (size_t)row * QLD + qcol);
#pragma unroll
                for (int d = 0; d < 64; ++d) o[d] = 0.f;
                m = -INFINITY; l = 0.f;
                for (int j = 0; j < nk0; ++j) { const bf16* kr = QKV + (size_t)(krow0 + j) * QLD; KEY_STEP(kr + kcol, kr + vcol, 0.f); }
                for (int j = 0; j < nk1; ++j) { const bf16* kr = QKV + (size_t)(krow1 + j) * QLD; KEY_STEP(kr + kcol, kr + vcol, 0.f); }
                const float il = 1.f / l;
                if (c == 0) {
#pragma unroll
                    for (int d = 0; d < 64; ++d) o1[d] = o[d] * il;
                } else {
                    float* dst = DIFFO + (size_t)row * 512 + h * 128 + vh * 64;
#pragma unroll
                    for (int d = 0; d < 64; d += 4) *(f32x4*)(dst + d) = (f32x4){o1[d] - lam * o[d] * il, o1[d + 1] - lam * o[d + 1] * il, o1[d + 2] - lam * o[d + 2] * il, o1[d + 3] - lam * o[d + 3] * il};
                }
            }
        } else {
            const bool lat = task < ND + NC; int idx = lat ? task - ND : task - ND - NC - NB;
            int n, b, h;
            if (lat) { n = idx & 2047; idx >>= 11; b = idx & 1; h = idx >> 1; } else { n = idx & 255; idx >>= 8; b = idx & 31; h = idx >> 5; }
            const int row = lat ? TCX + b * 2048 + n : b * 256 + n;
            const int kcol = 512 + h * 64, vcol = 1024 + h * 64;
            LOAD_Q(QKV + (size_t)row * QLD + h * 64);
#pragma unroll
            for (int d = 0; d < 64; ++d) o[d] = 0.f;
            m = -INFINITY; l = 0.f;
            if (lat) {
                const int r = n >> 6, qc = n & 63; const int rs = min(max(r - 4, 0), 24), cs = min(max(qc - 8, 0), 48);
                for (int i = 0; i < 8; ++i) for (int cc = 0; cc < 16; ++cc) { const int kr_ = rs + i, kc = cs + cc;
                    const bf16* kr = QKV + (size_t)(TCX + b * 2048 + kr_ * 64 + kc) * QLD; const float bias = rpb[h * 465 + (kr_ - r + 7) * 31 + (kc - qc + 15)];
                    KEY_STEP(kr + kcol, kr + vcol, bias); }
                for (int j = 0; j < 256; ++j) { const bf16* kr = QKV + (size_t)(T + b * 256 + j) * QLD; KEY_STEP(kr + kcol, kr + vcol, 0.f); }
            } else {
                for (int j = 0; j < 256; ++j) { const bf16* kr = QKV + (size_t)(b * 256 + j) * QLD; KEY_STEP(kr + kcol, kr + vcol, 0.f); }
            }
            const float il = 1.f / l; bf16* dst = F.MIX + (size_t)row * D + h * 64;
#pragma unroll
            for (int d = 0; d < 64; d += 8) { v4u w; w.x = pk2(o[d] * il, o[d + 1] * il); w.y = pk2(o[d + 2] * il, o[d + 3] * il); w.z = pk2(o[d + 4] * il, o[d + 5] * il); w.w = pk2(o[d + 6] * il, o[d + 7] * il); *(v4u*)(dst + d) = w; }
        }
    }
}
__device__ __forceinline__ void diff_post_phase(Frame& F) {
    const int gw = F.bid * NWAVES + F.wave, NGW = F.G * NWAVES; const float* DIFFO = F.S;
    for (int it = gw; it < T * 4; it += NGW) { const int row = it >> 2, h = it & 3;
        const f32x2v v = *(const f32x2v*)(DIFFO + (size_t)row * 512 + h * 128 + 2 * F.lane);
        const float r = rsqrtf(wave_sum(v.x * v.x + v.y * v.y) * (1.f / 128.f) + 1e-6f) * 0.8f;
        *(unsigned*)(F.MIX + (size_t)row * D + 512 + h * 128 + 2 * F.lane) = pk2(v.x * r, v.y * r); }
}

__device__ __forceinline__ void rwkv_job(Frame& F, int seq, int h, int dir) {
    LAS float* L = (LAS float*)F.lds;
    LAS float *WUP = L, *AUP = L + 4096, *Lr = L + 8192, *Lk = Lr + 1024, *Lv = Lk + 1024, *Lwd = Lv + 1024, *Lad = Lwd + 1024, *Lw = Lad + 1024, *La = Lw + 1024, *Lkk = La + 1024, *Lkef = Lkk + 1024, *Lb = Lkef + 1024, *Ly = Lb + 1024;
    const int tid = F.tid, lane = F.lane, w = F.wave;
    const bool lat = seq >= 32; const int b = lat ? seq - 32 : seq, N = lat ? 2048 : 256, R0 = lat ? TCX + b * 2048 : b * 256;
    const bf16* PROJ = F.P; float* Y = F.S;
    __syncthreads();
    for (int idx = tid; idx < 4096; idx += NTHR) { const int j = idx >> 6, k = idx & 63; WUP[idx] = F.in[26][(size_t)(dir * 64 + j) * 512 + h * 64 + k]; AUP[idx] = F.in[28][(size_t)(dir * 64 + j) * 512 + h * 64 + k]; }
    const int i = 8 * w + (lane >> 3), s = lane & 7;
    float S[8];
    {
        const float* st = F.in[7] + (size_t)((b * 2 + dir) * 8 + h) * 4096 + i * 64 + 8 * s;
#pragma unroll
        for (int kk = 0; kk < 8; ++kk) S[kk] = lat ? st[kk] : 0.f;
    }
    for (int t0 = 0; t0 < N; t0 += 16) {
#pragma unroll
        for (int rep = 0; rep < 2; ++rep) { const int idx = tid + NTHR * rep, j = idx >> 6, k = idx & 63; const int n = dir ? N - 1 - (t0 + j) : t0 + j;
            const bf16* pr = PROJ + (size_t)(R0 + n) * NREC;
            Lr[idx] = bf1(pr[2048 + h * 64 + k]); Lk[idx] = bf1(pr[2560 + h * 64 + k]); Lv[idx] = bf1(pr[3072 + h * 64 + k]); Lwd[idx] = tanhf(bf1(pr[3584 + k])); Lad[idx] = bf1(pr[3648 + k]); }
        __syncthreads();
#pragma unroll
        for (int rep = 0; rep < 2; ++rep) { const int idx = tid + NTHR * rep, j = idx >> 6, k = idx & 63;
            float zw = F.in[25][dir * 512 + h * 64 + k], za = F.in[27][dir * 512 + h * 64 + k];
#pragma unroll 8
            for (int jj = 0; jj < 64; ++jj) { zw += Lwd[j * 64 + jj] * WUP[jj * 64 + k]; za += Lad[j * 64 + jj] * AUP[jj * 64 + k]; }
            Lw[idx] = __expf(-0.6065306597f * sigmoidf_(zw)); La[idx] = sigmoidf_(za); }
        if (tid < 256) { const int j = tid >> 4, p = tid & 15; float v[4]; float ss = 0.f;
#pragma unroll
            for (int e = 0; e < 4; ++e) { v[e] = Lk[j * 64 + 4 * p + e] * F.in[30][h * 64 + 4 * p + e]; ss += v[e] * v[e]; }
            ss += __shfl_xor(ss, 1); ss += __shfl_xor(ss, 2); ss += __shfl_xor(ss, 4); ss += __shfl_xor(ss, 8);
            const float rs = rsqrtf(ss + 1e-12f);
#pragma unroll
            for (int e = 0; e < 4; ++e) Lkk[j * 64 + 4 * p + e] = v[e] * rs; }
        __syncthreads();
#pragma unroll
        for (int rep = 0; rep < 2; ++rep) { const int idx = tid + NTHR * rep, k = idx & 63; const float a = La[idx];
            Lkef[idx] = Lk[idx] * (1.f + (a - 1.f) * F.in[31][h * 64 + k]); Lb[idx] = Lkk[idx] * a; }
        __syncthreads();
        for (int j = 0; j < 16; ++j) {
            const int o8 = j * 64 + 8 * s;
            float sa = 0.f;
#pragma unroll
            for (int kk = 0; kk < 8; ++kk) sa -= S[kk] * Lkk[o8 + kk];
            sa += __shfl_xor(sa, 1); sa += __shfl_xor(sa, 2); sa += __shfl_xor(sa, 4);
            const float vi = Lv[j * 64 + i];
            float y = 0.f;
#pragma unroll
            for (int kk = 0; kk < 8; ++kk) { S[kk] = S[kk] * Lw[o8 + kk] + sa * Lb[o8 + kk] + vi * Lkef[o8 + kk]; y += S[kk] * Lr[o8 + kk]; }
            y += __shfl_xor(y, 1); y += __shfl_xor(y, 2); y += __shfl_xor(y, 4);
            if (s == 0) Ly[j * 64 + i] = y;
        }
        __syncthreads();
#pragma unroll
        for (int rep = 0; rep < 2; ++rep) { const int idx = tid + NTHR * rep, j = idx >> 6, k = idx & 63; const int n = dir ? N - 1 - (t0 + j) : t0 + j;
            atomicAdd(Y + (size_t)(R0 + n) * 512 + h * 64 + k, Ly[idx]); }
    }
    if (!lat) { float* so = F.out + O_SRW + (size_t)((b * 2 + dir) * 8 + h) * 4096 + i * 64 + 8 * s;
#pragma unroll
        for (int kk = 0; kk < 8; ++kk) so[kk] = S[kk]; }
}
__device__ __forceinline__ void ret_job(Frame& F, int seq, int h, int dir) {
    LAS float* L = (LAS float*)F.lds;
    LAS float *Lq = L, *Lk = L + 1024, *Lv = L + 2048, *Lo = L + 3072;
    const int tid = F.tid, lane = F.lane, w = F.wave;
    const bool lat = seq >= 32; const int b = lat ? seq - 32 : seq, N = lat ? 2048 : 256, R0 = lat ? TCX + b * 2048 : b * 256;
    const bf16* PROJ = F.P; float* O = F.S + (size_t)T * 512;
    const float g = sigmoidf_(F.in[24][dir * 8 + h]);
    const int e = 8 * w + (lane >> 3), s = lane & 7;
    float S[8];
    {
        const float* st = F.in[6] + (size_t)((b * 2 + dir) * 8 + h) * 4096;
#pragma unroll
        for (int dd = 0; dd < 8; ++dd) S[dd] = lat ? st[(8 * s + dd) * 64 + e] : 0.f;
    }
    __syncthreads();
    for (int t0 = 0; t0 < N; t0 += 16) {
#pragma unroll
        for (int rep = 0; rep < 2; ++rep) { const int idx = tid + NTHR * rep, j = idx >> 6, k = idx & 63; const int n = dir ? N - 1 - (t0 + j) : t0 + j;
            const bf16* pr = PROJ + (size_t)(R0 + n) * NREC;
            Lq[idx] = bf1(pr[h * 64 + k]); Lk[idx] = bf1(pr[512 + h * 64 + k]) * 0.125f; Lv[idx] = bf1(pr[1024 + h * 64 + k]); }
        __syncthreads();
        for (int j = 0; j < 16; ++j) {
            const int o8 = j * 64 + 8 * s; const float ve = Lv[j * 64 + e];
            float o = 0.f;
#pragma unroll
            for (int dd = 0; dd < 8; ++dd) { S[dd] = g * S[dd] + Lk[o8 + dd] * ve; o += Lq[o8 + dd] * S[dd]; }
            o += __shfl_xor(o, 1); o += __shfl_xor(o, 2); o += __shfl_xor(o, 4);
            if (s == 0) Lo[j * 64 + e] = o;
        }
        __syncthreads();
#pragma unroll
        for (int rep = 0; rep < 2; ++rep) { const int idx = tid + NTHR * rep, j = idx >> 6, k = idx & 63; const int n = dir ? N - 1 - (t0 + j) : t0 + j;
            atomicAdd(O + (size_t)(R0 + n) * 512 + h * 64 + k, Lo[idx]); }
        __syncthreads();
    }
    if (!lat) { float* so = F.out + O_SRET + (size_t)((b * 2 + dir) * 8 + h) * 4096;
#pragma unroll
        for (int dd = 0; dd < 8; ++dd) so[(8 * s + dd) * 64 + e] = S[dd]; }
}
__device__ __forceinline__ void run_job(Frame& F, int J) {
    int type, seq, h, dir;
    if (J < 64) { type = J >> 5; const int r = J & 31; seq = 32 + (r >> 4); h = (r >> 1) & 7; dir = r & 1; }
    else { const int r = J - 64; type = r >> 9; const int q = r & 511; seq = q >> 4; h = (q >> 1) & 7; dir = q & 1; }
    if (type == 0) rwkv_job(F, seq, h, dir); else ret_job(F, seq, h, dir);
}
__device__ __forceinline__ void scan_phase(Frame& F) {
    if (F.G > 128) { if (F.bid < 64) run_job(F, F.bid); else for (int J = 64 + (F.bid - 64); J < 1088; J += F.G - 64) run_job(F, J); }
    else for (int J = F.bid; J < 1088; J += F.G) run_job(F, J);
}
__device__ __forceinline__ void rec_post_phase(Frame& F) {
    LAS float* sg = (LAS float*)F.lds + F.wave * 128;
    const int gw = F.bid * NWAVES + F.wave, NGW = F.G * NWAVES, lane = F.lane;
    const bf16* PROJ = F.P; const float* Y = F.S; const float* O = F.S + (size_t)T * 512;
    for (int row = gw; row < T; row += NGW) {
        const bf16* pr = PROJ + (size_t)row * NREC;
        sg[lane] = sigmoidf_(bf1(pr[3712 + lane])); sg[64 + lane] = sigmoidf_(bf1(pr[3776 + lane]));
        asm volatile("s_waitcnt lgkmcnt(0)" ::: "memory");
        for (int h = 0; h < 8; ++h) {
            const int c = h * 64 + lane;
            const float y = Y[(size_t)row * 512 + c];
            const float mu = wave_sum(y) * (1.f / 64.f), dl = y - mu, var = wave_sum(dl * dl) * (1.f / 64.f);
            const float yn = dl * rsqrtf(var + 64e-5f) * F.in[33][c] + F.in[34][c];
            const float r = bf1(pr[2048 + c]), k = bf1(pr[2560 + c]), v = bf1(pr[3072 + c]);
            const float bonus = wave_sum(r * F.in[32][c] * k) * v;
            float g = 0.f;
#pragma unroll 8
            for (int j = 0; j < 128; ++j) g += sg[j] * F.in[29][(size_t)j * 512 + c];
            F.MIX[(size_t)row * D + 512 + c] = (bf16)f2bf((yn + bonus) * g);
        }
        for (int h = 0; h < 8; ++h) {
            const int c = h * 64 + lane;
            const float o = O[(size_t)row * 512 + c];
            const float on = o * rsqrtf(wave_sum(o * o) * (1.f / 64.f) + 1e-6f);
            const float xg = bf1(pr[1536 + c]);
            F.MIX[(size_t)row * D + c] = (bf16)f2bf(xg * sigmoidf_(xg) * on);
        }
        asm volatile("s_waitcnt lgkmcnt(0)" ::: "memory");
    }
}

constexpr int NPHASE = 18;
struct Args { const float* in[37]; float* out; unsigned char* ws; int ph_lo, ph_hi; };

template <bool COOP>
__global__ void __launch_bounds__(NTHR, 2) mk_fwd(Args args) {
    extern __shared__ __attribute__((aligned(16))) unsigned char lds[];
    Frame F;
    F.lds = (LAS unsigned char*)lds;
    F.tid = threadIdx.x; F.lane = F.tid & 63; F.wave = __builtin_amdgcn_readfirstlane(F.tid >> 6); F.G = gridDim.x; F.bid = blockIdx.x;
#pragma unroll
    for (int i = 0; i < 37; ++i) F.in[i] = args.in[i];
    F.out = args.out; F.ws = args.ws;
    unsigned char* ws = args.ws;
    F.Watt = (bf16*)(ws + WS_WATT); F.Woa = (bf16*)(ws + WS_WOA); F.Wrec = (bf16*)(ws + WS_WREC); F.Wor = (bf16*)(ws + WS_WOR); F.Wf1 = (bf16*)(ws + WS_WF1); F.Wf2 = (bf16*)(ws + WS_WF2);
    F.H = (bf16*)(ws + WS_H); F.MIX = (bf16*)(ws + WS_MIX); F.P = (bf16*)(ws + WS_P); F.MOD = (float*)(ws + WS_MOD); F.S = (float*)(ws + WS_S);
    const int lo = args.ph_lo, hi = args.ph_hi;
#define IN(k) (lo <= (k) && (k) < hi)
#define SEAM(k) do { if (COOP && IN((k) + 1)) { cooperative_groups::this_grid().sync(); } } while (0)
    const f32x2v* rope = (const f32x2v*)((unsigned char*)F.MOD + MOD_ROPE);

    if (IN(0)) { p0_prologue(F); SEAM(0); }
    if (IN(1)) { norm_phase(F, F.in[0], F.in[1], F.in[10], F.MOD, 0, 1, false); SEAM(1); }
    if (IN(2)) { pg8::Gemm g{F.H, F.Watt, T, NATT, D}; pg8::StaticOrder S; S.init(T, NATT, F.G, F.bid); EpiAttnIn E{F.P, F.out, rope};
        pg8::gemm_phase<EpiAttnIn, pg8::StaticOrder, true, true>(F.lds, g, S, E); SEAM(2); }
    if (IN(3)) { attn_naive_phase(F); SEAM(3); }
    if (IN(4)) { diff_post_phase(F); SEAM(4); }
    if (IN(5)) { pg8::Gemm g{F.MIX, F.Woa, T, D, D}; pg8::StaticOrder S; S.init(T, D, F.G, F.bid); EpiResid E{F.in[0], F.in[1], F.out, F.MOD, 2};
        pg8::gemm_phase<EpiResid, pg8::StaticOrder, true, true>(F.lds, g, S, E); SEAM(5); }
    if (IN(6)) { norm_phase(F, F.out, F.out + (size_t)TCX * D, F.in[11], F.MOD, 3, 4, false); SEAM(6); }
    if (IN(7)) { pg8::Gemm g{F.H, F.Wf1, T, NFF, D}; pg8::StaticOrder S; S.init(T, NFF, F.G, F.bid); EpiSwiglu E{F.P};
        pg8::gemm_phase<EpiSwiglu, pg8::StaticOrder, true, true>(F.lds, g, S, E); SEAM(7); }
    if (IN(8)) { pg8::Gemm g{F.P, F.Wf2, T, D, DFF}; pg8::StaticOrder S; S.init(T, D, F.G, F.bid); EpiResid E{F.out, F.out + (size_t)TCX * D, F.out, F.MOD, 5};
        pg8::gemm_phase<EpiResid, pg8::StaticOrder, true, true>(F.lds, g, S, E); SEAM(8); }
    if (IN(9)) { norm_phase(F, F.out, F.out + (size_t)TCX * D, F.in[10] + D, F.MOD + 3 * 6144, 0, 1, true); SEAM(9); }
    if (IN(10)) { pg8::Gemm g{F.H, F.Wrec, T, NREC, D}; pg8::StaticOrder S; S.init(T, NREC, F.G, F.bid); EpiBf16Plain E{F.P, NREC};
        pg8::gemm_phase<EpiBf16Plain, pg8::StaticOrder, true, true>(F.lds, g, S, E); SEAM(10); }
    if (IN(11)) { scan_phase(F); SEAM(11); }
    if (IN(12)) { rec_post_phase(F); SEAM(12); }
    if (IN(13)) { pg8::Gemm g{F.MIX, F.Wor, T, D, D}; pg8::StaticOrder S; S.init(T, D, F.G, F.bid); EpiResid E{F.out, F.out + (size_t)TCX * D, F.out, F.MOD + 3 * 6144, 2};
        pg8::gemm_phase<EpiResid, pg8::StaticOrder, true, true>(F.lds, g, S, E); SEAM(13); }
    if (IN(14)) { norm_phase(F, F.out, F.out + (size_t)TCX * D, F.in[11] + D, F.MOD + 3 * 6144, 3, 4, false); SEAM(14); }
    if (IN(15)) { pg8::Gemm g{F.H, F.Wf1 + WF1_STRIDE, T, NFF, D}; pg8::StaticOrder S; S.init(T, NFF, F.G, F.bid); EpiSwiglu E{F.P};
        pg8::gemm_phase<EpiSwiglu, pg8::StaticOrder, true, true>(F.lds, g, S, E); SEAM(15); }
    if (IN(16)) { pg8::Gemm g{F.P, F.Wf2 + WF2_STRIDE, T, D, DFF}; pg8::StaticOrder S; S.init(T, D, F.G, F.bid); EpiResid E{F.out, F.out + (size_t)TCX * D, F.out, F.MOD + 3 * 6144, 5};
        pg8::gemm_phase<EpiResid, pg8::StaticOrder, true, true>(F.lds, g, S, E); SEAM(16); }
    if (IN(17)) { final_norm_phase(F); }
#undef IN
#undef SEAM
}

#ifndef MK_N_LAUNCHES
#define MK_N_LAUNCHES 1
#endif
extern "C" void kernel_launch(void* const* d_in, const int* in_sizes, int n_in, void* d_out, int out_size, void* d_ws, size_t ws_size, hipStream_t stream) {
    static int grid = 0;
    if (grid == 0) {
        if (n_in != 37 || out_size != 33554432 || ws_size < WS_END) { fprintf(stderr, "kernel_launch: unexpected problem (n_in %d out %d ws %zu)\n", n_in, out_size, ws_size); grid = -1; return; }
        int dev = 0, cus = 0, per_cu = 0;
        if (hipGetDevice(&dev) != hipSuccess || hipDeviceGetAttribute(&cus, hipDeviceAttributeMultiprocessorCount, dev) != hipSuccess) { grid = -1; return; }
        (void)hipFuncSetAttribute((const void*)mk_fwd<false>, hipFuncAttributeMaxDynamicSharedMemorySize, LDS_BYTES);
        (void)hipFuncSetAttribute((const void*)mk_fwd<true>, hipFuncAttributeMaxDynamicSharedMemorySize, LDS_BYTES);
        if (hipOccupancyMaxActiveBlocksPerMultiprocessor(&per_cu, (const void*)mk_fwd<true>, NTHR, LDS_BYTES) != hipSuccess || per_cu < 1) per_cu = 1;
        (void)hipGetLastError();
        grid = cus;
    }
    if (grid < 0) return;
    Args a{};
    for (int i = 0; i < 37; ++i) a.in[i] = (const float*)d_in[i];
    a.out = (float*)d_out; a.ws = (unsigned char*)d_ws;
#if MK_N_LAUNCHES == 1
    a.ph_lo = 0; a.ph_hi = NPHASE;
    void* kargs[] = {&a};
    hipError_t e = hipLaunchCooperativeKernel((const void*)mk_fwd<true>, dim3(grid), dim3(NTHR), kargs, LDS_BYTES, stream);
    if (e != hipSuccess) fprintf(stderr, "cooperative launch failed: %s (grid %d)\n", hipGetErrorString(e), grid);
#else
    for (int ph = 0; ph < NPHASE; ++ph) { a.ph_lo = ph; a.ph_hi = ph + 1; hipLaunchKernelGGL(mk_fwd<false>, dim3(grid), dim3(NTHR), LDS_BYTES, stream, a); }
#endif
}
```

```cpp
#include <hip/hip_runtime.h>
#include <hip/hip_cooperative_groups.h>
#include <cstdio>
#include <cstdint>
namespace pg8 {
#define PG8_LAS __attribute__((address_space(3)))
typedef unsigned short bf16_t;
typedef short bf16x8 __attribute__((ext_vector_type(8)));
typedef float f32x4 __attribute__((ext_vector_type(4)));
typedef unsigned u32x4 __attribute__((ext_vector_type(4)));
constexpr int BM = 256, BK = 64, HALF = 128, HTB = HALF * BK * 2  , STAGE_BYTES = 8 * HTB, NXCD = 8, WGM = 8;

__host__ __device__ __forceinline__ int lds_byte(int r, int c) { const int st = (r >> 4) * 2 + (c >> 5), rr = r & 15, cc = c & 31, ob = rr * 64 + cc * 2; return st * 1024 + (ob ^ (((ob >> 9) & 1) << 5)); }
__host__ __device__ __forceinline__ void stage_rc(int b, int& R, int& C) { const int st = b / 1024, sb = b % 1024, swz = sb ^ (((sb >> 9) & 1) << 5); R = (st >> 1) * 16 + swz / 64; C = (st & 1) * 32 + (swz % 64) / 2; }
__host__ __device__ __forceinline__ int perm32(int rho) { const int n = rho >> 4, i = rho & 15; return 8 * (i >> 2) + 4 * n + (i & 3); }

struct Unit { int pm, pn; };
struct Gemm { const bf16_t* A; const bf16_t* Bt; int M, N, K; };

struct StaticOrder {
    int nM, nN, nwg, G, c;
    __host__ __device__ void init(int M, int N, int G_, int c_) { nM = M / BM; nN = N / BM; nwg = nM * nN; G = G_; c = c_; }
    __host__ __device__ bool next(int i, Unit& u) const {
        const long L = (long)i * G + c; if (L >= nwg) return false;
        int wgid = (int)L; { const int q = nwg / NXCD, r = nwg % NXCD, xcd = wgid % NXCD, off = wgid / NXCD; wgid = (xcd < r ? xcd * (q + 1) : r * (q + 1) + (xcd - r) * q) + off; }
        const int nig = WGM * nN, gid = wgid / nig, fm = gid * WGM, gsz = (nM - fm) < WGM ? (nM - fm) : WGM;
        u.pm = fm + ((wgid % nig) % gsz); u.pn = (wgid % nig) / gsz; return true;
    }
    __device__ __forceinline__ void a_ready(const Unit&) const {}
    __device__ __forceinline__ void done(const Unit&) const {}
};
__device__ __forceinline__ unsigned cvt_pk_bf16(float lo, float hi) { unsigned r; asm volatile("v_cvt_pk_bf16_f32 %0, %1, %2" : "=v"(r) : "v"(lo), "v"(hi)); return r; }
typedef float f32x2 __attribute__((ext_vector_type(2)));
template <class Epi, class Sched, bool ALIGN_EPI = false, bool SP2 = false>
__device__ __forceinline__ void gemm_phase(PG8_LAS unsigned char* lds, const Gemm g, const Sched& S, const Epi& E) {
    const int tid = threadIdx.x, wid = __builtin_amdgcn_readfirstlane(tid >> 6), lane = tid & 63, wr = wid >> 2, wc = wid & 3, fr = lane & 15, fq = lane >> 4;
    const int K = g.K, nt = K / BK;
    unsigned voffA[2], voffB[2];
#pragma unroll
    for (int i = 0; i < 2; ++i) { int R, C; stage_rc(tid * 16 + i * 8192, R, C); const int Rb = Epi::PERM ? ((R & ~31) + perm32(R & 31)) : R;
        voffA[i] = (unsigned)(R * K + C) * 2u; voffB[i] = (unsigned)(Rb * K + C) * 2u; }
    const size_t kstep = (size_t)(BK * 2);
    const size_t hstep = (size_t)HALF * K * 2;
    const size_t tstep = 2 * hstep;
    const unsigned ldsw = (unsigned)wid * 1024u;
    const int aoff = lds_byte(wr * 64 + fr, fq * 8), boff = lds_byte(wc * 32 + fr, fq * 8);
#define PG8_SA(b, h) (((b) * 2 + (h)) * HTB)
#define PG8_SB(b, h) ((4 + (b) * 2 + (h)) * HTB)
#define PG8_STAGE(bufoff, gbase, voff) do { _Pragma("unroll") for (int _i = 0; _i < 2; ++_i) \
        __builtin_amdgcn_global_load_lds((const unsigned*)((const char*)(gbase) + (voff)[_i]), (PG8_LAS unsigned*)(lds + (bufoff) + ldsw + _i * 8192), 16, 0, 0); } while (0)
#define PG8_LDA(dst, b, h) do { _Pragma("unroll") for (int m = 0; m < 4; ++m) _Pragma("unroll") for (int k = 0; k < 2; ++k) dst[m][k] = *(const PG8_LAS bf16x8*)(lds + PG8_SA(b, h) + aoff + m * 2048 + k * 1024); } while (0)
#define PG8_LDB(dst, b, h) do { _Pragma("unroll") for (int n = 0; n < 2; ++n) _Pragma("unroll") for (int k = 0; k < 2; ++k) dst[n][k] = *(const PG8_LAS bf16x8*)(lds + PG8_SB(b, h) + boff + n * 2048 + k * 1024); } while (0)
#define PG8_MMA(ai, bj, At, Bt) do { __builtin_amdgcn_s_setprio(1); _Pragma("unroll") for (int m = 0; m < 4; ++m) _Pragma("unroll") for (int n = 0; n < 2; ++n) _Pragma("unroll") for (int k = 0; k < 2; ++k) \
        acc[ai][bj][m][n] = __builtin_amdgcn_mfma_f32_16x16x32_bf16(Bt[n][k], At[m][k], acc[ai][bj][m][n], 0, 0, 0); __builtin_amdgcn_s_setprio(0); } while (0)
#define PG8_WAIT_V(n) asm volatile("s_waitcnt vmcnt(" #n ")" ::: "memory")
#define PG8_WAIT_L(n) asm volatile("s_waitcnt lgkmcnt(" #n ")" ::: "memory")
#define PG8_BAR __builtin_amdgcn_s_barrier()
#define PG8_SCHED __builtin_amdgcn_sched_barrier(0)
    Unit cur, nxt; int ui = 0;
    if (!S.next(0, cur)) return;
    f32x4 acc[2][2][4][2];
#pragma unroll
    for (int a = 0; a < 2; ++a)
#pragma unroll
        for (int b = 0; b < 2; ++b)
#pragma unroll
            for (int m = 0; m < 4; ++m)
#pragma unroll
                for (int n = 0; n < 2; ++n) acc[a][b][m][n] = (f32x4){0.f, 0.f, 0.f, 0.f};
    bf16x8 At[4][2], B0[2][2], B1[2][2];
    const char* cA = (const char*)g.A + (size_t)cur.pm * tstep; const char* cB = (const char*)g.Bt + (size_t)cur.pn * tstep;
    S.a_ready(cur);
    if constexpr (SP2) {
        PG8_STAGE(PG8_SB(0, 0), cB, voffB); PG8_STAGE(PG8_SB(0, 1), cB + hstep, voffB); PG8_STAGE(PG8_SA(0, 0), cA, voffA); PG8_STAGE(PG8_SA(0, 1), cA + hstep, voffA);
        if (wr == 1) PG8_BAR;
        PG8_WAIT_V(2); PG8_BAR;
        PG8_STAGE(PG8_SB(1, 0), cB + kstep, voffB); PG8_STAGE(PG8_SA(1, 0), cA + kstep, voffA); PG8_STAGE(PG8_SB(1, 1), cB + hstep + kstep, voffB);
        PG8_WAIT_V(6); PG8_BAR;
    } else {
        PG8_STAGE(PG8_SB(0, 0), cB, voffB); PG8_STAGE(PG8_SA(0, 0), cA, voffA); PG8_STAGE(PG8_SB(0, 1), cB + hstep, voffB); PG8_STAGE(PG8_SA(0, 1), cA + hstep, voffA);
        if (wr == 1) PG8_BAR;
        PG8_WAIT_V(4); PG8_BAR;
        PG8_STAGE(PG8_SB(1, 0), cB + kstep, voffB); PG8_STAGE(PG8_SA(1, 0), cA + kstep, voffA); PG8_STAGE(PG8_SB(1, 1), cB + hstep + kstep, voffB);
        PG8_WAIT_V(6); PG8_BAR;
    }
    for (;;) {
        const bool has_next = S.next(ui + 1, nxt);
        const char* nA = has_next ? (const char*)g.A + (size_t)nxt.pm * tstep : cA; const char* nB = has_next ? (const char*)g.Bt + (size_t)nxt.pn * tstep : cB;
        for (int t = 0; t < nt; t += 2) {
            const bool last = (t == nt - 2);
            const char* a1 = cA + (size_t)(t + 1) * kstep;
            const char* a2 = last ? nA : cA + (size_t)(t + 2) * kstep; const char* b2 = last ? nB : cB + (size_t)(t + 2) * kstep;
            const char* a3 = a2 + kstep; const char* b3 = b2 + kstep;
            if (last && has_next) S.a_ready(nxt);
            if constexpr (SP2) {
            PG8_LDB(B0, 0, 0); PG8_LDB(B1, 0, 1); PG8_SCHED; PG8_LDA(At, 0, 0); PG8_STAGE(PG8_SA(1, 1), a1 + hstep, voffA);
            PG8_WAIT_V(8); PG8_WAIT_L(0); PG8_BAR; PG8_MMA(0, 0, At, B0); PG8_MMA(0, 1, At, B1); PG8_BAR; PG8_SCHED;
            PG8_LDA(At, 0, 1); PG8_STAGE(PG8_SB(0, 0), b2, voffB); PG8_STAGE(PG8_SB(0, 1), b2 + hstep, voffB); PG8_STAGE(PG8_SA(0, 0), a2, voffA);
            PG8_WAIT_V(8); PG8_WAIT_L(0); PG8_BAR; PG8_MMA(1, 0, At, B0); PG8_MMA(1, 1, At, B1); PG8_BAR; PG8_SCHED;
            PG8_LDB(B0, 1, 0); PG8_LDB(B1, 1, 1); PG8_SCHED; PG8_LDA(At, 1, 0); PG8_STAGE(PG8_SA(0, 1), a2 + hstep, voffA);
            PG8_WAIT_V(8); PG8_WAIT_L(0); PG8_BAR; PG8_MMA(0, 0, At, B0); PG8_MMA(0, 1, At, B1); PG8_BAR; PG8_SCHED;
            PG8_LDA(At, 1, 1); PG8_STAGE(PG8_SB(1, 0), b3, voffB); PG8_STAGE(PG8_SB(1, 1), b3 + hstep, voffB); PG8_STAGE(PG8_SA(1, 0), a3, voffA);
            PG8_WAIT_V(8); PG8_WAIT_L(0); PG8_BAR; PG8_MMA(1, 0, At, B0); PG8_MMA(1, 1, At, B1); PG8_BAR; PG8_SCHED;
            } else {
            PG8_LDB(B0, 0, 0); PG8_SCHED; PG8_LDA(At, 0, 0); PG8_STAGE(PG8_SA(1, 1), a1 + hstep, voffA);
            PG8_WAIT_L(8); PG8_BAR; PG8_WAIT_L(0); PG8_MMA(0, 0, At, B0); PG8_BAR; PG8_SCHED;
            PG8_LDB(B1, 0, 1); PG8_STAGE(PG8_SB(0, 0), b2, voffB);
            PG8_BAR; PG8_WAIT_L(0); PG8_MMA(0, 1, At, B1); PG8_BAR;
            PG8_LDA(At, 0, 1); PG8_STAGE(PG8_SA(0, 0), a2, voffA);
            PG8_BAR; PG8_WAIT_L(0); PG8_MMA(1, 0, At, B0); PG8_BAR; PG8_SCHED;
            PG8_STAGE(PG8_SB(0, 1), b2 + hstep, voffB);
            PG8_WAIT_V(6); PG8_BAR; PG8_MMA(1, 1, At, B1); PG8_BAR;
            PG8_LDB(B0, 1, 0); PG8_SCHED; PG8_LDA(At, 1, 0); PG8_STAGE(PG8_SA(0, 1), a2 + hstep, voffA);
            PG8_WAIT_L(8); PG8_BAR; PG8_WAIT_L(0); PG8_MMA(0, 0, At, B0); PG8_BAR; PG8_SCHED;
            PG8_LDB(B1, 1, 1); PG8_STAGE(PG8_SB(1, 0), b3, voffB);
            PG8_BAR; PG8_WAIT_L(0); PG8_MMA(0, 1, At, B1); PG8_BAR;
            PG8_LDA(At, 1, 1); PG8_STAGE(PG8_SA(1, 0), a3, voffA);
            PG8_BAR; PG8_WAIT_L(0); PG8_MMA(1, 0, At, B0); PG8_BAR; PG8_SCHED;
            PG8_STAGE(PG8_SB(1, 1), b3 + hstep, voffB);
            PG8_WAIT_V(6); PG8_BAR; PG8_MMA(1, 1, At, B1); PG8_BAR;
            }
        }
        if constexpr (ALIGN_EPI) { if (wr == 0) PG8_BAR; }
        if constexpr (!Epi::AFTER_DRAIN) { E(acc, cur, wr, wc, fr, fq); S.done(cur); }
        if (!has_next) break;
#pragma unroll
        for (int a = 0; a < 2; ++a)
#pragma unroll
            for (int b = 0; b < 2; ++b)
#pragma unroll
                for (int m = 0; m < 4; ++m)
#pragma unroll
                    for (int n = 0; n < 2; ++n) acc[a][b][m][n] = (f32x4){0.f, 0.f, 0.f, 0.f};
        cur = nxt; cA = nA; cB = nB; ++ui;
        if constexpr (ALIGN_EPI) { if (wr == 1) PG8_BAR; }
    }
    PG8_WAIT_V(0);
    if constexpr (!ALIGN_EPI) { if (wr == 0) PG8_BAR; }
    PG8_BAR;
    if constexpr (Epi::AFTER_DRAIN) { E.fused(acc, cur, wr, wc, fr, fq, lds, wid, lane); S.done(cur); }
#undef PG8_SA
#undef PG8_SB
#undef PG8_STAGE
#undef PG8_LDA
#undef PG8_LDB
#undef PG8_MMA
#undef PG8_WAIT_V
#undef PG8_WAIT_L
#undef PG8_BAR
#undef PG8_SCHED
}
}

#define GAS __attribute__((address_space(1)))
#define LAS __attribute__((address_space(3)))
typedef unsigned short bf16;
typedef unsigned v4u __attribute__((ext_vector_type(4)));
typedef unsigned v2u __attribute__((ext_vector_type(2)));
typedef float f32x4 __attribute__((ext_vector_type(4)));
typedef float f32x2v __attribute__((ext_vector_type(2)));

constexpr int NWAVES = 8, NTHR = 512;
constexpr int D = 1024, TCX = 8192, TLT = 4096, T = 12288;
constexpr int NATT = 3072, NREC = 3840, DFF = 2816, NFF = 5632;
constexpr int QLD = NATT;
constexpr size_t MiB = 1u << 20;
constexpr size_t WS_CTL = 0, WS_MOD = 1 * MiB, WS_WATT = 2 * MiB, WS_WOA = 8 * MiB, WS_WREC = 10 * MiB, WS_WOR = 18 * MiB, WS_WF1 = 20 * MiB, WS_WF2 = 42 * MiB,
                 WS_H = 54 * MiB, WS_MIX = 78 * MiB, WS_P = 102 * MiB, WS_S = 192 * MiB, WS_END = 256 * MiB;
constexpr size_t MOD_ROPE = 160 * 1024, MOD_LAM = 176 * 1024;
constexpr size_t WF1_STRIDE = (size_t)NFF * D;
constexpr size_t WF2_STRIDE = (size_t)D * DFF;
constexpr size_t O_YP = 0, O_YS = 8388608, O_NAK = 12582912, O_NAV = 16777216, O_DFK = 20971520, O_DFV = 25165824, O_SRET = 29360128, O_SRW = 31457280;
constexpr int LDS_BYTES = 147456;

__device__ __forceinline__ float bflo(unsigned u) { return __uint_as_float(u << 16); }
__device__ __forceinline__ float bfhi(unsigned u) { return __uint_as_float(u & 0xffff0000u); }
__device__ __forceinline__ float bf1(bf16 b) { return __uint_as_float(((unsigned)b) << 16); }
__device__ __forceinline__ unsigned f2bf(float f) { unsigned u = __float_as_uint(f); return (u + 0x7fffu + ((u >> 16) & 1u)) >> 16; }
__device__ __forceinline__ unsigned pk2(float lo, float hi) { return f2bf(lo) | (f2bf(hi) << 16); }
__device__ __forceinline__ float wave_sum(float v) {
#pragma unroll
    for (int o = 1; o < 64; o <<= 1) v += __shfl_xor(v, o);
    return v;
}
__device__ __forceinline__ float sigmoidf_(float x) { return 1.f / (1.f + __expf(-x)); }

struct Frame {
    LAS unsigned char* lds;
    int tid, lane, wave, G, bid;
    const float* in[37];
    float* out; unsigned char* ws;
    bf16 *Watt, *Woa, *Wrec, *Wor, *Wf1, *Wf2, *H, *MIX, *P;
    float *MOD, *S;
};

__device__ __forceinline__ void transpose_item(const float* W, int K, int N, bf16* WT, int k0, int n0, int drow0, LAS float* scr, int lane) {
#pragma unroll 8
    for (int i = 0; i < 32; ++i) { const int kk = 2 * i + (lane >> 5); scr[kk * 33 + (lane & 31)] = W[(size_t)(k0 + kk) * N + n0 + (lane & 31)]; }
    asm volatile("s_waitcnt lgkmcnt(0)" ::: "memory");
    const int c = lane & 7;
#pragma unroll
    for (int j = 0; j < 4; ++j) { const int n = (lane >> 3) + 8 * j; const LAS float* s = scr + (8 * c) * 33 + n;
        v4u o; o.x = pk2(s[0 * 33], s[1 * 33]); o.y = pk2(s[2 * 33], s[3 * 33]); o.z = pk2(s[4 * 33], s[5 * 33]); o.w = pk2(s[6 * 33], s[7 * 33]);
        *(v4u*)(WT + (size_t)(drow0 + n) * K + k0 + 8 * c) = o; }
    asm volatile("s_waitcnt lgkmcnt(0)" ::: "memory");
}

__device__ __forceinline__ void p0_prologue(Frame& F) {
    {
        LAS float* sc = (LAS float*)F.lds;
        LAS float* red = sc + 3072;
        for (int idx = F.tid; idx < 3072; idx += NTHR) { const int j = idx >> 10, k = idx & 1023; const float c = (j == 0) ? F.in[9][k] : F.in[8][(j - 1) * 1024 + k]; sc[idx] = c * sigmoidf_(c); }
        __syncthreads();
        for (int item = F.bid; item < 192; item += F.G) {
            const int layer = item / 96, col = (item % 96) * 64 + (F.tid & 63), kg = F.tid >> 6;
            const float* w = F.in[13] + (size_t)layer * 1024 * 6144 + col;
            float a0 = 0.f, a1 = 0.f, a2 = 0.f;
#pragma unroll 8
            for (int k = kg * 128; k < kg * 128 + 128; ++k) { const float wv = w[(size_t)k * 6144]; a0 += sc[k] * wv; a1 += sc[1024 + k] * wv; a2 += sc[2048 + k] * wv; }
            red[(kg * 3 + 0) * 64 + (F.tid & 63)] = a0; red[(kg * 3 + 1) * 64 + (F.tid & 63)] = a1; red[(kg * 3 + 2) * 64 + (F.tid & 63)] = a2;
            __syncthreads();
            if (F.tid < 192) { const int j = F.tid >> 6, c = F.tid & 63; float s = 0.f;
#pragma unroll
                for (int g = 0; g < 8; ++g) s += red[(g * 3 + j) * 64 + c];
                const int cc = (item % 96) * 64 + c; F.MOD[(layer * 3 + j) * 6144 + cc] = s + F.in[14][layer * 6144 + cc]; }
            __syncthreads();
        }
    }
    if (F.bid == F.G - 1) {
        f32x2v* rope = (f32x2v*)((unsigned char*)F.MOD + MOD_ROPE);
        for (int idx = F.tid; idx < 1024; idx += NTHR) { const int pos = idx >> 4, i = idx & 15; const float inv = powf(10000.0f, -(float)i / 16.0f); const float ang = (float)pos * inv; rope[idx] = (f32x2v){cosf(ang), sinf(ang)}; }
        if (F.wave == 0) { const float s1 = wave_sum(F.in[18][F.lane] * F.in[19][F.lane]), s2 = wave_sum(F.in[20][F.lane] * F.in[21][F.lane]);
            if (F.lane == 0) *(float*)((unsigned char*)F.MOD + MOD_LAM) = expf(s1) - expf(s2) + 0.2f; }
    }
    {
        const int gt = F.bid * NTHR + F.tid, NG = F.G * NTHR;
        for (int idx = gt; idx < 4 * 512 * 64; idx += NG) { const int t = idx / (512 * 64), r = (idx / 64) % 512, c8 = idx % 64;
            const float* srcb = (t == 0) ? F.in[2] : (t == 1) ? F.in[3] : (t == 2) ? F.in[4] : F.in[5]; const float* src = srcb + (size_t)r * 512 + c8 * 8; const int colb = (t == 0) ? 512 : (t == 1) ? 1024 : (t == 2) ? 2048 : 2560;
            const f32x4 a = *(const f32x4*)src, b = *(const f32x4*)(src + 4);
            v4u o; o.x = pk2(a[0], a[1]); o.y = pk2(a[2], a[3]); o.z = pk2(b[0], b[1]); o.w = pk2(b[2], b[3]);
            *(v4u*)(F.P + (size_t)(T + r) * QLD + colb + c8 * 8) = o; }
    }
    {
        LAS float* scr = (LAS float*)(F.lds + 20480 + F.wave * 8448);
        __syncthreads();
        const int gw = F.bid * NWAVES + F.wave, NGW = F.G * NWAVES;
        constexpr int I0 = 16 * 96, I1 = 16 * 32, I2 = 16 * 120, I3 = 16 * 32, I4 = 16 * 176, I6 = 44 * 32;
        constexpr int NIT = I0 + I1 + I2 + I3 + 2 * I4 + 2 * I6;
        for (int it = gw; it < NIT; it += NGW) {
            int r = it;
            if (r < I0) { const int nb = 96; transpose_item(F.in[15], 1024, 3072, F.Watt, 64 * (r / nb), 32 * (r % nb), 32 * (r % nb), scr, F.lane); continue; } r -= I0;
            if (r < I1) { const int nb = 32; transpose_item(F.in[16], 1024, 1024, F.Woa, 64 * (r / nb), 32 * (r % nb), 32 * (r % nb), scr, F.lane); continue; } r -= I1;
            if (r < I2) { const int nb = 120; transpose_item(F.in[22], 1024, 3840, F.Wrec, 64 * (r / nb), 32 * (r % nb), 32 * (r % nb), scr, F.lane); continue; } r -= I2;
            if (r < I3) { const int nb = 32; transpose_item(F.in[23], 1024, 1024, F.Wor, 64 * (r / nb), 32 * (r % nb), 32 * (r % nb), scr, F.lane); continue; } r -= I3;
            if (r < 2 * I4) { const int l = r / I4; r -= l * I4; const int nb = 176, n0 = 32 * (r % nb);
                const int drow = (n0 < DFF) ? ((n0 / 128) * 256 + (n0 % 128)) : (((n0 - DFF) / 128) * 256 + 128 + ((n0 - DFF) % 128));
                transpose_item(F.in[35] + (size_t)l * 1024 * NFF, 1024, NFF, F.Wf1 + (size_t)l * WF1_STRIDE, 64 * (r / nb), n0, drow, scr, F.lane); continue; } r -= 2 * I4;
            { const int l = r / I6; r -= l * I6; const int nb = 32;
                transpose_item(F.in[36] + (size_t)l * DFF * 1024, DFF, 1024, F.Wf2 + (size_t)l * WF2_STRIDE, 64 * (r / nb), 32 * (r % nb), 32 * (r % nb), scr, F.lane); }
        }
    }
}

__device__ __forceinline__ void norm_phase(Frame& F, const float* xc, const float* xl, const float* g, const float* mod  , int shift_i, int scale_i, bool zero_s) {
    const int gw = F.bid * NWAVES + F.wave, NGW = F.G * NWAVES;
    for (int row = gw; row < T; row += NGW) {
        const float* xr = (row < TCX) ? xc + (size_t)row * D : xl + (size_t)(row - TCX) * D;
        const int cond = (row < TCX) ? 0 : 1 + ((row - TCX) >> 11);
        const float* sh = mod + cond * 6144 + shift_i * 1024; const float* sc = mod + cond * 6144 + scale_i * 1024;
        f32x4 v[4]; float ss = 0.f;
#pragma unroll
        for (int j = 0; j < 4; ++j) { v[j] = *(const f32x4*)(xr + 4 * F.lane + 256 * j); ss += (v[j][0] * v[j][0] + v[j][1] * v[j][1]) + (v[j][2] * v[j][2] + v[j][3] * v[j][3]); }
        const float rstd = rsqrtf(wave_sum(ss) * (1.f / D) + 1e-6f);
#pragma unroll
        for (int j = 0; j < 4; ++j) { const int c = 4 * F.lane + 256 * j; const f32x4 gg = *(const f32x4*)(g + c), s1 = *(const f32x4*)(sc + c), s0 = *(const f32x4*)(sh + c);
            f32x4 h;
#pragma unroll
            for (int e = 0; e < 4; ++e) h[e] = v[j][e] * rstd * gg[e] * (1.f + s1[e]) + s0[e];
            v2u o; o.x = pk2(h[0], h[1]); o.y = pk2(h[2], h[3]); *(v2u*)(F.H + (size_t)row * D + c) = o; }
    }
    if (zero_s) {
        const size_t n16 = (size_t)48 * MiB / 16; f32x4* p = (f32x4*)F.S;
        for (size_t i = (size_t)F.bid * NTHR + F.tid; i < n16; i += (size_t)F.G * NTHR) p[i] = (f32x4){0.f, 0.f, 0.f, 0.f};
    }
}
__device__ __forceinline__ void final_norm_phase(Frame& F) {
    const int gw = F.bid * NWAVES + F.wave, NGW = F.G * NWAVES; const float* g = F.in[12];
    for (int row = gw; row < T; row += NGW) {
        float* xr = F.out + (size_t)row * D;
        f32x4 v[4]; float ss = 0.f;
#pragma unroll
        for (int j = 0; j < 4; ++j) { v[j] = *(const f32x4*)(xr + 4 * F.lane + 256 * j); ss += (v[j][0] * v[j][0] + v[j][1] * v[j][1]) + (v[j][2] * v[j][2] + v[j][3] * v[j][3]); }
        const float rstd = rsqrtf(wave_sum(ss) * (1.f / D) + 1e-6f);
#pragma unroll
        for (int j = 0; j < 4; ++j) { const int c = 4 * F.lane + 256 * j; const f32x4 gg = *(const f32x4*)(g + c); *(f32x4*)(xr + c) = v[j] * rstd * gg; }
    }
}

struct EpiAttnIn {
    static constexpr bool PERM = true, AFTER_DRAIN = false;
    bf16* QKV; float* out; const f32x2v* rope;
    __device__ __forceinline__ void operator()(const f32x4 (&acc)[2][2][4][2], const pg8::Unit& u, int wr, int wc, int fr, int fq) const {
        const int pn = u.pn; const bool ctx = u.pm < 32;
        float* cdst = nullptr; int cbase = 0;
        if (ctx) { if (pn == 2 || pn == 3) { cdst = out + O_NAK; cbase = 512; } else if (pn == 4 || pn == 5) { cdst = out + O_NAV; cbase = 1024; }
                   else if (pn == 8 || pn == 9) { cdst = out + O_DFK; cbase = 2048; } else if (pn == 10 || pn == 11) { cdst = out + O_DFV; cbase = 2560; } }
        const bool rope_on = (!ctx) && pn >= 6 && pn <= 9;
        const float sgn = (fq < 2) ? -1.f : 1.f;
#pragma unroll
        for (int ai = 0; ai < 2; ++ai)
#pragma unroll
            for (int m = 0; m < 4; ++m) { const int row = u.pm * 256 + ai * 128 + wr * 64 + m * 16 + fr;
#pragma unroll
                for (int bj = 0; bj < 2; ++bj) { const int col = pn * 256 + bj * 128 + wc * 32 + 8 * fq;
                    f32x4 v0 = acc[ai][bj][m][0], v1 = acc[ai][bj][m][1];
                    if (rope_on) { const int n = (row - TCX) & 2047; const int p = (wc & 1) ? (n & 63) : (n >> 6); const f32x2v* tb = rope + p * 16 + 8 * (fq & 1);
#pragma unroll
                        for (int e = 0; e < 4; ++e) { const float p0 = __shfl_xor(v0[e], 32), p1 = __shfl_xor(v1[e], 32); const f32x2v c0 = tb[e], c1 = tb[4 + e];
                            v0[e] = v0[e] * c0.x + sgn * p0 * c0.y; v1[e] = v1[e] * c1.x + sgn * p1 * c1.y; } }
                    v4u w; w.x = pg8::cvt_pk_bf16(v0[0], v0[1]); w.y = pg8::cvt_pk_bf16(v0[2], v0[3]); w.z = pg8::cvt_pk_bf16(v1[0], v1[1]); w.w = pg8::cvt_pk_bf16(v1[2], v1[3]);
                    *(v4u*)(QKV + (size_t)row * QLD + col) = w;
                    if (cdst) { float* cp = cdst + (size_t)row * 512 + (col - cbase); *(f32x4*)cp = v0; *(f32x4*)(cp + 4) = v1; } } }
    }
};
struct EpiBf16Plain {
    static constexpr bool PERM = true, AFTER_DRAIN = false;
    bf16* O; int ldc;
    __device__ __forceinline__ void operator()(const f32x4 (&acc)[2][2][4][2], const pg8::Unit& u, int wr, int wc, int fr, int fq) const {
#pragma unroll
        for (int ai = 0; ai < 2; ++ai)
#pragma unroll
            for (int m = 0; m < 4; ++m) { const int row = u.pm * 256 + ai * 128 + wr * 64 + m * 16 + fr;
#pragma unroll
                for (int bj = 0; bj < 2; ++bj) { const int col = u.pn * 256 + bj * 128 + wc * 32 + 8 * fq; const f32x4 v0 = acc[ai][bj][m][0], v1 = acc[ai][bj][m][1];
                    v4u w; w.x = pg8::cvt_pk_bf16(v0[0], v0[1]); w.y = pg8::cvt_pk_bf16(v0[2], v0[3]); w.z = pg8::cvt_pk_bf16(v1[0], v1[1]); w.w = pg8::cvt_pk_bf16(v1[2], v1[3]);
                    *(v4u*)(O + (size_t)row * ldc + col) = w; } }
    }
};
struct EpiSwiglu {
    static constexpr bool PERM = true, AFTER_DRAIN = false;
    bf16* O;
    __device__ __forceinline__ void operator()(const f32x4 (&acc)[2][2][4][2], const pg8::Unit& u, int wr, int wc, int fr, int fq) const {
#pragma unroll
        for (int ai = 0; ai < 2; ++ai)
#pragma unroll
            for (int m = 0; m < 4; ++m) { const int row = u.pm * 256 + ai * 128 + wr * 64 + m * 16 + fr; const int col = u.pn * 128 + wc * 32 + 8 * fq;
                float r[8];
#pragma unroll
                for (int n = 0; n < 2; ++n)
#pragma unroll
                    for (int e = 0; e < 4; ++e) { const float g = acc[ai][0][m][n][e], up = acc[ai][1][m][n][e]; r[4 * n + e] = g * __builtin_amdgcn_rcpf(1.f + __expf(-g)) * up; }
                v4u w; w.x = pg8::cvt_pk_bf16(r[0], r[1]); w.y = pg8::cvt_pk_bf16(r[2], r[3]); w.z = pg8::cvt_pk_bf16(r[4], r[5]); w.w = pg8::cvt_pk_bf16(r[6], r[7]);
                *(v4u*)(O + (size_t)row * DFF + col) = w; }
    }
};
struct EpiResid {
    static constexpr bool PERM = false, AFTER_DRAIN = false;
    const float* bc; const float* bl; float* X; const float* mod; int gate_i;
    __device__ __forceinline__ void operator()(const f32x4 (&acc)[2][2][4][2], const pg8::Unit& u, int wr, int wc, int fr, int fq) const {
        const int cond = (u.pm < 32) ? 0 : ((u.pm < 40) ? 1 : 2);
        const float* gate = mod + cond * 6144 + gate_i * 1024;
        const float* base = (u.pm < 32) ? bc : bl - (size_t)TCX * D;
        const int col0 = u.pn * 256 + wc * 32 + 4 * fq;
        f32x4 gv[2][2];
#pragma unroll
        for (int bj = 0; bj < 2; ++bj)
#pragma unroll
            for (int n = 0; n < 2; ++n) gv[bj][n] = *(const f32x4*)(gate + col0 + bj * 128 + n * 16);
#pragma unroll
        for (int ai = 0; ai < 2; ++ai)
#pragma unroll
            for (int m = 0; m < 4; ++m) { const size_t off = (size_t)(u.pm * 256 + ai * 128 + wr * 64 + m * 16 + fr) * D + col0;
#pragma unroll
                for (int bj = 0; bj < 2; ++bj)
#pragma unroll
                    for (int n = 0; n < 2; ++n) { const f32x4 b = *(const f32x4*)(base + off + bj * 128 + n * 16); *(f32x4*)(X + off + bj * 128 + n * 16) = b + gv[bj][n] * acc[ai][bj][m][n]; } }
    }
};

#define KEY_STEP(kp, vp, biasv) do { \
    float s_ = 0.f; \
    _Pragma("unroll") for (int c_ = 0; c_ < 8; ++c_) { const v4u kv_ = *(const v4u*)((kp) + 8 * c_); \
        s_ += q[8 * c_ + 0] * bflo(kv_.x) + q[8 * c_ + 1] * bfhi(kv_.x) + q[8 * c_ + 2] * bflo(kv_.y) + q[8 * c_ + 3] * bfhi(kv_.y) \
            + q[8 * c_ + 4] * bflo(kv_.z) + q[8 * c_ + 5] * bfhi(kv_.z) + q[8 * c_ + 6] * bflo(kv_.w) + q[8 * c_ + 7] * bfhi(kv_.w); } \
    s_ = s_ * 0.125f + (biasv); \
    const float mn_ = fmaxf(m, s_), al_ = __expf(m - mn_), p_ = __expf(s_ - mn_); l = l * al_ + p_; m = mn_; \
    _Pragma("unroll") for (int c_ = 0; c_ < 8; ++c_) { const v4u vv_ = *(const v4u*)((vp) + 8 * c_); \
        o[8 * c_ + 0] = o[8 * c_ + 0] * al_ + p_ * bflo(vv_.x); o[8 * c_ + 1] = o[8 * c_ + 1] * al_ + p_ * bfhi(vv_.x); \
        o[8 * c_ + 2] = o[8 * c_ + 2] * al_ + p_ * bflo(vv_.y); o[8 * c_ + 3] = o[8 * c_ + 3] * al_ + p_ * bfhi(vv_.y); \
        o[8 * c_ + 4] = o[8 * c_ + 4] * al_ + p_ * bflo(vv_.z); o[8 * c_ + 5] = o[8 * c_ + 5] * al_ + p_ * bfhi(vv_.z); \
        o[8 * c_ + 6] = o[8 * c_ + 6] * al_ + p_ * bflo(vv_.w); o[8 * c_ + 7] = o[8 * c_ + 7] * al_ + p_ * bfhi(vv_.w); } } while (0)
#define LOAD_Q(qp) do { _Pragma("unroll") for (int c_ = 0; c_ < 8; ++c_) { const v4u qv_ = *(const v4u*)((qp) + 8 * c_); \
        q[8 * c_ + 0] = bflo(qv_.x); q[8 * c_ + 1] = bfhi(qv_.x); q[8 * c_ + 2] = bflo(qv_.y); q[8 * c_ + 3] = bfhi(qv_.y); \
        q[8 * c_ + 4] = bflo(qv_.z); q[8 * c_ + 5] = bfhi(qv_.z); q[8 * c_ + 6] = bflo(qv_.w); q[8 * c_ + 7] = bfhi(qv_.w); } } while (0)

__device__ __forceinline__ void attn_naive_phase(Frame& F) {
    const bf16* QKV = F.P; const float lam = *(const float*)((unsigned char*)F.MOD + MOD_LAM);
    float* DIFFO = F.S; const float* rpb = F.in[17];
    constexpr int ND = 32768, NC = 32768, NB = 65536, NA = 65536, NTASK = ND + NC + NB + NA;
    for (int task = F.bid * NTHR + F.tid; task < NTASK; task += F.G * NTHR) {
        float q[64], o[64]; float m, l;
        if (task < ND || (task >= ND + NC && task < ND + NC + NB)) {
            const bool lat = task < ND; int idx = lat ? task : task - ND - NC;
            int n, b, h, vh;
            if (lat) { n = idx & 2047; idx >>= 11; b = idx & 1; idx >>= 1; h = idx & 3; vh = idx >> 2; }
            else { n = idx & 255; idx >>= 8; b = idx & 31; idx >>= 5; h = idx & 3; vh = idx >> 2; }
            const int row = lat ? TCX + b * 2048 + n : b * 256 + n;
            const int krow0 = lat ? TCX + b * 2048 : b * 256, nk0 = lat ? 2048 : 256, krow1 = T + b * 256, nk1 = lat ? 256 : 0;
            const int vcol = 2560 + h * 128 + vh * 64;
            float o1[64];
#pragma unroll
            for (int c = 0; c < 2; ++c) {
                const int qcol = 1536 + h * 128 + c * 64, kcol = 2048 + h * 128 + c * 64;
                LOAD_Q(QKV + (size_t)row * QLD + qcol);
#pragma unroll
                for (int d = 0; d < 64; ++d) o[d] = 0.f;
                m = -INFINITY; l = 0.f;
                for (int j = 0; j < nk0; ++j) { const bf16* kr = QKV + (size_t)(krow0 + j) * QLD; KEY_STEP(kr + kcol, kr + vcol, 0.f); }
                for (int j = 0; j < nk1; ++j) { const bf16* kr = QKV + (size_t)(krow1 + j) * QLD; KEY_STEP(kr + kcol, kr + vcol, 0.f); }
                const float il = 1.f / l;
                if (c == 0) {
#pragma unroll
                    for (int d = 0; d < 64; ++d) o1[d] = o[d] * il;
                } else {
                    float* dst = DIFFO + (size_t)row * 512 + h * 128 + vh * 64;
#pragma unroll
                    for (int d = 0; d < 64; d += 4) *(f32x4*)(dst + d) = (f32x4){o1[d] - lam * o[d] * il, o1[d + 1] - lam * o[d + 1] * il, o1[d + 2] - lam * o[d + 2] * il, o1[d + 3] - lam * o[d + 3] * il};
                }
            }
        } else {
            const bool lat = task < ND + NC; int idx = lat ? task - ND : task - ND - NC - NB;
            int n, b, h;
            if (lat) { n = idx & 2047; idx >>= 11; b = idx & 1; h = idx >> 1; } else { n = idx & 255; idx >>= 8; b = idx & 31; h = idx >> 5; }
            const int row = lat ? TCX + b * 2048 + n : b * 256 + n;
            const int kcol = 512 + h * 64, vcol = 1024 + h * 64;
            LOAD_Q(QKV + (size_t)row * QLD + h * 64);
#pragma unroll
            for (int d = 0; d < 64; ++d) o[d] = 0.f;
            m = -INFINITY; l = 0.f;
            if (lat) {
                const int r = n >> 6, qc = n & 63; const int rs = min(max(r - 4, 0), 24), cs = min(max(qc - 8, 0), 48);
                for (int i = 0; i < 8; ++i) for (int cc = 0; cc < 16; ++cc) { const int kr_ = rs + i, kc = cs + cc;
                    const bf16* kr = QKV + (size_t)(TCX + b * 2048 + kr_ * 64 + kc) * QLD; const float bias = rpb[h * 465 + (kr_ - r + 7) * 31 + (kc - qc + 15)];
                    KEY_STEP(kr + kcol, kr + vcol, bias); }
                for (int j = 0; j < 256; ++j) { const bf16* kr = QKV + (size_t)(T + b * 256 + j) * QLD; KEY_STEP(kr + kcol, kr + vcol, 0.f); }
            } else {
                for (int j = 0; j < 256; ++j) { const bf16* kr = QKV + (size_t)(b * 256 + j) * QLD; KEY_STEP(kr + kcol, kr + vcol, 0.f); }
            }
            const float il = 1.f / l; bf16* dst = F.MIX + (size_t)row * D + h * 64;
#pragma unroll
            for (int d = 0; d < 64; d += 8) { v4u w; w.x = pk2(o[d] * il, o[d + 1] * il); w.y = pk2(o[d + 2] * il, o[d + 3] * il); w.z = pk2(o[d + 4] * il, o[d + 5] * il); w.w = pk2(o[d + 6] * il, o[d + 7] * il); *(v4u*)(dst + d) = w; }
        }
    }
}
__device__ __forceinline__ void diff_post_phase(Frame& F) {
    const int gw = F.bid * NWAVES + F.wave, NGW = F.G * NWAVES; const float* DIFFO = F.S;
    for (int it = gw; it < T * 4; it += NGW) { const int row = it >> 2, h = it & 3;
        const f32x2v v = *(const f32x2v*)(DIFFO + (size_t)row * 512 + h * 128 + 2 * F.lane);
        const float r = rsqrtf(wave_sum(v.x * v.x + v.y * v.y) * (1.f / 128.f) + 1e-6f) * 0.8f;
        *(unsigned*)(F.MIX + (size_t)row * D + 512 + h * 128 + 2 * F.lane) = pk2(v.x * r, v.y * r); }
}

typedef short bf16x8 __attribute__((ext_vector_type(8)));
typedef short s16x4 __attribute__((ext_vector_type(4)));
constexpr float LOG2E = 1.4426950408889634f;
__device__ __forceinline__ s16x4 tr_read(LAS unsigned char* p) { return __builtin_bit_cast(s16x4, __builtin_amdgcn_ds_read_tr16_b64_v4i16((LAS s16x4*)p)); }

template <int KIND>
__device__ __forceinline__ void attn_unit(Frame& F, int u) {
    constexpr bool DIFF = (KIND & 1) != 0;
    constexpr int DV = DIFF ? 128 : 64, NC = DV / 16, VSTR = DIFF ? 288 : 160, KSTR = 144;
    constexpr int K0_OFF = 0, K1_OFF = 9216, V_OFF = 18432, X_OFF = 40960, XSTR = 132, RPB_OFF = 110592;
    const int tid = F.tid, lane = F.lane, wave = F.wave, q16 = lane & 15, g = lane >> 4;
    LAS unsigned char* lds = F.lds;
    const bf16* QKV = F.P;
    int b, h, qrow0, ntiles, nW = 0, R0k = 0;
    if (KIND == 0) { b = u >> 3; h = u & 7; qrow0 = b * 256; ntiles = 4; }
    else if (KIND == 1) { const int half = u & 1; h = (u >> 1) & 3; b = u >> 3; qrow0 = b * 256 + half * 128; ntiles = 4; }
    else if (KIND == 2) { const int R = u & 7; h = (u >> 3) & 7; b = u >> 6; qrow0 = TCX + b * 2048 + R * 256; R0k = min(max(4 * R - 4, 0), 24); nW = min(max(4 * R - 1, 0), 24) + 8 - R0k; ntiles = nW + 4; }
    else { const int qb = u & 15; h = (u >> 4) & 3; b = u >> 6; qrow0 = TCX + b * 2048 + qb * 128; ntiles = 36; }
    const int sidx = DIFF ? (wave >> 2) : 0;
    const int wq = DIFF ? (wave & 3) * 32 : wave * 32;
    const int qcol = DIFF ? 1536 + h * 128 + sidx * 64 : h * 64;
    const int kcol0 = DIFF ? 2048 + h * 128 : 512 + h * 64;
    const int vcol = DIFF ? 2560 + h * 128 : 1024 + h * 64;
#define KROW(ti) ((KIND <= 1) ? (b * 256 + 64 * (ti)) : (KIND == 2) ? (((ti) < nW) ? (TCX + b * 2048 + (R0k + (ti)) * 64) : (T + b * 256 + 64 * ((ti) - nW))) : (((ti) < 32) ? (TCX + b * 2048 + 64 * (ti)) : (T + b * 256 + 64 * ((ti) - 32))))
    v4u rk0, rk1, rv0, rv1;
#define LOAD_TILE(ti) do { const bf16* rp_ = QKV + (size_t)(KROW(ti) + (tid >> 3)) * QLD + 8 * (tid & 7); rk0 = *(const v4u*)(rp_ + kcol0); rv0 = *(const v4u*)(rp_ + vcol); \
        if (DIFF) { rk1 = *(const v4u*)(rp_ + kcol0 + 64); rv1 = *(const v4u*)(rp_ + vcol + 64); } } while (0)
#define STORE_TILE() do { const int row_ = tid >> 3, ch_ = tid & 7; const int prow_ = (row_ & 39) | ((row_ & 8) << 1) | ((row_ & 16) >> 1); \
        *(LAS v4u*)(lds + K0_OFF + prow_ * KSTR + ch_ * 16) = rk0; *(LAS v4u*)(lds + V_OFF + row_ * VSTR + ch_ * 16) = rv0; \
        if (DIFF) { *(LAS v4u*)(lds + K1_OFF + prow_ * KSTR + ch_ * 16) = rk1; *(LAS v4u*)(lds + V_OFF + row_ * VSTR + 128 + ch_ * 16) = rv1; } } while (0)
    LAS float* rpbL = (LAS float*)(lds + RPB_OFF);
    if (KIND == 2) { __syncthreads(); if (tid < 465) rpbL[tid] = F.in[17][h * 465 + tid] * LOG2E; }
    bf16x8 qf[2][2];
#pragma unroll
    for (int grp = 0; grp < 2; ++grp)
#pragma unroll
        for (int kd = 0; kd < 2; ++kd) qf[grp][kd] = *(const bf16x8*)(QKV + (size_t)(qrow0 + wq + 16 * grp + q16) * QLD + qcol + 32 * kd + 8 * g);
    f32x4 o[2][NC];
#pragma unroll
    for (int grp = 0; grp < 2; ++grp)
#pragma unroll
        for (int c = 0; c < NC; ++c) o[grp][c] = (f32x4){0.f, 0.f, 0.f, 0.f};
    float mrun[2] = {-1e30f, -1e30f}, lsum[2] = {0.f, 0.f};
    const int wr_ = (KIND == 2) ? (((qrow0 - TCX) & 2047) >> 6) + (wave >> 1) : 0;
    const int wrs = min(max(wr_ - 4, 0), 24);
    const int koff = (DIFF && sidx) ? K1_OFF : K0_OFF;
    constexpr float C1 = 0.125f * LOG2E;
    LOAD_TILE(0);
    for (int ti = 0; ti < ntiles; ++ti) {
        __syncthreads();
        STORE_TILE();
        __syncthreads();
        if (ti + 1 < ntiles) LOAD_TILE(ti + 1);
        bool active = true; int krow_g = 0; bool win = false;
        if (KIND == 2) { win = ti < nW; krow_g = R0k + ti; active = (!win) || (krow_g >= wrs && krow_g < wrs + 8); }
        if (active) {
            f32x4 s[2][2][2];
#pragma unroll
            for (int ks = 0; ks < 2; ++ks)
#pragma unroll
                for (int t = 0; t < 2; ++t) {
                    s[0][ks][t] = (f32x4){0.f, 0.f, 0.f, 0.f}; s[1][ks][t] = (f32x4){0.f, 0.f, 0.f, 0.f};
#pragma unroll
                    for (int kd = 0; kd < 2; ++kd) { const bf16x8 kf = *(const LAS bf16x8*)(lds + koff + (32 * ks + 16 * t + q16) * KSTR + 64 * kd + 16 * g);
                        s[0][ks][t] = __builtin_amdgcn_mfma_f32_16x16x32_bf16(kf, qf[0][kd], s[0][ks][t], 0, 0, 0);
                        s[1][ks][t] = __builtin_amdgcn_mfma_f32_16x16x32_bf16(kf, qf[1][kd], s[1][ks][t], 0, 0, 0); }
                }
            bf16x8 pf[2][2];
#pragma unroll
            for (int grp = 0; grp < 2; ++grp) {
                float tv[2][2][4];
                if (KIND == 2 && win) {
                    const int qc = (wave & 1) * 32 + 16 * grp + q16, cs = min(max(qc - 8, 0), 48); const LAS float* brow = rpbL + (krow_g - wr_ + 7) * 31 + 15 - qc;
#pragma unroll
                    for (int ks = 0; ks < 2; ++ks)
#pragma unroll
                        for (int t = 0; t < 2; ++t)
#pragma unroll
                            for (int e = 0; e < 4; ++e) { const int kc = 32 * ks + 16 * (g >> 1) + 8 * t + 4 * (g & 1) + e; const bool ok = (unsigned)(kc - cs) < 16u;
                                tv[ks][t][e] = ok ? s[grp][ks][t][e] * C1 + brow[kc] : -1e30f; }
                } else {
#pragma unroll
                    for (int ks = 0; ks < 2; ++ks)
#pragma unroll
                        for (int t = 0; t < 2; ++t)
#pragma unroll
                            for (int e = 0; e < 4; ++e) tv[ks][t][e] = s[grp][ks][t][e] * C1;
                }
                float tmax = -1e30f;
#pragma unroll
                for (int ks = 0; ks < 2; ++ks)
#pragma unroll
                    for (int t = 0; t < 2; ++t)
#pragma unroll
                        for (int e = 0; e < 4; ++e) tmax = fmaxf(tmax, tv[ks][t][e]);
                tmax = fmaxf(tmax, __shfl_xor(tmax, 16)); tmax = fmaxf(tmax, __shfl_xor(tmax, 32));
                const float mn = fmaxf(mrun[grp], tmax), al = __builtin_amdgcn_exp2f(mrun[grp] - mn); mrun[grp] = mn;
                float ps = 0.f;
#pragma unroll
                for (int ks = 0; ks < 2; ++ks) {
                    float p[8];
#pragma unroll
                    for (int t = 0; t < 2; ++t)
#pragma unroll
                        for (int e = 0; e < 4; ++e) { p[4 * t + e] = __builtin_amdgcn_exp2f(tv[ks][t][e] - mn); ps += p[4 * t + e]; }
                    v4u w; w.x = pg8::cvt_pk_bf16(p[0], p[1]); w.y = pg8::cvt_pk_bf16(p[2], p[3]); w.z = pg8::cvt_pk_bf16(p[4], p[5]); w.w = pg8::cvt_pk_bf16(p[6], p[7]);
                    pf[grp][ks] = __builtin_bit_cast(bf16x8, w);
                }
                lsum[grp] = lsum[grp] * al + ps;
#pragma unroll
                for (int c = 0; c < NC; ++c) o[grp][c] = o[grp][c] * al;
            }
#pragma unroll
            for (int ks = 0; ks < 2; ++ks)
#pragma unroll
                for (int c = 0; c < NC; ++c) {
                    LAS unsigned char* vb = lds + V_OFF + (32 * ks + 16 * (g >> 1) + 4 * (g & 1) + (q16 >> 2)) * VSTR + (16 * c + 4 * (lane & 3)) * 2;
                    const s16x4 v0 = tr_read(vb), v1 = tr_read(vb + 8 * VSTR);
                    const bf16x8 vf = (bf16x8){v0[0], v0[1], v0[2], v0[3], v1[0], v1[1], v1[2], v1[3]};
                    o[0][c] = __builtin_amdgcn_mfma_f32_16x16x32_bf16(vf, pf[0][ks], o[0][c], 0, 0, 0);
                    o[1][c] = __builtin_amdgcn_mfma_f32_16x16x32_bf16(vf, pf[1][ks], o[1][c], 0, 0, 0);
                }
        }
    }
    float inv[2];
#pragma unroll
    for (int grp = 0; grp < 2; ++grp) { float l = lsum[grp]; l += __shfl_xor(l, 16); l += __shfl_xor(l, 32); inv[grp] = 1.f / l; }
    if (!DIFF) {
#pragma unroll
        for (int grp = 0; grp < 2; ++grp) { bf16* dst = F.MIX + (size_t)(qrow0 + wq + 16 * grp + q16) * D + h * 64 + 4 * g;
#pragma unroll
            for (int c = 0; c < NC; ++c) { const f32x4 v = o[grp][c] * inv[grp]; v2u w; w.x = pg8::cvt_pk_bf16(v[0], v[1]); w.y = pg8::cvt_pk_bf16(v[2], v[3]); *(v2u*)(dst + 16 * c) = w; } }
    } else {
        const float lam = *(const float*)((unsigned char*)F.MOD + MOD_LAM);
        LAS float* X = (LAS float*)(lds + X_OFF);
        if (sidx == 1) {
#pragma unroll
            for (int grp = 0; grp < 2; ++grp)
#pragma unroll
                for (int c = 0; c < NC; ++c) *(LAS f32x4*)(X + (wq + 16 * grp + q16) * XSTR + 16 * c + 4 * g) = o[grp][c] * inv[grp];
        }
        __syncthreads();
        if (sidx == 0) {
#pragma unroll
            for (int grp = 0; grp < 2; ++grp) {
                float ss = 0.f;
#pragma unroll
                for (int c = 0; c < NC; ++c) { const f32x4 x2 = *(const LAS f32x4*)(X + (wq + 16 * grp + q16) * XSTR + 16 * c + 4 * g); o[grp][c] = o[grp][c] * inv[grp] - x2 * lam;
                    ss += (o[grp][c][0] * o[grp][c][0] + o[grp][c][1] * o[grp][c][1]) + (o[grp][c][2] * o[grp][c][2] + o[grp][c][3] * o[grp][c][3]); }
                ss += __shfl_xor(ss, 16); ss += __shfl_xor(ss, 32);
                const float r = rsqrtf(ss * (1.f / 128.f) + 1e-6f) * 0.8f;
                bf16* dst = F.MIX + (size_t)(qrow0 + wq + 16 * grp + q16) * D + 512 + h * 128 + 4 * g;
#pragma unroll
                for (int c = 0; c < NC; ++c) { const f32x4 v = o[grp][c] * r; v2u w; w.x = pg8::cvt_pk_bf16(v[0], v[1]); w.y = pg8::cvt_pk_bf16(v[2], v[3]); *(v2u*)(dst + 16 * c) = w; }
            }
        }
    }
#undef KROW
#undef LOAD_TILE
#undef STORE_TILE
}
__device__ __forceinline__ void attn_mfma_phase(Frame& F) {
    if (F.G == 256) {
        if (F.bid < 128) attn_unit<3>(F, F.bid);
        else { const int i = F.bid - 128; attn_unit<2>(F, i); attn_unit<1>(F, 2 * i); attn_unit<1>(F, 2 * i + 1); attn_unit<0>(F, 2 * i); attn_unit<0>(F, 2 * i + 1); }
    } else {
        for (int i = F.bid; i < 768; i += F.G) { if (i < 128) attn_unit<3>(F, i); else if (i < 256) attn_unit<2>(F, i - 128); else if (i < 512) attn_unit<1>(F, i - 256); else attn_unit<0>(F, i - 512); }
    }
}

__device__ __forceinline__ void rwkv_job(Frame& F, int seq, int h, int dir) {
    LAS float* L = (LAS float*)F.lds;
    LAS float *WUP = L, *AUP = L + 4096, *Lr = L + 8192, *Lk = Lr + 1024, *Lv = Lk + 1024, *Lwd = Lv + 1024, *Lad = Lwd + 1024, *Lw = Lad + 1024, *La = Lw + 1024, *Lkk = La + 1024, *Lkef = Lkk + 1024, *Lb = Lkef + 1024, *Ly = Lb + 1024;
    const int tid = F.tid, lane = F.lane, w = F.wave;
    const bool lat = seq >= 32; const int b = lat ? seq - 32 : seq, N = lat ? 2048 : 256, R0 = lat ? TCX + b * 2048 : b * 256;
    const bf16* PROJ = F.P; float* Y = F.S;
    __syncthreads();
    for (int idx = tid; idx < 4096; idx += NTHR) { const int j = idx >> 6, k = idx & 63; WUP[idx] = F.in[26][(size_t)(dir * 64 + j) * 512 + h * 64 + k]; AUP[idx] = F.in[28][(size_t)(dir * 64 + j) * 512 + h * 64 + k]; }
    const int i = 8 * w + (lane >> 3), s = lane & 7;
    float S[8];
    {
        const float* st = F.in[7] + (size_t)((b * 2 + dir) * 8 + h) * 4096 + i * 64 + 8 * s;
#pragma unroll
        for (int kk = 0; kk < 8; ++kk) S[kk] = lat ? st[kk] : 0.f;
    }
    for (int t0 = 0; t0 < N; t0 += 16) {
#pragma unroll
        for (int rep = 0; rep < 2; ++rep) { const int idx = tid + NTHR * rep, j = idx >> 6, k = idx & 63; const int n = dir ? N - 1 - (t0 + j) : t0 + j;
            const bf16* pr = PROJ + (size_t)(R0 + n) * NREC;
            Lr[idx] = bf1(pr[2048 + h * 64 + k]); Lk[idx] = bf1(pr[2560 + h * 64 + k]); Lv[idx] = bf1(pr[3072 + h * 64 + k]); Lwd[idx] = tanhf(bf1(pr[3584 + k])); Lad[idx] = bf1(pr[3648 + k]); }
        __syncthreads();
#pragma unroll
        for (int rep = 0; rep < 2; ++rep) { const int idx = tid + NTHR * rep, j = idx >> 6, k = idx & 63;
            float zw = F.in[25][dir * 512 + h * 64 + k], za = F.in[27][dir * 512 + h * 64 + k];
#pragma unroll 8
            for (int jj = 0; jj < 64; ++jj) { zw += Lwd[j * 64 + jj] * WUP[jj * 64 + k]; za += Lad[j * 64 + jj] * AUP[jj * 64 + k]; }
            Lw[idx] = __expf(-0.6065306597f * sigmoidf_(zw)); La[idx] = sigmoidf_(za); }
        if (tid < 256) { const int j = tid >> 4, p = tid & 15; float v[4]; float ss = 0.f;
#pragma unroll
            for (int e = 0; e < 4; ++e) { v[e] = Lk[j * 64 + 4 * p + e] * F.in[30][h * 64 + 4 * p + e]; ss += v[e] * v[e]; }
            ss += __shfl_xor(ss, 1); ss += __shfl_xor(ss, 2); ss += __shfl_xor(ss, 4); ss += __shfl_xor(ss, 8);
            const float rs = rsqrtf(ss + 1e-12f);
#pragma unroll
            for (int e = 0; e < 4; ++e) Lkk[j * 64 + 4 * p + e] = v[e] * rs; }
        __syncthreads();
#pragma unroll
        for (int rep = 0; rep < 2; ++rep) { const int idx = tid + NTHR * rep, k = idx & 63; const float a = La[idx];
            Lkef[idx] = Lk[idx] * (1.f + (a - 1.f) * F.in[31][h * 64 + k]); Lb[idx] = Lkk[idx] * a; }
        __syncthreads();
        for (int j = 0; j < 16; ++j) {
            const int o8 = j * 64 + 8 * s;
            float sa = 0.f;
#pragma unroll
            for (int kk = 0; kk < 8; ++kk) sa -= S[kk] * Lkk[o8 + kk];
            sa += __shfl_xor(sa, 1); sa += __shfl_xor(sa, 2); sa += __shfl_xor(sa, 4);
            const float vi = Lv[j * 64 + i];
            float y = 0.f;
#pragma unroll
            for (int kk = 0; kk < 8; ++kk) { S[kk] = S[kk] * Lw[o8 + kk] + sa * Lb[o8 + kk] + vi * Lkef[o8 + kk]; y += S[kk] * Lr[o8 + kk]; }
            y += __shfl_xor(y, 1); y += __shfl_xor(y, 2); y += __shfl_xor(y, 4);
            if (s == 0) Ly[j * 64 + i] = y;
        }
        __syncthreads();
#pragma unroll
        for (int rep = 0; rep < 2; ++rep) { const int idx = tid + NTHR * rep, j = idx >> 6, k = idx & 63; const int n = dir ? N - 1 - (t0 + j) : t0 + j;
            atomicAdd(Y + (size_t)(R0 + n) * 512 + h * 64 + k, Ly[idx]); }
    }
    if (!lat) { float* so = F.out + O_SRW + (size_t)((b * 2 + dir) * 8 + h) * 4096 + i * 64 + 8 * s;
#pragma unroll
        for (int kk = 0; kk < 8; ++kk) so[kk] = S[kk]; }
}
__device__ __forceinline__ void ret_job(Frame& F, int seq, int h, int dir) {
    LAS float* L = (LAS float*)F.lds;
    LAS float *Lq = L, *Lk = L + 1024, *Lv = L + 2048, *Lo = L + 3072;
    const int tid = F.tid, lane = F.lane, w = F.wave;
    const bool lat = seq >= 32; const int b = lat ? seq - 32 : seq, N = lat ? 2048 : 256, R0 = lat ? TCX + b * 2048 : b * 256;
    const bf16* PROJ = F.P; float* O = F.S + (size_t)T * 512;
    const float g = sigmoidf_(F.in[24][dir * 8 + h]);
    const int e = 8 * w + (lane >> 3), s = lane & 7;
    float S[8];
    {
        const float* st = F.in[6] + (size_t)((b * 2 + dir) * 8 + h) * 4096;
#pragma unroll
        for (int dd = 0; dd < 8; ++dd) S[dd] = lat ? st[(8 * s + dd) * 64 + e] : 0.f;
    }
    __syncthreads();
    for (int t0 = 0; t0 < N; t0 += 16) {
#pragma unroll
        for (int rep = 0; rep < 2; ++rep) { const int idx = tid + NTHR * rep, j = idx >> 6, k = idx & 63; const int n = dir ? N - 1 - (t0 + j) : t0 + j;
            const bf16* pr = PROJ + (size_t)(R0 + n) * NREC;
            Lq[idx] = bf1(pr[h * 64 + k]); Lk[idx] = bf1(pr[512 + h * 64 + k]) * 0.125f; Lv[idx] = bf1(pr[1024 + h * 64 + k]); }
        __syncthreads();
        for (int j = 0; j < 16; ++j) {
            const int o8 = j * 64 + 8 * s; const float ve = Lv[j * 64 + e];
            float o = 0.f;
#pragma unroll
            for (int dd = 0; dd < 8; ++dd) { S[dd] = g * S[dd] + Lk[o8 + dd] * ve; o += Lq[o8 + dd] * S[dd]; }
            o += __shfl_xor(o, 1); o += __shfl_xor(o, 2); o += __shfl_xor(o, 4);
            if (s == 0) Lo[j * 64 + e] = o;
        }
        __syncthreads();
#pragma unroll
        for (int rep = 0; rep < 2; ++rep) { const int idx = tid + NTHR * rep, j = idx >> 6, k = idx & 63; const int n = dir ? N - 1 - (t0 + j) : t0 + j;
            atomicAdd(O + (size_t)(R0 + n) * 512 + h * 64 + k, Lo[idx]); }
        __syncthreads();
    }
    if (!lat) { float* so = F.out + O_SRET + (size_t)((b * 2 + dir) * 8 + h) * 4096;
#pragma unroll
        for (int dd = 0; dd < 8; ++dd) so[(8 * s + dd) * 64 + e] = S[dd]; }
}
__device__ __forceinline__ void run_job(Frame& F, int J) {
    int type, seq, h, dir;
    if (J < 64) { type = J >> 5; const int r = J & 31; seq = 32 + (r >> 4); h = (r >> 1) & 7; dir = r & 1; }
    else { const int r = J - 64; type = r >> 9; const int q = r & 511; seq = q >> 4; h = (q >> 1) & 7; dir = q & 1; }
    if (type == 0) rwkv_job(F, seq, h, dir); else ret_job(F, seq, h, dir);
}
__device__ __forceinline__ void scan_phase(Frame& F) {
    if (F.G > 128) { if (F.bid < 64) run_job(F, F.bid); else for (int J = 64 + (F.bid - 64); J < 1088; J += F.G - 64) run_job(F, J); }
    else for (int J = F.bid; J < 1088; J += F.G) run_job(F, J);
}
__device__ __forceinline__ void rec_post_phase(Frame& F) {
    LAS float* sg = (LAS float*)F.lds + F.wave * 128;
    const int gw = F.bid * NWAVES + F.wave, NGW = F.G * NWAVES, lane = F.lane;
    const bf16* PROJ = F.P; const float* Y = F.S; const float* O = F.S + (size_t)T * 512;
    for (int row = gw; row < T; row += NGW) {
        const bf16* pr = PROJ + (size_t)row * NREC;
        sg[lane] = sigmoidf_(bf1(pr[3712 + lane])); sg[64 + lane] = sigmoidf_(bf1(pr[3776 + lane]));
        asm volatile("s_waitcnt lgkmcnt(0)" ::: "memory");
        for (int h = 0; h < 8; ++h) {
            const int c = h * 64 + lane;
            const float y = Y[(size_t)row * 512 + c];
            const float mu = wave_sum(y) * (1.f / 64.f), dl = y - mu, var = wave_sum(dl * dl) * (1.f / 64.f);
            const float yn = dl * rsqrtf(var + 64e-5f) * F.in[33][c] + F.in[34][c];
            const float r = bf1(pr[2048 + c]), k = bf1(pr[2560 + c]), v = bf1(pr[3072 + c]);
            const float bonus = wave_sum(r * F.in[32][c] * k) * v;
            float g = 0.f;
#pragma unroll 8
            for (int j = 0; j < 128; ++j) g += sg[j] * F.in[29][(size_t)j * 512 + c];
            F.MIX[(size_t)row * D + 512 + c] = (bf16)f2bf((yn + bonus) * g);
        }
        for (int h = 0; h < 8; ++h) {
            const int c = h * 64 + lane;
            const float o = O[(size_t)row * 512 + c];
            const float on = o * rsqrtf(wave_sum(o * o) * (1.f / 64.f) + 1e-6f);
            const float xg = bf1(pr[1536 + c]);
            F.MIX[(size_t)row * D + c] = (bf16)f2bf(xg * sigmoidf_(xg) * on);
        }
        asm volatile("s_waitcnt lgkmcnt(0)" ::: "memory");
    }
}

#ifndef ATTN_MFMA
#define ATTN_MFMA 1
#endif
enum { PH_BASE = __COUNTER__ };
struct Args { const float* in[37]; float* out; unsigned char* ws; int ph_lo, ph_hi; };

template <bool COOP>
__global__ void __launch_bounds__(NTHR, 2) mk_fwd(Args args) {
    extern __shared__ __attribute__((aligned(16))) unsigned char lds[];
    Frame F;
    F.lds = (LAS unsigned char*)lds;
    F.tid = threadIdx.x; F.lane = F.tid & 63; F.wave = __builtin_amdgcn_readfirstlane(F.tid >> 6); F.G = gridDim.x; F.bid = blockIdx.x;
#pragma unroll
    for (int i = 0; i < 37; ++i) F.in[i] = args.in[i];
    F.out = args.out; F.ws = args.ws;
    unsigned char* ws = args.ws;
    F.Watt = (bf16*)(ws + WS_WATT); F.Woa = (bf16*)(ws + WS_WOA); F.Wrec = (bf16*)(ws + WS_WREC); F.Wor = (bf16*)(ws + WS_WOR); F.Wf1 = (bf16*)(ws + WS_WF1); F.Wf2 = (bf16*)(ws + WS_WF2);
    F.H = (bf16*)(ws + WS_H); F.MIX = (bf16*)(ws + WS_MIX); F.P = (bf16*)(ws + WS_P); F.MOD = (float*)(ws + WS_MOD); F.S = (float*)(ws + WS_S);
    const int lo = args.ph_lo, hi = args.ph_hi;
#define IN(k) (lo <= (k) && (k) < hi)
#define SEAM(k) do { if (COOP && IN((k) + 1)) { cooperative_groups::this_grid().sync(); } } while (0)
    const f32x2v* rope = (const f32x2v*)((unsigned char*)F.MOD + MOD_ROPE);

#define PHASE(...) { constexpr int k_ = __COUNTER__ - PH_BASE - 1; if (IN(k_)) { __VA_ARGS__; SEAM(k_); } }
    PHASE(p0_prologue(F))
    PHASE(norm_phase(F, F.in[0], F.in[1], F.in[10], F.MOD, 0, 1, false))
    PHASE(pg8::Gemm g{F.H, F.Watt, T, NATT, D}; pg8::StaticOrder S; S.init(T, NATT, F.G, F.bid); EpiAttnIn E{F.P, F.out, rope};
          pg8::gemm_phase<EpiAttnIn, pg8::StaticOrder, true, true>(F.lds, g, S, E))
#if ATTN_MFMA
    PHASE(attn_mfma_phase(F))
#else
    PHASE(attn_naive_phase(F))
    PHASE(diff_post_phase(F))
#endif
    PHASE(pg8::Gemm g{F.MIX, F.Woa, T, D, D}; pg8::StaticOrder S; S.init(T, D, F.G, F.bid); EpiResid E{F.in[0], F.in[1], F.out, F.MOD, 2};
          pg8::gemm_phase<EpiResid, pg8::StaticOrder, true, true>(F.lds, g, S, E))
    PHASE(norm_phase(F, F.out, F.out + (size_t)TCX * D, F.in[11], F.MOD, 3, 4, false))
    PHASE(pg8::Gemm g{F.H, F.Wf1, T, NFF, D}; pg8::StaticOrder S; S.init(T, NFF, F.G, F.bid); EpiSwiglu E{F.P};
          pg8::gemm_phase<EpiSwiglu, pg8::StaticOrder, true, true>(F.lds, g, S, E))
    PHASE(pg8::Gemm g{F.P, F.Wf2, T, D, DFF}; pg8::StaticOrder S; S.init(T, D, F.G, F.bid); EpiResid E{F.out, F.out + (size_t)TCX * D, F.out, F.MOD, 5};
          pg8::gemm_phase<EpiResid, pg8::StaticOrder, true, true>(F.lds, g, S, E))
    PHASE(norm_phase(F, F.out, F.out + (size_t)TCX * D, F.in[10] + D, F.MOD + 3 * 6144, 0, 1, true))
    PHASE(pg8::Gemm g{F.H, F.Wrec, T, NREC, D}; pg8::StaticOrder S; S.init(T, NREC, F.G, F.bid); EpiBf16Plain E{F.P, NREC};
          pg8::gemm_phase<EpiBf16Plain, pg8::StaticOrder, true, true>(F.lds, g, S, E))
    PHASE(scan_phase(F))
    PHASE(rec_post_phase(F))
    PHASE(pg8::Gemm g{F.MIX, F.Wor, T, D, D}; pg8::StaticOrder S; S.init(T, D, F.G, F.bid); EpiResid E{F.out, F.out + (size_t)TCX * D, F.out, F.MOD + 3 * 6144, 2};
          pg8::gemm_phase<EpiResid, pg8::StaticOrder, true, true>(F.lds, g, S, E))
    PHASE(norm_phase(F, F.out, F.out + (size_t)TCX * D, F.in[11] + D, F.MOD + 3 * 6144, 3, 4, false))
    PHASE(pg8::Gemm g{F.H, F.Wf1 + WF1_STRIDE, T, NFF, D}; pg8::StaticOrder S; S.init(T, NFF, F.G, F.bid); EpiSwiglu E{F.P};
          pg8::gemm_phase<EpiSwiglu, pg8::StaticOrder, true, true>(F.lds, g, S, E))
    PHASE(pg8::Gemm g{F.P, F.Wf2 + WF2_STRIDE, T, D, DFF}; pg8::StaticOrder S; S.init(T, D, F.G, F.bid); EpiResid E{F.out, F.out + (size_t)TCX * D, F.out, F.MOD + 3 * 6144, 5};
          pg8::gemm_phase<EpiResid, pg8::StaticOrder, true, true>(F.lds, g, S, E))
    PHASE(final_norm_phase(F))
#undef PHASE
#undef IN
#undef SEAM
}

constexpr int NPHASE = __COUNTER__ - PH_BASE - 1;
#ifndef MK_N_LAUNCHES
#define MK_N_LAUNCHES 1
#endif
extern "C" void kernel_launch(void* const* d_in, const int* in_sizes, int n_in, void* d_out, int out_size, void* d_ws, size_t ws_size, hipStream_t stream) {
    static int grid = 0;
    if (grid == 0) {
        if (n_in != 37 || out_size != 33554432 || ws_size < WS_END) { fprintf(stderr, "kernel_launch: unexpected problem (n_in %d out %d ws %zu)\n", n_in, out_size, ws_size); grid = -1; return; }
        int dev = 0, cus = 0, per_cu = 0;
        if (hipGetDevice(&dev) != hipSuccess || hipDeviceGetAttribute(&cus, hipDeviceAttributeMultiprocessorCount, dev) != hipSuccess) { grid = -1; return; }
        (void)hipFuncSetAttribute((const void*)mk_fwd<false>, hipFuncAttributeMaxDynamicSharedMemorySize, LDS_BYTES);
        (void)hipFuncSetAttribute((const void*)mk_fwd<true>, hipFuncAttributeMaxDynamicSharedMemorySize, LDS_BYTES);
        if (hipOccupancyMaxActiveBlocksPerMultiprocessor(&per_cu, (const void*)mk_fwd<true>, NTHR, LDS_BYTES) != hipSuccess || per_cu < 1) per_cu = 1;
        (void)hipGetLastError();
        grid = cus;
    }
    if (grid < 0) return;
    Args a{};
    for (int i = 0; i < 37; ++i) a.in[i] = (const float*)d_in[i];
    a.out = (float*)d_out; a.ws = (unsigned char*)d_ws;
#if MK_N_LAUNCHES == 1
    a.ph_lo = 0; a.ph_hi = NPHASE;
    void* kargs[] = {&a};
    hipError_t e = hipLaunchCooperativeKernel((const void*)mk_fwd<true>, dim3(grid), dim3(NTHR), kargs, LDS_BYTES, stream);
    if (e != hipSuccess) fprintf(stderr, "cooperative launch failed: %s (grid %d)\n", hipGetErrorString(e), grid);
#else
    for (int ph = 0; ph < NPHASE; ++ph) { a.ph_lo = ph; a.ph_hi = ph + 1; hipLaunchKernelGGL(mk_fwd<false>, dim3(grid), dim3(NTHR), LDS_BYTES, stream, a); }
#endif
}
```

```cpp
#include <hip/hip_runtime.h>
#include <hip/hip_cooperative_groups.h>
#include <cstdio>
#include <cstdint>
namespace pg8 {
#define PG8_LAS __attribute__((address_space(3)))
typedef unsigned short bf16_t;
typedef short bf16x8 __attribute__((ext_vector_type(8)));
typedef float f32x4 __attribute__((ext_vector_type(4)));
typedef unsigned u32x4 __attribute__((ext_vector_type(4)));
constexpr int BM = 256, BK = 64, HALF = 128, HTB = HALF * BK * 2  , STAGE_BYTES = 8 * HTB, NXCD = 8, WGM = 8;

__host__ __device__ __forceinline__ int lds_byte(int r, int c) { const int st = (r >> 4) * 2 + (c >> 5), rr = r & 15, cc = c & 31, ob = rr * 64 + cc * 2; return st * 1024 + (ob ^ (((ob >> 9) & 1) << 5)); }
__host__ __device__ __forceinline__ void stage_rc(int b, int& R, int& C) { const int st = b / 1024, sb = b % 1024, swz = sb ^ (((sb >> 9) & 1) << 5); R = (st >> 1) * 16 + swz / 64; C = (st & 1) * 32 + (swz % 64) / 2; }
__host__ __device__ __forceinline__ int perm32(int rho) { const int n = rho >> 4, i = rho & 15; return 8 * (i >> 2) + 4 * n + (i & 3); }

struct Unit { int pm, pn; };
struct Gemm { const bf16_t* A; const bf16_t* Bt; int M, N, K; };

struct StaticOrder {
    int nM, nN, nwg, G, c;
    __host__ __device__ void init(int M, int N, int G_, int c_) { nM = M / BM; nN = N / BM; nwg = nM * nN; G = G_; c = c_; }
    __host__ __device__ bool next(int i, Unit& u) const {
        const long L = (long)i * G + c; if (L >= nwg) return false;
        int wgid = (int)L; { const int q = nwg / NXCD, r = nwg % NXCD, xcd = wgid % NXCD, off = wgid / NXCD; wgid = (xcd < r ? xcd * (q + 1) : r * (q + 1) + (xcd - r) * q) + off; }
        const int nig = WGM * nN, gid = wgid / nig, fm = gid * WGM, gsz = (nM - fm) < WGM ? (nM - fm) : WGM;
        u.pm = fm + ((wgid % nig) % gsz); u.pn = (wgid % nig) / gsz; return true;
    }
    __device__ __forceinline__ void a_ready(const Unit&) const {}
    __device__ __forceinline__ void done(const Unit&) const {}
};
__device__ __forceinline__ unsigned cvt_pk_bf16(float lo, float hi) { unsigned r; asm volatile("v_cvt_pk_bf16_f32 %0, %1, %2" : "=v"(r) : "v"(lo), "v"(hi)); return r; }
typedef float f32x2 __attribute__((ext_vector_type(2)));
template <class Epi, class Sched, bool ALIGN_EPI = false, bool SP2 = false>
__device__ __forceinline__ void gemm_phase(PG8_LAS unsigned char* lds, const Gemm g, const Sched& S, const Epi& E) {
    const int tid = threadIdx.x, wid = __builtin_amdgcn_readfirstlane(tid >> 6), lane = tid & 63, wr = wid >> 2, wc = wid & 3, fr = lane & 15, fq = lane >> 4;
    const int K = g.K, nt = K / BK;
    unsigned voffA[2], voffB[2];
#pragma unroll
    for (int i = 0; i < 2; ++i) { int R, C; stage_rc(tid * 16 + i * 8192, R, C); const int Rb = Epi::PERM ? ((R & ~31) + perm32(R & 31)) : R;
        voffA[i] = (unsigned)(R * K + C) * 2u; voffB[i] = (unsigned)(Rb * K + C) * 2u; }
    const size_t kstep = (size_t)(BK * 2);
    const size_t hstep = (size_t)HALF * K * 2;
    const size_t tstep = 2 * hstep;
    const unsigned ldsw = (unsigned)wid * 1024u;
    const int aoff = lds_byte(wr * 64 + fr, fq * 8), boff = lds_byte(wc * 32 + fr, fq * 8);
#define PG8_SA(b, h) (((b) * 2 + (h)) * HTB)
#define PG8_SB(b, h) ((4 + (b) * 2 + (h)) * HTB)
#define PG8_STAGE(bufoff, gbase, voff) do { _Pragma("unroll") for (int _i = 0; _i < 2; ++_i) \
        __builtin_amdgcn_global_load_lds((const unsigned*)((const char*)(gbase) + (voff)[_i]), (PG8_LAS unsigned*)(lds + (bufoff) + ldsw + _i * 8192), 16, 0, 0); } while (0)
#define PG8_LDA(dst, b, h) do { _Pragma("unroll") for (int m = 0; m < 4; ++m) _Pragma("unroll") for (int k = 0; k < 2; ++k) dst[m][k] = *(const PG8_LAS bf16x8*)(lds + PG8_SA(b, h) + aoff + m * 2048 + k * 1024); } while (0)
#define PG8_LDB(dst, b, h) do { _Pragma("unroll") for (int n = 0; n < 2; ++n) _Pragma("unroll") for (int k = 0; k < 2; ++k) dst[n][k] = *(const PG8_LAS bf16x8*)(lds + PG8_SB(b, h) + boff + n * 2048 + k * 1024); } while (0)
#define PG8_MMA(ai, bj, At, Bt) do { __builtin_amdgcn_s_setprio(1); _Pragma("unroll") for (int m = 0; m < 4; ++m) _Pragma("unroll") for (int n = 0; n < 2; ++n) _Pragma("unroll") for (int k = 0; k < 2; ++k) \
        acc[ai][bj][m][n] = __builtin_amdgcn_mfma_f32_16x16x32_bf16(Bt[n][k], At[m][k], acc[ai][bj][m][n], 0, 0, 0); __builtin_amdgcn_s_setprio(0); } while (0)
#define PG8_WAIT_V(n) asm volatile("s_waitcnt vmcnt(" #n ")" ::: "memory")
#define PG8_WAIT_L(n) asm volatile("s_waitcnt lgkmcnt(" #n ")" ::: "memory")
#define PG8_BAR __builtin_amdgcn_s_barrier()
#define PG8_SCHED __builtin_amdgcn_sched_barrier(0)
    Unit cur, nxt; int ui = 0;
    if (!S.next(0, cur)) return;
    f32x4 acc[2][2][4][2];
#pragma unroll
    for (int a = 0; a < 2; ++a)
#pragma unroll
        for (int b = 0; b < 2; ++b)
#pragma unroll
            for (int m = 0; m < 4; ++m)
#pragma unroll
                for (int n = 0; n < 2; ++n) acc[a][b][m][n] = (f32x4){0.f, 0.f, 0.f, 0.f};
    bf16x8 At[4][2], B0[2][2], B1[2][2];
    const char* cA = (const char*)g.A + (size_t)cur.pm * tstep; const char* cB = (const char*)g.Bt + (size_t)cur.pn * tstep;
    S.a_ready(cur);
    if constexpr (SP2) {
        PG8_STAGE(PG8_SB(0, 0), cB, voffB); PG8_STAGE(PG8_SB(0, 1), cB + hstep, voffB); PG8_STAGE(PG8_SA(0, 0), cA, voffA); PG8_STAGE(PG8_SA(0, 1), cA + hstep, voffA);
        if (wr == 1) PG8_BAR;
        PG8_WAIT_V(2); PG8_BAR;
        PG8_STAGE(PG8_SB(1, 0), cB + kstep, voffB); PG8_STAGE(PG8_SA(1, 0), cA + kstep, voffA); PG8_STAGE(PG8_SB(1, 1), cB + hstep + kstep, voffB);
        PG8_WAIT_V(6); PG8_BAR;
    } else {
        PG8_STAGE(PG8_SB(0, 0), cB, voffB); PG8_STAGE(PG8_SA(0, 0), cA, voffA); PG8_STAGE(PG8_SB(0, 1), cB + hstep, voffB); PG8_STAGE(PG8_SA(0, 1), cA + hstep, voffA);
        if (wr == 1) PG8_BAR;
        PG8_WAIT_V(4); PG8_BAR;
        PG8_STAGE(PG8_SB(1, 0), cB + kstep, voffB); PG8_STAGE(PG8_SA(1, 0), cA + kstep, voffA); PG8_STAGE(PG8_SB(1, 1), cB + hstep + kstep, voffB);
        PG8_WAIT_V(6); PG8_BAR;
    }
    for (;;) {
        const bool has_next = S.next(ui + 1, nxt);
        const char* nA = has_next ? (const char*)g.A + (size_t)nxt.pm * tstep : cA; const char* nB = has_next ? (const char*)g.Bt + (size_t)nxt.pn * tstep : cB;
        for (int t = 0; t < nt; t += 2) {
            const bool last = (t == nt - 2);
            const char* a1 = cA + (size_t)(t + 1) * kstep;
            const char* a2 = last ? nA : cA + (size_t)(t + 2) * kstep; const char* b2 = last ? nB : cB + (size_t)(t + 2) * kstep;
            const char* a3 = a2 + kstep; const char* b3 = b2 + kstep;
            if (last && has_next) S.a_ready(nxt);
            if constexpr (SP2) {
            PG8_LDB(B0, 0, 0); PG8_LDB(B1, 0, 1); PG8_SCHED; PG8_LDA(At, 0, 0); PG8_STAGE(PG8_SA(1, 1), a1 + hstep, voffA);
            PG8_WAIT_V(8); PG8_WAIT_L(0); PG8_BAR; PG8_MMA(0, 0, At, B0); PG8_MMA(0, 1, At, B1); PG8_BAR; PG8_SCHED;
            PG8_LDA(At, 0, 1); PG8_STAGE(PG8_SB(0, 0), b2, voffB); PG8_STAGE(PG8_SB(0, 1), b2 + hstep, voffB); PG8_STAGE(PG8_SA(0, 0), a2, voffA);
            PG8_WAIT_V(8); PG8_WAIT_L(0); PG8_BAR; PG8_MMA(1, 0, At, B0); PG8_MMA(1, 1, At, B1); PG8_BAR; PG8_SCHED;
            PG8_LDB(B0, 1, 0); PG8_LDB(B1, 1, 1); PG8_SCHED; PG8_LDA(At, 1, 0); PG8_STAGE(PG8_SA(0, 1), a2 + hstep, voffA);
            PG8_WAIT_V(8); PG8_WAIT_L(0); PG8_BAR; PG8_MMA(0, 0, At, B0); PG8_MMA(0, 1, At, B1); PG8_BAR; PG8_SCHED;
            PG8_LDA(At, 1, 1); PG8_STAGE(PG8_SB(1, 0), b3, voffB); PG8_STAGE(PG8_SB(1, 1), b3 + hstep, voffB); PG8_STAGE(PG8_SA(1, 0), a3, voffA);
            PG8_WAIT_V(8); PG8_WAIT_L(0); PG8_BAR; PG8_MMA(1, 0, At, B0); PG8_MMA(1, 1, At, B1); PG8_BAR; PG8_SCHED;
            } else {
            PG8_LDB(B0, 0, 0); PG8_SCHED; PG8_LDA(At, 0, 0); PG8_STAGE(PG8_SA(1, 1), a1 + hstep, voffA);
            PG8_WAIT_L(8); PG8_BAR; PG8_WAIT_L(0); PG8_MMA(0, 0, At, B0); PG8_BAR; PG8_SCHED;
            PG8_LDB(B1, 0, 1); PG8_STAGE(PG8_SB(0, 0), b2, voffB);
            PG8_BAR; PG8_WAIT_L(0); PG8_MMA(0, 1, At, B1); PG8_BAR;
            PG8_LDA(At, 0, 1); PG8_STAGE(PG8_SA(0, 0), a2, voffA);
            PG8_BAR; PG8_WAIT_L(0); PG8_MMA(1, 0, At, B0); PG8_BAR; PG8_SCHED;
            PG8_STAGE(PG8_SB(0, 1), b2 + hstep, voffB);
            PG8_WAIT_V(6); PG8_BAR; PG8_MMA(1, 1, At, B1); PG8_BAR;
            PG8_LDB(B0, 1, 0); PG8_SCHED; PG8_LDA(At, 1, 0); PG8_STAGE(PG8_SA(0, 1), a2 + hstep, voffA);
            PG8_WAIT_L(8); PG8_BAR; PG8_WAIT_L(0); PG8_MMA(0, 0, At, B0); PG8_BAR; PG8_SCHED;
            PG8_LDB(B1, 1, 1); PG8_STAGE(PG8_SB(1, 0), b3, voffB);
            PG8_BAR; PG8_WAIT_L(0); PG8_MMA(0, 1, At, B1); PG8_BAR;
            PG8_LDA(At, 1, 1); PG8_STAGE(PG8_SA(1, 0), a3, voffA);
            PG8_BAR; PG8_WAIT_L(0); PG8_MMA(1, 0, At, B0); PG8_BAR; PG8_SCHED;
            PG8_STAGE(PG8_SB(1, 1), b3 + hstep, voffB);
            PG8_WAIT_V(6); PG8_BAR; PG8_MMA(1, 1, At, B1); PG8_BAR;
            }
        }
        if constexpr (ALIGN_EPI) { if (wr == 0) PG8_BAR; }
        if constexpr (!Epi::AFTER_DRAIN) { E(acc, cur, wr, wc, fr, fq); S.done(cur); }
        if (!has_next) break;
#pragma unroll
        for (int a = 0; a < 2; ++a)
#pragma unroll
            for (int b = 0; b < 2; ++b)
#pragma unroll
                for (int m = 0; m < 4; ++m)
#pragma unroll
                    for (int n = 0; n < 2; ++n) acc[a][b][m][n] = (f32x4){0.f, 0.f, 0.f, 0.f};
        cur = nxt; cA = nA; cB = nB; ++ui;
        if constexpr (ALIGN_EPI) { if (wr == 1) PG8_BAR; }
    }
    PG8_WAIT_V(0);
    if constexpr (!ALIGN_EPI) { if (wr == 0) PG8_BAR; }
    PG8_BAR;
    if constexpr (Epi::AFTER_DRAIN) { E.fused(acc, cur, wr, wc, fr, fq, lds, wid, lane); S.done(cur); }
#undef PG8_SA
#undef PG8_SB
#undef PG8_STAGE
#undef PG8_LDA
#undef PG8_LDB
#undef PG8_MMA
#undef PG8_WAIT_V
#undef PG8_WAIT_L
#undef PG8_BAR
#undef PG8_SCHED
}
}

#define GAS __attribute__((address_space(1)))
#define LAS __attribute__((address_space(3)))
typedef unsigned short bf16;
typedef unsigned v4u __attribute__((ext_vector_type(4)));
typedef unsigned v2u __attribute__((ext_vector_type(2)));
typedef float f32x4 __attribute__((ext_vector_type(4)));
typedef float f32x2v __attribute__((ext_vector_type(2)));

constexpr int NWAVES = 8, NTHR = 512;
constexpr int D = 1024, TCX = 8192, TLT = 4096, T = 12288;
constexpr int NATT = 3072, NREC = 3840, DFF = 2816, NFF = 5632;
constexpr int QLD = NATT;
constexpr size_t MiB = 1u << 20;
constexpr size_t WS_CTL = 0, WS_MOD = 1 * MiB, WS_WATT = 2 * MiB, WS_WOA = 8 * MiB, WS_WREC = 10 * MiB, WS_WOR = 18 * MiB, WS_WF1 = 20 * MiB, WS_WF2 = 42 * MiB,
                 WS_H = 54 * MiB, WS_MIX = 78 * MiB, WS_P = 102 * MiB, WS_S = 192 * MiB, WS_END = 256 * MiB;
constexpr size_t MOD_ROPE = 160 * 1024, MOD_LAM = 176 * 1024;
constexpr size_t WF1_STRIDE = (size_t)NFF * D;
constexpr size_t WF2_STRIDE = (size_t)D * DFF;
constexpr size_t O_YP = 0, O_YS = 8388608, O_NAK = 12582912, O_NAV = 16777216, O_DFK = 20971520, O_DFV = 25165824, O_SRET = 29360128, O_SRW = 31457280;
constexpr int LDS_BYTES = 147456;

__device__ __forceinline__ float bflo(unsigned u) { return __uint_as_float(u << 16); }
__device__ __forceinline__ float bfhi(unsigned u) { return __uint_as_float(u & 0xffff0000u); }
__device__ __forceinline__ float bf1(bf16 b) { return __uint_as_float(((unsigned)b) << 16); }
__device__ __forceinline__ unsigned f2bf(float f) { unsigned u = __float_as_uint(f); return (u + 0x7fffu + ((u >> 16) & 1u)) >> 16; }
__device__ __forceinline__ unsigned pk2(float lo, float hi) { return f2bf(lo) | (f2bf(hi) << 16); }
__device__ __forceinline__ float wave_sum(float v) {
#pragma unroll
    for (int o = 1; o < 64; o <<= 1) v += __shfl_xor(v, o);
    return v;
}
__device__ __forceinline__ float sigmoidf_(float x) { return 1.f / (1.f + __expf(-x)); }

struct Frame {
    LAS unsigned char* lds;
    int tid, lane, wave, G, bid;
    const float* in[37];
    float* out; unsigned char* ws;
    bf16 *Watt, *Woa, *Wrec, *Wor, *Wf1, *Wf2, *H, *MIX, *P;
    float *MOD, *S;
};

__device__ __forceinline__ void transpose_item(const float* W, int K, int N, bf16* WT, int k0, int n0, int drow0, LAS float* scr, int lane) {
#pragma unroll 8
    for (int i = 0; i < 32; ++i) { const int kk = 2 * i + (lane >> 5); scr[kk * 33 + (lane & 31)] = W[(size_t)(k0 + kk) * N + n0 + (lane & 31)]; }
    asm volatile("s_waitcnt lgkmcnt(0)" ::: "memory");
    const int c = lane & 7;
#pragma unroll
    for (int j = 0; j < 4; ++j) { const int n = (lane >> 3) + 8 * j; const LAS float* s = scr + (8 * c) * 33 + n;
        v4u o; o.x = pk2(s[0 * 33], s[1 * 33]); o.y = pk2(s[2 * 33], s[3 * 33]); o.z = pk2(s[4 * 33], s[5 * 33]); o.w = pk2(s[6 * 33], s[7 * 33]);
        *(v4u*)(WT + (size_t)(drow0 + n) * K + k0 + 8 * c) = o; }
    asm volatile("s_waitcnt lgkmcnt(0)" ::: "memory");
}

__device__ __forceinline__ void p0_prologue(Frame& F) {
    {
        LAS float* sc = (LAS float*)F.lds;
        LAS float* red = sc + 3072;
        for (int idx = F.tid; idx < 3072; idx += NTHR) { const int j = idx >> 10, k = idx & 1023; const float c = (j == 0) ? F.in[9][k] : F.in[8][(j - 1) * 1024 + k]; sc[idx] = c * sigmoidf_(c); }
        __syncthreads();
        for (int item = F.bid; item < 192; item += F.G) {
            const int layer = item / 96, col = (item % 96) * 64 + (F.tid & 63), kg = F.tid >> 6;
            const float* w = F.in[13] + (size_t)layer * 1024 * 6144 + col;
            float a0 = 0.f, a1 = 0.f, a2 = 0.f;
#pragma unroll 8
            for (int k = kg * 128; k < kg * 128 + 128; ++k) { const float wv = w[(size_t)k * 6144]; a0 += sc[k] * wv; a1 += sc[1024 + k] * wv; a2 += sc[2048 + k] * wv; }
            red[(kg * 3 + 0) * 64 + (F.tid & 63)] = a0; red[(kg * 3 + 1) * 64 + (F.tid & 63)] = a1; red[(kg * 3 + 2) * 64 + (F.tid & 63)] = a2;
            __syncthreads();
            if (F.tid < 192) { const int j = F.tid >> 6, c = F.tid & 63; float s = 0.f;
#pragma unroll
                for (int g = 0; g < 8; ++g) s += red[(g * 3 + j) * 64 + c];
                const int cc = (item % 96) * 64 + c; F.MOD[(layer * 3 + j) * 6144 + cc] = s + F.in[14][layer * 6144 + cc]; }
            __syncthreads();
        }
    }
    if (F.bid == F.G - 1) {
        f32x2v* rope = (f32x2v*)((unsigned char*)F.MOD + MOD_ROPE);
        for (int idx = F.tid; idx < 1024; idx += NTHR) { const int pos = idx >> 4, i = idx & 15; const float inv = powf(10000.0f, -(float)i / 16.0f); const float ang = (float)pos * inv; rope[idx] = (f32x2v){cosf(ang), sinf(ang)}; }
        if (F.wave == 0) { const float s1 = wave_sum(F.in[18][F.lane] * F.in[19][F.lane]), s2 = wave_sum(F.in[20][F.lane] * F.in[21][F.lane]);
            if (F.lane == 0) *(float*)((unsigned char*)F.MOD + MOD_LAM) = expf(s1) - expf(s2) + 0.2f; }
    }
    {
        const int gt = F.bid * NTHR + F.tid, NG = F.G * NTHR;
        for (int idx = gt; idx < 4 * 512 * 64; idx += NG) { const int t = idx / (512 * 64), r = (idx / 64) % 512, c8 = idx % 64;
            const float* srcb = (t == 0) ? F.in[2] : (t == 1) ? F.in[3] : (t == 2) ? F.in[4] : F.in[5]; const float* src = srcb + (size_t)r * 512 + c8 * 8; const int colb = (t == 0) ? 512 : (t == 1) ? 1024 : (t == 2) ? 2048 : 2560;
            const f32x4 a = *(const f32x4*)src, b = *(const f32x4*)(src + 4);
            v4u o; o.x = pk2(a[0], a[1]); o.y = pk2(a[2], a[3]); o.z = pk2(b[0], b[1]); o.w = pk2(b[2], b[3]);
            *(v4u*)(F.P + (size_t)(T + r) * QLD + colb + c8 * 8) = o; }
    }
    {
        LAS float* scr = (LAS float*)(F.lds + 20480 + F.wave * 8448);
        __syncthreads();
        const int gw = F.bid * NWAVES + F.wave, NGW = F.G * NWAVES;
        constexpr int I0 = 16 * 96, I1 = 16 * 32, I2 = 16 * 120, I3 = 16 * 32, I4 = 16 * 176, I6 = 44 * 32;
        constexpr int NIT = I0 + I1 + I2 + I3 + 2 * I4 + 2 * I6;
        for (int it = gw; it < NIT; it += NGW) {
            int r = it;
            if (r < I0) { const int nb = 96; transpose_item(F.in[15], 1024, 3072, F.Watt, 64 * (r / nb), 32 * (r % nb), 32 * (r % nb), scr, F.lane); continue; } r -= I0;
            if (r < I1) { const int nb = 32; transpose_item(F.in[16], 1024, 1024, F.Woa, 64 * (r / nb), 32 * (r % nb), 32 * (r % nb), scr, F.lane); continue; } r -= I1;
            if (r < I2) { const int nb = 120; transpose_item(F.in[22], 1024, 3840, F.Wrec, 64 * (r / nb), 32 * (r % nb), 32 * (r % nb), scr, F.lane); continue; } r -= I2;
            if (r < I3) { const int nb = 32; transpose_item(F.in[23], 1024, 1024, F.Wor, 64 * (r / nb), 32 * (r % nb), 32 * (r % nb), scr, F.lane); continue; } r -= I3;
            if (r < 2 * I4) { const int l = r / I4; r -= l * I4; const int nb = 176, n0 = 32 * (r % nb);
                const int drow = (n0 < DFF) ? ((n0 / 128) * 256 + (n0 % 128)) : (((n0 - DFF) / 128) * 256 + 128 + ((n0 - DFF) % 128));
                transpose_item(F.in[35] + (size_t)l * 1024 * NFF, 1024, NFF, F.Wf1 + (size_t)l * WF1_STRIDE, 64 * (r / nb), n0, drow, scr, F.lane); continue; } r -= 2 * I4;
            { const int l = r / I6; r -= l * I6; const int nb = 32;
                transpose_item(F.in[36] + (size_t)l * DFF * 1024, DFF, 1024, F.Wf2 + (size_t)l * WF2_STRIDE, 64 * (r / nb), 32 * (r % nb), 32 * (r % nb), scr, F.lane); }
        }
    }
}

__device__ __forceinline__ void norm_phase(Frame& F, const float* xc, const float* xl, const float* g, const float* mod  , int shift_i, int scale_i, bool zero_s) {
    const int gw = F.bid * NWAVES + F.wave, NGW = F.G * NWAVES;
    for (int row = gw; row < T; row += NGW) {
        const float* xr = (row < TCX) ? xc + (size_t)row * D : xl + (size_t)(row - TCX) * D;
        const int cond = (row < TCX) ? 0 : 1 + ((row - TCX) >> 11);
        const float* sh = mod + cond * 6144 + shift_i * 1024; const float* sc = mod + cond * 6144 + scale_i * 1024;
        f32x4 v[4]; float ss = 0.f;
#pragma unroll
        for (int j = 0; j < 4; ++j) { v[j] = *(const f32x4*)(xr + 4 * F.lane + 256 * j); ss += (v[j][0] * v[j][0] + v[j][1] * v[j][1]) + (v[j][2] * v[j][2] + v[j][3] * v[j][3]); }
        const float rstd = rsqrtf(wave_sum(ss) * (1.f / D) + 1e-6f);
#pragma unroll
        for (int j = 0; j < 4; ++j) { const int c = 4 * F.lane + 256 * j; const f32x4 gg = *(const f32x4*)(g + c), s1 = *(const f32x4*)(sc + c), s0 = *(const f32x4*)(sh + c);
            f32x4 h;
#pragma unroll
            for (int e = 0; e < 4; ++e) h[e] = v[j][e] * rstd * gg[e] * (1.f + s1[e]) + s0[e];
            v2u o; o.x = pk2(h[0], h[1]); o.y = pk2(h[2], h[3]); *(v2u*)(F.H + (size_t)row * D + c) = o; }
    }
    if (zero_s) {
        const size_t n16 = (size_t)48 * MiB / 16; f32x4* p = (f32x4*)F.S;
        for (size_t i = (size_t)F.bid * NTHR + F.tid; i < n16; i += (size_t)F.G * NTHR) p[i] = (f32x4){0.f, 0.f, 0.f, 0.f};
    }
}
__device__ __forceinline__ void zero_s_phase(Frame& F) {
    const size_t n16 = (size_t)48 * MiB / 16; f32x4* p = (f32x4*)F.S;
    for (size_t i = (size_t)F.bid * NTHR + F.tid; i < n16; i += (size_t)F.G * NTHR) p[i] = (f32x4){0.f, 0.f, 0.f, 0.f};
}
__device__ __forceinline__ void final_norm_phase(Frame& F) {
    const int gw = F.bid * NWAVES + F.wave, NGW = F.G * NWAVES; const float* g = F.in[12];
    for (int row = gw; row < T; row += NGW) {
        float* xr = F.out + (size_t)row * D;
        f32x4 v[4]; float ss = 0.f;
#pragma unroll
        for (int j = 0; j < 4; ++j) { v[j] = *(const f32x4*)(xr + 4 * F.lane + 256 * j); ss += (v[j][0] * v[j][0] + v[j][1] * v[j][1]) + (v[j][2] * v[j][2] + v[j][3] * v[j][3]); }
        const float rstd = rsqrtf(wave_sum(ss) * (1.f / D) + 1e-6f);
#pragma unroll
        for (int j = 0; j < 4; ++j) { const int c = 4 * F.lane + 256 * j; const f32x4 gg = *(const f32x4*)(g + c); *(f32x4*)(xr + c) = v[j] * rstd * gg; }
    }
}

struct EpiAttnIn {
    static constexpr bool PERM = true, AFTER_DRAIN = false;
    bf16* QKV; float* out; const f32x2v* rope;
    __device__ __forceinline__ void operator()(const f32x4 (&acc)[2][2][4][2], const pg8::Unit& u, int wr, int wc, int fr, int fq) const {
        const int pn = u.pn; const bool ctx = u.pm < 32;
        float* cdst = nullptr; int cbase = 0;
        if (ctx) { if (pn == 2 || pn == 3) { cdst = out + O_NAK; cbase = 512; } else if (pn == 4 || pn == 5) { cdst = out + O_NAV; cbase = 1024; }
                   else if (pn == 8 || pn == 9) { cdst = out + O_DFK; cbase = 2048; } else if (pn == 10 || pn == 11) { cdst = out + O_DFV; cbase = 2560; } }
        const bool rope_on = (!ctx) && pn >= 6 && pn <= 9;
        const float sgn = (fq < 2) ? -1.f : 1.f;
#pragma unroll
        for (int ai = 0; ai < 2; ++ai)
#pragma unroll
            for (int m = 0; m < 4; ++m) { const int row = u.pm * 256 + ai * 128 + wr * 64 + m * 16 + fr;
#pragma unroll
                for (int bj = 0; bj < 2; ++bj) { const int col = pn * 256 + bj * 128 + wc * 32 + 8 * fq;
                    f32x4 v0 = acc[ai][bj][m][0], v1 = acc[ai][bj][m][1];
                    if (rope_on) { const int n = (row - TCX) & 2047; const int p = (wc & 1) ? (n & 63) : (n >> 6); const f32x2v* tb = rope + p * 16 + 8 * (fq & 1);
#pragma unroll
                        for (int e = 0; e < 4; ++e) { const float p0 = __shfl_xor(v0[e], 32), p1 = __shfl_xor(v1[e], 32); const f32x2v c0 = tb[e], c1 = tb[4 + e];
                            v0[e] = v0[e] * c0.x + sgn * p0 * c0.y; v1[e] = v1[e] * c1.x + sgn * p1 * c1.y; } }
                    v4u w; w.x = pg8::cvt_pk_bf16(v0[0], v0[1]); w.y = pg8::cvt_pk_bf16(v0[2], v0[3]); w.z = pg8::cvt_pk_bf16(v1[0], v1[1]); w.w = pg8::cvt_pk_bf16(v1[2], v1[3]);
                    *(v4u*)(QKV + (size_t)row * QLD + col) = w;
                    if (cdst) { float* cp = cdst + (size_t)row * 512 + (col - cbase); *(f32x4*)cp = v0; *(f32x4*)(cp + 4) = v1; } } }
    }
};
struct EpiBf16Plain {
    static constexpr bool PERM = true, AFTER_DRAIN = false;
    bf16* O; int ldc;
    __device__ __forceinline__ void operator()(const f32x4 (&acc)[2][2][4][2], const pg8::Unit& u, int wr, int wc, int fr, int fq) const {
#pragma unroll
        for (int ai = 0; ai < 2; ++ai)
#pragma unroll
            for (int m = 0; m < 4; ++m) { const int row = u.pm * 256 + ai * 128 + wr * 64 + m * 16 + fr;
#pragma unroll
                for (int bj = 0; bj < 2; ++bj) { const int col = u.pn * 256 + bj * 128 + wc * 32 + 8 * fq; const f32x4 v0 = acc[ai][bj][m][0], v1 = acc[ai][bj][m][1];
                    v4u w; w.x = pg8::cvt_pk_bf16(v0[0], v0[1]); w.y = pg8::cvt_pk_bf16(v0[2], v0[3]); w.z = pg8::cvt_pk_bf16(v1[0], v1[1]); w.w = pg8::cvt_pk_bf16(v1[2], v1[3]);
                    *(v4u*)(O + (size_t)row * ldc + col) = w; } }
    }
};
struct EpiSwiglu {
    static constexpr bool PERM = true, AFTER_DRAIN = false;
    bf16* O;
    __device__ __forceinline__ void operator()(const f32x4 (&acc)[2][2][4][2], const pg8::Unit& u, int wr, int wc, int fr, int fq) const {
#pragma unroll
        for (int ai = 0; ai < 2; ++ai)
#pragma unroll
            for (int m = 0; m < 4; ++m) { const int row = u.pm * 256 + ai * 128 + wr * 64 + m * 16 + fr; const int col = u.pn * 128 + wc * 32 + 8 * fq;
                float r[8];
#pragma unroll
                for (int n = 0; n < 2; ++n)
#pragma unroll
                    for (int e = 0; e < 4; ++e) { const float g = acc[ai][0][m][n][e], up = acc[ai][1][m][n][e]; r[4 * n + e] = g * __builtin_amdgcn_rcpf(1.f + __expf(-g)) * up; }
                v4u w; w.x = pg8::cvt_pk_bf16(r[0], r[1]); w.y = pg8::cvt_pk_bf16(r[2], r[3]); w.z = pg8::cvt_pk_bf16(r[4], r[5]); w.w = pg8::cvt_pk_bf16(r[6], r[7]);
                *(v4u*)(O + (size_t)row * DFF + col) = w; }
    }
};
struct EpiResid {
    static constexpr bool PERM = false, AFTER_DRAIN = false;
    const float* bc; const float* bl; float* X; const float* mod; int gate_i;
    __device__ __forceinline__ void operator()(const f32x4 (&acc)[2][2][4][2], const pg8::Unit& u, int wr, int wc, int fr, int fq) const {
        const int cond = (u.pm < 32) ? 0 : ((u.pm < 40) ? 1 : 2);
        const float* gate = mod + cond * 6144 + gate_i * 1024;
        const float* base = (u.pm < 32) ? bc : bl - (size_t)TCX * D;
        const int col0 = u.pn * 256 + wc * 32 + 4 * fq;
        f32x4 gv[2][2];
#pragma unroll
        for (int bj = 0; bj < 2; ++bj)
#pragma unroll
            for (int n = 0; n < 2; ++n) gv[bj][n] = *(const f32x4*)(gate + col0 + bj * 128 + n * 16);
#pragma unroll
        for (int ai = 0; ai < 2; ++ai)
#pragma unroll
            for (int m = 0; m < 4; ++m) { const size_t off = (size_t)(u.pm * 256 + ai * 128 + wr * 64 + m * 16 + fr) * D + col0;
#pragma unroll
                for (int bj = 0; bj < 2; ++bj)
#pragma unroll
                    for (int n = 0; n < 2; ++n) { const f32x4 b = *(const f32x4*)(base + off + bj * 128 + n * 16); *(f32x4*)(X + off + bj * 128 + n * 16) = b + gv[bj][n] * acc[ai][bj][m][n]; } }
    }
};

#define KEY_STEP(kp, vp, biasv) do { \
    float s_ = 0.f; \
    _Pragma("unroll") for (int c_ = 0; c_ < 8; ++c_) { const v4u kv_ = *(const v4u*)((kp) + 8 * c_); \
        s_ += q[8 * c_ + 0] * bflo(kv_.x) + q[8 * c_ + 1] * bfhi(kv_.x) + q[8 * c_ + 2] * bflo(kv_.y) + q[8 * c_ + 3] * bfhi(kv_.y) \
            + q[8 * c_ + 4] * bflo(kv_.z) + q[8 * c_ + 5] * bfhi(kv_.z) + q[8 * c_ + 6] * bflo(kv_.w) + q[8 * c_ + 7] * bfhi(kv_.w); } \
    s_ = s_ * 0.125f + (biasv); \
    const float mn_ = fmaxf(m, s_), al_ = __expf(m - mn_), p_ = __expf(s_ - mn_); l = l * al_ + p_; m = mn_; \
    _Pragma("unroll") for (int c_ = 0; c_ < 8; ++c_) { const v4u vv_ = *(const v4u*)((vp) + 8 * c_); \
        o[8 * c_ + 0] = o[8 * c_ + 0] * al_ + p_ * bflo(vv_.x); o[8 * c_ + 1] = o[8 * c_ + 1] * al_ + p_ * bfhi(vv_.x); \
        o[8 * c_ + 2] = o[8 * c_ + 2] * al_ + p_ * bflo(vv_.y); o[8 * c_ + 3] = o[8 * c_ + 3] * al_ + p_ * bfhi(vv_.y); \
        o[8 * c_ + 4] = o[8 * c_ + 4] * al_ + p_ * bflo(vv_.z); o[8 * c_ + 5] = o[8 * c_ + 5] * al_ + p_ * bfhi(vv_.z); \
        o[8 * c_ + 6] = o[8 * c_ + 6] * al_ + p_ * bflo(vv_.w); o[8 * c_ + 7] = o[8 * c_ + 7] * al_ + p_ * bfhi(vv_.w); } } while (0)
#define LOAD_Q(qp) do { _Pragma("unroll") for (int c_ = 0; c_ < 8; ++c_) { const v4u qv_ = *(const v4u*)((qp) + 8 * c_); \
        q[8 * c_ + 0] = bflo(qv_.x); q[8 * c_ + 1] = bfhi(qv_.x); q[8 * c_ + 2] = bflo(qv_.y); q[8 * c_ + 3] = bfhi(qv_.y); \
        q[8 * c_ + 4] = bflo(qv_.z); q[8 * c_ + 5] = bfhi(qv_.z); q[8 * c_ + 6] = bflo(qv_.w); q[8 * c_ + 7] = bfhi(qv_.w); } } while (0)

__device__ __forceinline__ void attn_naive_phase(Frame& F) {
    const bf16* QKV = F.P; const float lam = *(const float*)((unsigned char*)F.MOD + MOD_LAM);
    float* DIFFO = F.S; const float* rpb = F.in[17];
    constexpr int ND = 32768, NC = 32768, NB = 65536, NA = 65536, NTASK = ND + NC + NB + NA;
    for (int task = F.bid * NTHR + F.tid; task < NTASK; task += F.G * NTHR) {
        float q[64], o[64]; float m, l;
        if (task < ND || (task >= ND + NC && task < ND + NC + NB)) {
            const bool lat = task < ND; int idx = lat ? task : task - ND - NC;
            int n, b, h, vh;
            if (lat) { n = idx & 2047; idx >>= 11; b = idx & 1; idx >>= 1; h = idx & 3; vh = idx >> 2; }
            else { n = idx & 255; idx >>= 8; b = idx & 31; idx >>= 5; h = idx & 3; vh = idx >> 2; }
            const int row = lat ? TCX + b * 2048 + n : b * 256 + n;
            const int krow0 = lat ? TCX + b * 2048 : b * 256, nk0 = lat ? 2048 : 256, krow1 = T + b * 256, nk1 = lat ? 256 : 0;
            const int vcol = 2560 + h * 128 + vh * 64;
            float o1[64];
#pragma unroll
            for (int c = 0; c < 2; ++c) {
                const int qcol = 1536 + h * 128 + c * 64, kcol = 2048 + h * 128 + c * 64;
                LOAD_Q(QKV + (size_t)row * QLD + qcol);
#pragma unroll
                for (int d = 0; d < 64; ++d) o[d] = 0.f;
                m = -INFINITY; l = 0.f;
                for (int j = 0; j < nk0; ++j) { const bf16* kr = QKV + (size_t)(krow0 + j) * QLD; KEY_STEP(kr + kcol, kr + vcol, 0.f); }
                for (int j = 0; j < nk1; ++j) { const bf16* kr = QKV + (size_t)(krow1 + j) * QLD; KEY_STEP(kr + kcol, kr + vcol, 0.f); }
                const float il = 1.f / l;
                if (c == 0) {
#pragma unroll
                    for (int d = 0; d < 64; ++d) o1[d] = o[d] * il;
                } else {
                    float* dst = DIFFO + (size_t)row * 512 + h * 128 + vh * 64;
#pragma unroll
                    for (int d = 0; d < 64; d += 4) *(f32x4*)(dst + d) = (f32x4){o1[d] - lam * o[d] * il, o1[d + 1] - lam * o[d + 1] * il, o1[d + 2] - lam * o[d + 2] * il, o1[d + 3] - lam * o[d + 3] * il};
                }
            }
        } else {
            const bool lat = task < ND + NC; int idx = lat ? task - ND : task - ND - NC - NB;
            int n, b, h;
            if (lat) { n = idx & 2047; idx >>= 11; b = idx & 1; h = idx >> 1; } else { n = idx & 255; idx >>= 8; b = idx & 31; h = idx >> 5; }
            const int row = lat ? TCX + b * 2048 + n : b * 256 + n;
            const int kcol = 512 + h * 64, vcol = 1024 + h * 64;
            LOAD_Q(QKV + (size_t)row * QLD + h * 64);
#pragma unroll
            for (int d = 0; d < 64; ++d) o[d] = 0.f;
            m = -INFINITY; l = 0.f;
            if (lat) {
                const int r = n >> 6, qc = n & 63; const int rs = min(max(r - 4, 0), 24), cs = min(max(qc - 8, 0), 48);
                for (int i = 0; i < 8; ++i) for (int cc = 0; cc < 16; ++cc) { const int kr_ = rs + i, kc = cs + cc;
                    const bf16* kr = QKV + (size_t)(TCX + b * 2048 + kr_ * 64 + kc) * QLD; const float bias = rpb[h * 465 + (kr_ - r + 7) * 31 + (kc - qc + 15)];
                    KEY_STEP(kr + kcol, kr + vcol, bias); }
                for (int j = 0; j < 256; ++j) { const bf16* kr = QKV + (size_t)(T + b * 256 + j) * QLD; KEY_STEP(kr + kcol, kr + vcol, 0.f); }
            } else {
                for (int j = 0; j < 256; ++j) { const bf16* kr = QKV + (size_t)(b * 256 + j) * QLD; KEY_STEP(kr + kcol, kr + vcol, 0.f); }
            }
            const float il = 1.f / l; bf16* dst = F.MIX + (size_t)row * D + h * 64;
#pragma unroll
            for (int d = 0; d < 64; d += 8) { v4u w; w.x = pk2(o[d] * il, o[d + 1] * il); w.y = pk2(o[d + 2] * il, o[d + 3] * il); w.z = pk2(o[d + 4] * il, o[d + 5] * il); w.w = pk2(o[d + 6] * il, o[d + 7] * il); *(v4u*)(dst + d) = w; }
        }
    }
}
__device__ __forceinline__ void diff_post_phase(Frame& F) {
    const int gw = F.bid * NWAVES + F.wave, NGW = F.G * NWAVES; const float* DIFFO = F.S;
    for (int it = gw; it < T * 4; it += NGW) { const int row = it >> 2, h = it & 3;
        const f32x2v v = *(const f32x2v*)(DIFFO + (size_t)row * 512 + h * 128 + 2 * F.lane);
        const float r = rsqrtf(wave_sum(v.x * v.x + v.y * v.y) * (1.f / 128.f) + 1e-6f) * 0.8f;
        *(unsigned*)(F.MIX + (size_t)row * D + 512 + h * 128 + 2 * F.lane) = pk2(v.x * r, v.y * r); }
}

typedef short bf16x8 __attribute__((ext_vector_type(8)));
typedef short s16x4 __attribute__((ext_vector_type(4)));
constexpr float LOG2E = 1.4426950408889634f;
__device__ __forceinline__ s16x4 tr_read(LAS unsigned char* p) { return __builtin_bit_cast(s16x4, __builtin_amdgcn_ds_read_tr16_b64_v4i16((LAS s16x4*)p)); }

template <int KIND>
__device__ __forceinline__ void attn_unit(Frame& F, int u) {
    constexpr bool DIFF = (KIND & 1) != 0;
    constexpr int DV = DIFF ? 128 : 64, NC = DV / 16, VSTR = DIFF ? 288 : 160, KSTR = 144;
    constexpr int K0_OFF = 0, K1_OFF = 9216, V_OFF = 18432, X_OFF = 40960, XSTR = 132, RPB_OFF = 110592;
    const int tid = F.tid, lane = F.lane, wave = F.wave, q16 = lane & 15, g = lane >> 4;
    LAS unsigned char* lds = F.lds;
    const bf16* QKV = F.P;
    int b, h, qrow0, ntiles, nW = 0, R0k = 0;
    if (KIND == 0) { b = u >> 3; h = u & 7; qrow0 = b * 256; ntiles = 4; }
    else if (KIND == 1) { const int half = u & 1; h = (u >> 1) & 3; b = u >> 3; qrow0 = b * 256 + half * 128; ntiles = 4; }
    else if (KIND == 2) { const int R = u & 7; h = (u >> 3) & 7; b = u >> 6; qrow0 = TCX + b * 2048 + R * 256; R0k = min(max(4 * R - 4, 0), 24); nW = min(max(4 * R - 1, 0), 24) + 8 - R0k; ntiles = nW + 4; }
    else { const int qb = u & 15; h = (u >> 4) & 3; b = u >> 6; qrow0 = TCX + b * 2048 + qb * 128; ntiles = 36; }
    const int sidx = DIFF ? (wave >> 2) : 0;
    const int wq = DIFF ? (wave & 3) * 32 : wave * 32;
    const int qcol = DIFF ? 1536 + h * 128 + sidx * 64 : h * 64;
    const int kcol0 = DIFF ? 2048 + h * 128 : 512 + h * 64;
    const int vcol = DIFF ? 2560 + h * 128 : 1024 + h * 64;
#define KROW(ti) ((KIND <= 1) ? (b * 256 + 64 * (ti)) : (KIND == 2) ? (((ti) < nW) ? (TCX + b * 2048 + (R0k + (ti)) * 64) : (T + b * 256 + 64 * ((ti) - nW))) : (((ti) < 32) ? (TCX + b * 2048 + 64 * (ti)) : (T + b * 256 + 64 * ((ti) - 32))))
    v4u rk0, rk1, rv0, rv1;
#define LOAD_TILE(ti) do { const bf16* rp_ = QKV + (size_t)(KROW(ti) + (tid >> 3)) * QLD + 8 * (tid & 7); rk0 = *(const v4u*)(rp_ + kcol0); rv0 = *(const v4u*)(rp_ + vcol); \
        if (DIFF) { rk1 = *(const v4u*)(rp_ + kcol0 + 64); rv1 = *(const v4u*)(rp_ + vcol + 64); } } while (0)
#define STORE_TILE() do { const int row_ = tid >> 3, ch_ = tid & 7; const int prow_ = (row_ & 39) | ((row_ & 8) << 1) | ((row_ & 16) >> 1); \
        *(LAS v4u*)(lds + K0_OFF + prow_ * KSTR + ch_ * 16) = rk0; *(LAS v4u*)(lds + V_OFF + row_ * VSTR + ch_ * 16) = rv0; \
        if (DIFF) { *(LAS v4u*)(lds + K1_OFF + prow_ * KSTR + ch_ * 16) = rk1; *(LAS v4u*)(lds + V_OFF + row_ * VSTR + 128 + ch_ * 16) = rv1; } } while (0)
    LAS float* rpbL = (LAS float*)(lds + RPB_OFF);
    if (KIND == 2) { __syncthreads(); if (tid < 465) rpbL[tid] = F.in[17][h * 465 + tid] * LOG2E; }
    bf16x8 qf[2][2];
#pragma unroll
    for (int grp = 0; grp < 2; ++grp)
#pragma unroll
        for (int kd = 0; kd < 2; ++kd) qf[grp][kd] = *(const bf16x8*)(QKV + (size_t)(qrow0 + wq + 16 * grp + q16) * QLD + qcol + 32 * kd + 8 * g);
    f32x4 o[2][NC];
#pragma unroll
    for (int grp = 0; grp < 2; ++grp)
#pragma unroll
        for (int c = 0; c < NC; ++c) o[grp][c] = (f32x4){0.f, 0.f, 0.f, 0.f};
    float mrun[2] = {-1e30f, -1e30f}, lsum[2] = {0.f, 0.f};
    const int wr_ = (KIND == 2) ? (((qrow0 - TCX) & 2047) >> 6) + (wave >> 1) : 0;
    const int wrs = min(max(wr_ - 4, 0), 24);
    const int koff = (DIFF && sidx) ? K1_OFF : K0_OFF;
    constexpr float C1 = 0.125f * LOG2E;
    LOAD_TILE(0);
    for (int ti = 0; ti < ntiles; ++ti) {
        __syncthreads();
        STORE_TILE();
        __syncthreads();
        if (ti + 1 < ntiles) LOAD_TILE(ti + 1);
        bool active = true; int krow_g = 0; bool win = false;
        if (KIND == 2) { win = ti < nW; krow_g = R0k + ti; active = (!win) || (krow_g >= wrs && krow_g < wrs + 8); }
        if (active) {
            f32x4 s[2][2][2];
#pragma unroll
            for (int ks = 0; ks < 2; ++ks)
#pragma unroll
                for (int t = 0; t < 2; ++t) {
                    s[0][ks][t] = (f32x4){0.f, 0.f, 0.f, 0.f}; s[1][ks][t] = (f32x4){0.f, 0.f, 0.f, 0.f};
#pragma unroll
                    for (int kd = 0; kd < 2; ++kd) { const bf16x8 kf = *(const LAS bf16x8*)(lds + koff + (32 * ks + 16 * t + q16) * KSTR + 64 * kd + 16 * g);
                        s[0][ks][t] = __builtin_amdgcn_mfma_f32_16x16x32_bf16(kf, qf[0][kd], s[0][ks][t], 0, 0, 0);
                        s[1][ks][t] = __builtin_amdgcn_mfma_f32_16x16x32_bf16(kf, qf[1][kd], s[1][ks][t], 0, 0, 0); }
                }
            bf16x8 pf[2][2];
#pragma unroll
            for (int grp = 0; grp < 2; ++grp) {
                float tv[2][2][4];
                if (KIND == 2 && win) {
                    const int qc = (wave & 1) * 32 + 16 * grp + q16, cs = min(max(qc - 8, 0), 48); const LAS float* brow = rpbL + (krow_g - wr_ + 7) * 31 + 15 - qc;
#pragma unroll
                    for (int ks = 0; ks < 2; ++ks)
#pragma unroll
                        for (int t = 0; t < 2; ++t)
#pragma unroll
                            for (int e = 0; e < 4; ++e) { const int kc = 32 * ks + 16 * (g >> 1) + 8 * t + 4 * (g & 1) + e; const bool ok = (unsigned)(kc - cs) < 16u;
                                tv[ks][t][e] = ok ? s[grp][ks][t][e] * C1 + brow[kc] : -1e30f; }
                } else {
#pragma unroll
                    for (int ks = 0; ks < 2; ++ks)
#pragma unroll
                        for (int t = 0; t < 2; ++t)
#pragma unroll
                            for (int e = 0; e < 4; ++e) tv[ks][t][e] = s[grp][ks][t][e] * C1;
                }
                float tmax = -1e30f;
#pragma unroll
                for (int ks = 0; ks < 2; ++ks)
#pragma unroll
                    for (int t = 0; t < 2; ++t)
#pragma unroll
                        for (int e = 0; e < 4; ++e) tmax = fmaxf(tmax, tv[ks][t][e]);
                tmax = fmaxf(tmax, __shfl_xor(tmax, 16)); tmax = fmaxf(tmax, __shfl_xor(tmax, 32));
                const float mn = fmaxf(mrun[grp], tmax), al = __builtin_amdgcn_exp2f(mrun[grp] - mn); mrun[grp] = mn;
                float ps = 0.f;
#pragma unroll
                for (int ks = 0; ks < 2; ++ks) {
                    float p[8];
#pragma unroll
                    for (int t = 0; t < 2; ++t)
#pragma unroll
                        for (int e = 0; e < 4; ++e) { p[4 * t + e] = __builtin_amdgcn_exp2f(tv[ks][t][e] - mn); ps += p[4 * t + e]; }
                    v4u w; w.x = pg8::cvt_pk_bf16(p[0], p[1]); w.y = pg8::cvt_pk_bf16(p[2], p[3]); w.z = pg8::cvt_pk_bf16(p[4], p[5]); w.w = pg8::cvt_pk_bf16(p[6], p[7]);
                    pf[grp][ks] = __builtin_bit_cast(bf16x8, w);
                }
                lsum[grp] = lsum[grp] * al + ps;
#pragma unroll
                for (int c = 0; c < NC; ++c) o[grp][c] = o[grp][c] * al;
            }
#pragma unroll
            for (int ks = 0; ks < 2; ++ks)
#pragma unroll
                for (int c = 0; c < NC; ++c) {
                    LAS unsigned char* vb = lds + V_OFF + (32 * ks + 16 * (g >> 1) + 4 * (g & 1) + (q16 >> 2)) * VSTR + (16 * c + 4 * (lane & 3)) * 2;
                    const s16x4 v0 = tr_read(vb), v1 = tr_read(vb + 8 * VSTR);
                    const bf16x8 vf = (bf16x8){v0[0], v0[1], v0[2], v0[3], v1[0], v1[1], v1[2], v1[3]};
                    o[0][c] = __builtin_amdgcn_mfma_f32_16x16x32_bf16(vf, pf[0][ks], o[0][c], 0, 0, 0);
                    o[1][c] = __builtin_amdgcn_mfma_f32_16x16x32_bf16(vf, pf[1][ks], o[1][c], 0, 0, 0);
                }
        }
    }
    float inv[2];
#pragma unroll
    for (int grp = 0; grp < 2; ++grp) { float l = lsum[grp]; l += __shfl_xor(l, 16); l += __shfl_xor(l, 32); inv[grp] = 1.f / l; }
    if (!DIFF) {
#pragma unroll
        for (int grp = 0; grp < 2; ++grp) { bf16* dst = F.MIX + (size_t)(qrow0 + wq + 16 * grp + q16) * D + h * 64 + 4 * g;
#pragma unroll
            for (int c = 0; c < NC; ++c) { const f32x4 v = o[grp][c] * inv[grp]; v2u w; w.x = pg8::cvt_pk_bf16(v[0], v[1]); w.y = pg8::cvt_pk_bf16(v[2], v[3]); *(v2u*)(dst + 16 * c) = w; } }
    } else {
        const float lam = *(const float*)((unsigned char*)F.MOD + MOD_LAM);
        LAS float* X = (LAS float*)(lds + X_OFF);
        if (sidx == 1) {
#pragma unroll
            for (int grp = 0; grp < 2; ++grp)
#pragma unroll
                for (int c = 0; c < NC; ++c) *(LAS f32x4*)(X + (wq + 16 * grp + q16) * XSTR + 16 * c + 4 * g) = o[grp][c] * inv[grp];
        }
        __syncthreads();
        if (sidx == 0) {
#pragma unroll
            for (int grp = 0; grp < 2; ++grp) {
                float ss = 0.f;
#pragma unroll
                for (int c = 0; c < NC; ++c) { const f32x4 x2 = *(const LAS f32x4*)(X + (wq + 16 * grp + q16) * XSTR + 16 * c + 4 * g); o[grp][c] = o[grp][c] * inv[grp] - x2 * lam;
                    ss += (o[grp][c][0] * o[grp][c][0] + o[grp][c][1] * o[grp][c][1]) + (o[grp][c][2] * o[grp][c][2] + o[grp][c][3] * o[grp][c][3]); }
                ss += __shfl_xor(ss, 16); ss += __shfl_xor(ss, 32);
                const float r = rsqrtf(ss * (1.f / 128.f) + 1e-6f) * 0.8f;
                bf16* dst = F.MIX + (size_t)(qrow0 + wq + 16 * grp + q16) * D + 512 + h * 128 + 4 * g;
#pragma unroll
                for (int c = 0; c < NC; ++c) { const f32x4 v = o[grp][c] * r; v2u w; w.x = pg8::cvt_pk_bf16(v[0], v[1]); w.y = pg8::cvt_pk_bf16(v[2], v[3]); *(v2u*)(dst + 16 * c) = w; }
            }
        }
    }
#undef KROW
#undef LOAD_TILE
#undef STORE_TILE
}
__device__ __forceinline__ void attn_mfma_phase(Frame& F) {
    if (F.G == 256) {
        if (F.bid < 128) attn_unit<3>(F, F.bid);
        else { const int i = F.bid - 128; attn_unit<2>(F, i); attn_unit<1>(F, 2 * i); attn_unit<1>(F, 2 * i + 1); attn_unit<0>(F, 2 * i); attn_unit<0>(F, 2 * i + 1); }
    } else {
        for (int i = F.bid; i < 768; i += F.G) { if (i < 128) attn_unit<3>(F, i); else if (i < 256) attn_unit<2>(F, i - 128); else if (i < 512) attn_unit<1>(F, i - 256); else attn_unit<0>(F, i - 512); }
    }
}

__device__ __forceinline__ void rwkv_job(Frame& F, int seq, int h, int dir) {
    LAS float* L = (LAS float*)F.lds;
    LAS float *WUP = L, *AUP = L + 4096, *Lr = L + 8192, *Lk = Lr + 1024, *Lv = Lk + 1024, *Lwd = Lv + 1024, *Lad = Lwd + 1024, *Lw = Lad + 1024, *La = Lw + 1024, *Lkk = La + 1024, *Lkef = Lkk + 1024, *Lb = Lkef + 1024, *Ly = Lb + 1024;
    const int tid = F.tid, lane = F.lane, w = F.wave;
    const bool lat = seq >= 32; const int b = lat ? seq - 32 : seq, N = lat ? 2048 : 256, R0 = lat ? TCX + b * 2048 : b * 256;
    const bf16* PROJ = F.P; float* Y = F.S;
    __syncthreads();
    for (int idx = tid; idx < 4096; idx += NTHR) { const int j = idx >> 6, k = idx & 63; WUP[idx] = F.in[26][(size_t)(dir * 64 + j) * 512 + h * 64 + k]; AUP[idx] = F.in[28][(size_t)(dir * 64 + j) * 512 + h * 64 + k]; }
    const int i = 8 * w + (lane >> 3), s = lane & 7;
    float S[8];
    {
        const float* st = F.in[7] + (size_t)((b * 2 + dir) * 8 + h) * 4096 + i * 64 + 8 * s;
#pragma unroll
        for (int kk = 0; kk < 8; ++kk) S[kk] = lat ? st[kk] : 0.f;
    }
    for (int t0 = 0; t0 < N; t0 += 16) {
#pragma unroll
        for (int rep = 0; rep < 2; ++rep) { const int idx = tid + NTHR * rep, j = idx >> 6, k = idx & 63; const int n = dir ? N - 1 - (t0 + j) : t0 + j;
            const bf16* pr = PROJ + (size_t)(R0 + n) * NREC;
            Lr[idx] = bf1(pr[2048 + h * 64 + k]); Lk[idx] = bf1(pr[2560 + h * 64 + k]); Lv[idx] = bf1(pr[3072 + h * 64 + k]); Lwd[idx] = tanhf(bf1(pr[3584 + k])); Lad[idx] = bf1(pr[3648 + k]); }
        __syncthreads();
#pragma unroll
        for (int rep = 0; rep < 2; ++rep) { const int idx = tid + NTHR * rep, j = idx >> 6, k = idx & 63;
            float zw = F.in[25][dir * 512 + h * 64 + k], za = F.in[27][dir * 512 + h * 64 + k];
#pragma unroll 8
            for (int jj = 0; jj < 64; ++jj) { zw += Lwd[j * 64 + jj] * WUP[jj * 64 + k]; za += Lad[j * 64 + jj] * AUP[jj * 64 + k]; }
            Lw[idx] = __expf(-0.6065306597f * sigmoidf_(zw)); La[idx] = sigmoidf_(za); }
        if (tid < 256) { const int j = tid >> 4, p = tid & 15; float v[4]; float ss = 0.f;
#pragma unroll
            for (int e = 0; e < 4; ++e) { v[e] = Lk[j * 64 + 4 * p + e] * F.in[30][h * 64 + 4 * p + e]; ss += v[e] * v[e]; }
            ss += __shfl_xor(ss, 1); ss += __shfl_xor(ss, 2); ss += __shfl_xor(ss, 4); ss += __shfl_xor(ss, 8);
            const float rs = rsqrtf(ss + 1e-12f);
#pragma unroll
            for (int e = 0; e < 4; ++e) Lkk[j * 64 + 4 * p + e] = v[e] * rs; }
        __syncthreads();
#pragma unroll
        for (int rep = 0; rep < 2; ++rep) { const int idx = tid + NTHR * rep, k = idx & 63; const float a = La[idx];
            Lkef[idx] = Lk[idx] * (1.f + (a - 1.f) * F.in[31][h * 64 + k]); Lb[idx] = Lkk[idx] * a; }
        __syncthreads();
        for (int j = 0; j < 16; ++j) {
            const int o8 = j * 64 + 8 * s;
            float sa = 0.f;
#pragma unroll
            for (int kk = 0; kk < 8; ++kk) sa -= S[kk] * Lkk[o8 + kk];
            sa += __shfl_xor(sa, 1); sa += __shfl_xor(sa, 2); sa += __shfl_xor(sa, 4);
            const float vi = Lv[j * 64 + i];
            float y = 0.f;
#pragma unroll
            for (int kk = 0; kk < 8; ++kk) { S[kk] = S[kk] * Lw[o8 + kk] + sa * Lb[o8 + kk] + vi * Lkef[o8 + kk]; y += S[kk] * Lr[o8 + kk]; }
            y += __shfl_xor(y, 1); y += __shfl_xor(y, 2); y += __shfl_xor(y, 4);
            if (s == 0) Ly[j * 64 + i] = y;
        }
        __syncthreads();
#pragma unroll
        for (int rep = 0; rep < 2; ++rep) { const int idx = tid + NTHR * rep, j = idx >> 6, k = idx & 63; const int n = dir ? N - 1 - (t0 + j) : t0 + j;
            atomicAdd(Y + (size_t)(R0 + n) * 512 + h * 64 + k, Ly[idx]); }
    }
    if (!lat) { float* so = F.out + O_SRW + (size_t)((b * 2 + dir) * 8 + h) * 4096 + i * 64 + 8 * s;
#pragma unroll
        for (int kk = 0; kk < 8; ++kk) so[kk] = S[kk]; }
}
__device__ __forceinline__ void ret_job(Frame& F, int seq, int h, int dir) {
    LAS float* L = (LAS float*)F.lds;
    LAS float *Lq = L, *Lk = L + 1024, *Lv = L + 2048, *Lo = L + 3072;
    const int tid = F.tid, lane = F.lane, w = F.wave;
    const bool lat = seq >= 32; const int b = lat ? seq - 32 : seq, N = lat ? 2048 : 256, R0 = lat ? TCX + b * 2048 : b * 256;
    const bf16* PROJ = F.P; float* O = F.S + (size_t)T * 512;
    const float g = sigmoidf_(F.in[24][dir * 8 + h]);
    const int e = 8 * w + (lane >> 3), s = lane & 7;
    float S[8];
    {
        const float* st = F.in[6] + (size_t)((b * 2 + dir) * 8 + h) * 4096;
#pragma unroll
        for (int dd = 0; dd < 8; ++dd) S[dd] = lat ? st[(8 * s + dd) * 64 + e] : 0.f;
    }
    __syncthreads();
    for (int t0 = 0; t0 < N; t0 += 16) {
#pragma unroll
        for (int rep = 0; rep < 2; ++rep) { const int idx = tid + NTHR * rep, j = idx >> 6, k = idx & 63; const int n = dir ? N - 1 - (t0 + j) : t0 + j;
            const bf16* pr = PROJ + (size_t)(R0 + n) * NREC;
            Lq[idx] = bf1(pr[h * 64 + k]); Lk[idx] = bf1(pr[512 + h * 64 + k]) * 0.125f; Lv[idx] = bf1(pr[1024 + h * 64 + k]); }
        __syncthreads();
        for (int j = 0; j < 16; ++j) {
            const int o8 = j * 64 + 8 * s; const float ve = Lv[j * 64 + e];
            float o = 0.f;
#pragma unroll
            for (int dd = 0; dd < 8; ++dd) { S[dd] = g * S[dd] + Lk[o8 + dd] * ve; o += Lq[o8 + dd] * S[dd]; }
            o += __shfl_xor(o, 1); o += __shfl_xor(o, 2); o += __shfl_xor(o, 4);
            if (s == 0) Lo[j * 64 + e] = o;
        }
        __syncthreads();
#pragma unroll
        for (int rep = 0; rep < 2; ++rep) { const int idx = tid + NTHR * rep, j = idx >> 6, k = idx & 63; const int n = dir ? N - 1 - (t0 + j) : t0 + j;
            atomicAdd(O + (size_t)(R0 + n) * 512 + h * 64 + k, Lo[idx]); }
        __syncthreads();
    }
    if (!lat) { float* so = F.out + O_SRET + (size_t)((b * 2 + dir) * 8 + h) * 4096;
#pragma unroll
        for (int dd = 0; dd < 8; ++dd) so[(8 * s + dd) * 64 + e] = S[dd]; }
}
__device__ __forceinline__ void run_job(Frame& F, int J) {
    int type, seq, h, dir;
    if (J < 64) { type = J >> 5; const int r = J & 31; seq = 32 + (r >> 4); h = (r >> 1) & 7; dir = r & 1; }
    else { const int r = J - 64; type = r >> 9; const int q = r & 511; seq = q >> 4; h = (q >> 1) & 7; dir = q & 1; }
    if (type == 0) rwkv_job(F, seq, h, dir); else ret_job(F, seq, h, dir);
}
__device__ __forceinline__ void scan_phase(Frame& F) {
    if (F.G > 128) { if (F.bid < 64) run_job(F, F.bid); else for (int J = 64 + (F.bid - 64); J < 1088; J += F.G - 64) run_job(F, J); }
    else for (int J = F.bid; J < 1088; J += F.G) run_job(F, J);
}
__device__ __forceinline__ void rec_post_phase(Frame& F) {
    LAS float* sg = (LAS float*)F.lds + F.wave * 128;
    const int gw = F.bid * NWAVES + F.wave, NGW = F.G * NWAVES, lane = F.lane;
    const bf16* PROJ = F.P; const float* Y = F.S; const float* O = F.S + (size_t)T * 512;
    for (int row = gw; row < T; row += NGW) {
        const bf16* pr = PROJ + (size_t)row * NREC;
        sg[lane] = sigmoidf_(bf1(pr[3712 + lane])); sg[64 + lane] = sigmoidf_(bf1(pr[3776 + lane]));
        asm volatile("s_waitcnt lgkmcnt(0)" ::: "memory");
        for (int h = 0; h < 8; ++h) {
            const int c = h * 64 + lane;
            const float y = Y[(size_t)row * 512 + c];
            const float mu = wave_sum(y) * (1.f / 64.f), dl = y - mu, var = wave_sum(dl * dl) * (1.f / 64.f);
            const float yn = dl * rsqrtf(var + 64e-5f) * F.in[33][c] + F.in[34][c];
            const float r = bf1(pr[2048 + c]), k = bf1(pr[2560 + c]), v = bf1(pr[3072 + c]);
            const float bonus = wave_sum(r * F.in[32][c] * k) * v;
            float g = 0.f;
#pragma unroll 8
            for (int j = 0; j < 128; ++j) g += sg[j] * F.in[29][(size_t)j * 512 + c];
            F.MIX[(size_t)row * D + 512 + c] = (bf16)f2bf((yn + bonus) * g);
        }
        for (int h = 0; h < 8; ++h) {
            const int c = h * 64 + lane;
            const float o = O[(size_t)row * 512 + c];
            const float on = o * rsqrtf(wave_sum(o * o) * (1.f / 64.f) + 1e-6f);
            const float xg = bf1(pr[1536 + c]);
            F.MIX[(size_t)row * D + c] = (bf16)f2bf(xg * sigmoidf_(xg) * on);
        }
        asm volatile("s_waitcnt lgkmcnt(0)" ::: "memory");
    }
}

typedef GAS unsigned gu32;
#define XB_TMO      128
#define XB_XCNT(j)  (256  + 64 * (j))
#define XB_XSUB(j)  (1280 + 64 * (j))
#define XB_XGEN(j)  (2304 + 64 * (j))
#define XB_TOP      3328
#define XB_TOPGEN   3392
#define XCD_BAR_WORDS 3456
#define XB_SPIN_CAP (1u << 18)

__device__ __forceinline__ unsigned xb_ld(unsigned* p)              { return __hip_atomic_load(p, __ATOMIC_RELAXED, __HIP_MEMORY_SCOPE_AGENT); }
__device__ __forceinline__ unsigned xb_add(unsigned* p, unsigned v) { return __hip_atomic_fetch_add(p, v, __ATOMIC_RELAXED, __HIP_MEMORY_SCOPE_AGENT); }
__device__ __forceinline__ unsigned xb_xcc_id() { return (unsigned)__builtin_amdgcn_s_getreg((3 << 11) | 20) & 0xFu; }
#define XB_SPIN(cond, bar) do { unsigned _sp = 0; while (cond) { __builtin_amdgcn_s_sleep(1); \
    if ((++_sp & 255u) == 0u) { if (xb_ld(&(bar)[XB_TMO])) break; if (_sp > XB_SPIN_CAP) { atomicAdd(&(bar)[XB_TMO], 1u); break; } } } } while (0)

struct XcdBarrier {
    unsigned* bar; unsigned x;
    volatile LAS unsigned* st;
};

__device__ __forceinline__ XcdBarrier xcd_barrier_post(unsigned* bar, volatile LAS unsigned* st) {
    XcdBarrier b; b.bar = bar; b.x = xb_xcc_id(); b.st = st;
    if (threadIdx.x == 0) (void)xb_add(&bar[XB_XCNT(b.x)], 1u);
    return b;
}
__device__ __forceinline__ void xcd_barrier_complete(unsigned* bar, unsigned x, unsigned& nloc, unsigned& nx) {
    const unsigned G = gridDim.x * gridDim.y * gridDim.z;
    unsigned sum, cnt, mine, sp = 0u;
    for (;;) {
        sum = 0u; cnt = 0u; mine = 0u;
#pragma unroll
        for (unsigned j = 0; j < 16; ++j) { const unsigned c = xb_ld(&bar[XB_XCNT(j)]); sum += c; cnt += (c > 0u) ? 1u : 0u; mine = (j == x) ? c : mine; }
        if (sum == G) break;
        __builtin_amdgcn_s_sleep(1);
        if ((++sp & 255u) == 0u) { if (xb_ld(&bar[XB_TMO])) break; if (sp > XB_SPIN_CAP) { atomicAdd(&bar[XB_TMO], 1u); break; } }
    }
    nloc = mine > 0u ? mine : 1u; nx = cnt > 0u ? cnt : 1u;
}

__device__ __forceinline__ void xcd_barrier(const XcdBarrier& b) {
    asm volatile("s_waitcnt vmcnt(0)" ::: "memory");
    __syncthreads();
    if (threadIdx.x == 0) {
        unsigned* bar = b.bar;
        __builtin_amdgcn_s_waitcnt(0);
        unsigned nloc = b.st[0], nx = b.st[1];
        if (nloc == 0u) { xcd_barrier_complete(bar, b.x, nloc, nx); b.st[0] = nloc; b.st[1] = nx; }
        const unsigned old = xb_add(&bar[XB_XSUB(b.x)], 1u);
        const unsigned gen = old / nloc;
        if (old + 1u == (gen + 1u) * nloc) {
            __builtin_amdgcn_fence(__ATOMIC_RELEASE, "agent");
            asm volatile("s_waitcnt vmcnt(0)" ::: "memory");
            const unsigned og = xb_add(&bar[XB_TOP], 1u);
            const unsigned tg = og / nx;
            if (og + 1u == (tg + 1u) * nx) xb_add(&bar[XB_TOPGEN], 1u);
            else XB_SPIN(xb_ld(&bar[XB_TOPGEN]) == tg, bar);
            __builtin_amdgcn_fence(__ATOMIC_ACQUIRE, "agent");
            xb_add(&bar[XB_XGEN(b.x)], 1u);
            asm volatile("s_waitcnt vmcnt(0)" ::: "memory");
        } else {
            XB_SPIN(xb_ld(&bar[XB_XGEN(b.x)]) == gen, bar);
            __builtin_amdgcn_fence(__ATOMIC_ACQUIRE, "agent");
            asm volatile("s_waitcnt vmcnt(0)" ::: "memory");
        }
    }
    __syncthreads();
}

#ifndef PROBE_DUP
#define PROBE_DUP 0
#endif
#ifndef ATTN_MFMA
#define ATTN_MFMA 1
#endif
enum { PH_BASE = __COUNTER__ };
struct Args { const float* in[37]; float* out; unsigned char* ws; int ph_lo, ph_hi; };

template <bool COOP>
__global__ void __launch_bounds__(NTHR, 2) mk_fwd(Args args) {
    extern __shared__ __attribute__((aligned(16))) unsigned char lds[];
    Frame F;
    F.lds = (LAS unsigned char*)lds;
    F.tid = threadIdx.x; F.lane = F.tid & 63; F.wave = __builtin_amdgcn_readfirstlane(F.tid >> 6); F.G = gridDim.x; F.bid = blockIdx.x;
#pragma unroll
    for (int i = 0; i < 37; ++i) F.in[i] = args.in[i];
    F.out = args.out; F.ws = args.ws;
    unsigned char* ws = args.ws;
    F.Watt = (bf16*)(ws + WS_WATT); F.Woa = (bf16*)(ws + WS_WOA); F.Wrec = (bf16*)(ws + WS_WREC); F.Wor = (bf16*)(ws + WS_WOR); F.Wf1 = (bf16*)(ws + WS_WF1); F.Wf2 = (bf16*)(ws + WS_WF2);
    F.H = (bf16*)(ws + WS_H); F.MIX = (bf16*)(ws + WS_MIX); F.P = (bf16*)(ws + WS_P); F.MOD = (float*)(ws + WS_MOD); F.S = (float*)(ws + WS_S);
    volatile LAS unsigned* MISC = (volatile LAS unsigned*)(F.lds + LDS_BYTES - 256);
    if (F.tid < 16) MISC[F.tid] = 0u;
    __syncthreads();
    XcdBarrier bar; bar.bar = (unsigned*)(ws + WS_CTL) + 4096; bar.x = 0; bar.st = nullptr;
    if (COOP) bar = xcd_barrier_post((unsigned*)(ws + WS_CTL) + 4096, MISC + 8);
    const int lo = args.ph_lo, hi = args.ph_hi;
#define IN(k) (lo <= (k) && (k) < hi)
#define SEAM(k) do { if (COOP && IN((k) + 1)) { if ((k) == 0) cooperative_groups::this_grid().sync(); else xcd_barrier(bar); } } while (0)
    const f32x2v* rope = (const f32x2v*)((unsigned char*)F.MOD + MOD_ROPE);

#define PHASE(...) { constexpr int k_ = __COUNTER__ - PH_BASE - 1; if (IN(k_)) { __VA_ARGS__; SEAM(k_); } }
    PHASE(p0_prologue(F))
#if PROBE_DUP == 3
    PHASE(p0_prologue(F))
#endif
    PHASE(norm_phase(F, F.in[0], F.in[1], F.in[10], F.MOD, 0, 1, false))
    PHASE(pg8::Gemm g{F.H, F.Watt, T, NATT, D}; pg8::StaticOrder S; S.init(T, NATT, F.G, F.bid); EpiAttnIn E{F.P, F.out, rope};
          pg8::gemm_phase<EpiAttnIn, pg8::StaticOrder, true, true>(F.lds, g, S, E))
#if ATTN_MFMA
    PHASE(attn_mfma_phase(F))
#if PROBE_DUP == 1
    PHASE(attn_mfma_phase(F))
#endif
#else
    PHASE(attn_naive_phase(F))
    PHASE(diff_post_phase(F))
#endif
    PHASE(pg8::Gemm g{F.MIX, F.Woa, T, D, D}; pg8::StaticOrder S; S.init(T, D, F.G, F.bid); EpiResid E{F.in[0], F.in[1], F.out, F.MOD, 2};
          pg8::gemm_phase<EpiResid, pg8::StaticOrder, true, true>(F.lds, g, S, E))
    PHASE(norm_phase(F, F.out, F.out + (size_t)TCX * D, F.in[11], F.MOD, 3, 4, false))
    PHASE(pg8::Gemm g{F.H, F.Wf1, T, NFF, D}; pg8::StaticOrder S; S.init(T, NFF, F.G, F.bid); EpiSwiglu E{F.P};
          pg8::gemm_phase<EpiSwiglu, pg8::StaticOrder, true, true>(F.lds, g, S, E))
#if PROBE_DUP == 5
    PHASE(pg8::Gemm g{F.H, F.Wf1, T, NFF, D}; pg8::StaticOrder S; S.init(T, NFF, F.G, F.bid); EpiSwiglu E{F.P};
          pg8::gemm_phase<EpiSwiglu, pg8::StaticOrder, true, true>(F.lds, g, S, E))
#endif
    PHASE(pg8::Gemm g{F.P, F.Wf2, T, D, DFF}; pg8::StaticOrder S; S.init(T, D, F.G, F.bid); EpiResid E{F.out, F.out + (size_t)TCX * D, F.out, F.MOD, 5};
          pg8::gemm_phase<EpiResid, pg8::StaticOrder, true, true>(F.lds, g, S, E))
    PHASE(norm_phase(F, F.out, F.out + (size_t)TCX * D, F.in[10] + D, F.MOD + 3 * 6144, 0, 1, true))
    PHASE(pg8::Gemm g{F.H, F.Wrec, T, NREC, D}; pg8::StaticOrder S; S.init(T, NREC, F.G, F.bid); EpiBf16Plain E{F.P, NREC};
          pg8::gemm_phase<EpiBf16Plain, pg8::StaticOrder, true, true>(F.lds, g, S, E))
    PHASE(scan_phase(F))
#if PROBE_DUP == 2
    PHASE(zero_s_phase(F))
    PHASE(scan_phase(F))
#endif
    PHASE(rec_post_phase(F))
#if PROBE_DUP == 4
    PHASE(rec_post_phase(F))
#endif
    PHASE(pg8::Gemm g{F.MIX, F.Wor, T, D, D}; pg8::StaticOrder S; S.init(T, D, F.G, F.bid); EpiResid E{F.out, F.out + (size_t)TCX * D, F.out, F.MOD + 3 * 6144, 2};
          pg8::gemm_phase<EpiResid, pg8::StaticOrder, true, true>(F.lds, g, S, E))
    PHASE(norm_phase(F, F.out, F.out + (size_t)TCX * D, F.in[11] + D, F.MOD + 3 * 6144, 3, 4, false))
    PHASE(pg8::Gemm g{F.H, F.Wf1 + WF1_STRIDE, T, NFF, D}; pg8::StaticOrder S; S.init(T, NFF, F.G, F.bid); EpiSwiglu E{F.P};
          pg8::gemm_phase<EpiSwiglu, pg8::StaticOrder, true, true>(F.lds, g, S, E))
    PHASE(pg8::Gemm g{F.P, F.Wf2 + WF2_STRIDE, T, D, DFF}; pg8::StaticOrder S; S.init(T, D, F.G, F.bid); EpiResid E{F.out, F.out + (size_t)TCX * D, F.out, F.MOD + 3 * 6144, 5};
          pg8::gemm_phase<EpiResid, pg8::StaticOrder, true, true>(F.lds, g, S, E))
    PHASE(final_norm_phase(F))
#undef PHASE
#undef IN
#undef SEAM
}

constexpr int NPHASE = __COUNTER__ - PH_BASE - 1;
#ifndef MK_N_LAUNCHES
#define MK_N_LAUNCHES 1
#endif
extern "C" void kernel_launch(void* const* d_in, const int* in_sizes, int n_in, void* d_out, int out_size, void* d_ws, size_t ws_size, hipStream_t stream) {
    static int grid = 0;
    if (grid == 0) {
        if (n_in != 37 || out_size != 33554432 || ws_size < WS_END) { fprintf(stderr, "kernel_launch: unexpected problem (n_in %d out %d ws %zu)\n", n_in, out_size, ws_size); grid = -1; return; }
        int dev = 0, cus = 0, per_cu = 0;
        if (hipGetDevice(&dev) != hipSuccess || hipDeviceGetAttribute(&cus, hipDeviceAttributeMultiprocessorCount, dev) != hipSuccess) { grid = -1; return; }
        (void)hipFuncSetAttribute((const void*)mk_fwd<false>, hipFuncAttributeMaxDynamicSharedMemorySize, LDS_BYTES);
        (void)hipFuncSetAttribute((const void*)mk_fwd<true>, hipFuncAttributeMaxDynamicSharedMemorySize, LDS_BYTES);
        if (hipOccupancyMaxActiveBlocksPerMultiprocessor(&per_cu, (const void*)mk_fwd<true>, NTHR, LDS_BYTES) != hipSuccess || per_cu < 1) per_cu = 1;
        (void)hipGetLastError();
        grid = cus;
    }
    if (grid < 0) return;
    if (hipMemsetAsync((char*)d_ws + WS_CTL, 0, 65536, stream) != hipSuccess) { fprintf(stderr, "memset failed\n"); return; }
    Args a{};
    for (int i = 0; i < 37; ++i) a.in[i] = (const float*)d_in[i];
    a.out = (float*)d_out; a.ws = (unsigned char*)d_ws;
#if MK_N_LAUNCHES == 1
    a.ph_lo = 0; a.ph_hi = NPHASE;
    void* kargs[] = {&a};
    hipError_t e = hipLaunchCooperativeKernel((const void*)mk_fwd<true>, dim3(grid), dim3(NTHR), kargs, LDS_BYTES, stream);
    if (e != hipSuccess) fprintf(stderr, "cooperative launch failed: %s (grid %d)\n", hipGetErrorString(e), grid);
#else
    for (int ph = 0; ph < NPHASE; ++ph) { a.ph_lo = ph; a.ph_hi = ph + 1; hipLaunchKernelGGL(mk_fwd<false>, dim3(grid), dim3(NTHR), LDS_BYTES, stream, a); }
#endif
}
```

```cpp
#include <hip/hip_runtime.h>
#include <hip/hip_cooperative_groups.h>
#include <cstdio>
#include <cstdint>
namespace pg8 {
#define PG8_LAS __attribute__((address_space(3)))
typedef unsigned short bf16_t;
typedef short bf16x8 __attribute__((ext_vector_type(8)));
typedef float f32x4 __attribute__((ext_vector_type(4)));
typedef unsigned u32x4 __attribute__((ext_vector_type(4)));
constexpr int BM = 256, BK = 64, HALF = 128, HTB = HALF * BK * 2  , STAGE_BYTES = 8 * HTB, NXCD = 8, WGM = 8;

__host__ __device__ __forceinline__ int lds_byte(int r, int c) { const int st = (r >> 4) * 2 + (c >> 5), rr = r & 15, cc = c & 31, ob = rr * 64 + cc * 2; return st * 1024 + (ob ^ (((ob >> 9) & 1) << 5)); }
__host__ __device__ __forceinline__ void stage_rc(int b, int& R, int& C) { const int st = b / 1024, sb = b % 1024, swz = sb ^ (((sb >> 9) & 1) << 5); R = (st >> 1) * 16 + swz / 64; C = (st & 1) * 32 + (swz % 64) / 2; }
__host__ __device__ __forceinline__ int perm32(int rho) { const int n = rho >> 4, i = rho & 15; return 8 * (i >> 2) + 4 * n + (i & 3); }

struct Unit { int pm, pn; };
struct Gemm { const bf16_t* A; const bf16_t* Bt; int M, N, K; };

struct StaticOrder {
    int nM, nN, nwg, G, c;
    __host__ __device__ void init(int M, int N, int G_, int c_) { nM = M / BM; nN = N / BM; nwg = nM * nN; G = G_; c = c_; }
    __host__ __device__ bool next(int i, Unit& u) const {
        const long L = (long)i * G + c; if (L >= nwg) return false;
        int wgid = (int)L; { const int q = nwg / NXCD, r = nwg % NXCD, xcd = wgid % NXCD, off = wgid / NXCD; wgid = (xcd < r ? xcd * (q + 1) : r * (q + 1) + (xcd - r) * q) + off; }
        const int nig = WGM * nN, gid = wgid / nig, fm = gid * WGM, gsz = (nM - fm) < WGM ? (nM - fm) : WGM;
        u.pm = fm + ((wgid % nig) % gsz); u.pn = (wgid % nig) / gsz; return true;
    }
    __device__ __forceinline__ void a_ready(const Unit&) const {}
    __device__ __forceinline__ void done(const Unit&) const {}
};
__device__ __forceinline__ unsigned cvt_pk_bf16(float lo, float hi) { unsigned r; asm volatile("v_cvt_pk_bf16_f32 %0, %1, %2" : "=v"(r) : "v"(lo), "v"(hi)); return r; }
typedef float f32x2 __attribute__((ext_vector_type(2)));
template <class Epi, class Sched, bool ALIGN_EPI = false, bool SP2 = false>
__device__ __forceinline__ void gemm_phase(PG8_LAS unsigned char* lds, const Gemm g, const Sched& S, const Epi& E) {
    const int tid = threadIdx.x, wid = __builtin_amdgcn_readfirstlane(tid >> 6), lane = tid & 63, wr = wid >> 2, wc = wid & 3, fr = lane & 15, fq = lane >> 4;
    const int K = g.K, nt = K / BK;
    unsigned voffA[2], voffB[2];
#pragma unroll
    for (int i = 0; i < 2; ++i) { int R, C; stage_rc(tid * 16 + i * 8192, R, C); const int Rb = Epi::PERM ? ((R & ~31) + perm32(R & 31)) : R;
        voffA[i] = (unsigned)(R * K + C) * 2u; voffB[i] = (unsigned)(Rb * K + C) * 2u; }
    const size_t kstep = (size_t)(BK * 2);
    const size_t hstep = (size_t)HALF * K * 2;
    const size_t tstep = 2 * hstep;
    const unsigned ldsw = (unsigned)wid * 1024u;
    const int aoff = lds_byte(wr * 64 + fr, fq * 8), boff = lds_byte(wc * 32 + fr, fq * 8);
#define PG8_SA(b, h) (((b) * 2 + (h)) * HTB)
#define PG8_SB(b, h) ((4 + (b) * 2 + (h)) * HTB)
#define PG8_STAGE(bufoff, gbase, voff) do { _Pragma("unroll") for (int _i = 0; _i < 2; ++_i) \
        __builtin_amdgcn_global_load_lds((const unsigned*)((const char*)(gbase) + (voff)[_i]), (PG8_LAS unsigned*)(lds + (bufoff) + ldsw + _i * 8192), 16, 0, 0); } while (0)
#define PG8_LDA(dst, b, h) do { _Pragma("unroll") for (int m = 0; m < 4; ++m) _Pragma("unroll") for (int k = 0; k < 2; ++k) dst[m][k] = *(const PG8_LAS bf16x8*)(lds + PG8_SA(b, h) + aoff + m * 2048 + k * 1024); } while (0)
#define PG8_LDB(dst, b, h) do { _Pragma("unroll") for (int n = 0; n < 2; ++n) _Pragma("unroll") for (int k = 0; k < 2; ++k) dst[n][k] = *(const PG8_LAS bf16x8*)(lds + PG8_SB(b, h) + boff + n * 2048 + k * 1024); } while (0)
#define PG8_MMA(ai, bj, At, Bt) do { __builtin_amdgcn_s_setprio(1); _Pragma("unroll") for (int m = 0; m < 4; ++m) _Pragma("unroll") for (int n = 0; n < 2; ++n) _Pragma("unroll") for (int k = 0; k < 2; ++k) \
        acc[ai][bj][m][n] = __builtin_amdgcn_mfma_f32_16x16x32_bf16(Bt[n][k], At[m][k], acc[ai][bj][m][n], 0, 0, 0); __builtin_amdgcn_s_setprio(0); } while (0)
#define PG8_WAIT_V(n) asm volatile("s_waitcnt vmcnt(" #n ")" ::: "memory")
#define PG8_WAIT_L(n) asm volatile("s_waitcnt lgkmcnt(" #n ")" ::: "memory")
#define PG8_BAR __builtin_amdgcn_s_barrier()
#define PG8_SCHED __builtin_amdgcn_sched_barrier(0)
    Unit cur, nxt; int ui = 0;
    if (!S.next(0, cur)) return;
    f32x4 acc[2][2][4][2];
#pragma unroll
    for (int a = 0; a < 2; ++a)
#pragma unroll
        for (int b = 0; b < 2; ++b)
#pragma unroll
            for (int m = 0; m < 4; ++m)
#pragma unroll
                for (int n = 0; n < 2; ++n) acc[a][b][m][n] = (f32x4){0.f, 0.f, 0.f, 0.f};
    bf16x8 At[4][2], B0[2][2], B1[2][2];
    const char* cA = (const char*)g.A + (size_t)cur.pm * tstep; const char* cB = (const char*)g.Bt + (size_t)cur.pn * tstep;
    S.a_ready(cur);
    if constexpr (SP2) {
        PG8_STAGE(PG8_SB(0, 0), cB, voffB); PG8_STAGE(PG8_SB(0, 1), cB + hstep, voffB); PG8_STAGE(PG8_SA(0, 0), cA, voffA); PG8_STAGE(PG8_SA(0, 1), cA + hstep, voffA);
        if (wr == 1) PG8_BAR;
        PG8_WAIT_V(2); PG8_BAR;
        PG8_STAGE(PG8_SB(1, 0), cB + kstep, voffB); PG8_STAGE(PG8_SA(1, 0), cA + kstep, voffA); PG8_STAGE(PG8_SB(1, 1), cB + hstep + kstep, voffB);
        PG8_WAIT_V(6); PG8_BAR;
    } else {
        PG8_STAGE(PG8_SB(0, 0), cB, voffB); PG8_STAGE(PG8_SA(0, 0), cA, voffA); PG8_STAGE(PG8_SB(0, 1), cB + hstep, voffB); PG8_STAGE(PG8_SA(0, 1), cA + hstep, voffA);
        if (wr == 1) PG8_BAR;
        PG8_WAIT_V(4); PG8_BAR;
        PG8_STAGE(PG8_SB(1, 0), cB + kstep, voffB); PG8_STAGE(PG8_SA(1, 0), cA + kstep, voffA); PG8_STAGE(PG8_SB(1, 1), cB + hstep + kstep, voffB);
        PG8_WAIT_V(6); PG8_BAR;
    }
    for (;;) {
        const bool has_next = S.next(ui + 1, nxt);
        const char* nA = has_next ? (const char*)g.A + (size_t)nxt.pm * tstep : cA; const char* nB = has_next ? (const char*)g.Bt + (size_t)nxt.pn * tstep : cB;
        for (int t = 0; t < nt; t += 2) {
            const bool last = (t == nt - 2);
            const char* a1 = cA + (size_t)(t + 1) * kstep;
            const char* a2 = last ? nA : cA + (size_t)(t + 2) * kstep; const char* b2 = last ? nB : cB + (size_t)(t + 2) * kstep;
            const char* a3 = a2 + kstep; const char* b3 = b2 + kstep;
            if (last && has_next) S.a_ready(nxt);
            if constexpr (SP2) {
            PG8_LDB(B0, 0, 0); PG8_LDB(B1, 0, 1); PG8_SCHED; PG8_LDA(At, 0, 0); PG8_STAGE(PG8_SA(1, 1), a1 + hstep, voffA);
            PG8_WAIT_V(8); PG8_WAIT_L(0); PG8_BAR; PG8_MMA(0, 0, At, B0); PG8_MMA(0, 1, At, B1); PG8_BAR; PG8_SCHED;
            PG8_LDA(At, 0, 1); PG8_STAGE(PG8_SB(0, 0), b2, voffB); PG8_STAGE(PG8_SB(0, 1), b2 + hstep, voffB); PG8_STAGE(PG8_SA(0, 0), a2, voffA);
            PG8_WAIT_V(8); PG8_WAIT_L(0); PG8_BAR; PG8_MMA(1, 0, At, B0); PG8_MMA(1, 1, At, B1); PG8_BAR; PG8_SCHED;
            PG8_LDB(B0, 1, 0); PG8_LDB(B1, 1, 1); PG8_SCHED; PG8_LDA(At, 1, 0); PG8_STAGE(PG8_SA(0, 1), a2 + hstep, voffA);
            PG8_WAIT_V(8); PG8_WAIT_L(0); PG8_BAR; PG8_MMA(0, 0, At, B0); PG8_MMA(0, 1, At, B1); PG8_BAR; PG8_SCHED;
            PG8_LDA(At, 1, 1); PG8_STAGE(PG8_SB(1, 0), b3, voffB); PG8_STAGE(PG8_SB(1, 1), b3 + hstep, voffB); PG8_STAGE(PG8_SA(1, 0), a3, voffA);
            PG8_WAIT_V(8); PG8_WAIT_L(0); PG8_BAR; PG8_MMA(1, 0, At, B0); PG8_MMA(1, 1, At, B1); PG8_BAR; PG8_SCHED;
            } else {
            PG8_LDB(B0, 0, 0); PG8_SCHED; PG8_LDA(At, 0, 0); PG8_STAGE(PG8_SA(1, 1), a1 + hstep, voffA);
            PG8_WAIT_L(8); PG8_BAR; PG8_WAIT_L(0); PG8_MMA(0, 0, At, B0); PG8_BAR; PG8_SCHED;
            PG8_LDB(B1, 0, 1); PG8_STAGE(PG8_SB(0, 0), b2, voffB);
            PG8_BAR; PG8_WAIT_L(0); PG8_MMA(0, 1, At, B1); PG8_BAR;
            PG8_LDA(At, 0, 1); PG8_STAGE(PG8_SA(0, 0), a2, voffA);
            PG8_BAR; PG8_WAIT_L(0); PG8_MMA(1, 0, At, B0); PG8_BAR; PG8_SCHED;
            PG8_STAGE(PG8_SB(0, 1), b2 + hstep, voffB);
            PG8_WAIT_V(6); PG8_BAR; PG8_MMA(1, 1, At, B1); PG8_BAR;
            PG8_LDB(B0, 1, 0); PG8_SCHED; PG8_LDA(At, 1, 0); PG8_STAGE(PG8_SA(0, 1), a2 + hstep, voffA);
            PG8_WAIT_L(8); PG8_BAR; PG8_WAIT_L(0); PG8_MMA(0, 0, At, B0); PG8_BAR; PG8_SCHED;
            PG8_LDB(B1, 1, 1); PG8_STAGE(PG8_SB(1, 0), b3, voffB);
            PG8_BAR; PG8_WAIT_L(0); PG8_MMA(0, 1, At, B1); PG8_BAR;
            PG8_LDA(At, 1, 1); PG8_STAGE(PG8_SA(1, 0), a3, voffA);
            PG8_BAR; PG8_WAIT_L(0); PG8_MMA(1, 0, At, B0); PG8_BAR; PG8_SCHED;
            PG8_STAGE(PG8_SB(1, 1), b3 + hstep, voffB);
            PG8_WAIT_V(6); PG8_BAR; PG8_MMA(1, 1, At, B1); PG8_BAR;
            }
        }
        if constexpr (ALIGN_EPI) { if (wr == 0) PG8_BAR; }
        if constexpr (!Epi::AFTER_DRAIN) { E(acc, cur, wr, wc, fr, fq); S.done(cur); }
        if (!has_next) break;
#pragma unroll
        for (int a = 0; a < 2; ++a)
#pragma unroll
            for (int b = 0; b < 2; ++b)
#pragma unroll
                for (int m = 0; m < 4; ++m)
#pragma unroll
                    for (int n = 0; n < 2; ++n) acc[a][b][m][n] = (f32x4){0.f, 0.f, 0.f, 0.f};
        cur = nxt; cA = nA; cB = nB; ++ui;
        if constexpr (ALIGN_EPI) { if (wr == 1) PG8_BAR; }
    }
    PG8_WAIT_V(0);
    if constexpr (!ALIGN_EPI) { if (wr == 0) PG8_BAR; }
    PG8_BAR;
    if constexpr (Epi::AFTER_DRAIN) { E.fused(acc, cur, wr, wc, fr, fq, lds, wid, lane); S.done(cur); }
#undef PG8_SA
#undef PG8_SB
#undef PG8_STAGE
#undef PG8_LDA
#undef PG8_LDB
#undef PG8_MMA
#undef PG8_WAIT_V
#undef PG8_WAIT_L
#undef PG8_BAR
#undef PG8_SCHED
}
}

#define GAS __attribute__((address_space(1)))
#define LAS __attribute__((address_space(3)))
typedef unsigned short bf16;
typedef unsigned v4u __attribute__((ext_vector_type(4)));
typedef unsigned v2u __attribute__((ext_vector_type(2)));
typedef float f32x4 __attribute__((ext_vector_type(4)));
typedef float f32x2v __attribute__((ext_vector_type(2)));

constexpr int NWAVES = 8, NTHR = 512;
constexpr int D = 1024, TCX = 8192, TLT = 4096, T = 12288;
constexpr int NATT = 3072, NREC = 3840, DFF = 2816, NFF = 5632;
constexpr int QLD = NATT;
constexpr size_t MiB = 1u << 20;
constexpr size_t WS_CTL = 0, WS_MOD = 1 * MiB, WS_WATT = 2 * MiB, WS_WOA = 8 * MiB, WS_WREC = 10 * MiB, WS_WOR = 18 * MiB, WS_WF1 = 20 * MiB, WS_WF2 = 42 * MiB,
                 WS_H = 54 * MiB, WS_MIX = 78 * MiB, WS_P = 102 * MiB, WS_S = 192 * MiB, WS_END = 256 * MiB;
constexpr size_t MOD_ROPE = 160 * 1024, MOD_LAM = 176 * 1024, MOD_GUPT = 256 * 1024;
constexpr size_t WF1_STRIDE = (size_t)NFF * D;
constexpr size_t WF2_STRIDE = (size_t)D * DFF;
constexpr size_t O_YP = 0, O_YS = 8388608, O_NAK = 12582912, O_NAV = 16777216, O_DFK = 20971520, O_DFV = 25165824, O_SRET = 29360128, O_SRW = 31457280;
constexpr int LDS_BYTES = 147456;

__device__ __forceinline__ float bflo(unsigned u) { return __uint_as_float(u << 16); }
__device__ __forceinline__ float bfhi(unsigned u) { return __uint_as_float(u & 0xffff0000u); }
__device__ __forceinline__ float bf1(bf16 b) { return __uint_as_float(((unsigned)b) << 16); }
__device__ __forceinline__ unsigned f2bf(float f) { unsigned u = __float_as_uint(f); return (u + 0x7fffu + ((u >> 16) & 1u)) >> 16; }
__device__ __forceinline__ unsigned pk2(float lo, float hi) { return f2bf(lo) | (f2bf(hi) << 16); }
__device__ __forceinline__ float wave_sum(float v) {
#pragma unroll
    for (int o = 1; o < 64; o <<= 1) v += __shfl_xor(v, o);
    return v;
}
__device__ __forceinline__ float sigmoidf_(float x) { return 1.f / (1.f + __expf(-x)); }

struct Frame {
    LAS unsigned char* lds;
    int tid, lane, wave, G, bid;
    const float* in[37];
    float* out; unsigned char* ws;
    bf16 *Watt, *Woa, *Wrec, *Wor, *Wf1, *Wf2, *H, *MIX, *P;
    float *MOD, *S;
};

__device__ __forceinline__ void transpose_item(const float* W, int K, int N, bf16* WT, int k0, int n0, int drow0, LAS float* scr, int lane) {
#pragma unroll 8
    for (int i = 0; i < 32; ++i) { const int kk = 2 * i + (lane >> 5); scr[kk * 33 + (lane & 31)] = W[(size_t)(k0 + kk) * N + n0 + (lane & 31)]; }
    asm volatile("s_waitcnt lgkmcnt(0)" ::: "memory");
    const int c = lane & 7;
#pragma unroll
    for (int j = 0; j < 4; ++j) { const int n = (lane >> 3) + 8 * j; const LAS float* s = scr + (8 * c) * 33 + n;
        v4u o; o.x = pk2(s[0 * 33], s[1 * 33]); o.y = pk2(s[2 * 33], s[3 * 33]); o.z = pk2(s[4 * 33], s[5 * 33]); o.w = pk2(s[6 * 33], s[7 * 33]);
        *(v4u*)(WT + (size_t)(drow0 + n) * K + k0 + 8 * c) = o; }
    asm volatile("s_waitcnt lgkmcnt(0)" ::: "memory");
}

__device__ __forceinline__ void p0_prologue(Frame& F) {
    {
        LAS float* sc = (LAS float*)F.lds;
        LAS float* red = sc + 3072;
        for (int idx = F.tid; idx < 3072; idx += NTHR) { const int j = idx >> 10, k = idx & 1023; const float c = (j == 0) ? F.in[9][k] : F.in[8][(j - 1) * 1024 + k]; sc[idx] = c * sigmoidf_(c); }
        __syncthreads();
        for (int item = F.bid; item < 192; item += F.G) {
            const int layer = item / 96, col = (item % 96) * 64 + (F.tid & 63), kg = F.tid >> 6;
            const float* w = F.in[13] + (size_t)layer * 1024 * 6144 + col;
            float a0 = 0.f, a1 = 0.f, a2 = 0.f;
#pragma unroll 8
            for (int k = kg * 128; k < kg * 128 + 128; ++k) { const float wv = w[(size_t)k * 6144]; a0 += sc[k] * wv; a1 += sc[1024 + k] * wv; a2 += sc[2048 + k] * wv; }
            red[(kg * 3 + 0) * 64 + (F.tid & 63)] = a0; red[(kg * 3 + 1) * 64 + (F.tid & 63)] = a1; red[(kg * 3 + 2) * 64 + (F.tid & 63)] = a2;
            __syncthreads();
            if (F.tid < 192) { const int j = F.tid >> 6, c = F.tid & 63; float s = 0.f;
#pragma unroll
                for (int g = 0; g < 8; ++g) s += red[(g * 3 + j) * 64 + c];
                const int cc = (item % 96) * 64 + c; F.MOD[(layer * 3 + j) * 6144 + cc] = s + F.in[14][layer * 6144 + cc]; }
            __syncthreads();
        }
    }
    if (F.bid == F.G - 1) {
        f32x2v* rope = (f32x2v*)((unsigned char*)F.MOD + MOD_ROPE);
        for (int idx = F.tid; idx < 1024; idx += NTHR) { const int pos = idx >> 4, i = idx & 15; const float inv = powf(10000.0f, -(float)i / 16.0f); const float ang = (float)pos * inv; rope[idx] = (f32x2v){cosf(ang), sinf(ang)}; }
        if (F.wave == 0) { const float s1 = wave_sum(F.in[18][F.lane] * F.in[19][F.lane]), s2 = wave_sum(F.in[20][F.lane] * F.in[21][F.lane]);
            if (F.lane == 0) *(float*)((unsigned char*)F.MOD + MOD_LAM) = expf(s1) - expf(s2) + 0.2f; }
    }
    { bf16* GUPT = (bf16*)(F.ws + WS_MOD + MOD_GUPT);
      for (int idx = F.bid * NTHR + F.tid; idx < 65536; idx += F.G * NTHR) { const int n = idx >> 7, k = idx & 127; GUPT[idx] = (bf16)f2bf(F.in[29][(size_t)k * 512 + n]); } }
    {
        const int gt = F.bid * NTHR + F.tid, NG = F.G * NTHR;
        for (int idx = gt; idx < 4 * 512 * 64; idx += NG) { const int t = idx / (512 * 64), r = (idx / 64) % 512, c8 = idx % 64;
            const float* srcb = (t == 0) ? F.in[2] : (t == 1) ? F.in[3] : (t == 2) ? F.in[4] : F.in[5]; const float* src = srcb + (size_t)r * 512 + c8 * 8; const int colb = (t == 0) ? 512 : (t == 1) ? 1024 : (t == 2) ? 2048 : 2560;
            const f32x4 a = *(const f32x4*)src, b = *(const f32x4*)(src + 4);
            v4u o; o.x = pk2(a[0], a[1]); o.y = pk2(a[2], a[3]); o.z = pk2(b[0], b[1]); o.w = pk2(b[2], b[3]);
            *(v4u*)(F.P + (size_t)(T + r) * QLD + colb + c8 * 8) = o; }
    }
    {
        LAS float* scr = (LAS float*)(F.lds + 20480 + F.wave * 8448);
        __syncthreads();
        const int gw = F.bid * NWAVES + F.wave, NGW = F.G * NWAVES;
        constexpr int I0 = 16 * 96, I1 = 16 * 32, I2 = 16 * 120, I3 = 16 * 32, I4 = 16 * 176, I6 = 44 * 32;
        constexpr int NIT = I0 + I1 + I2 + I3 + 2 * I4 + 2 * I6;
        for (int it = gw; it < NIT; it += NGW) {
            int r = it;
            if (r < I0) { const int nb = 96; transpose_item(F.in[15], 1024, 3072, F.Watt, 64 * (r / nb), 32 * (r % nb), 32 * (r % nb), scr, F.lane); continue; } r -= I0;
            if (r < I1) { const int nb = 32; transpose_item(F.in[16], 1024, 1024, F.Woa, 64 * (r / nb), 32 * (r % nb), 32 * (r % nb), scr, F.lane); continue; } r -= I1;
            if (r < I2) { const int nb = 120; transpose_item(F.in[22], 1024, 3840, F.Wrec, 64 * (r / nb), 32 * (r % nb), 32 * (r % nb), scr, F.lane); continue; } r -= I2;
            if (r < I3) { const int nb = 32; transpose_item(F.in[23], 1024, 1024, F.Wor, 64 * (r / nb), 32 * (r % nb), 32 * (r % nb), scr, F.lane); continue; } r -= I3;
            if (r < 2 * I4) { const int l = r / I4; r -= l * I4; const int nb = 176, n0 = 32 * (r % nb);
                const int drow = (n0 < DFF) ? ((n0 / 128) * 256 + (n0 % 128)) : (((n0 - DFF) / 128) * 256 + 128 + ((n0 - DFF) % 128));
                transpose_item(F.in[35] + (size_t)l * 1024 * NFF, 1024, NFF, F.Wf1 + (size_t)l * WF1_STRIDE, 64 * (r / nb), n0, drow, scr, F.lane); continue; } r -= 2 * I4;
            { const int l = r / I6; r -= l * I6; const int nb = 32;
                transpose_item(F.in[36] + (size_t)l * DFF * 1024, DFF, 1024, F.Wf2 + (size_t)l * WF2_STRIDE, 64 * (r / nb), 32 * (r % nb), 32 * (r % nb), scr, F.lane); }
        }
    }
}

__device__ __forceinline__ void norm_phase(Frame& F, const float* xc, const float* xl, const float* g, const float* mod  , int shift_i, int scale_i, bool zero_s) {
    const int gw = F.bid * NWAVES + F.wave, NGW = F.G * NWAVES;
    for (int row = gw; row < T; row += NGW) {
        const float* xr = (row < TCX) ? xc + (size_t)row * D : xl + (size_t)(row - TCX) * D;
        const int cond = (row < TCX) ? 0 : 1 + ((row - TCX) >> 11);
        const float* sh = mod + cond * 6144 + shift_i * 1024; const float* sc = mod + cond * 6144 + scale_i * 1024;
        f32x4 v[4]; float ss = 0.f;
#pragma unroll
        for (int j = 0; j < 4; ++j) { v[j] = *(const f32x4*)(xr + 4 * F.lane + 256 * j); ss += (v[j][0] * v[j][0] + v[j][1] * v[j][1]) + (v[j][2] * v[j][2] + v[j][3] * v[j][3]); }
        const float rstd = rsqrtf(wave_sum(ss) * (1.f / D) + 1e-6f);
#pragma unroll
        for (int j = 0; j < 4; ++j) { const int c = 4 * F.lane + 256 * j; const f32x4 gg = *(const f32x4*)(g + c), s1 = *(const f32x4*)(sc + c), s0 = *(const f32x4*)(sh + c);
            f32x4 h;
#pragma unroll
            for (int e = 0; e < 4; ++e) h[e] = v[j][e] * rstd * gg[e] * (1.f + s1[e]) + s0[e];
            v2u o; o.x = pk2(h[0], h[1]); o.y = pk2(h[2], h[3]); *(v2u*)(F.H + (size_t)row * D + c) = o; }
    }
    if (zero_s) {
        const size_t n16 = (size_t)48 * MiB / 16; f32x4* p = (f32x4*)F.S;
        for (size_t i = (size_t)F.bid * NTHR + F.tid; i < n16; i += (size_t)F.G * NTHR) p[i] = (f32x4){0.f, 0.f, 0.f, 0.f};
    }
}
__device__ __forceinline__ void zero_s_phase(Frame& F) {
    const size_t n16 = (size_t)48 * MiB / 16; f32x4* p = (f32x4*)F.S;
    for (size_t i = (size_t)F.bid * NTHR + F.tid; i < n16; i += (size_t)F.G * NTHR) p[i] = (f32x4){0.f, 0.f, 0.f, 0.f};
}
__device__ __forceinline__ void final_norm_phase(Frame& F) {
    const int gw = F.bid * NWAVES + F.wave, NGW = F.G * NWAVES; const float* g = F.in[12];
    for (int row = gw; row < T; row += NGW) {
        float* xr = F.out + (size_t)row * D;
        f32x4 v[4]; float ss = 0.f;
#pragma unroll
        for (int j = 0; j < 4; ++j) { v[j] = *(const f32x4*)(xr + 4 * F.lane + 256 * j); ss += (v[j][0] * v[j][0] + v[j][1] * v[j][1]) + (v[j][2] * v[j][2] + v[j][3] * v[j][3]); }
        const float rstd = rsqrtf(wave_sum(ss) * (1.f / D) + 1e-6f);
#pragma unroll
        for (int j = 0; j < 4; ++j) { const int c = 4 * F.lane + 256 * j; const f32x4 gg = *(const f32x4*)(g + c); *(f32x4*)(xr + c) = v[j] * rstd * gg; }
    }
}

struct EpiAttnIn {
    static constexpr bool PERM = true, AFTER_DRAIN = false;
    bf16* QKV; float* out; const f32x2v* rope;
    __device__ __forceinline__ void operator()(const f32x4 (&acc)[2][2][4][2], const pg8::Unit& u, int wr, int wc, int fr, int fq) const {
        const int pn = u.pn; const bool ctx = u.pm < 32;
        float* cdst = nullptr; int cbase = 0;
        if (ctx) { if (pn == 2 || pn == 3) { cdst = out + O_NAK; cbase = 512; } else if (pn == 4 || pn == 5) { cdst = out + O_NAV; cbase = 1024; }
                   else if (pn == 8 || pn == 9) { cdst = out + O_DFK; cbase = 2048; } else if (pn == 10 || pn == 11) { cdst = out + O_DFV; cbase = 2560; } }
        const bool rope_on = (!ctx) && pn >= 6 && pn <= 9;
        const float sgn = (fq < 2) ? -1.f : 1.f;
#pragma unroll
        for (int ai = 0; ai < 2; ++ai)
#pragma unroll
            for (int m = 0; m < 4; ++m) { const int row = u.pm * 256 + ai * 128 + wr * 64 + m * 16 + fr;
#pragma unroll
                for (int bj = 0; bj < 2; ++bj) { const int col = pn * 256 + bj * 128 + wc * 32 + 8 * fq;
                    f32x4 v0 = acc[ai][bj][m][0], v1 = acc[ai][bj][m][1];
                    if (rope_on) { const int n = (row - TCX) & 2047; const int p = (wc & 1) ? (n & 63) : (n >> 6); const f32x2v* tb = rope + p * 16 + 8 * (fq & 1);
#pragma unroll
                        for (int e = 0; e < 4; ++e) { const float p0 = __shfl_xor(v0[e], 32), p1 = __shfl_xor(v1[e], 32); const f32x2v c0 = tb[e], c1 = tb[4 + e];
                            v0[e] = v0[e] * c0.x + sgn * p0 * c0.y; v1[e] = v1[e] * c1.x + sgn * p1 * c1.y; } }
                    v4u w; w.x = pg8::cvt_pk_bf16(v0[0], v0[1]); w.y = pg8::cvt_pk_bf16(v0[2], v0[3]); w.z = pg8::cvt_pk_bf16(v1[0], v1[1]); w.w = pg8::cvt_pk_bf16(v1[2], v1[3]);
                    *(v4u*)(QKV + (size_t)row * QLD + col) = w;
                    if (cdst) { float* cp = cdst + (size_t)row * 512 + (col - cbase); *(f32x4*)cp = v0; *(f32x4*)(cp + 4) = v1; } } }
    }
};
struct EpiBf16Plain {
    static constexpr bool PERM = true, AFTER_DRAIN = false;
    bf16* O; int ldc;
    __device__ __forceinline__ void operator()(const f32x4 (&acc)[2][2][4][2], const pg8::Unit& u, int wr, int wc, int fr, int fq) const {
#pragma unroll
        for (int ai = 0; ai < 2; ++ai)
#pragma unroll
            for (int m = 0; m < 4; ++m) { const int row = u.pm * 256 + ai * 128 + wr * 64 + m * 16 + fr;
#pragma unroll
                for (int bj = 0; bj < 2; ++bj) { const int col = u.pn * 256 + bj * 128 + wc * 32 + 8 * fq; const f32x4 v0 = acc[ai][bj][m][0], v1 = acc[ai][bj][m][1];
                    v4u w; w.x = pg8::cvt_pk_bf16(v0[0], v0[1]); w.y = pg8::cvt_pk_bf16(v0[2], v0[3]); w.z = pg8::cvt_pk_bf16(v1[0], v1[1]); w.w = pg8::cvt_pk_bf16(v1[2], v1[3]);
                    *(v4u*)(O + (size_t)row * ldc + col) = w; } }
    }
};
struct EpiSwiglu {
    static constexpr bool PERM = true, AFTER_DRAIN = false;
    bf16* O;
    __device__ __forceinline__ void operator()(const f32x4 (&acc)[2][2][4][2], const pg8::Unit& u, int wr, int wc, int fr, int fq) const {
#pragma unroll
        for (int ai = 0; ai < 2; ++ai)
#pragma unroll
            for (int m = 0; m < 4; ++m) { const int row = u.pm * 256 + ai * 128 + wr * 64 + m * 16 + fr; const int col = u.pn * 128 + wc * 32 + 8 * fq;
                float r[8];
#pragma unroll
                for (int n = 0; n < 2; ++n)
#pragma unroll
                    for (int e = 0; e < 4; ++e) { const float g = acc[ai][0][m][n][e], up = acc[ai][1][m][n][e]; r[4 * n + e] = g * __builtin_amdgcn_rcpf(1.f + __expf(-g)) * up; }
                v4u w; w.x = pg8::cvt_pk_bf16(r[0], r[1]); w.y = pg8::cvt_pk_bf16(r[2], r[3]); w.z = pg8::cvt_pk_bf16(r[4], r[5]); w.w = pg8::cvt_pk_bf16(r[6], r[7]);
                *(v4u*)(O + (size_t)row * DFF + col) = w; }
    }
};
struct EpiResid {
    static constexpr bool PERM = false, AFTER_DRAIN = false;
    const float* bc; const float* bl; float* X; const float* mod; int gate_i;
    __device__ __forceinline__ void operator()(const f32x4 (&acc)[2][2][4][2], const pg8::Unit& u, int wr, int wc, int fr, int fq) const {
        const int cond = (u.pm < 32) ? 0 : ((u.pm < 40) ? 1 : 2);
        const float* gate = mod + cond * 6144 + gate_i * 1024;
        const float* base = (u.pm < 32) ? bc : bl - (size_t)TCX * D;
        const int col0 = u.pn * 256 + wc * 32 + 4 * fq;
        f32x4 gv[2][2];
#pragma unroll
        for (int bj = 0; bj < 2; ++bj)
#pragma unroll
            for (int n = 0; n < 2; ++n) gv[bj][n] = *(const f32x4*)(gate + col0 + bj * 128 + n * 16);
#pragma unroll
        for (int ai = 0; ai < 2; ++ai)
#pragma unroll
            for (int m = 0; m < 4; ++m) { const size_t off = (size_t)(u.pm * 256 + ai * 128 + wr * 64 + m * 16 + fr) * D + col0;
#pragma unroll
                for (int bj = 0; bj < 2; ++bj)
#pragma unroll
                    for (int n = 0; n < 2; ++n) { const f32x4 b = *(const f32x4*)(base + off + bj * 128 + n * 16); *(f32x4*)(X + off + bj * 128 + n * 16) = b + gv[bj][n] * acc[ai][bj][m][n]; } }
    }
};

#define KEY_STEP(kp, vp, biasv) do { \
    float s_ = 0.f; \
    _Pragma("unroll") for (int c_ = 0; c_ < 8; ++c_) { const v4u kv_ = *(const v4u*)((kp) + 8 * c_); \
        s_ += q[8 * c_ + 0] * bflo(kv_.x) + q[8 * c_ + 1] * bfhi(kv_.x) + q[8 * c_ + 2] * bflo(kv_.y) + q[8 * c_ + 3] * bfhi(kv_.y) \
            + q[8 * c_ + 4] * bflo(kv_.z) + q[8 * c_ + 5] * bfhi(kv_.z) + q[8 * c_ + 6] * bflo(kv_.w) + q[8 * c_ + 7] * bfhi(kv_.w); } \
    s_ = s_ * 0.125f + (biasv); \
    const float mn_ = fmaxf(m, s_), al_ = __expf(m - mn_), p_ = __expf(s_ - mn_); l = l * al_ + p_; m = mn_; \
    _Pragma("unroll") for (int c_ = 0; c_ < 8; ++c_) { const v4u vv_ = *(const v4u*)((vp) + 8 * c_); \
        o[8 * c_ + 0] = o[8 * c_ + 0] * al_ + p_ * bflo(vv_.x); o[8 * c_ + 1] = o[8 * c_ + 1] * al_ + p_ * bfhi(vv_.x); \
        o[8 * c_ + 2] = o[8 * c_ + 2] * al_ + p_ * bflo(vv_.y); o[8 * c_ + 3] = o[8 * c_ + 3] * al_ + p_ * bfhi(vv_.y); \
        o[8 * c_ + 4] = o[8 * c_ + 4] * al_ + p_ * bflo(vv_.z); o[8 * c_ + 5] = o[8 * c_ + 5] * al_ + p_ * bfhi(vv_.z); \
        o[8 * c_ + 6] = o[8 * c_ + 6] * al_ + p_ * bflo(vv_.w); o[8 * c_ + 7] = o[8 * c_ + 7] * al_ + p_ * bfhi(vv_.w); } } while (0)
#define LOAD_Q(qp) do { _Pragma("unroll") for (int c_ = 0; c_ < 8; ++c_) { const v4u qv_ = *(const v4u*)((qp) + 8 * c_); \
        q[8 * c_ + 0] = bflo(qv_.x); q[8 * c_ + 1] = bfhi(qv_.x); q[8 * c_ + 2] = bflo(qv_.y); q[8 * c_ + 3] = bfhi(qv_.y); \
        q[8 * c_ + 4] = bflo(qv_.z); q[8 * c_ + 5] = bfhi(qv_.z); q[8 * c_ + 6] = bflo(qv_.w); q[8 * c_ + 7] = bfhi(qv_.w); } } while (0)

__device__ __forceinline__ void attn_naive_phase(Frame& F) {
    const bf16* QKV = F.P; const float lam = *(const float*)((unsigned char*)F.MOD + MOD_LAM);
    float* DIFFO = F.S; const float* rpb = F.in[17];
    constexpr int ND = 32768, NC = 32768, NB = 65536, NA = 65536, NTASK = ND + NC + NB + NA;
    for (int task = F.bid * NTHR + F.tid; task < NTASK; task += F.G * NTHR) {
        float q[64], o[64]; float m, l;
        if (task < ND || (task >= ND + NC && task < ND + NC + NB)) {
            const bool lat = task < ND; int idx = lat ? task : task - ND - NC;
            int n, b, h, vh;
            if (lat) { n = idx & 2047; idx >>= 11; b = idx & 1; idx >>= 1; h = idx & 3; vh = idx >> 2; }
            else { n = idx & 255; idx >>= 8; b = idx & 31; idx >>= 5; h = idx & 3; vh = idx >> 2; }
            const int row = lat ? TCX + b * 2048 + n : b * 256 + n;
            const int krow0 = lat ? TCX + b * 2048 : b * 256, nk0 = lat ? 2048 : 256, krow1 = T + b * 256, nk1 = lat ? 256 : 0;
            const int vcol = 2560 + h * 128 + vh * 64;
            float o1[64];
#pragma unroll
            for (int c = 0; c < 2; ++c) {
                const int qcol = 1536 + h * 128 + c * 64, kcol = 2048 + h * 128 + c * 64;
                LOAD_Q(QKV + (size_t)row * QLD + qcol);
#pragma unroll
                for (int d = 0; d < 64; ++d) o[d] = 0.f;
                m = -INFINITY; l = 0.f;
                for (int j = 0; j < nk0; ++j) { const bf16* kr = QKV + (size_t)(krow0 + j) * QLD; KEY_STEP(kr + kcol, kr + vcol, 0.f); }
                for (int j = 0; j < nk1; ++j) { const bf16* kr = QKV + (size_t)(krow1 + j) * QLD; KEY_STEP(kr + kcol, kr + vcol, 0.f); }
                const float il = 1.f / l;
                if (c == 0) {
#pragma unroll
                    for (int d = 0; d < 64; ++d) o1[d] = o[d] * il;
                } else {
                    float* dst = DIFFO + (size_t)row * 512 + h * 128 + vh * 64;
#pragma unroll
                    for (int d = 0; d < 64; d += 4) *(f32x4*)(dst + d) = (f32x4){o1[d] - lam * o[d] * il, o1[d + 1] - lam * o[d + 1] * il, o1[d + 2] - lam * o[d + 2] * il, o1[d + 3] - lam * o[d + 3] * il};
                }
            }
        } else {
            const bool lat = task < ND + NC; int idx = lat ? task - ND : task - ND - NC - NB;
            int n, b, h;
            if (lat) { n = idx & 2047; idx >>= 11; b = idx & 1; h = idx >> 1; } else { n = idx & 255; idx >>= 8; b = idx & 31; h = idx >> 5; }
            const int row = lat ? TCX + b * 2048 + n : b * 256 + n;
            const int kcol = 512 + h * 64, vcol = 1024 + h * 64;
            LOAD_Q(QKV + (size_t)row * QLD + h * 64);
#pragma unroll
            for (int d = 0; d < 64; ++d) o[d] = 0.f;
            m = -INFINITY; l = 0.f;
            if (lat) {
                const int r = n >> 6, qc = n & 63; const int rs = min(max(r - 4, 0), 24), cs = min(max(qc - 8, 0), 48);
                for (int i = 0; i < 8; ++i) for (int cc = 0; cc < 16; ++cc) { const int kr_ = rs + i, kc = cs + cc;
                    const bf16* kr = QKV + (size_t)(TCX + b * 2048 + kr_ * 64 + kc) * QLD; const float bias = rpb[h * 465 + (kr_ - r + 7) * 31 + (kc - qc + 15)];
                    KEY_STEP(kr + kcol, kr + vcol, bias); }
                for (int j = 0; j < 256; ++j) { const bf16* kr = QKV + (size_t)(T + b * 256 + j) * QLD; KEY_STEP(kr + kcol, kr + vcol, 0.f); }
            } else {
                for (int j = 0; j < 256; ++j) { const bf16* kr = QKV + (size_t)(b * 256 + j) * QLD; KEY_STEP(kr + kcol, kr + vcol, 0.f); }
            }
            const float il = 1.f / l; bf16* dst = F.MIX + (size_t)row * D + h * 64;
#pragma unroll
            for (int d = 0; d < 64; d += 8) { v4u w; w.x = pk2(o[d] * il, o[d + 1] * il); w.y = pk2(o[d + 2] * il, o[d + 3] * il); w.z = pk2(o[d + 4] * il, o[d + 5] * il); w.w = pk2(o[d + 6] * il, o[d + 7] * il); *(v4u*)(dst + d) = w; }
        }
    }
}
__device__ __forceinline__ void diff_post_phase(Frame& F) {
    const int gw = F.bid * NWAVES + F.wave, NGW = F.G * NWAVES; const float* DIFFO = F.S;
    for (int it = gw; it < T * 4; it += NGW) { const int row = it >> 2, h = it & 3;
        const f32x2v v = *(const f32x2v*)(DIFFO + (size_t)row * 512 + h * 128 + 2 * F.lane);
        const float r = rsqrtf(wave_sum(v.x * v.x + v.y * v.y) * (1.f / 128.f) + 1e-6f) * 0.8f;
        *(unsigned*)(F.MIX + (size_t)row * D + 512 + h * 128 + 2 * F.lane) = pk2(v.x * r, v.y * r); }
}

typedef short bf16x8 __attribute__((ext_vector_type(8)));
typedef short s16x4 __attribute__((ext_vector_type(4)));
constexpr float LOG2E = 1.4426950408889634f;
__device__ __forceinline__ s16x4 tr_read(LAS unsigned char* p) { return __builtin_bit_cast(s16x4, __builtin_amdgcn_ds_read_tr16_b64_v4i16((LAS s16x4*)p)); }

template <int KIND>
__device__ __forceinline__ void attn_unit(Frame& F, int u) {
    constexpr bool DIFF = (KIND & 1) != 0;
    constexpr int DV = DIFF ? 128 : 64, NC = DV / 16, VSTR = DIFF ? 288 : 160, KSTR = 144;
    constexpr int K0_OFF = 0, K1_OFF = 9216, V_OFF = 18432, X_OFF = 40960, XSTR = 132, RPB_OFF = 110592;
    const int tid = F.tid, lane = F.lane, wave = F.wave, q16 = lane & 15, g = lane >> 4;
    LAS unsigned char* lds = F.lds;
    const bf16* QKV = F.P;
    int b, h, qrow0, ntiles, nW = 0, R0k = 0;
    if (KIND == 0) { b = u >> 3; h = u & 7; qrow0 = b * 256; ntiles = 4; }
    else if (KIND == 1) { const int half = u & 1; h = (u >> 1) & 3; b = u >> 3; qrow0 = b * 256 + half * 128; ntiles = 4; }
    else if (KIND == 2) { const int R = u & 7; h = (u >> 3) & 7; b = u >> 6; qrow0 = TCX + b * 2048 + R * 256; R0k = min(max(4 * R - 4, 0), 24); nW = min(max(4 * R - 1, 0), 24) + 8 - R0k; ntiles = nW + 4; }
    else { const int qb = u & 15; h = (u >> 4) & 3; b = u >> 6; qrow0 = TCX + b * 2048 + qb * 128; ntiles = 36; }
    const int sidx = DIFF ? (wave >> 2) : 0;
    const int wq = DIFF ? (wave & 3) * 32 : wave * 32;
    const int qcol = DIFF ? 1536 + h * 128 + sidx * 64 : h * 64;
    const int kcol0 = DIFF ? 2048 + h * 128 : 512 + h * 64;
    const int vcol = DIFF ? 2560 + h * 128 : 1024 + h * 64;
#define KROW(ti) ((KIND <= 1) ? (b * 256 + 64 * (ti)) : (KIND == 2) ? (((ti) < nW) ? (TCX + b * 2048 + (R0k + (ti)) * 64) : (T + b * 256 + 64 * ((ti) - nW))) : (((ti) < 32) ? (TCX + b * 2048 + 64 * (ti)) : (T + b * 256 + 64 * ((ti) - 32))))
    v4u rk0, rk1, rv0, rv1;
#define LOAD_TILE(ti) do { const bf16* rp_ = QKV + (size_t)(KROW(ti) + (tid >> 3)) * QLD + 8 * (tid & 7); rk0 = *(const v4u*)(rp_ + kcol0); rv0 = *(const v4u*)(rp_ + vcol); \
        if (DIFF) { rk1 = *(const v4u*)(rp_ + kcol0 + 64); rv1 = *(const v4u*)(rp_ + vcol + 64); } } while (0)
#define STORE_TILE() do { const int row_ = tid >> 3, ch_ = tid & 7; const int prow_ = (row_ & 39) | ((row_ & 8) << 1) | ((row_ & 16) >> 1); \
        *(LAS v4u*)(lds + K0_OFF + prow_ * KSTR + ch_ * 16) = rk0; *(LAS v4u*)(lds + V_OFF + row_ * VSTR + ch_ * 16) = rv0; \
        if (DIFF) { *(LAS v4u*)(lds + K1_OFF + prow_ * KSTR + ch_ * 16) = rk1; *(LAS v4u*)(lds + V_OFF + row_ * VSTR + 128 + ch_ * 16) = rv1; } } while (0)
    LAS float* rpbL = (LAS float*)(lds + RPB_OFF);
    if (KIND == 2) { __syncthreads(); if (tid < 465) rpbL[tid] = F.in[17][h * 465 + tid] * LOG2E; }
    bf16x8 qf[2][2];
#pragma unroll
    for (int grp = 0; grp < 2; ++grp)
#pragma unroll
        for (int kd = 0; kd < 2; ++kd) qf[grp][kd] = *(const bf16x8*)(QKV + (size_t)(qrow0 + wq + 16 * grp + q16) * QLD + qcol + 32 * kd + 8 * g);
    f32x4 o[2][NC];
#pragma unroll
    for (int grp = 0; grp < 2; ++grp)
#pragma unroll
        for (int c = 0; c < NC; ++c) o[grp][c] = (f32x4){0.f, 0.f, 0.f, 0.f};
    float mrun[2] = {-1e30f, -1e30f}, lsum[2] = {0.f, 0.f};
    const int wr_ = (KIND == 2) ? (((qrow0 - TCX) & 2047) >> 6) + (wave >> 1) : 0;
    const int wrs = min(max(wr_ - 4, 0), 24);
    const int koff = (DIFF && sidx) ? K1_OFF : K0_OFF;
    constexpr float C1 = 0.125f * LOG2E;
    LOAD_TILE(0);
    for (int ti = 0; ti < ntiles; ++ti) {
        __syncthreads();
        STORE_TILE();
        __syncthreads();
        if (ti + 1 < ntiles) LOAD_TILE(ti + 1);
        bool active = true; int krow_g = 0; bool win = false;
        if (KIND == 2) { win = ti < nW; krow_g = R0k + ti; active = (!win) || (krow_g >= wrs && krow_g < wrs + 8); }
        if (active) {
            f32x4 s[2][2][2];
#pragma unroll
            for (int ks = 0; ks < 2; ++ks)
#pragma unroll
                for (int t = 0; t < 2; ++t) {
                    s[0][ks][t] = (f32x4){0.f, 0.f, 0.f, 0.f}; s[1][ks][t] = (f32x4){0.f, 0.f, 0.f, 0.f};
#pragma unroll
                    for (int kd = 0; kd < 2; ++kd) { const bf16x8 kf = *(const LAS bf16x8*)(lds + koff + (32 * ks + 16 * t + q16) * KSTR + 64 * kd + 16 * g);
                        s[0][ks][t] = __builtin_amdgcn_mfma_f32_16x16x32_bf16(kf, qf[0][kd], s[0][ks][t], 0, 0, 0);
                        s[1][ks][t] = __builtin_amdgcn_mfma_f32_16x16x32_bf16(kf, qf[1][kd], s[1][ks][t], 0, 0, 0); }
                }
            bf16x8 pf[2][2];
#pragma unroll
            for (int grp = 0; grp < 2; ++grp) {
                float tv[2][2][4];
                if (KIND == 2 && win) {
                    const int qc = (wave & 1) * 32 + 16 * grp + q16, cs = min(max(qc - 8, 0), 48); const LAS float* brow = rpbL + (krow_g - wr_ + 7) * 31 + 15 - qc;
#pragma unroll
                    for (int ks = 0; ks < 2; ++ks)
#pragma unroll
                        for (int t = 0; t < 2; ++t)
#pragma unroll
                            for (int e = 0; e < 4; ++e) { const int kc = 32 * ks + 16 * (g >> 1) + 8 * t + 4 * (g & 1) + e; const bool ok = (unsigned)(kc - cs) < 16u;
                                tv[ks][t][e] = ok ? s[grp][ks][t][e] * C1 + brow[kc] : -1e30f; }
                } else {
#pragma unroll
                    for (int ks = 0; ks < 2; ++ks)
#pragma unroll
                        for (int t = 0; t < 2; ++t)
#pragma unroll
                            for (int e = 0; e < 4; ++e) tv[ks][t][e] = s[grp][ks][t][e] * C1;
                }
                float tmax = -1e30f;
#pragma unroll
                for (int ks = 0; ks < 2; ++ks)
#pragma unroll
                    for (int t = 0; t < 2; ++t)
#pragma unroll
                        for (int e = 0; e < 4; ++e) tmax = fmaxf(tmax, tv[ks][t][e]);
                tmax = fmaxf(tmax, __shfl_xor(tmax, 16)); tmax = fmaxf(tmax, __shfl_xor(tmax, 32));
                const float mn = fmaxf(mrun[grp], tmax), al = __builtin_amdgcn_exp2f(mrun[grp] - mn); mrun[grp] = mn;
                float ps = 0.f;
#pragma unroll
                for (int ks = 0; ks < 2; ++ks) {
                    float p[8];
#pragma unroll
                    for (int t = 0; t < 2; ++t)
#pragma unroll
                        for (int e = 0; e < 4; ++e) { p[4 * t + e] = __builtin_amdgcn_exp2f(tv[ks][t][e] - mn); ps += p[4 * t + e]; }
                    v4u w; w.x = pg8::cvt_pk_bf16(p[0], p[1]); w.y = pg8::cvt_pk_bf16(p[2], p[3]); w.z = pg8::cvt_pk_bf16(p[4], p[5]); w.w = pg8::cvt_pk_bf16(p[6], p[7]);
                    pf[grp][ks] = __builtin_bit_cast(bf16x8, w);
                }
                lsum[grp] = lsum[grp] * al + ps;
#pragma unroll
                for (int c = 0; c < NC; ++c) o[grp][c] = o[grp][c] * al;
            }
#pragma unroll
            for (int ks = 0; ks < 2; ++ks)
#pragma unroll
                for (int c = 0; c < NC; ++c) {
                    LAS unsigned char* vb = lds + V_OFF + (32 * ks + 16 * (g >> 1) + 4 * (g & 1) + (q16 >> 2)) * VSTR + (16 * c + 4 * (lane & 3)) * 2;
                    const s16x4 v0 = tr_read(vb), v1 = tr_read(vb + 8 * VSTR);
                    const bf16x8 vf = (bf16x8){v0[0], v0[1], v0[2], v0[3], v1[0], v1[1], v1[2], v1[3]};
                    o[0][c] = __builtin_amdgcn_mfma_f32_16x16x32_bf16(vf, pf[0][ks], o[0][c], 0, 0, 0);
                    o[1][c] = __builtin_amdgcn_mfma_f32_16x16x32_bf16(vf, pf[1][ks], o[1][c], 0, 0, 0);
                }
        }
    }
    float inv[2];
#pragma unroll
    for (int grp = 0; grp < 2; ++grp) { float l = lsum[grp]; l += __shfl_xor(l, 16); l += __shfl_xor(l, 32); inv[grp] = 1.f / l; }
    if (!DIFF) {
#pragma unroll
        for (int grp = 0; grp < 2; ++grp) { bf16* dst = F.MIX + (size_t)(qrow0 + wq + 16 * grp + q16) * D + h * 64 + 4 * g;
#pragma unroll
            for (int c = 0; c < NC; ++c) { const f32x4 v = o[grp][c] * inv[grp]; v2u w; w.x = pg8::cvt_pk_bf16(v[0], v[1]); w.y = pg8::cvt_pk_bf16(v[2], v[3]); *(v2u*)(dst + 16 * c) = w; } }
    } else {
        const float lam = *(const float*)((unsigned char*)F.MOD + MOD_LAM);
        LAS float* X = (LAS float*)(lds + X_OFF);
        if (sidx == 1) {
#pragma unroll
            for (int grp = 0; grp < 2; ++grp)
#pragma unroll
                for (int c = 0; c < NC; ++c) *(LAS f32x4*)(X + (wq + 16 * grp + q16) * XSTR + 16 * c + 4 * g) = o[grp][c] * inv[grp];
        }
        __syncthreads();
        if (sidx == 0) {
#pragma unroll
            for (int grp = 0; grp < 2; ++grp) {
                float ss = 0.f;
#pragma unroll
                for (int c = 0; c < NC; ++c) { const f32x4 x2 = *(const LAS f32x4*)(X + (wq + 16 * grp + q16) * XSTR + 16 * c + 4 * g); o[grp][c] = o[grp][c] * inv[grp] - x2 * lam;
                    ss += (o[grp][c][0] * o[grp][c][0] + o[grp][c][1] * o[grp][c][1]) + (o[grp][c][2] * o[grp][c][2] + o[grp][c][3] * o[grp][c][3]); }
                ss += __shfl_xor(ss, 16); ss += __shfl_xor(ss, 32);
                const float r = rsqrtf(ss * (1.f / 128.f) + 1e-6f) * 0.8f;
                bf16* dst = F.MIX + (size_t)(qrow0 + wq + 16 * grp + q16) * D + 512 + h * 128 + 4 * g;
#pragma unroll
                for (int c = 0; c < NC; ++c) { const f32x4 v = o[grp][c] * r; v2u w; w.x = pg8::cvt_pk_bf16(v[0], v[1]); w.y = pg8::cvt_pk_bf16(v[2], v[3]); *(v2u*)(dst + 16 * c) = w; }
            }
        }
    }
#undef KROW
#undef LOAD_TILE
#undef STORE_TILE
}
__device__ __forceinline__ void attn_mfma_phase(Frame& F) {
    if (F.G == 256) {
        if (F.bid < 128) attn_unit<3>(F, F.bid);
        else { const int i = F.bid - 128; attn_unit<2>(F, i); attn_unit<1>(F, 2 * i); attn_unit<1>(F, 2 * i + 1); attn_unit<0>(F, 2 * i); attn_unit<0>(F, 2 * i + 1); }
    } else {
        for (int i = F.bid; i < 768; i += F.G) { if (i < 128) attn_unit<3>(F, i); else if (i < 256) attn_unit<2>(F, i - 128); else if (i < 512) attn_unit<1>(F, i - 256); else attn_unit<0>(F, i - 512); }
    }
}

__device__ __forceinline__ void rwkv_job(Frame& F, int seq, int h, int dir) {
    LAS float* L = (LAS float*)F.lds;
    LAS float *WUP = L, *AUP = L + 4096, *Lr = L + 8192, *Lk = Lr + 1024, *Lv = Lk + 1024, *Lwd = Lv + 1024, *Lad = Lwd + 1024, *Lw = Lad + 1024, *La = Lw + 1024, *Lkk = La + 1024, *Lkef = Lkk + 1024, *Lb = Lkef + 1024, *Ly = Lb + 1024;
    const int tid = F.tid, lane = F.lane, w = F.wave;
    const bool lat = seq >= 32; const int b = lat ? seq - 32 : seq, N = lat ? 2048 : 256, R0 = lat ? TCX + b * 2048 : b * 256;
    const bf16* PROJ = F.P; float* Y = F.S;
    __syncthreads();
    for (int idx = tid; idx < 4096; idx += NTHR) { const int j = idx >> 6, k = idx & 63; WUP[idx] = F.in[26][(size_t)(dir * 64 + j) * 512 + h * 64 + k]; AUP[idx] = F.in[28][(size_t)(dir * 64 + j) * 512 + h * 64 + k]; }
    const int i = 8 * w + (lane >> 3), s = lane & 7;
    float S[8];
    {
        const float* st = F.in[7] + (size_t)((b * 2 + dir) * 8 + h) * 4096 + i * 64 + 8 * s;
#pragma unroll
        for (int kk = 0; kk < 8; ++kk) S[kk] = lat ? st[kk] : 0.f;
    }
    for (int t0 = 0; t0 < N; t0 += 16) {
#pragma unroll
        for (int rep = 0; rep < 2; ++rep) { const int idx = tid + NTHR * rep, j = idx >> 6, k = idx & 63; const int n = dir ? N - 1 - (t0 + j) : t0 + j;
            const bf16* pr = PROJ + (size_t)(R0 + n) * NREC;
            Lr[idx] = bf1(pr[2048 + h * 64 + k]); Lk[idx] = bf1(pr[2560 + h * 64 + k]); Lv[idx] = bf1(pr[3072 + h * 64 + k]); Lwd[idx] = tanhf(bf1(pr[3584 + k])); Lad[idx] = bf1(pr[3648 + k]); }
        __syncthreads();
#pragma unroll
        for (int rep = 0; rep < 2; ++rep) { const int idx = tid + NTHR * rep, j = idx >> 6, k = idx & 63;
            float zw = F.in[25][dir * 512 + h * 64 + k], za = F.in[27][dir * 512 + h * 64 + k];
#pragma unroll 8
            for (int jj = 0; jj < 64; ++jj) { zw += Lwd[j * 64 + jj] * WUP[jj * 64 + k]; za += Lad[j * 64 + jj] * AUP[jj * 64 + k]; }
            Lw[idx] = __expf(-0.6065306597f * sigmoidf_(zw)); La[idx] = sigmoidf_(za); }
        if (tid < 256) { const int j = tid >> 4, p = tid & 15; float v[4]; float ss = 0.f;
#pragma unroll
            for (int e = 0; e < 4; ++e) { v[e] = Lk[j * 64 + 4 * p + e] * F.in[30][h * 64 + 4 * p + e]; ss += v[e] * v[e]; }
            ss += __shfl_xor(ss, 1); ss += __shfl_xor(ss, 2); ss += __shfl_xor(ss, 4); ss += __shfl_xor(ss, 8);
            const float rs = rsqrtf(ss + 1e-12f);
#pragma unroll
            for (int e = 0; e < 4; ++e) Lkk[j * 64 + 4 * p + e] = v[e] * rs; }
        __syncthreads();
#pragma unroll
        for (int rep = 0; rep < 2; ++rep) { const int idx = tid + NTHR * rep, k = idx & 63; const float a = La[idx];
            Lkef[idx] = Lk[idx] * (1.f + (a - 1.f) * F.in[31][h * 64 + k]); Lb[idx] = Lkk[idx] * a; }
        __syncthreads();
        for (int j = 0; j < 16; ++j) {
            const int o8 = j * 64 + 8 * s;
            float sa = 0.f;
#pragma unroll
            for (int kk = 0; kk < 8; ++kk) sa -= S[kk] * Lkk[o8 + kk];
            sa += __shfl_xor(sa, 1); sa += __shfl_xor(sa, 2); sa += __shfl_xor(sa, 4);
            const float vi = Lv[j * 64 + i];
            float y = 0.f;
#pragma unroll
            for (int kk = 0; kk < 8; ++kk) { S[kk] = S[kk] * Lw[o8 + kk] + sa * Lb[o8 + kk] + vi * Lkef[o8 + kk]; y += S[kk] * Lr[o8 + kk]; }
            y += __shfl_xor(y, 1); y += __shfl_xor(y, 2); y += __shfl_xor(y, 4);
            if (s == 0) Ly[j * 64 + i] = y;
        }
        __syncthreads();
#pragma unroll
        for (int rep = 0; rep < 2; ++rep) { const int idx = tid + NTHR * rep, j = idx >> 6, k = idx & 63; const int n = dir ? N - 1 - (t0 + j) : t0 + j;
            atomicAdd(Y + (size_t)(R0 + n) * 512 + h * 64 + k, Ly[idx]); }
    }
    if (!lat) { float* so = F.out + O_SRW + (size_t)((b * 2 + dir) * 8 + h) * 4096 + i * 64 + 8 * s;
#pragma unroll
        for (int kk = 0; kk < 8; ++kk) so[kk] = S[kk]; }
}
__device__ __forceinline__ void ret_job(Frame& F, int seq, int h, int dir) {
    LAS float* L = (LAS float*)F.lds;
    LAS float *Lq = L, *Lk = L + 1024, *Lv = L + 2048, *Lo = L + 3072;
    const int tid = F.tid, lane = F.lane, w = F.wave;
    const bool lat = seq >= 32; const int b = lat ? seq - 32 : seq, N = lat ? 2048 : 256, R0 = lat ? TCX + b * 2048 : b * 256;
    const bf16* PROJ = F.P; float* O = F.S + (size_t)T * 512;
    const float g = sigmoidf_(F.in[24][dir * 8 + h]);
    const int e = 8 * w + (lane >> 3), s = lane & 7;
    float S[8];
    {
        const float* st = F.in[6] + (size_t)((b * 2 + dir) * 8 + h) * 4096;
#pragma unroll
        for (int dd = 0; dd < 8; ++dd) S[dd] = lat ? st[(8 * s + dd) * 64 + e] : 0.f;
    }
    __syncthreads();
    for (int t0 = 0; t0 < N; t0 += 16) {
#pragma unroll
        for (int rep = 0; rep < 2; ++rep) { const int idx = tid + NTHR * rep, j = idx >> 6, k = idx & 63; const int n = dir ? N - 1 - (t0 + j) : t0 + j;
            const bf16* pr = PROJ + (size_t)(R0 + n) * NREC;
            Lq[idx] = bf1(pr[h * 64 + k]); Lk[idx] = bf1(pr[512 + h * 64 + k]) * 0.125f; Lv[idx] = bf1(pr[1024 + h * 64 + k]); }
        __syncthreads();
        for (int j = 0; j < 16; ++j) {
            const int o8 = j * 64 + 8 * s; const float ve = Lv[j * 64 + e];
            float o = 0.f;
#pragma unroll
            for (int dd = 0; dd < 8; ++dd) { S[dd] = g * S[dd] + Lk[o8 + dd] * ve; o += Lq[o8 + dd] * S[dd]; }
            o += __shfl_xor(o, 1); o += __shfl_xor(o, 2); o += __shfl_xor(o, 4);
            if (s == 0) Lo[j * 64 + e] = o;
        }
        __syncthreads();
#pragma unroll
        for (int rep = 0; rep < 2; ++rep) { const int idx = tid + NTHR * rep, j = idx >> 6, k = idx & 63; const int n = dir ? N - 1 - (t0 + j) : t0 + j;
            atomicAdd(O + (size_t)(R0 + n) * 512 + h * 64 + k, Lo[idx]); }
        __syncthreads();
    }
    if (!lat) { float* so = F.out + O_SRET + (size_t)((b * 2 + dir) * 8 + h) * 4096;
#pragma unroll
        for (int dd = 0; dd < 8; ++dd) so[(8 * s + dd) * 64 + e] = S[dd]; }
}
__device__ __forceinline__ void run_job(Frame& F, int J) {
    int type, seq, h, dir;
    if (J < 64) { type = J >> 5; const int r = J & 31; seq = 32 + (r >> 4); h = (r >> 1) & 7; dir = r & 1; }
    else { const int r = J - 64; type = r >> 9; const int q = r & 511; seq = q >> 4; h = (q >> 1) & 7; dir = q & 1; }
    if (type == 0) rwkv_job(F, seq, h, dir); else ret_job(F, seq, h, dir);
}
__device__ __forceinline__ void scan_phase(Frame& F) {
    if (F.G > 128) { if (F.bid < 64) run_job(F, F.bid); else for (int J = 64 + (F.bid - 64); J < 1088; J += F.G - 64) run_job(F, J); }
    else for (int J = F.bid; J < 1088; J += F.G) run_job(F, J);
}
__device__ __forceinline__ void rec_post_phase(Frame& F) {
    LAS float* sg = (LAS float*)F.lds + F.wave * 128;
    const int gw = F.bid * NWAVES + F.wave, NGW = F.G * NWAVES, lane = F.lane;
    const bf16* PROJ = F.P; const float* Y = F.S; const float* O = F.S + (size_t)T * 512;
    for (int row = gw; row < T; row += NGW) {
        const bf16* pr = PROJ + (size_t)row * NREC;
        sg[lane] = sigmoidf_(bf1(pr[3712 + lane])); sg[64 + lane] = sigmoidf_(bf1(pr[3776 + lane]));
        asm volatile("s_waitcnt lgkmcnt(0)" ::: "memory");
        for (int h = 0; h < 8; ++h) {
            const int c = h * 64 + lane;
            const float y = Y[(size_t)row * 512 + c];
            const float mu = wave_sum(y) * (1.f / 64.f), dl = y - mu, var = wave_sum(dl * dl) * (1.f / 64.f);
            const float yn = dl * rsqrtf(var + 64e-5f) * F.in[33][c] + F.in[34][c];
            const float r = bf1(pr[2048 + c]), k = bf1(pr[2560 + c]), v = bf1(pr[3072 + c]);
            const float bonus = wave_sum(r * F.in[32][c] * k) * v;
            float g = 0.f;
#pragma unroll 8
            for (int j = 0; j < 128; ++j) g += sg[j] * F.in[29][(size_t)j * 512 + c];
            F.MIX[(size_t)row * D + 512 + c] = (bf16)f2bf((yn + bonus) * g);
        }
        for (int h = 0; h < 8; ++h) {
            const int c = h * 64 + lane;
            const float o = O[(size_t)row * 512 + c];
            const float on = o * rsqrtf(wave_sum(o * o) * (1.f / 64.f) + 1e-6f);
            const float xg = bf1(pr[1536 + c]);
            F.MIX[(size_t)row * D + c] = (bf16)f2bf(xg * sigmoidf_(xg) * on);
        }
        asm volatile("s_waitcnt lgkmcnt(0)" ::: "memory");
    }
}

#define DPP_F(v, ctrl) __int_as_float(__builtin_amdgcn_mov_dpp(__float_as_int(v), (ctrl), 0xf, 0xf, true))
template <int NSL> __device__ __forceinline__ float row_reduce(float v) {
    v += DPP_F(v, 0xB1); v += DPP_F(v, 0x4E); v += DPP_F(v, 0x141); if (NSL == 16) v += DPP_F(v, 0x140); return v;
}
__device__ __forceinline__ void unpack8(const v4u r, float (&f)[8]) { f[0] = bflo(r.x); f[1] = bfhi(r.x); f[2] = bflo(r.y); f[3] = bfhi(r.y); f[4] = bflo(r.z); f[5] = bfhi(r.z); f[6] = bflo(r.w); f[7] = bfhi(r.w); }
__device__ __forceinline__ v4u pack8(const float (&f)[8]) { v4u w; w.x = pg8::cvt_pk_bf16(f[0], f[1]); w.y = pg8::cvt_pk_bf16(f[2], f[3]); w.z = pg8::cvt_pk_bf16(f[4], f[5]); w.w = pg8::cvt_pk_bf16(f[6], f[7]); return w; }

template <int NSL>
__device__ __forceinline__ void rwkv_job2(Frame& F, int seq, int h, int dir, int row0) {
    constexpr int KPT = 64 / NSL, ROWS = 512 / NSL, TCH = 32;
    constexpr int WUPT = 0, AUPT = 9216, TWO = 18432, TAO = 23040, F0 = 27648;
    LAS unsigned char* lds = F.lds;
    LAS float *Lr = (LAS float*)(lds + F0), *Lk = Lr + 2048, *Lv = Lk + 2048, *Lw = Lv + 2048, *La = Lw + 2048, *Lnk = La + 2048, *Lkef = Lnk + 2048, *Lb = Lkef + 2048, *Ly = Lb + 2048;
    const int tid = F.tid, lane = F.lane, wave = F.wave, q16 = lane & 15, g = lane >> 4;
    const bool lat = seq >= 32; const int b = lat ? seq - 32 : seq, N = lat ? 2048 : 256, R0 = lat ? TCX + b * 2048 : b * 256;
    const bf16* PROJ = F.P; float* Y = F.S;
    __syncthreads();
    for (int idx = tid; idx < 4096; idx += NTHR) { const int j = idx >> 6, k = idx & 63;
        *(LAS bf16*)(lds + WUPT + k * 144 + j * 2) = (bf16)f2bf(F.in[26][(size_t)(dir * 64 + j) * 512 + h * 64 + k]);
        *(LAS bf16*)(lds + AUPT + k * 144 + j * 2) = (bf16)f2bf(F.in[28][(size_t)(dir * 64 + j) * 512 + h * 64 + k]); }
    const int rowl = tid / NSL, sl = tid % NSL, irow = row0 + rowl;
    float S[KPT];
    {
        const float* st = F.in[7] + (size_t)((b * 2 + dir) * 8 + h) * 4096 + irow * 64 + KPT * sl;
#pragma unroll
        for (int kk = 0; kk < KPT; ++kk) S[kk] = lat ? st[kk] : 0.f;
    }
    const int ep = tid & 15, etok = tid >> 4;
    f32x4 ckk, cka;
#pragma unroll
    for (int e = 0; e < 4; ++e) { ckk[e] = F.in[30][h * 64 + 4 * ep + e]; cka[e] = F.in[31][h * 64 + 4 * ep + e]; }
    const int mat = wave >> 2, ct = wave & 3;
    const float zbias = (mat ? F.in[27] : F.in[25])[dir * 512 + h * 64 + 16 * ct + q16];
    for (int t0 = 0; t0 < N; t0 += TCH) {
        for (int idx = tid; idx < 1280; idx += NTHR) { const int tok = idx / 40, rem = idx - tok * 40, seg = rem >> 3, ch = rem & 7; const int n = dir ? N - 1 - (t0 + tok) : t0 + tok;
            const int col = (seg == 0) ? 2048 + h * 64 : (seg == 1) ? 2560 + h * 64 : (seg == 2) ? 3072 + h * 64 : (seg == 3) ? 3584 : 3648;
            const v4u raw = *(const v4u*)(PROJ + (size_t)(R0 + n) * NREC + col + 8 * ch);
            if (seg < 3) { float f[8]; unpack8(raw, f); LAS float* dst = ((seg == 0) ? Lr : (seg == 1) ? Lk : Lv) + tok * 64 + 8 * ch; *(LAS f32x4*)dst = (f32x4){f[0], f[1], f[2], f[3]}; *(LAS f32x4*)(dst + 4) = (f32x4){f[4], f[5], f[6], f[7]}; }
            else if (seg == 3) { float f[8]; unpack8(raw, f);
#pragma unroll
                for (int e = 0; e < 8; ++e) f[e] = 1.f - 2.f / (1.f + __expf(2.f * f[e]));
                *(LAS v4u*)(lds + TWO + tok * 144 + ch * 16) = pack8(f); }
            else *(LAS v4u*)(lds + TAO + tok * 144 + ch * 16) = raw; }
        __syncthreads();
        {
            f32x4 z[2] = {(f32x4){0.f, 0.f, 0.f, 0.f}, (f32x4){0.f, 0.f, 0.f, 0.f}};
#pragma unroll
            for (int kd = 0; kd < 2; ++kd) { const bf16x8 bfr = *(const LAS bf16x8*)(lds + (mat ? AUPT : WUPT) + (16 * ct + q16) * 144 + 64 * kd + 16 * g);
#pragma unroll
                for (int rt = 0; rt < 2; ++rt) { const bf16x8 afr = *(const LAS bf16x8*)(lds + (mat ? TAO : TWO) + (16 * rt + q16) * 144 + 64 * kd + 16 * g);
                    z[rt] = __builtin_amdgcn_mfma_f32_16x16x32_bf16(afr, bfr, z[rt], 0, 0, 0); } }
#pragma unroll
            for (int rt = 0; rt < 2; ++rt)
#pragma unroll
                for (int e = 0; e < 4; ++e) { const int tok = 16 * rt + 4 * g + e; const float sg = sigmoidf_(z[rt][e] + zbias);
                    if (mat) La[tok * 64 + 16 * ct + q16] = sg; else Lw[tok * 64 + 16 * ct + q16] = __expf(-0.6065306597f * sg); }
        }
        __syncthreads();
        {
            const f32x4 kv = *(const LAS f32x4*)(Lk + etok * 64 + 4 * ep), av = *(const LAS f32x4*)(La + etok * 64 + 4 * ep);
            const f32x4 kr = kv * ckk; float ss = (kr[0] * kr[0] + kr[1] * kr[1]) + (kr[2] * kr[2] + kr[3] * kr[3]);
            ss = row_reduce<16>(ss);
            const float rs = rsqrtf(ss + 1e-12f);
            const f32x4 kkv = kr * rs;
            *(LAS f32x4*)(Lnk + etok * 64 + 4 * ep) = -kkv;
            *(LAS f32x4*)(Lb + etok * 64 + 4 * ep) = kkv * av;
            *(LAS f32x4*)(Lkef + etok * 64 + 4 * ep) = kv * (1.f + (av - 1.f) * cka);
        }
        __syncthreads();
#pragma unroll 2
        for (int j = 0; j < TCH; ++j) {
            const int o8 = j * 64 + KPT * sl;
            float nk[KPT], wv[KPT], bv[KPT], ke[KPT], rv[KPT];
#pragma unroll
            for (int q4 = 0; q4 < KPT; q4 += 4) { const f32x4 a0 = *(const LAS f32x4*)(Lnk + o8 + q4), a1 = *(const LAS f32x4*)(Lw + o8 + q4), a2 = *(const LAS f32x4*)(Lb + o8 + q4), a3 = *(const LAS f32x4*)(Lkef + o8 + q4), a4 = *(const LAS f32x4*)(Lr + o8 + q4);
#pragma unroll
                for (int e = 0; e < 4; ++e) { nk[q4 + e] = a0[e]; wv[q4 + e] = a1[e]; bv[q4 + e] = a2[e]; ke[q4 + e] = a3[e]; rv[q4 + e] = a4[e]; } }
            const float vi = Lv[j * 64 + irow];
            float sa = 0.f;
#pragma unroll
            for (int kk = 0; kk < KPT; ++kk) sa += S[kk] * nk[kk];
            sa = row_reduce<NSL>(sa);
            float y = 0.f;
#pragma unroll
            for (int kk = 0; kk < KPT; ++kk) { S[kk] = S[kk] * wv[kk] + (sa * bv[kk] + vi * ke[kk]); y += S[kk] * rv[kk]; }
            y = row_reduce<NSL>(y);
            if (sl == 0) Ly[j * 64 + rowl] = y;
        }
        __syncthreads();
        for (int idx = tid; idx < TCH * ROWS; idx += NTHR) { const int tok = idx / ROWS, i = idx % ROWS; const int n = dir ? N - 1 - (t0 + tok) : t0 + tok;
            atomicAdd(Y + (size_t)(R0 + n) * 512 + h * 64 + row0 + i, Ly[tok * 64 + i]); }
    }
    if (!lat) { float* so = F.out + O_SRW + (size_t)((b * 2 + dir) * 8 + h) * 4096 + irow * 64 + KPT * sl;
#pragma unroll
        for (int kk = 0; kk < KPT; ++kk) so[kk] = S[kk]; }
}

__device__ __forceinline__ void ret_job2(Frame& F, int seq, int h, int dir) {
    constexpr int KP = 0, VT = 9216, KW = 19456, SB = 29696, DM = 39936, KSTR = 144, VSTR = 160;
    LAS unsigned char* lds = F.lds;
    LAS float* dm = (LAS float*)(lds + DM);
    const int tid = F.tid, lane = F.lane, wave = F.wave, q16 = lane & 15, g = lane >> 4;
    const bool lat = seq >= 32; const int b = lat ? seq - 32 : seq, N = lat ? 2048 : 256, R0 = lat ? TCX + b * 2048 : b * 256;
    const bf16* PROJ = F.P; float* O = F.S + (size_t)T * 512;
    const float lg2 = log2f(sigmoidf_(F.in[24][dir * 8 + h]));
    __syncthreads();
    if (tid < 65) dm[tid] = exp2f(lg2 * (float)tid);
    const float gC = exp2f(lg2 * 64.f);
    const int cd = wave >> 1, ce0 = 2 * (wave & 1);
    f32x4 Sreg[2];
#pragma unroll
    for (int c2 = 0; c2 < 2; ++c2)
#pragma unroll
        for (int e = 0; e < 4; ++e) { const int d_ = 16 * cd + 4 * g + e, e_ = 16 * (ce0 + c2) + q16;
            Sreg[c2][e] = lat ? F.in[6][(size_t)((b * 2 + dir) * 8 + h) * 4096 + d_ * 64 + e_] : 0.f;
            *(LAS bf16*)(lds + SB + d_ * VSTR + e_ * 2) = (bf16)f2bf(Sreg[c2][e]); }
    const int qg = wave & 3, eh = wave >> 2, iq = 16 * qg + q16;
    const int srow = tid >> 3, sch = tid & 7, sprow = (srow & 39) | ((srow & 8) << 1) | ((srow & 16) >> 1);
    for (int t0 = 0; t0 < N; t0 += 64) {
        {
            const int n = dir ? N - 1 - (t0 + srow) : t0 + srow; const bf16* rp = PROJ + (size_t)(R0 + n) * NREC + h * 64 + 8 * sch;
            const v4u rk = *(const v4u*)(rp + 512), rv = *(const v4u*)(rp + 1024);
            *(LAS v4u*)(lds + KP + sprow * KSTR + sch * 16) = rk; *(LAS v4u*)(lds + VT + srow * VSTR + sch * 16) = rv;
            float f[8]; unpack8(rk, f); const float wsc = 0.125f * exp2f(lg2 * (float)(63 - srow));
#pragma unroll
            for (int e = 0; e < 8; ++e) f[e] *= wsc;
            *(LAS v4u*)(lds + KW + srow * VSTR + sch * 16) = pack8(f);
        }
        bf16x8 qf[2], qs[2];
        {
            const int n = dir ? N - 1 - (t0 + iq) : t0 + iq; const bf16* qp = PROJ + (size_t)(R0 + n) * NREC + h * 64 + 8 * g; const float sc = exp2f(lg2 * (float)(iq + 1));
#pragma unroll
            for (int kd = 0; kd < 2; ++kd) { const v4u raw = *(const v4u*)(qp + 32 * kd); qf[kd] = __builtin_bit_cast(bf16x8, raw); float f[8]; unpack8(raw, f);
#pragma unroll
                for (int e = 0; e < 8; ++e) f[e] *= sc;
                qs[kd] = __builtin_bit_cast(bf16x8, pack8(f)); }
        }
        __syncthreads();
        bf16x8 pf[2];
#pragma unroll
        for (int ks = 0; ks < 2; ++ks) {
            float p[8];
#pragma unroll
            for (int t = 0; t < 2; ++t) { f32x4 s = (f32x4){0.f, 0.f, 0.f, 0.f};
#pragma unroll
                for (int kd = 0; kd < 2; ++kd) { const bf16x8 kf = *(const LAS bf16x8*)(lds + KP + (32 * ks + 16 * t + q16) * KSTR + 64 * kd + 16 * g); s = __builtin_amdgcn_mfma_f32_16x16x32_bf16(kf, qf[kd], s, 0, 0, 0); }
#pragma unroll
                for (int e = 0; e < 4; ++e) { const int j = 32 * ks + 16 * (g >> 1) + 8 * t + 4 * (g & 1) + e; const int dlt = iq - j; p[4 * t + e] = (dlt >= 0) ? s[e] * 0.125f * dm[dlt & 63] : 0.f; } }
            pf[ks] = __builtin_bit_cast(bf16x8, pack8(p));
        }
        f32x4 o[2] = {(f32x4){0.f, 0.f, 0.f, 0.f}, (f32x4){0.f, 0.f, 0.f, 0.f}};
#pragma unroll
        for (int c2 = 0; c2 < 2; ++c2) { const int c = 2 * eh + c2;
#pragma unroll
            for (int ks = 0; ks < 2; ++ks) { LAS unsigned char* vb = lds + VT + (32 * ks + 16 * (g >> 1) + 4 * (g & 1) + (q16 >> 2)) * VSTR + (16 * c + 4 * (lane & 3)) * 2;
                const s16x4 v0 = tr_read(vb), v1 = tr_read(vb + 8 * VSTR); const bf16x8 vf = (bf16x8){v0[0], v0[1], v0[2], v0[3], v1[0], v1[1], v1[2], v1[3]};
                o[c2] = __builtin_amdgcn_mfma_f32_16x16x32_bf16(vf, pf[ks], o[c2], 0, 0, 0); }
#pragma unroll
            for (int kd = 0; kd < 2; ++kd) { LAS unsigned char* sb = lds + SB + (32 * kd + 8 * g + (q16 >> 2)) * VSTR + (16 * c + 4 * (lane & 3)) * 2;
                const s16x4 v0 = tr_read(sb), v1 = tr_read(sb + 4 * VSTR); const bf16x8 sf = (bf16x8){v0[0], v0[1], v0[2], v0[3], v1[0], v1[1], v1[2], v1[3]};
                o[c2] = __builtin_amdgcn_mfma_f32_16x16x32_bf16(sf, qs[kd], o[c2], 0, 0, 0); }
        }
        {
            const int n = dir ? N - 1 - (t0 + iq) : t0 + iq; float* op = O + (size_t)(R0 + n) * 512 + h * 64 + 4 * g;
#pragma unroll
            for (int c2 = 0; c2 < 2; ++c2)
#pragma unroll
                for (int e = 0; e < 4; ++e) atomicAdd(op + 16 * (2 * eh + c2) + e, o[c2][e]);
        }
        f32x4 U[2] = {(f32x4){0.f, 0.f, 0.f, 0.f}, (f32x4){0.f, 0.f, 0.f, 0.f}};
#pragma unroll
        for (int ks = 0; ks < 2; ++ks) { LAS unsigned char* ka = lds + KW + (32 * ks + 8 * g + (q16 >> 2)) * VSTR + (16 * cd + 4 * (lane & 3)) * 2;
            const s16x4 a0 = tr_read(ka), a1 = tr_read(ka + 4 * VSTR); const bf16x8 af = (bf16x8){a0[0], a0[1], a0[2], a0[3], a1[0], a1[1], a1[2], a1[3]};
#pragma unroll
            for (int c2 = 0; c2 < 2; ++c2) { LAS unsigned char* vb = lds + VT + (32 * ks + 8 * g + (q16 >> 2)) * VSTR + (16 * (ce0 + c2) + 4 * (lane & 3)) * 2;
                const s16x4 b0 = tr_read(vb), b1 = tr_read(vb + 4 * VSTR); const bf16x8 bfr = (bf16x8){b0[0], b0[1], b0[2], b0[3], b1[0], b1[1], b1[2], b1[3]};
                U[c2] = __builtin_amdgcn_mfma_f32_16x16x32_bf16(af, bfr, U[c2], 0, 0, 0); } }
        __syncthreads();
#pragma unroll
        for (int c2 = 0; c2 < 2; ++c2)
#pragma unroll
            for (int e = 0; e < 4; ++e) { Sreg[c2][e] = gC * Sreg[c2][e] + U[c2][e];
                *(LAS bf16*)(lds + SB + (16 * cd + 4 * g + e) * VSTR + (16 * (ce0 + c2) + q16) * 2) = (bf16)f2bf(Sreg[c2][e]); }
    }
    if (!lat) {
#pragma unroll
        for (int c2 = 0; c2 < 2; ++c2)
#pragma unroll
            for (int e = 0; e < 4; ++e) F.out[O_SRET + (size_t)((b * 2 + dir) * 8 + h) * 4096 + (16 * cd + 4 * g + e) * 64 + 16 * (ce0 + c2) + q16] = Sreg[c2][e];
    }
}
__device__ __forceinline__ void scan_phase2(Frame& F) {
    if (F.G == 256) {
        if (F.bid < 64) { const int job = F.bid >> 1; rwkv_job2<16>(F, 32 + (job >> 4), (job >> 1) & 7, job & 1, 32 * (F.bid & 1)); }
        else if (F.bid < 96) { const int u = F.bid - 64; ret_job2(F, 32 + (u >> 4), (u >> 1) & 7, u & 1); }
        else for (int it = F.bid - 96; it < 1024; it += 160) { const int q = it & 511; if (it < 512) rwkv_job2<8>(F, q >> 4, (q >> 1) & 7, q & 1, 0); else ret_job2(F, q >> 4, (q >> 1) & 7, q & 1); }
    } else {
        for (int it = F.bid; it < 1088 + 32; it += F.G) {
            if (it < 64) { const int job = it >> 1; rwkv_job2<16>(F, 32 + (job >> 4), (job >> 1) & 7, job & 1, 32 * (it & 1)); }
            else if (it < 96) { const int u = it - 64; ret_job2(F, 32 + (u >> 4), (u >> 1) & 7, u & 1); }
            else { const int r = it - 96, q = r & 511; if (r < 512) rwkv_job2<8>(F, q >> 4, (q >> 1) & 7, q & 1, 0); else ret_job2(F, q >> 4, (q >> 1) & 7, q & 1); }
        }
    }
}

__device__ __forceinline__ void rec_post_phase2(Frame& F) {
    const int lane = F.lane, q16 = lane & 15, g = lane >> 4;
    const bf16* PROJ = F.P; const float* Y = F.S; const float* O = F.S + (size_t)T * 512; const bf16* GUPT = (const bf16*)(F.ws + WS_MOD + MOD_GUPT);
    for (int it = F.wave * F.G + F.bid; it < T / 16; it += F.G * NWAVES) {
        const int tk0 = 16 * it;
        bf16x8 af[4];
#pragma unroll
        for (int kd = 0; kd < 4; ++kd) { const v4u raw = *(const v4u*)(PROJ + (size_t)(tk0 + q16) * NREC + 3712 + 32 * kd + 8 * g); float f[8]; unpack8(raw, f);
#pragma unroll
            for (int e = 0; e < 8; ++e) f[e] = sigmoidf_(f[e]);
            af[kd] = __builtin_bit_cast(bf16x8, pack8(f)); }
        for (int h = 0; h < 8; ++h) {
            f32x4 ga[4];
#pragma unroll
            for (int ct = 0; ct < 4; ++ct) { ga[ct] = (f32x4){0.f, 0.f, 0.f, 0.f};
#pragma unroll
                for (int kd = 0; kd < 4; ++kd) { const bf16x8 bfr = *(const bf16x8*)(GUPT + (size_t)(h * 64 + 16 * ct + q16) * 128 + 32 * kd + 8 * g); ga[ct] = __builtin_amdgcn_mfma_f32_16x16x32_bf16(af[kd], bfr, ga[ct], 0, 0, 0); } }
            float lng[4], lnb[4], rk_[4];
#pragma unroll
            for (int ct = 0; ct < 4; ++ct) { const int c = h * 64 + 16 * ct + q16; lng[ct] = F.in[33][c]; lnb[ct] = F.in[34][c]; rk_[ct] = F.in[32][c]; }
#pragma unroll
            for (int e = 0; e < 4; ++e) { const int tk = tk0 + 4 * g + e; const bf16* pr = PROJ + (size_t)tk * NREC + h * 64 + q16;
                float y[4], v[4]; float s1 = 0.f, s3 = 0.f;
#pragma unroll
                for (int ct = 0; ct < 4; ++ct) { y[ct] = Y[(size_t)tk * 512 + h * 64 + 16 * ct + q16]; const float r = bf1(pr[2048 + 16 * ct]), k = bf1(pr[2560 + 16 * ct]); v[ct] = bf1(pr[3072 + 16 * ct]); s1 += y[ct]; s3 += r * rk_[ct] * k; }
                s1 = row_reduce<16>(s1); s3 = row_reduce<16>(s3);
                const float mu = s1 * (1.f / 64.f); float s2 = 0.f;
#pragma unroll
                for (int ct = 0; ct < 4; ++ct) { y[ct] -= mu; s2 += y[ct] * y[ct]; }
                s2 = row_reduce<16>(s2);
                const float rstd = rsqrtf(s2 * (1.f / 64.f) + 64e-5f);
#pragma unroll
                for (int ct = 0; ct < 4; ++ct) F.MIX[(size_t)tk * D + 512 + h * 64 + 16 * ct + q16] = (bf16)f2bf((y[ct] * rstd * lng[ct] + lnb[ct] + s3 * v[ct]) * ga[ct][e]);
            }
        }
        for (int h = 0; h < 8; ++h) {
#pragma unroll
            for (int e = 0; e < 4; ++e) { const int tk = tk0 + 4 * g + e; const bf16* pr = PROJ + (size_t)tk * NREC + 1536 + h * 64 + q16;
                float o[4]; float ms = 0.f;
#pragma unroll
                for (int ct = 0; ct < 4; ++ct) { o[ct] = O[(size_t)tk * 512 + h * 64 + 16 * ct + q16]; ms += o[ct] * o[ct]; }
                ms = row_reduce<16>(ms);
                const float rn = rsqrtf(ms * (1.f / 64.f) + 1e-6f);
#pragma unroll
                for (int ct = 0; ct < 4; ++ct) { const float xg = bf1(pr[16 * ct]); F.MIX[(size_t)tk * D + h * 64 + 16 * ct + q16] = (bf16)f2bf(xg * sigmoidf_(xg) * o[ct] * rn); }
            }
        }
    }
}

typedef GAS unsigned gu32;
#define XB_TMO      128
#define XB_XCNT(j)  (256  + 64 * (j))
#define XB_XSUB(j)  (1280 + 64 * (j))
#define XB_XGEN(j)  (2304 + 64 * (j))
#define XB_TOP      3328
#define XB_TOPGEN   3392
#define XCD_BAR_WORDS 3456
#define XB_SPIN_CAP (1u << 18)

__device__ __forceinline__ unsigned xb_ld(unsigned* p)              { return __hip_atomic_load(p, __ATOMIC_RELAXED, __HIP_MEMORY_SCOPE_AGENT); }
__device__ __forceinline__ unsigned xb_add(unsigned* p, unsigned v) { return __hip_atomic_fetch_add(p, v, __ATOMIC_RELAXED, __HIP_MEMORY_SCOPE_AGENT); }
__device__ __forceinline__ unsigned xb_xcc_id() { return (unsigned)__builtin_amdgcn_s_getreg((3 << 11) | 20) & 0xFu; }
#define XB_SPIN(cond, bar) do { unsigned _sp = 0; while (cond) { __builtin_amdgcn_s_sleep(1); \
    if ((++_sp & 255u) == 0u) { if (xb_ld(&(bar)[XB_TMO])) break; if (_sp > XB_SPIN_CAP) { atomicAdd(&(bar)[XB_TMO], 1u); break; } } } } while (0)

struct XcdBarrier {
    unsigned* bar; unsigned x;
    volatile LAS unsigned* st;
};

__device__ __forceinline__ XcdBarrier xcd_barrier_post(unsigned* bar, volatile LAS unsigned* st) {
    XcdBarrier b; b.bar = bar; b.x = xb_xcc_id(); b.st = st;
    if (threadIdx.x == 0) (void)xb_add(&bar[XB_XCNT(b.x)], 1u);
    return b;
}
__device__ __forceinline__ void xcd_barrier_complete(unsigned* bar, unsigned x, unsigned& nloc, unsigned& nx) {
    const unsigned G = gridDim.x * gridDim.y * gridDim.z;
    unsigned sum, cnt, mine, sp = 0u;
    for (;;) {
        sum = 0u; cnt = 0u; mine = 0u;
#pragma unroll
        for (unsigned j = 0; j < 16; ++j) { const unsigned c = xb_ld(&bar[XB_XCNT(j)]); sum += c; cnt += (c > 0u) ? 1u : 0u; mine = (j == x) ? c : mine; }
        if (sum == G) break;
        __builtin_amdgcn_s_sleep(1);
        if ((++sp & 255u) == 0u) { if (xb_ld(&bar[XB_TMO])) break; if (sp > XB_SPIN_CAP) { atomicAdd(&bar[XB_TMO], 1u); break; } }
    }
    nloc = mine > 0u ? mine : 1u; nx = cnt > 0u ? cnt : 1u;
}

__device__ __forceinline__ void xcd_barrier(const XcdBarrier& b) {
    asm volatile("s_waitcnt vmcnt(0)" ::: "memory");
    __syncthreads();
    if (threadIdx.x == 0) {
        unsigned* bar = b.bar;
        __builtin_amdgcn_s_waitcnt(0);
        unsigned nloc = b.st[0], nx = b.st[1];
        if (nloc == 0u) { xcd_barrier_complete(bar, b.x, nloc, nx); b.st[0] = nloc; b.st[1] = nx; }
        const unsigned old = xb_add(&bar[XB_XSUB(b.x)], 1u);
        const unsigned gen = old / nloc;
        if (old + 1u == (gen + 1u) * nloc) {
            __builtin_amdgcn_fence(__ATOMIC_RELEASE, "agent");
            asm volatile("s_waitcnt vmcnt(0)" ::: "memory");
            const unsigned og = xb_add(&bar[XB_TOP], 1u);
            const unsigned tg = og / nx;
            if (og + 1u == (tg + 1u) * nx) xb_add(&bar[XB_TOPGEN], 1u);
            else XB_SPIN(xb_ld(&bar[XB_TOPGEN]) == tg, bar);
            __builtin_amdgcn_fence(__ATOMIC_ACQUIRE, "agent");
            xb_add(&bar[XB_XGEN(b.x)], 1u);
            asm volatile("s_waitcnt vmcnt(0)" ::: "memory");
        } else {
            XB_SPIN(xb_ld(&bar[XB_XGEN(b.x)]) == gen, bar);
            __builtin_amdgcn_fence(__ATOMIC_ACQUIRE, "agent");
            asm volatile("s_waitcnt vmcnt(0)" ::: "memory");
        }
    }
    __syncthreads();
}

#ifndef PROBE_DUP
#define PROBE_DUP 0
#endif
#ifndef ATTN_MFMA
#define ATTN_MFMA 1
#endif
enum { PH_BASE = __COUNTER__ };
struct Args { const float* in[37]; float* out; unsigned char* ws; int ph_lo, ph_hi; };

template <bool COOP>
__global__ void __launch_bounds__(NTHR, 2) mk_fwd(Args args) {
    extern __shared__ __attribute__((aligned(16))) unsigned char lds[];
    Frame F;
    F.lds = (LAS unsigned char*)lds;
    F.tid = threadIdx.x; F.lane = F.tid & 63; F.wave = __builtin_amdgcn_readfirstlane(F.tid >> 6); F.G = gridDim.x; F.bid = blockIdx.x;
#pragma unroll
    for (int i = 0; i < 37; ++i) F.in[i] = args.in[i];
    F.out = args.out; F.ws = args.ws;
    unsigned char* ws = args.ws;
    F.Watt = (bf16*)(ws + WS_WATT); F.Woa = (bf16*)(ws + WS_WOA); F.Wrec = (bf16*)(ws + WS_WREC); F.Wor = (bf16*)(ws + WS_WOR); F.Wf1 = (bf16*)(ws + WS_WF1); F.Wf2 = (bf16*)(ws + WS_WF2);
    F.H = (bf16*)(ws + WS_H); F.MIX = (bf16*)(ws + WS_MIX); F.P = (bf16*)(ws + WS_P); F.MOD = (float*)(ws + WS_MOD); F.S = (float*)(ws + WS_S);
    volatile LAS unsigned* MISC = (volatile LAS unsigned*)(F.lds + LDS_BYTES - 256);
    if (F.tid < 16) MISC[F.tid] = 0u;
    __syncthreads();
    XcdBarrier bar; bar.bar = (unsigned*)(ws + WS_CTL) + 4096; bar.x = 0; bar.st = nullptr;
    if (COOP) bar = xcd_barrier_post((unsigned*)(ws + WS_CTL) + 4096, MISC + 8);
    const int lo = args.ph_lo, hi = args.ph_hi;
#define IN(k) (lo <= (k) && (k) < hi)
#define SEAM(k) do { if (COOP && IN((k) + 1)) { if ((k) == 0) cooperative_groups::this_grid().sync(); else xcd_barrier(bar); } } while (0)
    const f32x2v* rope = (const f32x2v*)((unsigned char*)F.MOD + MOD_ROPE);

#define PHASE(...) { constexpr int k_ = __COUNTER__ - PH_BASE - 1; if (IN(k_)) { __VA_ARGS__; SEAM(k_); } }
    PHASE(p0_prologue(F))
#if PROBE_DUP == 3
    PHASE(p0_prologue(F))
#endif
    PHASE(norm_phase(F, F.in[0], F.in[1], F.in[10], F.MOD, 0, 1, false))
    PHASE(pg8::Gemm g{F.H, F.Watt, T, NATT, D}; pg8::StaticOrder S; S.init(T, NATT, F.G, F.bid); EpiAttnIn E{F.P, F.out, rope};
          pg8::gemm_phase<EpiAttnIn, pg8::StaticOrder, true, true>(F.lds, g, S, E))
#if ATTN_MFMA
    PHASE(attn_mfma_phase(F))
#if PROBE_DUP == 1
    PHASE(attn_mfma_phase(F))
#endif
#else
    PHASE(attn_naive_phase(F))
    PHASE(diff_post_phase(F))
#endif
    PHASE(pg8::Gemm g{F.MIX, F.Woa, T, D, D}; pg8::StaticOrder S; S.init(T, D, F.G, F.bid); EpiResid E{F.in[0], F.in[1], F.out, F.MOD, 2};
          pg8::gemm_phase<EpiResid, pg8::StaticOrder, true, true>(F.lds, g, S, E))
    PHASE(norm_phase(F, F.out, F.out + (size_t)TCX * D, F.in[11], F.MOD, 3, 4, false))
    PHASE(pg8::Gemm g{F.H, F.Wf1, T, NFF, D}; pg8::StaticOrder S; S.init(T, NFF, F.G, F.bid); EpiSwiglu E{F.P};
          pg8::gemm_phase<EpiSwiglu, pg8::StaticOrder, true, true>(F.lds, g, S, E))
#if PROBE_DUP == 5
    PHASE(pg8::Gemm g{F.H, F.Wf1, T, NFF, D}; pg8::StaticOrder S; S.init(T, NFF, F.G, F.bid); EpiSwiglu E{F.P};
          pg8::gemm_phase<EpiSwiglu, pg8::StaticOrder, true, true>(F.lds, g, S, E))
#endif
    PHASE(pg8::Gemm g{F.P, F.Wf2, T, D, DFF}; pg8::StaticOrder S; S.init(T, D, F.G, F.bid); EpiResid E{F.out, F.out + (size_t)TCX * D, F.out, F.MOD, 5};
          pg8::gemm_phase<EpiResid, pg8::StaticOrder, true, true>(F.lds, g, S, E))
    PHASE(norm_phase(F, F.out, F.out + (size_t)TCX * D, F.in[10] + D, F.MOD + 3 * 6144, 0, 1, true))
    PHASE(pg8::Gemm g{F.H, F.Wrec, T, NREC, D}; pg8::StaticOrder S; S.init(T, NREC, F.G, F.bid); EpiBf16Plain E{F.P, NREC};
          pg8::gemm_phase<EpiBf16Plain, pg8::StaticOrder, true, true>(F.lds, g, S, E))
    PHASE(scan_phase2(F))
#if PROBE_DUP == 2
    PHASE(zero_s_phase(F))
    PHASE(scan_phase2(F))
#endif
    PHASE(rec_post_phase2(F))
#if PROBE_DUP == 4
    PHASE(rec_post_phase2(F))
#endif
    PHASE(pg8::Gemm g{F.MIX, F.Wor, T, D, D}; pg8::StaticOrder S; S.init(T, D, F.G, F.bid); EpiResid E{F.out, F.out + (size_t)TCX * D, F.out, F.MOD + 3 * 6144, 2};
          pg8::gemm_phase<EpiResid, pg8::StaticOrder, true, true>(F.lds, g, S, E))
    PHASE(norm_phase(F, F.out, F.out + (size_t)TCX * D, F.in[11] + D, F.MOD + 3 * 6144, 3, 4, false))
    PHASE(pg8::Gemm g{F.H, F.Wf1 + WF1_STRIDE, T, NFF, D}; pg8::StaticOrder S; S.init(T, NFF, F.G, F.bid); EpiSwiglu E{F.P};
          pg8::gemm_phase<EpiSwiglu, pg8::StaticOrder, true, true>(F.lds, g, S, E))
    PHASE(pg8::Gemm g{F.P, F.Wf2 + WF2_STRIDE, T, D, DFF}; pg8::StaticOrder S; S.init(T, D, F.G, F.bid); EpiResid E{F.out, F.out + (size_t)TCX * D, F.out, F.MOD + 3 * 6144, 5};
          pg8::gemm_phase<EpiResid, pg8::StaticOrder, true, true>(F.lds, g, S, E))
    PHASE(final_norm_phase(F))
#undef PHASE
#undef IN
#undef SEAM
}

constexpr int NPHASE = __COUNTER__ - PH_BASE - 1;
#ifndef MK_N_LAUNCHES
#define MK_N_LAUNCHES 1
#endif
extern "C" void kernel_launch(void* const* d_in, const int* in_sizes, int n_in, void* d_out, int out_size, void* d_ws, size_t ws_size, hipStream_t stream) {
    static int grid = 0;
    if (grid == 0) {
        if (n_in != 37 || out_size != 33554432 || ws_size < WS_END) { fprintf(stderr, "kernel_launch: unexpected problem (n_in %d out %d ws %zu)\n", n_in, out_size, ws_size); grid = -1; return; }
        int dev = 0, cus = 0, per_cu = 0;
        if (hipGetDevice(&dev) != hipSuccess || hipDeviceGetAttribute(&cus, hipDeviceAttributeMultiprocessorCount, dev) != hipSuccess) { grid = -1; return; }
        (void)hipFuncSetAttribute((const void*)mk_fwd<false>, hipFuncAttributeMaxDynamicSharedMemorySize, LDS_BYTES);
        (void)hipFuncSetAttribute((const void*)mk_fwd<true>, hipFuncAttributeMaxDynamicSharedMemorySize, LDS_BYTES);
        if (hipOccupancyMaxActiveBlocksPerMultiprocessor(&per_cu, (const void*)mk_fwd<true>, NTHR, LDS_BYTES) != hipSuccess || per_cu < 1) per_cu = 1;
        (void)hipGetLastError();
        grid = cus;
    }
    if (grid < 0) return;
    if (hipMemsetAsync((char*)d_ws + WS_CTL, 0, 65536, stream) != hipSuccess) { fprintf(stderr, "memset failed\n"); return; }
    Args a{};
    for (int i = 0; i < 37; ++i) a.in[i] = (const float*)d_in[i];
    a.out = (float*)d_out; a.ws = (unsigned char*)d_ws;
#if MK_N_LAUNCHES == 1
    a.ph_lo = 0; a.ph_hi = NPHASE;
    void* kargs[] = {&a};
    hipError_t e = hipLaunchCooperativeKernel((const void*)mk_fwd<true>, dim3(grid), dim3(NTHR), kargs, LDS_BYTES, stream);
    if (e != hipSuccess) fprintf(stderr, "cooperative launch failed: %s (grid %d)\n", hipGetErrorString(e), grid);
#else
    for (int ph = 0; ph < NPHASE; ++ph) { a.ph_lo = ph; a.ph_hi = ph + 1; hipLaunchKernelGGL(mk_fwd<false>, dim3(grid), dim3(NTHR), LDS_BYTES, stream, a); }
#endif
}
```

```cpp
#include <hip/hip_runtime.h>
#include <hip/hip_cooperative_groups.h>
#include <cstdio>
#include <cstdint>
namespace pg8 {
#define PG8_LAS __attribute__((address_space(3)))
typedef unsigned short bf16_t;
typedef short bf16x8 __attribute__((ext_vector_type(8)));
typedef float f32x4 __attribute__((ext_vector_type(4)));
typedef unsigned u32x4 __attribute__((ext_vector_type(4)));
constexpr int BM = 256, BK = 64, HALF = 128, HTB = HALF * BK * 2  , STAGE_BYTES = 8 * HTB, NXCD = 8, WGM = 8;

__host__ __device__ __forceinline__ int lds_byte(int r, int c) { const int st = (r >> 4) * 2 + (c >> 5), rr = r & 15, cc = c & 31, ob = rr * 64 + cc * 2; return st * 1024 + (ob ^ (((ob >> 9) & 1) << 5)); }
__host__ __device__ __forceinline__ void stage_rc(int b, int& R, int& C) { const int st = b / 1024, sb = b % 1024, swz = sb ^ (((sb >> 9) & 1) << 5); R = (st >> 1) * 16 + swz / 64; C = (st & 1) * 32 + (swz % 64) / 2; }
__host__ __device__ __forceinline__ int perm32(int rho) { const int n = rho >> 4, i = rho & 15; return 8 * (i >> 2) + 4 * n + (i & 3); }

struct Unit { int pm, pn; };
struct Gemm { const bf16_t* A; const bf16_t* Bt; int M, N, K; };

struct StaticOrder {
    int nM, nN, nwg, G, c;
    __host__ __device__ void init(int M, int N, int G_, int c_) { nM = M / BM; nN = N / BM; nwg = nM * nN; G = G_; c = c_; }
    __host__ __device__ bool next(int i, Unit& u) const {
        const long L = (long)i * G + c; if (L >= nwg) return false;
        int wgid = (int)L; { const int q = nwg / NXCD, r = nwg % NXCD, xcd = wgid % NXCD, off = wgid / NXCD; wgid = (xcd < r ? xcd * (q + 1) : r * (q + 1) + (xcd - r) * q) + off; }
        const int nig = WGM * nN, gid = wgid / nig, fm = gid * WGM, gsz = (nM - fm) < WGM ? (nM - fm) : WGM;
        u.pm = fm + ((wgid % nig) % gsz); u.pn = (wgid % nig) / gsz; return true;
    }
    __device__ __forceinline__ void a_ready(const Unit&) const {}
    __device__ __forceinline__ void done(const Unit&) const {}
};
__device__ __forceinline__ unsigned cvt_pk_bf16(float lo, float hi) { unsigned r; asm volatile("v_cvt_pk_bf16_f32 %0, %1, %2" : "=v"(r) : "v"(lo), "v"(hi)); return r; }
typedef float f32x2 __attribute__((ext_vector_type(2)));
template <class Epi, class Sched, bool ALIGN_EPI = false, bool SP2 = false>
__device__ __forceinline__ void gemm_phase(PG8_LAS unsigned char* lds, const Gemm g, const Sched& S, const Epi& E) {
    const int tid = threadIdx.x, wid = __builtin_amdgcn_readfirstlane(tid >> 6), lane = tid & 63, wr = wid >> 2, wc = wid & 3, fr = lane & 15, fq = lane >> 4;
    const int K = g.K, nt = K / BK;
    unsigned voffA[2], voffB[2];
#pragma unroll
    for (int i = 0; i < 2; ++i) { int R, C; stage_rc(tid * 16 + i * 8192, R, C); const int Rb = Epi::PERM ? ((R & ~31) + perm32(R & 31)) : R;
        voffA[i] = (unsigned)(R * K + C) * 2u; voffB[i] = (unsigned)(Rb * K + C) * 2u; }
    const size_t kstep = (size_t)(BK * 2);
    const size_t hstep = (size_t)HALF * K * 2;
    const size_t tstep = 2 * hstep;
    const unsigned ldsw = (unsigned)wid * 1024u;
    const int aoff = lds_byte(wr * 64 + fr, fq * 8), boff = lds_byte(wc * 32 + fr, fq * 8);
#define PG8_SA(b, h) (((b) * 2 + (h)) * HTB)
#define PG8_SB(b, h) ((4 + (b) * 2 + (h)) * HTB)
#define PG8_STAGE(bufoff, gbase, voff) do { _Pragma("unroll") for (int _i = 0; _i < 2; ++_i) \
        __builtin_amdgcn_global_load_lds((const unsigned*)((const char*)(gbase) + (voff)[_i]), (PG8_LAS unsigned*)(lds + (bufoff) + ldsw + _i * 8192), 16, 0, 0); } while (0)
#define PG8_LDA(dst, b, h) do { _Pragma("unroll") for (int m = 0; m < 4; ++m) _Pragma("unroll") for (int k = 0; k < 2; ++k) dst[m][k] = *(const PG8_LAS bf16x8*)(lds + PG8_SA(b, h) + aoff + m * 2048 + k * 1024); } while (0)
#define PG8_LDB(dst, b, h) do { _Pragma("unroll") for (int n = 0; n < 2; ++n) _Pragma("unroll") for (int k = 0; k < 2; ++k) dst[n][k] = *(const PG8_LAS bf16x8*)(lds + PG8_SB(b, h) + boff + n * 2048 + k * 1024); } while (0)
#define PG8_MMA(ai, bj, At, Bt) do { __builtin_amdgcn_s_setprio(1); _Pragma("unroll") for (int m = 0; m < 4; ++m) _Pragma("unroll") for (int n = 0; n < 2; ++n) _Pragma("unroll") for (int k = 0; k < 2; ++k) \
        acc[ai][bj][m][n] = __builtin_amdgcn_mfma_f32_16x16x32_bf16(Bt[n][k], At[m][k], acc[ai][bj][m][n], 0, 0, 0); __builtin_amdgcn_s_setprio(0); } while (0)
#define PG8_WAIT_V(n) asm volatile("s_waitcnt vmcnt(" #n ")" ::: "memory")
#define PG8_WAIT_L(n) asm volatile("s_waitcnt lgkmcnt(" #n ")" ::: "memory")
#define PG8_BAR __builtin_amdgcn_s_barrier()
#define PG8_SCHED __builtin_amdgcn_sched_barrier(0)
    Unit cur, nxt; int ui = 0;
    if (!S.next(0, cur)) return;
    f32x4 acc[2][2][4][2];
#pragma unroll
    for (int a = 0; a < 2; ++a)
#pragma unroll
        for (int b = 0; b < 2; ++b)
#pragma unroll
            for (int m = 0; m < 4; ++m)
#pragma unroll
                for (int n = 0; n < 2; ++n) acc[a][b][m][n] = (f32x4){0.f, 0.f, 0.f, 0.f};
    bf16x8 At[4][2], B0[2][2], B1[2][2];
    const char* cA = (const char*)g.A + (size_t)cur.pm * tstep; const char* cB = (const char*)g.Bt + (size_t)cur.pn * tstep;
    S.a_ready(cur);
    if constexpr (SP2) {
        PG8_STAGE(PG8_SB(0, 0), cB, voffB); PG8_STAGE(PG8_SB(0, 1), cB + hstep, voffB); PG8_STAGE(PG8_SA(0, 0), cA, voffA); PG8_STAGE(PG8_SA(0, 1), cA + hstep, voffA);
        if (wr == 1) PG8_BAR;
        PG8_WAIT_V(2); PG8_BAR;
        PG8_STAGE(PG8_SB(1, 0), cB + kstep, voffB); PG8_STAGE(PG8_SA(1, 0), cA + kstep, voffA); PG8_STAGE(PG8_SB(1, 1), cB + hstep + kstep, voffB);
        PG8_WAIT_V(6); PG8_BAR;
    } else {
        PG8_STAGE(PG8_SB(0, 0), cB, voffB); PG8_STAGE(PG8_SA(0, 0), cA, voffA); PG8_STAGE(PG8_SB(0, 1), cB + hstep, voffB); PG8_STAGE(PG8_SA(0, 1), cA + hstep, voffA);
        if (wr == 1) PG8_BAR;
        PG8_WAIT_V(4); PG8_BAR;
        PG8_STAGE(PG8_SB(1, 0), cB + kstep, voffB); PG8_STAGE(PG8_SA(1, 0), cA + kstep, voffA); PG8_STAGE(PG8_SB(1, 1), cB + hstep + kstep, voffB);
        PG8_WAIT_V(6); PG8_BAR;
    }
    for (;;) {
        const bool has_next = S.next(ui + 1, nxt);
        const char* nA = has_next ? (const char*)g.A + (size_t)nxt.pm * tstep : cA; const char* nB = has_next ? (const char*)g.Bt + (size_t)nxt.pn * tstep : cB;
        for (int t = 0; t < nt; t += 2) {
            const bool last = (t == nt - 2);
            const char* a1 = cA + (size_t)(t + 1) * kstep;
            const char* a2 = last ? nA : cA + (size_t)(t + 2) * kstep; const char* b2 = last ? nB : cB + (size_t)(t + 2) * kstep;
            const char* a3 = a2 + kstep; const char* b3 = b2 + kstep;
            if (last && has_next) S.a_ready(nxt);
            if constexpr (SP2) {
            PG8_LDB(B0, 0, 0); PG8_LDB(B1, 0, 1); PG8_SCHED; PG8_LDA(At, 0, 0); PG8_STAGE(PG8_SA(1, 1), a1 + hstep, voffA);
            PG8_WAIT_V(8); PG8_WAIT_L(0); PG8_BAR; PG8_MMA(0, 0, At, B0); PG8_MMA(0, 1, At, B1); PG8_BAR; PG8_SCHED;
            PG8_LDA(At, 0, 1); PG8_STAGE(PG8_SB(0, 0), b2, voffB); PG8_STAGE(PG8_SB(0, 1), b2 + hstep, voffB); PG8_STAGE(PG8_SA(0, 0), a2, voffA);
            PG8_WAIT_V(8); PG8_WAIT_L(0); PG8_BAR; PG8_MMA(1, 0, At, B0); PG8_MMA(1, 1, At, B1); PG8_BAR; PG8_SCHED;
            PG8_LDB(B0, 1, 0); PG8_LDB(B1, 1, 1); PG8_SCHED; PG8_LDA(At, 1, 0); PG8_STAGE(PG8_SA(0, 1), a2 + hstep, voffA);
            PG8_WAIT_V(8); PG8_WAIT_L(0); PG8_BAR; PG8_MMA(0, 0, At, B0); PG8_MMA(0, 1, At, B1); PG8_BAR; PG8_SCHED;
            PG8_LDA(At, 1, 1); PG8_STAGE(PG8_SB(1, 0), b3, voffB); PG8_STAGE(PG8_SB(1, 1), b3 + hstep, voffB); PG8_STAGE(PG8_SA(1, 0), a3, voffA);
            PG8_WAIT_V(8); PG8_WAIT_L(0); PG8_BAR; PG8_MMA(1, 0, At, B0); PG8_MMA(1, 1, At, B1); PG8_BAR; PG8_SCHED;
            } else {
            PG8_LDB(B0, 0, 0); PG8_SCHED; PG8_LDA(At, 0, 0); PG8_STAGE(PG8_SA(1, 1), a1 + hstep, voffA);
            PG8_WAIT_L(8); PG8_BAR; PG8_WAIT_L(0); PG8_MMA(0, 0, At, B0); PG8_BAR; PG8_SCHED;
            PG8_LDB(B1, 0, 1); PG8_STAGE(PG8_SB(0, 0), b2, voffB);
            PG8_BAR; PG8_WAIT_L(0); PG8_MMA(0, 1, At, B1); PG8_BAR;
            PG8_LDA(At, 0, 1); PG8_STAGE(PG8_SA(0, 0), a2, voffA);
            PG8_BAR; PG8_WAIT_L(0); PG8_MMA(1, 0, At, B0); PG8_BAR; PG8_SCHED;
            PG8_STAGE(PG8_SB(0, 1), b2 + hstep, voffB);
            PG8_WAIT_V(6); PG8_BAR; PG8_MMA(1, 1, At, B1); PG8_BAR;
            PG8_LDB(B0, 1, 0); PG8_SCHED; PG8_LDA(At, 1, 0); PG8_STAGE(PG8_SA(0, 1), a2 + hstep, voffA);
            PG8_WAIT_L(8); PG8_BAR; PG8_WAIT_L(0); PG8_MMA(0, 0, At, B0); PG8_BAR; PG8_SCHED;
            PG8_LDB(B1, 1, 1); PG8_STAGE(PG8_SB(1, 0), b3, voffB);
            PG8_BAR; PG8_WAIT_L(0); PG8_MMA(0, 1, At, B1); PG8_BAR;
            PG8_LDA(At, 1, 1); PG8_STAGE(PG8_SA(1, 0), a3, voffA);
            PG8_BAR; PG8_WAIT_L(0); PG8_MMA(1, 0, At, B0); PG8_BAR; PG8_SCHED;
            PG8_STAGE(PG8_SB(1, 1), b3 + hstep, voffB);
            PG8_WAIT_V(6); PG8_BAR; PG8_MMA(1, 1, At, B1); PG8_BAR;
            }
        }
        if constexpr (ALIGN_EPI) { if (wr == 0) PG8_BAR; }
        if constexpr (!Epi::AFTER_DRAIN) { E(acc, cur, wr, wc, fr, fq); S.done(cur); }
        if (!has_next) break;
#pragma unroll
        for (int a = 0; a < 2; ++a)
#pragma unroll
            for (int b = 0; b < 2; ++b)
#pragma unroll
                for (int m = 0; m < 4; ++m)
#pragma unroll
                    for (int n = 0; n < 2; ++n) acc[a][b][m][n] = (f32x4){0.f, 0.f, 0.f, 0.f};
        cur = nxt; cA = nA; cB = nB; ++ui;
        if constexpr (ALIGN_EPI) { if (wr == 1) PG8_BAR; }
    }
    PG8_WAIT_V(0);
    if constexpr (!ALIGN_EPI) { if (wr == 0) PG8_BAR; }
    PG8_BAR;
    if constexpr (Epi::AFTER_DRAIN) { E.fused(acc, cur, wr, wc, fr, fq, lds, wid, lane); S.done(cur); }
#undef PG8_SA
#undef PG8_SB
#undef PG8_STAGE
#undef PG8_LDA
#undef PG8_LDB
#undef PG8_MMA
#undef PG8_WAIT_V
#undef PG8_WAIT_L
#undef PG8_BAR
#undef PG8_SCHED
}
}

#define GAS __attribute__((address_space(1)))
#define LAS __attribute__((address_space(3)))
typedef unsigned short bf16;
typedef unsigned v4u __attribute__((ext_vector_type(4)));
typedef unsigned v2u __attribute__((ext_vector_type(2)));
typedef float f32x4 __attribute__((ext_vector_type(4)));
typedef float f32x2v __attribute__((ext_vector_type(2)));

constexpr int NWAVES = 8, NTHR = 512;
constexpr int D = 1024, TCX = 8192, TLT = 4096, T = 12288;
constexpr int NATT = 3072, NREC = 3840, DFF = 2816, NFF = 5632;
constexpr int QLD = NATT;
constexpr size_t MiB = 1u << 20;
constexpr size_t WS_CTL = 0, WS_MOD = 1 * MiB, WS_WATT = 2 * MiB, WS_WOA = 8 * MiB, WS_WREC = 10 * MiB, WS_WOR = 18 * MiB, WS_WF1 = 20 * MiB, WS_WF2 = 42 * MiB,
                 WS_H = 54 * MiB, WS_MIX = 78 * MiB, WS_P = 102 * MiB, WS_S = 192 * MiB, WS_END = 256 * MiB;
constexpr size_t MOD_ROPE = 160 * 1024, MOD_LAM = 176 * 1024, MOD_GUPT = 256 * 1024;
constexpr size_t WF1_STRIDE = (size_t)NFF * D;
constexpr size_t WF2_STRIDE = (size_t)D * DFF;
constexpr size_t O_YP = 0, O_YS = 8388608, O_NAK = 12582912, O_NAV = 16777216, O_DFK = 20971520, O_DFV = 25165824, O_SRET = 29360128, O_SRW = 31457280;
constexpr int LDS_BYTES = 147456;

__device__ __forceinline__ float bflo(unsigned u) { return __uint_as_float(u << 16); }
__device__ __forceinline__ float bfhi(unsigned u) { return __uint_as_float(u & 0xffff0000u); }
__device__ __forceinline__ float bf1(bf16 b) { return __uint_as_float(((unsigned)b) << 16); }
__device__ __forceinline__ unsigned f2bf(float f) { unsigned u = __float_as_uint(f); return (u + 0x7fffu + ((u >> 16) & 1u)) >> 16; }
__device__ __forceinline__ unsigned pk2(float lo, float hi) { return f2bf(lo) | (f2bf(hi) << 16); }
__device__ __forceinline__ float wave_sum(float v) {
#pragma unroll
    for (int o = 1; o < 64; o <<= 1) v += __shfl_xor(v, o);
    return v;
}
__device__ __forceinline__ float sigmoidf_(float x) { return 1.f / (1.f + __expf(-x)); }

struct Frame {
    LAS unsigned char* lds;
    int tid, lane, wave, G, bid;
    const float* in[37];
    float* out; unsigned char* ws;
    bf16 *Watt, *Woa, *Wrec, *Wor, *Wf1, *Wf2, *H, *MIX, *P;
    float *MOD, *S;
};

__device__ __forceinline__ void transpose_item(const float* W, int K, int N, bf16* WT, int k0, int n0, int drow0, LAS float* scr, int lane) {
#pragma unroll 8
    for (int i = 0; i < 32; ++i) { const int kk = 2 * i + (lane >> 5); scr[kk * 33 + (lane & 31)] = W[(size_t)(k0 + kk) * N + n0 + (lane & 31)]; }
    asm volatile("s_waitcnt lgkmcnt(0)" ::: "memory");
    const int c = lane & 7;
#pragma unroll
    for (int j = 0; j < 4; ++j) { const int n = (lane >> 3) + 8 * j; const LAS float* s = scr + (8 * c) * 33 + n;
        v4u o; o.x = pk2(s[0 * 33], s[1 * 33]); o.y = pk2(s[2 * 33], s[3 * 33]); o.z = pk2(s[4 * 33], s[5 * 33]); o.w = pk2(s[6 * 33], s[7 * 33]);
        *(v4u*)(WT + (size_t)(drow0 + n) * K + k0 + 8 * c) = o; }
    asm volatile("s_waitcnt lgkmcnt(0)" ::: "memory");
}

__device__ __forceinline__ void p0_prologue(Frame& F) {
    {
        LAS float* sc = (LAS float*)F.lds;
        LAS float* red = sc + 3072;
        for (int idx = F.tid; idx < 3072; idx += NTHR) { const int j = idx >> 10, k = idx & 1023; const float c = (j == 0) ? F.in[9][k] : F.in[8][(j - 1) * 1024 + k]; sc[idx] = c * sigmoidf_(c); }
        __syncthreads();
        for (int item = F.bid; item < 192; item += F.G) {
            const int layer = item / 96, col = (item % 96) * 64 + (F.tid & 63), kg = F.tid >> 6;
            const float* w = F.in[13] + (size_t)layer * 1024 * 6144 + col;
            float a0 = 0.f, a1 = 0.f, a2 = 0.f;
#pragma unroll 8
            for (int k = kg * 128; k < kg * 128 + 128; ++k) { const float wv = w[(size_t)k * 6144]; a0 += sc[k] * wv; a1 += sc[1024 + k] * wv; a2 += sc[2048 + k] * wv; }
            red[(kg * 3 + 0) * 64 + (F.tid & 63)] = a0; red[(kg * 3 + 1) * 64 + (F.tid & 63)] = a1; red[(kg * 3 + 2) * 64 + (F.tid & 63)] = a2;
            __syncthreads();
            if (F.tid < 192) { const int j = F.tid >> 6, c = F.tid & 63; float s = 0.f;
#pragma unroll
                for (int g = 0; g < 8; ++g) s += red[(g * 3 + j) * 64 + c];
                const int cc = (item % 96) * 64 + c; F.MOD[(layer * 3 + j) * 6144 + cc] = s + F.in[14][layer * 6144 + cc]; }
            __syncthreads();
        }
    }
    if (F.bid == F.G - 1) {
        f32x2v* rope = (f32x2v*)((unsigned char*)F.MOD + MOD_ROPE);
        for (int idx = F.tid; idx < 1024; idx += NTHR) { const int pos = idx >> 4, i = idx & 15; const float inv = powf(10000.0f, -(float)i / 16.0f); const float ang = (float)pos * inv; rope[idx] = (f32x2v){cosf(ang), sinf(ang)}; }
        if (F.wave == 0) { const float s1 = wave_sum(F.in[18][F.lane] * F.in[19][F.lane]), s2 = wave_sum(F.in[20][F.lane] * F.in[21][F.lane]);
            if (F.lane == 0) *(float*)((unsigned char*)F.MOD + MOD_LAM) = expf(s1) - expf(s2) + 0.2f; }
    }
    { bf16* GUPT = (bf16*)(F.ws + WS_MOD + MOD_GUPT);
      for (int idx = F.bid * NTHR + F.tid; idx < 65536; idx += F.G * NTHR) { const int n = idx >> 7, k = idx & 127; GUPT[idx] = (bf16)f2bf(F.in[29][(size_t)k * 512 + n]); } }
    {
        const int gt = F.bid * NTHR + F.tid, NG = F.G * NTHR;
        for (int idx = gt; idx < 4 * 512 * 64; idx += NG) { const int t = idx / (512 * 64), r = (idx / 64) % 512, c8 = idx % 64;
            const float* srcb = (t == 0) ? F.in[2] : (t == 1) ? F.in[3] : (t == 2) ? F.in[4] : F.in[5]; const float* src = srcb + (size_t)r * 512 + c8 * 8; const int colb = (t == 0) ? 512 : (t == 1) ? 1024 : (t == 2) ? 2048 : 2560;
            const f32x4 a = *(const f32x4*)src, b = *(const f32x4*)(src + 4);
            v4u o; o.x = pk2(a[0], a[1]); o.y = pk2(a[2], a[3]); o.z = pk2(b[0], b[1]); o.w = pk2(b[2], b[3]);
            *(v4u*)(F.P + (size_t)(T + r) * QLD + colb + c8 * 8) = o; }
    }
    {
        LAS float* scr = (LAS float*)(F.lds + 20480 + F.wave * 8448);
        __syncthreads();
        const int gw = F.bid * NWAVES + F.wave, NGW = F.G * NWAVES;
        constexpr int I0 = 16 * 96, I1 = 16 * 32, I2 = 16 * 120, I3 = 16 * 32, I4 = 16 * 176, I6 = 44 * 32;
        constexpr int NIT = I0 + I1 + I2 + I3 + 2 * I4 + 2 * I6;
        for (int it = gw; it < NIT; it += NGW) {
            int r = it;
            if (r < I0) { const int nb = 96; transpose_item(F.in[15], 1024, 3072, F.Watt, 64 * (r / nb), 32 * (r % nb), 32 * (r % nb), scr, F.lane); continue; } r -= I0;
            if (r < I1) { const int nb = 32; transpose_item(F.in[16], 1024, 1024, F.Woa, 64 * (r / nb), 32 * (r % nb), 32 * (r % nb), scr, F.lane); continue; } r -= I1;
            if (r < I2) { const int nb = 120; transpose_item(F.in[22], 1024, 3840, F.Wrec, 64 * (r / nb), 32 * (r % nb), 32 * (r % nb), scr, F.lane); continue; } r -= I2;
            if (r < I3) { const int nb = 32; transpose_item(F.in[23], 1024, 1024, F.Wor, 64 * (r / nb), 32 * (r % nb), 32 * (r % nb), scr, F.lane); continue; } r -= I3;
            if (r < 2 * I4) { const int l = r / I4; r -= l * I4; const int nb = 176, n0 = 32 * (r % nb);
                const int drow = (n0 < DFF) ? ((n0 / 128) * 256 + (n0 % 128)) : (((n0 - DFF) / 128) * 256 + 128 + ((n0 - DFF) % 128));
                transpose_item(F.in[35] + (size_t)l * 1024 * NFF, 1024, NFF, F.Wf1 + (size_t)l * WF1_STRIDE, 64 * (r / nb), n0, drow, scr, F.lane); continue; } r -= 2 * I4;
            { const int l = r / I6; r -= l * I6; const int nb = 32;
                transpose_item(F.in[36] + (size_t)l * DFF * 1024, DFF, 1024, F.Wf2 + (size_t)l * WF2_STRIDE, 64 * (r / nb), 32 * (r % nb), 32 * (r % nb), scr, F.lane); }
        }
    }
}

__device__ __forceinline__ void norm_phase(Frame& F, const float* xc, const float* xl, const float* g, const float* mod  , int shift_i, int scale_i, bool zero_s) {
    const int gw = F.bid * NWAVES + F.wave, NGW = F.G * NWAVES;
    for (int row = gw; row < T; row += NGW) {
        const float* xr = (row < TCX) ? xc + (size_t)row * D : xl + (size_t)(row - TCX) * D;
        const int cond = (row < TCX) ? 0 : 1 + ((row - TCX) >> 11);
        const float* sh = mod + cond * 6144 + shift_i * 1024; const float* sc = mod + cond * 6144 + scale_i * 1024;
        f32x4 v[4]; float ss = 0.f;
#pragma unroll
        for (int j = 0; j < 4; ++j) { v[j] = *(const f32x4*)(xr + 4 * F.lane + 256 * j); ss += (v[j][0] * v[j][0] + v[j][1] * v[j][1]) + (v[j][2] * v[j][2] + v[j][3] * v[j][3]); }
        const float rstd = rsqrtf(wave_sum(ss) * (1.f / D) + 1e-6f);
#pragma unroll
        for (int j = 0; j < 4; ++j) { const int c = 4 * F.lane + 256 * j; const f32x4 gg = *(const f32x4*)(g + c), s1 = *(const f32x4*)(sc + c), s0 = *(const f32x4*)(sh + c);
            f32x4 h;
#pragma unroll
            for (int e = 0; e < 4; ++e) h[e] = v[j][e] * rstd * gg[e] * (1.f + s1[e]) + s0[e];
            v2u o; o.x = pk2(h[0], h[1]); o.y = pk2(h[2], h[3]); *(v2u*)(F.H + (size_t)row * D + c) = o; }
    }
    if (zero_s) {
        const size_t n16 = (size_t)48 * MiB / 16; f32x4* p = (f32x4*)F.S;
        for (size_t i = (size_t)F.bid * NTHR + F.tid; i < n16; i += (size_t)F.G * NTHR) p[i] = (f32x4){0.f, 0.f, 0.f, 0.f};
    }
}
__device__ __forceinline__ void zero_s_phase(Frame& F) {
    const size_t n16 = (size_t)48 * MiB / 16; f32x4* p = (f32x4*)F.S;
    for (size_t i = (size_t)F.bid * NTHR + F.tid; i < n16; i += (size_t)F.G * NTHR) p[i] = (f32x4){0.f, 0.f, 0.f, 0.f};
}
__device__ __forceinline__ void final_norm_phase(Frame& F) {
    const int gw = F.bid * NWAVES + F.wave, NGW = F.G * NWAVES; const float* g = F.in[12];
    for (int row = gw; row < T; row += NGW) {
        float* xr = F.out + (size_t)row * D;
        f32x4 v[4]; float ss = 0.f;
#pragma unroll
        for (int j = 0; j < 4; ++j) { v[j] = *(const f32x4*)(xr + 4 * F.lane + 256 * j); ss += (v[j][0] * v[j][0] + v[j][1] * v[j][1]) + (v[j][2] * v[j][2] + v[j][3] * v[j][3]); }
        const float rstd = rsqrtf(wave_sum(ss) * (1.f / D) + 1e-6f);
#pragma unroll
        for (int j = 0; j < 4; ++j) { const int c = 4 * F.lane + 256 * j; const f32x4 gg = *(const f32x4*)(g + c); *(f32x4*)(xr + c) = v[j] * rstd * gg; }
    }
}

struct EpiAttnIn {
    static constexpr bool PERM = true, AFTER_DRAIN = false;
    bf16* QKV; float* out; const f32x2v* rope;
    __device__ __forceinline__ void operator()(const f32x4 (&acc)[2][2][4][2], const pg8::Unit& u, int wr, int wc, int fr, int fq) const {
        const int pn = u.pn; const bool ctx = u.pm < 32;
        float* cdst = nullptr; int cbase = 0;
        if (ctx) { if (pn == 2 || pn == 3) { cdst = out + O_NAK; cbase = 512; } else if (pn == 4 || pn == 5) { cdst = out + O_NAV; cbase = 1024; }
                   else if (pn == 8 || pn == 9) { cdst = out + O_DFK; cbase = 2048; } else if (pn == 10 || pn == 11) { cdst = out + O_DFV; cbase = 2560; } }
        const bool rope_on = (!ctx) && pn >= 6 && pn <= 9;
        const float sgn = (fq < 2) ? -1.f : 1.f;
#pragma unroll
        for (int ai = 0; ai < 2; ++ai)
#pragma unroll
            for (int m = 0; m < 4; ++m) { const int row = u.pm * 256 + ai * 128 + wr * 64 + m * 16 + fr;
#pragma unroll
                for (int bj = 0; bj < 2; ++bj) { const int col = pn * 256 + bj * 128 + wc * 32 + 8 * fq;
                    f32x4 v0 = acc[ai][bj][m][0], v1 = acc[ai][bj][m][1];
                    if (rope_on) { const int n = (row - TCX) & 2047; const int p = (wc & 1) ? (n & 63) : (n >> 6); const f32x2v* tb = rope + p * 16 + 8 * (fq & 1);
#pragma unroll
                        for (int e = 0; e < 4; ++e) { const float p0 = __shfl_xor(v0[e], 32), p1 = __shfl_xor(v1[e], 32); const f32x2v c0 = tb[e], c1 = tb[4 + e];
                            v0[e] = v0[e] * c0.x + sgn * p0 * c0.y; v1[e] = v1[e] * c1.x + sgn * p1 * c1.y; } }
                    v4u w; w.x = pg8::cvt_pk_bf16(v0[0], v0[1]); w.y = pg8::cvt_pk_bf16(v0[2], v0[3]); w.z = pg8::cvt_pk_bf16(v1[0], v1[1]); w.w = pg8::cvt_pk_bf16(v1[2], v1[3]);
                    *(v4u*)(QKV + (size_t)row * QLD + col) = w;
                    if (cdst) { float* cp = cdst + (size_t)row * 512 + (col - cbase); *(f32x4*)cp = v0; *(f32x4*)(cp + 4) = v1; } } }
    }
};
struct EpiBf16Plain {
    static constexpr bool PERM = true, AFTER_DRAIN = false;
    bf16* O; int ldc;
    __device__ __forceinline__ void operator()(const f32x4 (&acc)[2][2][4][2], const pg8::Unit& u, int wr, int wc, int fr, int fq) const {
#pragma unroll
        for (int ai = 0; ai < 2; ++ai)
#pragma unroll
            for (int m = 0; m < 4; ++m) { const int row = u.pm * 256 + ai * 128 + wr * 64 + m * 16 + fr;
#pragma unroll
                for (int bj = 0; bj < 2; ++bj) { const int col = u.pn * 256 + bj * 128 + wc * 32 + 8 * fq; const f32x4 v0 = acc[ai][bj][m][0], v1 = acc[ai][bj][m][1];
                    v4u w; w.x = pg8::cvt_pk_bf16(v0[0], v0[1]); w.y = pg8::cvt_pk_bf16(v0[2], v0[3]); w.z = pg8::cvt_pk_bf16(v1[0], v1[1]); w.w = pg8::cvt_pk_bf16(v1[2], v1[3]);
                    *(v4u*)(O + (size_t)row * ldc + col) = w; } }
    }
};
struct EpiSwiglu {
    static constexpr bool PERM = true, AFTER_DRAIN = false;
    bf16* O;
    __device__ __forceinline__ void operator()(const f32x4 (&acc)[2][2][4][2], const pg8::Unit& u, int wr, int wc, int fr, int fq) const {
#pragma unroll
        for (int ai = 0; ai < 2; ++ai)
#pragma unroll
            for (int m = 0; m < 4; ++m) { const int row = u.pm * 256 + ai * 128 + wr * 64 + m * 16 + fr; const int col = u.pn * 128 + wc * 32 + 8 * fq;
                float r[8];
#pragma unroll
                for (int n = 0; n < 2; ++n)
#pragma unroll
                    for (int e = 0; e < 4; ++e) { const float g = acc[ai][0][m][n][e], up = acc[ai][1][m][n][e]; r[4 * n + e] = g * __builtin_amdgcn_rcpf(1.f + __expf(-g)) * up; }
                v4u w; w.x = pg8::cvt_pk_bf16(r[0], r[1]); w.y = pg8::cvt_pk_bf16(r[2], r[3]); w.z = pg8::cvt_pk_bf16(r[4], r[5]); w.w = pg8::cvt_pk_bf16(r[6], r[7]);
                *(v4u*)(O + (size_t)row * DFF + col) = w; }
    }
};
struct EpiResid {
    static constexpr bool PERM = false, AFTER_DRAIN = false;
    const float* bc; const float* bl; float* X; const float* mod; int gate_i;
    __device__ __forceinline__ void operator()(const f32x4 (&acc)[2][2][4][2], const pg8::Unit& u, int wr, int wc, int fr, int fq) const {
        const int cond = (u.pm < 32) ? 0 : ((u.pm < 40) ? 1 : 2);
        const float* gate = mod + cond * 6144 + gate_i * 1024;
        const float* base = (u.pm < 32) ? bc : bl - (size_t)TCX * D;
        const int col0 = u.pn * 256 + wc * 32 + 4 * fq;
        f32x4 gv[2][2];
#pragma unroll
        for (int bj = 0; bj < 2; ++bj)
#pragma unroll
            for (int n = 0; n < 2; ++n) gv[bj][n] = *(const f32x4*)(gate + col0 + bj * 128 + n * 16);
#pragma unroll
        for (int ai = 0; ai < 2; ++ai)
#pragma unroll
            for (int m = 0; m < 4; ++m) { const size_t off = (size_t)(u.pm * 256 + ai * 128 + wr * 64 + m * 16 + fr) * D + col0;
#pragma unroll
                for (int bj = 0; bj < 2; ++bj)
#pragma unroll
                    for (int n = 0; n < 2; ++n) { const f32x4 b = *(const f32x4*)(base + off + bj * 128 + n * 16); *(f32x4*)(X + off + bj * 128 + n * 16) = b + gv[bj][n] * acc[ai][bj][m][n]; } }
    }
};

#define KEY_STEP(kp, vp, biasv) do { \
    float s_ = 0.f; \
    _Pragma("unroll") for (int c_ = 0; c_ < 8; ++c_) { const v4u kv_ = *(const v4u*)((kp) + 8 * c_); \
        s_ += q[8 * c_ + 0] * bflo(kv_.x) + q[8 * c_ + 1] * bfhi(kv_.x) + q[8 * c_ + 2] * bflo(kv_.y) + q[8 * c_ + 3] * bfhi(kv_.y) \
            + q[8 * c_ + 4] * bflo(kv_.z) + q[8 * c_ + 5] * bfhi(kv_.z) + q[8 * c_ + 6] * bflo(kv_.w) + q[8 * c_ + 7] * bfhi(kv_.w); } \
    s_ = s_ * 0.125f + (biasv); \
    const float mn_ = fmaxf(m, s_), al_ = __expf(m - mn_), p_ = __expf(s_ - mn_); l = l * al_ + p_; m = mn_; \
    _Pragma("unroll") for (int c_ = 0; c_ < 8; ++c_) { const v4u vv_ = *(const v4u*)((vp) + 8 * c_); \
        o[8 * c_ + 0] = o[8 * c_ + 0] * al_ + p_ * bflo(vv_.x); o[8 * c_ + 1] = o[8 * c_ + 1] * al_ + p_ * bfhi(vv_.x); \
        o[8 * c_ + 2] = o[8 * c_ + 2] * al_ + p_ * bflo(vv_.y); o[8 * c_ + 3] = o[8 * c_ + 3] * al_ + p_ * bfhi(vv_.y); \
        o[8 * c_ + 4] = o[8 * c_ + 4] * al_ + p_ * bflo(vv_.z); o[8 * c_ + 5] = o[8 * c_ + 5] * al_ + p_ * bfhi(vv_.z); \
        o[8 * c_ + 6] = o[8 * c_ + 6] * al_ + p_ * bflo(vv_.w); o[8 * c_ + 7] = o[8 * c_ + 7] * al_ + p_ * bfhi(vv_.w); } } while (0)
#define LOAD_Q(qp) do { _Pragma("unroll") for (int c_ = 0; c_ < 8; ++c_) { const v4u qv_ = *(const v4u*)((qp) + 8 * c_); \
        q[8 * c_ + 0] = bflo(qv_.x); q[8 * c_ + 1] = bfhi(qv_.x); q[8 * c_ + 2] = bflo(qv_.y); q[8 * c_ + 3] = bfhi(qv_.y); \
        q[8 * c_ + 4] = bflo(qv_.z); q[8 * c_ + 5] = bfhi(qv_.z); q[8 * c_ + 6] = bflo(qv_.w); q[8 * c_ + 7] = bfhi(qv_.w); } } while (0)

__device__ __forceinline__ void attn_naive_phase(Frame& F) {
    const bf16* QKV = F.P; const float lam = *(const float*)((unsigned char*)F.MOD + MOD_LAM);
    float* DIFFO = F.S; const float* rpb = F.in[17];
    constexpr int ND = 32768, NC = 32768, NB = 65536, NA = 65536, NTASK = ND + NC + NB + NA;
    for (int task = F.bid * NTHR + F.tid; task < NTASK; task += F.G * NTHR) {
        float q[64], o[64]; float m, l;
        if (task < ND || (task >= ND + NC && task < ND + NC + NB)) {
            const bool lat = task < ND; int idx = lat ? task : task - ND - NC;
            int n, b, h, vh;
            if (lat) { n = idx & 2047; idx >>= 11; b = idx & 1; idx >>= 1; h = idx & 3; vh = idx >> 2; }
            else { n = idx & 255; idx >>= 8; b = idx & 31; idx >>= 5; h = idx & 3; vh = idx >> 2; }
            const int row = lat ? TCX + b * 2048 + n : b * 256 + n;
            const int krow0 = lat ? TCX + b * 2048 : b * 256, nk0 = lat ? 2048 : 256, krow1 = T + b * 256, nk1 = lat ? 256 : 0;
            const int vcol = 2560 + h * 128 + vh * 64;
            float o1[64];
#pragma unroll
            for (int c = 0; c < 2; ++c) {
                const int qcol = 1536 + h * 128 + c * 64, kcol = 2048 + h * 128 + c * 64;
                LOAD_Q(QKV + (size_t)row * QLD + qcol);
#pragma unroll
                for (int d = 0; d < 64; ++d) o[d] = 0.f;
                m = -INFINITY; l = 0.f;
                for (int j = 0; j < nk0; ++j) { const bf16* kr = QKV + (size_t)(krow0 + j) * QLD; KEY_STEP(kr + kcol, kr + vcol, 0.f); }
                for (int j = 0; j < nk1; ++j) { const bf16* kr = QKV + (size_t)(krow1 + j) * QLD; KEY_STEP(kr + kcol, kr + vcol, 0.f); }
                const float il = 1.f / l;
                if (c == 0) {
#pragma unroll
                    for (int d = 0; d < 64; ++d) o1[d] = o[d] * il;
                } else {
                    float* dst = DIFFO + (size_t)row * 512 + h * 128 + vh * 64;
#pragma unroll
                    for (int d = 0; d < 64; d += 4) *(f32x4*)(dst + d) = (f32x4){o1[d] - lam * o[d] * il, o1[d + 1] - lam * o[d + 1] * il, o1[d + 2] - lam * o[d + 2] * il, o1[d + 3] - lam * o[d + 3] * il};
                }
            }
        } else {
            const bool lat = task < ND + NC; int idx = lat ? task - ND : task - ND - NC - NB;
            int n, b, h;
            if (lat) { n = idx & 2047; idx >>= 11; b = idx & 1; h = idx >> 1; } else { n = idx & 255; idx >>= 8; b = idx & 31; h = idx >> 5; }
            const int row = lat ? TCX + b * 2048 + n : b * 256 + n;
            const int kcol = 512 + h * 64, vcol = 1024 + h * 64;
            LOAD_Q(QKV + (size_t)row * QLD + h * 64);
#pragma unroll
            for (int d = 0; d < 64; ++d) o[d] = 0.f;
            m = -INFINITY; l = 0.f;
            if (lat) {
                const int r = n >> 6, qc = n & 63; const int rs = min(max(r - 4, 0), 24), cs = min(max(qc - 8, 0), 48);
                for (int i = 0; i < 8; ++i) for (int cc = 0; cc < 16; ++cc) { const int kr_ = rs + i, kc = cs + cc;
                    const bf16* kr = QKV + (size_t)(TCX + b * 2048 + kr_ * 64 + kc) * QLD; const float bias = rpb[h * 465 + (kr_ - r + 7) * 31 + (kc - qc + 15)];
                    KEY_STEP(kr + kcol, kr + vcol, bias); }
                for (int j = 0; j < 256; ++j) { const bf16* kr = QKV + (size_t)(T + b * 256 + j) * QLD; KEY_STEP(kr + kcol, kr + vcol, 0.f); }
            } else {
                for (int j = 0; j < 256; ++j) { const bf16* kr = QKV + (size_t)(b * 256 + j) * QLD; KEY_STEP(kr + kcol, kr + vcol, 0.f); }
            }
            const float il = 1.f / l; bf16* dst = F.MIX + (size_t)row * D + h * 64;
#pragma unroll
            for (int d = 0; d < 64; d += 8) { v4u w; w.x = pk2(o[d] * il, o[d + 1] * il); w.y = pk2(o[d + 2] * il, o[d + 3] * il); w.z = pk2(o[d + 4] * il, o[d + 5] * il); w.w = pk2(o[d + 6] * il, o[d + 7] * il); *(v4u*)(dst + d) = w; }
        }
    }
}
__device__ __forceinline__ void diff_post_phase(Frame& F) {
    const int gw = F.bid * NWAVES + F.wave, NGW = F.G * NWAVES; const float* DIFFO = F.S;
    for (int it = gw; it < T * 4; it += NGW) { const int row = it >> 2, h = it & 3;
        const f32x2v v = *(const f32x2v*)(DIFFO + (size_t)row * 512 + h * 128 + 2 * F.lane);
        const float r = rsqrtf(wave_sum(v.x * v.x + v.y * v.y) * (1.f / 128.f) + 1e-6f) * 0.8f;
        *(unsigned*)(F.MIX + (size_t)row * D + 512 + h * 128 + 2 * F.lane) = pk2(v.x * r, v.y * r); }
}

typedef short bf16x8 __attribute__((ext_vector_type(8)));
typedef short s16x4 __attribute__((ext_vector_type(4)));
constexpr float LOG2E = 1.4426950408889634f;
__device__ __forceinline__ s16x4 tr_read(LAS unsigned char* p) { return __builtin_bit_cast(s16x4, __builtin_amdgcn_ds_read_tr16_b64_v4i16((LAS s16x4*)p)); }

template <int KIND>
__device__ __forceinline__ void attn_unit(Frame& F, int u) {
    constexpr bool DIFF = (KIND & 1) != 0;
    constexpr int DV = DIFF ? 128 : 64, NC = DV / 16, VSTR = DIFF ? 288 : 160, KSTR = 144;
    constexpr int K0_OFF = 0, K1_OFF = 9216, V_OFF = 18432, X_OFF = 40960, XSTR = 132, RPB_OFF = 110592;
    const int tid = F.tid, lane = F.lane, wave = F.wave, q16 = lane & 15, g = lane >> 4;
    LAS unsigned char* lds = F.lds;
    const bf16* QKV = F.P;
    int b, h, qrow0, ntiles, nW = 0, R0k = 0;
    if (KIND == 0) { b = u >> 3; h = u & 7; qrow0 = b * 256; ntiles = 4; }
    else if (KIND == 1) { const int half = u & 1; h = (u >> 1) & 3; b = u >> 3; qrow0 = b * 256 + half * 128; ntiles = 4; }
    else if (KIND == 2) { const int R = u & 7; h = (u >> 3) & 7; b = u >> 6; qrow0 = TCX + b * 2048 + R * 256; R0k = min(max(4 * R - 4, 0), 24); nW = min(max(4 * R - 1, 0), 24) + 8 - R0k; ntiles = nW + 4; }
    else { const int qb = u & 15; h = (u >> 4) & 3; b = u >> 6; qrow0 = TCX + b * 2048 + qb * 128; ntiles = 36; }
    const int sidx = DIFF ? (wave >> 2) : 0;
    const int wq = DIFF ? (wave & 3) * 32 : wave * 32;
    const int qcol = DIFF ? 1536 + h * 128 + sidx * 64 : h * 64;
    const int kcol0 = DIFF ? 2048 + h * 128 : 512 + h * 64;
    const int vcol = DIFF ? 2560 + h * 128 : 1024 + h * 64;
#define KROW(ti) ((KIND <= 1) ? (b * 256 + 64 * (ti)) : (KIND == 2) ? (((ti) < nW) ? (TCX + b * 2048 + (R0k + (ti)) * 64) : (T + b * 256 + 64 * ((ti) - nW))) : (((ti) < 32) ? (TCX + b * 2048 + 64 * (ti)) : (T + b * 256 + 64 * ((ti) - 32))))
    v4u rk0, rk1, rv0, rv1;
#define LOAD_TILE(ti) do { const bf16* rp_ = QKV + (size_t)(KROW(ti) + (tid >> 3)) * QLD + 8 * (tid & 7); rk0 = *(const v4u*)(rp_ + kcol0); rv0 = *(const v4u*)(rp_ + vcol); \
        if (DIFF) { rk1 = *(const v4u*)(rp_ + kcol0 + 64); rv1 = *(const v4u*)(rp_ + vcol + 64); } } while (0)
#define STORE_TILE() do { const int row_ = tid >> 3, ch_ = tid & 7; const int prow_ = (row_ & 39) | ((row_ & 8) << 1) | ((row_ & 16) >> 1); \
        *(LAS v4u*)(lds + K0_OFF + prow_ * KSTR + ch_ * 16) = rk0; *(LAS v4u*)(lds + V_OFF + row_ * VSTR + ch_ * 16) = rv0; \
        if (DIFF) { *(LAS v4u*)(lds + K1_OFF + prow_ * KSTR + ch_ * 16) = rk1; *(LAS v4u*)(lds + V_OFF + row_ * VSTR + 128 + ch_ * 16) = rv1; } } while (0)
    LAS float* rpbL = (LAS float*)(lds + RPB_OFF);
    if (KIND == 2) { __syncthreads(); if (tid < 465) rpbL[tid] = F.in[17][h * 465 + tid] * LOG2E; }
    bf16x8 qf[2][2];
#pragma unroll
    for (int grp = 0; grp < 2; ++grp)
#pragma unroll
        for (int kd = 0; kd < 2; ++kd) qf[grp][kd] = *(const bf16x8*)(QKV + (size_t)(qrow0 + wq + 16 * grp + q16) * QLD + qcol + 32 * kd + 8 * g);
    f32x4 o[2][NC];
#pragma unroll
    for (int grp = 0; grp < 2; ++grp)
#pragma unroll
        for (int c = 0; c < NC; ++c) o[grp][c] = (f32x4){0.f, 0.f, 0.f, 0.f};
    float mrun[2] = {-1e30f, -1e30f}, lsum[2] = {0.f, 0.f};
    const int wr_ = (KIND == 2) ? (((qrow0 - TCX) & 2047) >> 6) + (wave >> 1) : 0;
    const int wrs = min(max(wr_ - 4, 0), 24);
    const int koff = (DIFF && sidx) ? K1_OFF : K0_OFF;
    constexpr float C1 = 0.125f * LOG2E;
    LOAD_TILE(0);
    for (int ti = 0; ti < ntiles; ++ti) {
        __syncthreads();
        STORE_TILE();
        __syncthreads();
        if (ti + 1 < ntiles) LOAD_TILE(ti + 1);
        bool active = true; int krow_g = 0; bool win = false;
        if (KIND == 2) { win = ti < nW; krow_g = R0k + ti; active = (!win) || (krow_g >= wrs && krow_g < wrs + 8); }
        if (active) {
            f32x4 s[2][2][2];
#pragma unroll
            for (int ks = 0; ks < 2; ++ks)
#pragma unroll
                for (int t = 0; t < 2; ++t) {
                    s[0][ks][t] = (f32x4){0.f, 0.f, 0.f, 0.f}; s[1][ks][t] = (f32x4){0.f, 0.f, 0.f, 0.f};
#pragma unroll
                    for (int kd = 0; kd < 2; ++kd) { const bf16x8 kf = *(const LAS bf16x8*)(lds + koff + (32 * ks + 16 * t + q16) * KSTR + 64 * kd + 16 * g);
                        s[0][ks][t] = __builtin_amdgcn_mfma_f32_16x16x32_bf16(kf, qf[0][kd], s[0][ks][t], 0, 0, 0);
                        s[1][ks][t] = __builtin_amdgcn_mfma_f32_16x16x32_bf16(kf, qf[1][kd], s[1][ks][t], 0, 0, 0); }
                }
            bf16x8 pf[2][2];
#pragma unroll
            for (int grp = 0; grp < 2; ++grp) {
                float tv[2][2][4];
                if (KIND == 2 && win) {
                    const int qc = (wave & 1) * 32 + 16 * grp + q16, cs = min(max(qc - 8, 0), 48); const LAS float* brow = rpbL + (krow_g - wr_ + 7) * 31 + 15 - qc;
#pragma unroll
                    for (int ks = 0; ks < 2; ++ks)
#pragma unroll
                        for (int t = 0; t < 2; ++t)
#pragma unroll
                            for (int e = 0; e < 4; ++e) { const int kc = 32 * ks + 16 * (g >> 1) + 8 * t + 4 * (g & 1) + e; const bool ok = (unsigned)(kc - cs) < 16u;
                                tv[ks][t][e] = ok ? s[grp][ks][t][e] * C1 + brow[kc] : -1e30f; }
                } else {
#pragma unroll
                    for (int ks = 0; ks < 2; ++ks)
#pragma unroll
                        for (int t = 0; t < 2; ++t)
#pragma unroll
                            for (int e = 0; e < 4; ++e) tv[ks][t][e] = s[grp][ks][t][e] * C1;
                }
                float tmax = -1e30f;
#pragma unroll
                for (int ks = 0; ks < 2; ++ks)
#pragma unroll
                    for (int t = 0; t < 2; ++t)
#pragma unroll
                        for (int e = 0; e < 4; ++e) tmax = fmaxf(tmax, tv[ks][t][e]);
                tmax = fmaxf(tmax, __shfl_xor(tmax, 16)); tmax = fmaxf(tmax, __shfl_xor(tmax, 32));
                const float mn = fmaxf(mrun[grp], tmax), al = __builtin_amdgcn_exp2f(mrun[grp] - mn); mrun[grp] = mn;
                float ps = 0.f;
#pragma unroll
                for (int ks = 0; ks < 2; ++ks) {
                    float p[8];
#pragma unroll
                    for (int t = 0; t < 2; ++t)
#pragma unroll
                        for (int e = 0; e < 4; ++e) { p[4 * t + e] = __builtin_amdgcn_exp2f(tv[ks][t][e] - mn); ps += p[4 * t + e]; }
                    v4u w; w.x = pg8::cvt_pk_bf16(p[0], p[1]); w.y = pg8::cvt_pk_bf16(p[2], p[3]); w.z = pg8::cvt_pk_bf16(p[4], p[5]); w.w = pg8::cvt_pk_bf16(p[6], p[7]);
                    pf[grp][ks] = __builtin_bit_cast(bf16x8, w);
                }
                lsum[grp] = lsum[grp] * al + ps;
#pragma unroll
                for (int c = 0; c < NC; ++c) o[grp][c] = o[grp][c] * al;
            }
#pragma unroll
            for (int ks = 0; ks < 2; ++ks)
#pragma unroll
                for (int c = 0; c < NC; ++c) {
                    LAS unsigned char* vb = lds + V_OFF + (32 * ks + 16 * (g >> 1) + 4 * (g & 1) + (q16 >> 2)) * VSTR + (16 * c + 4 * (lane & 3)) * 2;
                    const s16x4 v0 = tr_read(vb), v1 = tr_read(vb + 8 * VSTR);
                    const bf16x8 vf = (bf16x8){v0[0], v0[1], v0[2], v0[3], v1[0], v1[1], v1[2], v1[3]};
                    o[0][c] = __builtin_amdgcn_mfma_f32_16x16x32_bf16(vf, pf[0][ks], o[0][c], 0, 0, 0);
                    o[1][c] = __builtin_amdgcn_mfma_f32_16x16x32_bf16(vf, pf[1][ks], o[1][c], 0, 0, 0);
                }
        }
    }
    float inv[2];
#pragma unroll
    for (int grp = 0; grp < 2; ++grp) { float l = lsum[grp]; l += __shfl_xor(l, 16); l += __shfl_xor(l, 32); inv[grp] = 1.f / l; }
    if (!DIFF) {
#pragma unroll
        for (int grp = 0; grp < 2; ++grp) { bf16* dst = F.MIX + (size_t)(qrow0 + wq + 16 * grp + q16) * D + h * 64 + 4 * g;
#pragma unroll
            for (int c = 0; c < NC; ++c) { const f32x4 v = o[grp][c] * inv[grp]; v2u w; w.x = pg8::cvt_pk_bf16(v[0], v[1]); w.y = pg8::cvt_pk_bf16(v[2], v[3]); *(v2u*)(dst + 16 * c) = w; } }
    } else {
        const float lam = *(const float*)((unsigned char*)F.MOD + MOD_LAM);
        LAS float* X = (LAS float*)(lds + X_OFF);
        if (sidx == 1) {
#pragma unroll
            for (int grp = 0; grp < 2; ++grp)
#pragma unroll
                for (int c = 0; c < NC; ++c) *(LAS f32x4*)(X + (wq + 16 * grp + q16) * XSTR + 16 * c + 4 * g) = o[grp][c] * inv[grp];
        }
        __syncthreads();
        if (sidx == 0) {
#pragma unroll
            for (int grp = 0; grp < 2; ++grp) {
                float ss = 0.f;
#pragma unroll
                for (int c = 0; c < NC; ++c) { const f32x4 x2 = *(const LAS f32x4*)(X + (wq + 16 * grp + q16) * XSTR + 16 * c + 4 * g); o[grp][c] = o[grp][c] * inv[grp] - x2 * lam;
                    ss += (o[grp][c][0] * o[grp][c][0] + o[grp][c][1] * o[grp][c][1]) + (o[grp][c][2] * o[grp][c][2] + o[grp][c][3] * o[grp][c][3]); }
                ss += __shfl_xor(ss, 16); ss += __shfl_xor(ss, 32);
                const float r = rsqrtf(ss * (1.f / 128.f) + 1e-6f) * 0.8f;
                bf16* dst = F.MIX + (size_t)(qrow0 + wq + 16 * grp + q16) * D + 512 + h * 128 + 4 * g;
#pragma unroll
                for (int c = 0; c < NC; ++c) { const f32x4 v = o[grp][c] * r; v2u w; w.x = pg8::cvt_pk_bf16(v[0], v[1]); w.y = pg8::cvt_pk_bf16(v[2], v[3]); *(v2u*)(dst + 16 * c) = w; }
            }
        }
    }
#undef KROW
#undef LOAD_TILE
#undef STORE_TILE
}
__device__ __forceinline__ void attn_mfma_phase(Frame& F) {
    if (F.G == 256) {
        if (F.bid < 128) attn_unit<3>(F, F.bid);
        else { const int i = F.bid - 128; attn_unit<2>(F, i); attn_unit<1>(F, 2 * i); attn_unit<1>(F, 2 * i + 1); attn_unit<0>(F, 2 * i); attn_unit<0>(F, 2 * i + 1); }
    } else {
        for (int i = F.bid; i < 768; i += F.G) { if (i < 128) attn_unit<3>(F, i); else if (i < 256) attn_unit<2>(F, i - 128); else if (i < 512) attn_unit<1>(F, i - 256); else attn_unit<0>(F, i - 512); }
    }
}

__device__ __forceinline__ void rwkv_job(Frame& F, int seq, int h, int dir) {
    LAS float* L = (LAS float*)F.lds;
    LAS float *WUP = L, *AUP = L + 4096, *Lr = L + 8192, *Lk = Lr + 1024, *Lv = Lk + 1024, *Lwd = Lv + 1024, *Lad = Lwd + 1024, *Lw = Lad + 1024, *La = Lw + 1024, *Lkk = La + 1024, *Lkef = Lkk + 1024, *Lb = Lkef + 1024, *Ly = Lb + 1024;
    const int tid = F.tid, lane = F.lane, w = F.wave;
    const bool lat = seq >= 32; const int b = lat ? seq - 32 : seq, N = lat ? 2048 : 256, R0 = lat ? TCX + b * 2048 : b * 256;
    const bf16* PROJ = F.P; float* Y = F.S;
    __syncthreads();
    for (int idx = tid; idx < 4096; idx += NTHR) { const int j = idx >> 6, k = idx & 63; WUP[idx] = F.in[26][(size_t)(dir * 64 + j) * 512 + h * 64 + k]; AUP[idx] = F.in[28][(size_t)(dir * 64 + j) * 512 + h * 64 + k]; }
    const int i = 8 * w + (lane >> 3), s = lane & 7;
    float S[8];
    {
        const float* st = F.in[7] + (size_t)((b * 2 + dir) * 8 + h) * 4096 + i * 64 + 8 * s;
#pragma unroll
        for (int kk = 0; kk < 8; ++kk) S[kk] = lat ? st[kk] : 0.f;
    }
    for (int t0 = 0; t0 < N; t0 += 16) {
#pragma unroll
        for (int rep = 0; rep < 2; ++rep) { const int idx = tid + NTHR * rep, j = idx >> 6, k = idx & 63; const int n = dir ? N - 1 - (t0 + j) : t0 + j;
            const bf16* pr = PROJ + (size_t)(R0 + n) * NREC;
            Lr[idx] = bf1(pr[2048 + h * 64 + k]); Lk[idx] = bf1(pr[2560 + h * 64 + k]); Lv[idx] = bf1(pr[3072 + h * 64 + k]); Lwd[idx] = tanhf(bf1(pr[3584 + k])); Lad[idx] = bf1(pr[3648 + k]); }
        __syncthreads();
#pragma unroll
        for (int rep = 0; rep < 2; ++rep) { const int idx = tid + NTHR * rep, j = idx >> 6, k = idx & 63;
            float zw = F.in[25][dir * 512 + h * 64 + k], za = F.in[27][dir * 512 + h * 64 + k];
#pragma unroll 8
            for (int jj = 0; jj < 64; ++jj) { zw += Lwd[j * 64 + jj] * WUP[jj * 64 + k]; za += Lad[j * 64 + jj] * AUP[jj * 64 + k]; }
            Lw[idx] = __expf(-0.6065306597f * sigmoidf_(zw)); La[idx] = sigmoidf_(za); }
        if (tid < 256) { const int j = tid >> 4, p = tid & 15; float v[4]; float ss = 0.f;
#pragma unroll
            for (int e = 0; e < 4; ++e) { v[e] = Lk[j * 64 + 4 * p + e] * F.in[30][h * 64 + 4 * p + e]; ss += v[e] * v[e]; }
            ss += __shfl_xor(ss, 1); ss += __shfl_xor(ss, 2); ss += __shfl_xor(ss, 4); ss += __shfl_xor(ss, 8);
            const float rs = rsqrtf(ss + 1e-12f);
#pragma unroll
            for (int e = 0; e < 4; ++e) Lkk[j * 64 + 4 * p + e] = v[e] * rs; }
        __syncthreads();
#pragma unroll
        for (int rep = 0; rep < 2; ++rep) { const int idx = tid + NTHR * rep, k = idx & 63; const float a = La[idx];
            Lkef[idx] = Lk[idx] * (1.f + (a - 1.f) * F.in[31][h * 64 + k]); Lb[idx] = Lkk[idx] * a; }
        __syncthreads();
        for (int j = 0; j < 16; ++j) {
            const int o8 = j * 64 + 8 * s;
            float sa = 0.f;
#pragma unroll
            for (int kk = 0; kk < 8; ++kk) sa -= S[kk] * Lkk[o8 + kk];
            sa += __shfl_xor(sa, 1); sa += __shfl_xor(sa, 2); sa += __shfl_xor(sa, 4);
            const float vi = Lv[j * 64 + i];
            float y = 0.f;
#pragma unroll
            for (int kk = 0; kk < 8; ++kk) { S[kk] = S[kk] * Lw[o8 + kk] + sa * Lb[o8 + kk] + vi * Lkef[o8 + kk]; y += S[kk] * Lr[o8 + kk]; }
            y += __shfl_xor(y, 1); y += __shfl_xor(y, 2); y += __shfl_xor(y, 4);
            if (s == 0) Ly[j * 64 + i] = y;
        }
        __syncthreads();
#pragma unroll
        for (int rep = 0; rep < 2; ++rep) { const int idx = tid + NTHR * rep, j = idx >> 6, k = idx & 63; const int n = dir ? N - 1 - (t0 + j) : t0 + j;
            atomicAdd(Y + (size_t)(R0 + n) * 512 + h * 64 + k, Ly[idx]); }
    }
    if (!lat) { float* so = F.out + O_SRW + (size_t)((b * 2 + dir) * 8 + h) * 4096 + i * 64 + 8 * s;
#pragma unroll
        for (int kk = 0; kk < 8; ++kk) so[kk] = S[kk]; }
}
__device__ __forceinline__ void ret_job(Frame& F, int seq, int h, int dir) {
    LAS float* L = (LAS float*)F.lds;
    LAS float *Lq = L, *Lk = L + 1024, *Lv = L + 2048, *Lo = L + 3072;
    const int tid = F.tid, lane = F.lane, w = F.wave;
    const bool lat = seq >= 32; const int b = lat ? seq - 32 : seq, N = lat ? 2048 : 256, R0 = lat ? TCX + b * 2048 : b * 256;
    const bf16* PROJ = F.P; float* O = F.S + (size_t)T * 512;
    const float g = sigmoidf_(F.in[24][dir * 8 + h]);
    const int e = 8 * w + (lane >> 3), s = lane & 7;
    float S[8];
    {
        const float* st = F.in[6] + (size_t)((b * 2 + dir) * 8 + h) * 4096;
#pragma unroll
        for (int dd = 0; dd < 8; ++dd) S[dd] = lat ? st[(8 * s + dd) * 64 + e] : 0.f;
    }
    __syncthreads();
    for (int t0 = 0; t0 < N; t0 += 16) {
#pragma unroll
        for (int rep = 0; rep < 2; ++rep) { const int idx = tid + NTHR * rep, j = idx >> 6, k = idx & 63; const int n = dir ? N - 1 - (t0 + j) : t0 + j;
            const bf16* pr = PROJ + (size_t)(R0 + n) * NREC;
            Lq[idx] = bf1(pr[h * 64 + k]); Lk[idx] = bf1(pr[512 + h * 64 + k]) * 0.125f; Lv[idx] = bf1(pr[1024 + h * 64 + k]); }
        __syncthreads();
        for (int j = 0; j < 16; ++j) {
            const int o8 = j * 64 + 8 * s; const float ve = Lv[j * 64 + e];
            float o = 0.f;
#pragma unroll
            for (int dd = 0; dd < 8; ++dd) { S[dd] = g * S[dd] + Lk[o8 + dd] * ve; o += Lq[o8 + dd] * S[dd]; }
            o += __shfl_xor(o, 1); o += __shfl_xor(o, 2); o += __shfl_xor(o, 4);
            if (s == 0) Lo[j * 64 + e] = o;
        }
        __syncthreads();
#pragma unroll
        for (int rep = 0; rep < 2; ++rep) { const int idx = tid + NTHR * rep, j = idx >> 6, k = idx & 63; const int n = dir ? N - 1 - (t0 + j) : t0 + j;
            atomicAdd(O + (size_t)(R0 + n) * 512 + h * 64 + k, Lo[idx]); }
        __syncthreads();
    }
    if (!lat) { float* so = F.out + O_SRET + (size_t)((b * 2 + dir) * 8 + h) * 4096;
#pragma unroll
        for (int dd = 0; dd < 8; ++dd) so[(8 * s + dd) * 64 + e] = S[dd]; }
}
__device__ __forceinline__ void run_job(Frame& F, int J) {
    int type, seq, h, dir;
    if (J < 64) { type = J >> 5; const int r = J & 31; seq = 32 + (r >> 4); h = (r >> 1) & 7; dir = r & 1; }
    else { const int r = J - 64; type = r >> 9; const int q = r & 511; seq = q >> 4; h = (q >> 1) & 7; dir = q & 1; }
    if (type == 0) rwkv_job(F, seq, h, dir); else ret_job(F, seq, h, dir);
}
__device__ __forceinline__ void scan_phase(Frame& F) {
    if (F.G > 128) { if (F.bid < 64) run_job(F, F.bid); else for (int J = 64 + (F.bid - 64); J < 1088; J += F.G - 64) run_job(F, J); }
    else for (int J = F.bid; J < 1088; J += F.G) run_job(F, J);
}
__device__ __forceinline__ void rec_post_phase(Frame& F) {
    LAS float* sg = (LAS float*)F.lds + F.wave * 128;
    const int gw = F.bid * NWAVES + F.wave, NGW = F.G * NWAVES, lane = F.lane;
    const bf16* PROJ = F.P; const float* Y = F.S; const float* O = F.S + (size_t)T * 512;
    for (int row = gw; row < T; row += NGW) {
        const bf16* pr = PROJ + (size_t)row * NREC;
        sg[lane] = sigmoidf_(bf1(pr[3712 + lane])); sg[64 + lane] = sigmoidf_(bf1(pr[3776 + lane]));
        asm volatile("s_waitcnt lgkmcnt(0)" ::: "memory");
        for (int h = 0; h < 8; ++h) {
            const int c = h * 64 + lane;
            const float y = Y[(size_t)row * 512 + c];
            const float mu = wave_sum(y) * (1.f / 64.f), dl = y - mu, var = wave_sum(dl * dl) * (1.f / 64.f);
            const float yn = dl * rsqrtf(var + 64e-5f) * F.in[33][c] + F.in[34][c];
            const float r = bf1(pr[2048 + c]), k = bf1(pr[2560 + c]), v = bf1(pr[3072 + c]);
            const float bonus = wave_sum(r * F.in[32][c] * k) * v;
            float g = 0.f;
#pragma unroll 8
            for (int j = 0; j < 128; ++j) g += sg[j] * F.in[29][(size_t)j * 512 + c];
            F.MIX[(size_t)row * D + 512 + c] = (bf16)f2bf((yn + bonus) * g);
        }
        for (int h = 0; h < 8; ++h) {
            const int c = h * 64 + lane;
            const float o = O[(size_t)row * 512 + c];
            const float on = o * rsqrtf(wave_sum(o * o) * (1.f / 64.f) + 1e-6f);
            const float xg = bf1(pr[1536 + c]);
            F.MIX[(size_t)row * D + c] = (bf16)f2bf(xg * sigmoidf_(xg) * on);
        }
        asm volatile("s_waitcnt lgkmcnt(0)" ::: "memory");
    }
}

#define DPP_F(v, ctrl) __int_as_float(__builtin_amdgcn_mov_dpp(__float_as_int(v), (ctrl), 0xf, 0xf, true))
template <int NSL> __device__ __forceinline__ float row_reduce(float v) {
    v += DPP_F(v, 0xB1); v += DPP_F(v, 0x4E); v += DPP_F(v, 0x141); if (NSL == 16) v += DPP_F(v, 0x140); return v;
}
__device__ __forceinline__ void unpack8(const v4u r, float (&f)[8]) { f[0] = bflo(r.x); f[1] = bfhi(r.x); f[2] = bflo(r.y); f[3] = bfhi(r.y); f[4] = bflo(r.z); f[5] = bfhi(r.z); f[6] = bflo(r.w); f[7] = bfhi(r.w); }
__device__ __forceinline__ v4u pack8(const float (&f)[8]) { v4u w; w.x = pg8::cvt_pk_bf16(f[0], f[1]); w.y = pg8::cvt_pk_bf16(f[2], f[3]); w.z = pg8::cvt_pk_bf16(f[4], f[5]); w.w = pg8::cvt_pk_bf16(f[6], f[7]); return w; }

template <int NSL>
__device__ __forceinline__ void rwkv_job2(Frame& F, int seq, int h, int dir, int row0) {
    constexpr int KPT = 64 / NSL, ROWS = 512 / NSL, TCH = 32;
    constexpr int WUPT = 0, AUPT = 9216, TWO = 18432, TAO = 23040, F0 = 27648;
    LAS unsigned char* lds = F.lds;
    LAS float *Lr = (LAS float*)(lds + F0), *Lk = Lr + 2048, *Lv = Lk + 2048, *Lw = Lv + 2048, *La = Lw + 2048, *Lnk = La + 2048, *Lkef = Lnk + 2048, *Lb = Lkef + 2048, *Ly = Lb + 2048;
    const int tid = F.tid, lane = F.lane, wave = F.wave, q16 = lane & 15, g = lane >> 4;
    const bool lat = seq >= 32; const int b = lat ? seq - 32 : seq, N = lat ? 2048 : 256, R0 = lat ? TCX + b * 2048 : b * 256;
    const bf16* PROJ = F.P; float* Y = F.S;
    __syncthreads();
    for (int idx = tid; idx < 4096; idx += NTHR) { const int j = idx >> 6, k = idx & 63;
        *(LAS bf16*)(lds + WUPT + k * 144 + j * 2) = (bf16)f2bf(F.in[26][(size_t)(dir * 64 + j) * 512 + h * 64 + k]);
        *(LAS bf16*)(lds + AUPT + k * 144 + j * 2) = (bf16)f2bf(F.in[28][(size_t)(dir * 64 + j) * 512 + h * 64 + k]); }
    const int rowl = tid / NSL, sl = tid % NSL, irow = row0 + rowl;
    float S[KPT];
    {
        const float* st = F.in[7] + (size_t)((b * 2 + dir) * 8 + h) * 4096 + irow * 64 + KPT * sl;
#pragma unroll
        for (int kk = 0; kk < KPT; ++kk) S[kk] = lat ? st[kk] : 0.f;
    }
    const int ep = tid & 15, etok = tid >> 4;
    f32x4 ckk, cka;
#pragma unroll
    for (int e = 0; e < 4; ++e) { ckk[e] = F.in[30][h * 64 + 4 * ep + e]; cka[e] = F.in[31][h * 64 + 4 * ep + e]; }
    const int mat = wave >> 2, ct = wave & 3;
    const float zbias = (mat ? F.in[27] : F.in[25])[dir * 512 + h * 64 + 16 * ct + q16];
    for (int t0 = 0; t0 < N; t0 += TCH) {
        for (int idx = tid; idx < 1280; idx += NTHR) { const int tok = idx / 40, rem = idx - tok * 40, seg = rem >> 3, ch = rem & 7; const int n = dir ? N - 1 - (t0 + tok) : t0 + tok;
            const int col = (seg == 0) ? 2048 + h * 64 : (seg == 1) ? 2560 + h * 64 : (seg == 2) ? 3072 + h * 64 : (seg == 3) ? 3584 : 3648;
            const v4u raw = *(const v4u*)(PROJ + (size_t)(R0 + n) * NREC + col + 8 * ch);
            if (seg < 3) { float f[8]; unpack8(raw, f); LAS float* dst = ((seg == 0) ? Lr : (seg == 1) ? Lk : Lv) + tok * 64 + 8 * ch; *(LAS f32x4*)dst = (f32x4){f[0], f[1], f[2], f[3]}; *(LAS f32x4*)(dst + 4) = (f32x4){f[4], f[5], f[6], f[7]}; }
            else if (seg == 3) { float f[8]; unpack8(raw, f);
#pragma unroll
                for (int e = 0; e < 8; ++e) f[e] = 1.f - 2.f / (1.f + __expf(2.f * f[e]));
                *(LAS v4u*)(lds + TWO + tok * 144 + ch * 16) = pack8(f); }
            else *(LAS v4u*)(lds + TAO + tok * 144 + ch * 16) = raw; }
        __syncthreads();
        {
            f32x4 z[2] = {(f32x4){0.f, 0.f, 0.f, 0.f}, (f32x4){0.f, 0.f, 0.f, 0.f}};
#pragma unroll
            for (int kd = 0; kd < 2; ++kd) { const bf16x8 bfr = *(const LAS bf16x8*)(lds + (mat ? AUPT : WUPT) + (16 * ct + q16) * 144 + 64 * kd + 16 * g);
#pragma unroll
                for (int rt = 0; rt < 2; ++rt) { const bf16x8 afr = *(const LAS bf16x8*)(lds + (mat ? TAO : TWO) + (16 * rt + q16) * 144 + 64 * kd + 16 * g);
                    z[rt] = __builtin_amdgcn_mfma_f32_16x16x32_bf16(afr, bfr, z[rt], 0, 0, 0); } }
#pragma unroll
            for (int rt = 0; rt < 2; ++rt)
#pragma unroll
                for (int e = 0; e < 4; ++e) { const int tok = 16 * rt + 4 * g + e; const float sg = sigmoidf_(z[rt][e] + zbias);
                    if (mat) La[tok * 64 + 16 * ct + q16] = sg; else Lw[tok * 64 + 16 * ct + q16] = __expf(-0.6065306597f * sg); }
        }
        __syncthreads();
        {
            const f32x4 kv = *(const LAS f32x4*)(Lk + etok * 64 + 4 * ep), av = *(const LAS f32x4*)(La + etok * 64 + 4 * ep);
            const f32x4 kr = kv * ckk; float ss = (kr[0] * kr[0] + kr[1] * kr[1]) + (kr[2] * kr[2] + kr[3] * kr[3]);
            ss = row_reduce<16>(ss);
            const float rs = rsqrtf(ss + 1e-12f);
            const f32x4 kkv = kr * rs;
            *(LAS f32x4*)(Lnk + etok * 64 + 4 * ep) = -kkv;
            *(LAS f32x4*)(Lb + etok * 64 + 4 * ep) = kkv * av;
            *(LAS f32x4*)(Lkef + etok * 64 + 4 * ep) = kv * (1.f + (av - 1.f) * cka);
        }
        __syncthreads();
#pragma unroll 2
        for (int j = 0; j < TCH; ++j) {
            const int o8 = j * 64 + KPT * sl;
            float nk[KPT], wv[KPT], bv[KPT], ke[KPT], rv[KPT];
#pragma unroll
            for (int q4 = 0; q4 < KPT; q4 += 4) { const f32x4 a0 = *(const LAS f32x4*)(Lnk + o8 + q4), a1 = *(const LAS f32x4*)(Lw + o8 + q4), a2 = *(const LAS f32x4*)(Lb + o8 + q4), a3 = *(const LAS f32x4*)(Lkef + o8 + q4), a4 = *(const LAS f32x4*)(Lr + o8 + q4);
#pragma unroll
                for (int e = 0; e < 4; ++e) { nk[q4 + e] = a0[e]; wv[q4 + e] = a1[e]; bv[q4 + e] = a2[e]; ke[q4 + e] = a3[e]; rv[q4 + e] = a4[e]; } }
            const float vi = Lv[j * 64 + irow];
            float sa = 0.f;
#pragma unroll
            for (int kk = 0; kk < KPT; ++kk) sa += S[kk] * nk[kk];
            sa = row_reduce<NSL>(sa);
            float y = 0.f;
#pragma unroll
            for (int kk = 0; kk < KPT; ++kk) { S[kk] = S[kk] * wv[kk] + (sa * bv[kk] + vi * ke[kk]); y += S[kk] * rv[kk]; }
            y = row_reduce<NSL>(y);
            if (sl == 0) Ly[j * 64 + rowl] = y;
        }
        __syncthreads();
        for (int idx = tid; idx < TCH * ROWS; idx += NTHR) { const int tok = idx / ROWS, i = idx % ROWS; const int n = dir ? N - 1 - (t0 + tok) : t0 + tok;
            atomicAdd(Y + (size_t)(R0 + n) * 512 + h * 64 + row0 + i, Ly[tok * 64 + i]); }
    }
    if (!lat) { float* so = F.out + O_SRW + (size_t)((b * 2 + dir) * 8 + h) * 4096 + irow * 64 + KPT * sl;
#pragma unroll
        for (int kk = 0; kk < KPT; ++kk) so[kk] = S[kk]; }
}

__device__ __forceinline__ void ret_job2(Frame& F, int seq, int h, int dir) {
    constexpr int KP = 0, VT = 9216, KW = 19456, SB = 29696, DM = 39936, KSTR = 144, VSTR = 160;
    LAS unsigned char* lds = F.lds;
    LAS float* dm = (LAS float*)(lds + DM);
    const int tid = F.tid, lane = F.lane, wave = F.wave, q16 = lane & 15, g = lane >> 4;
    const bool lat = seq >= 32; const int b = lat ? seq - 32 : seq, N = lat ? 2048 : 256, R0 = lat ? TCX + b * 2048 : b * 256;
    const bf16* PROJ = F.P; bf16* OD = (bf16*)F.S + (size_t)(2 + dir) * T * 512;
    const float lg2 = log2f(sigmoidf_(F.in[24][dir * 8 + h]));
    __syncthreads();
    if (tid < 65) dm[tid] = exp2f(lg2 * (float)tid);
    const float gC = exp2f(lg2 * 64.f);
    const int cd = wave >> 1, ce0 = 2 * (wave & 1);
    f32x4 Sreg[2];
#pragma unroll
    for (int c2 = 0; c2 < 2; ++c2)
#pragma unroll
        for (int e = 0; e < 4; ++e) { const int d_ = 16 * cd + 4 * g + e, e_ = 16 * (ce0 + c2) + q16;
            Sreg[c2][e] = lat ? F.in[6][(size_t)((b * 2 + dir) * 8 + h) * 4096 + d_ * 64 + e_] : 0.f;
            *(LAS bf16*)(lds + SB + d_ * VSTR + e_ * 2) = (bf16)f2bf(Sreg[c2][e]); }
    const int qg = wave & 3, eh = wave >> 2, iq = 16 * qg + q16;
    const int srow = tid >> 3, sch = tid & 7, sprow = (srow & 39) | ((srow & 8) << 1) | ((srow & 16) >> 1);
    for (int t0 = 0; t0 < N; t0 += 64) {
        {
            const int n = dir ? N - 1 - (t0 + srow) : t0 + srow; const bf16* rp = PROJ + (size_t)(R0 + n) * NREC + h * 64 + 8 * sch;
            const v4u rk = *(const v4u*)(rp + 512), rv = *(const v4u*)(rp + 1024);
            *(LAS v4u*)(lds + KP + sprow * KSTR + sch * 16) = rk; *(LAS v4u*)(lds + VT + srow * VSTR + sch * 16) = rv;
            float f[8]; unpack8(rk, f); const float wsc = 0.125f * exp2f(lg2 * (float)(63 - srow));
#pragma unroll
            for (int e = 0; e < 8; ++e) f[e] *= wsc;
            *(LAS v4u*)(lds + KW + srow * VSTR + sch * 16) = pack8(f);
        }
        bf16x8 qf[2], qs[2];
        {
            const int n = dir ? N - 1 - (t0 + iq) : t0 + iq; const bf16* qp = PROJ + (size_t)(R0 + n) * NREC + h * 64 + 8 * g; const float sc = exp2f(lg2 * (float)(iq + 1));
#pragma unroll
            for (int kd = 0; kd < 2; ++kd) { const v4u raw = *(const v4u*)(qp + 32 * kd); qf[kd] = __builtin_bit_cast(bf16x8, raw); float f[8]; unpack8(raw, f);
#pragma unroll
                for (int e = 0; e < 8; ++e) f[e] *= sc;
                qs[kd] = __builtin_bit_cast(bf16x8, pack8(f)); }
        }
        __syncthreads();
        bf16x8 pf[2];
#pragma unroll
        for (int ks = 0; ks < 2; ++ks) {
            float p[8];
#pragma unroll
            for (int t = 0; t < 2; ++t) { f32x4 s = (f32x4){0.f, 0.f, 0.f, 0.f};
#pragma unroll
                for (int kd = 0; kd < 2; ++kd) { const bf16x8 kf = *(const LAS bf16x8*)(lds + KP + (32 * ks + 16 * t + q16) * KSTR + 64 * kd + 16 * g); s = __builtin_amdgcn_mfma_f32_16x16x32_bf16(kf, qf[kd], s, 0, 0, 0); }
#pragma unroll
                for (int e = 0; e < 4; ++e) { const int j = 32 * ks + 16 * (g >> 1) + 8 * t + 4 * (g & 1) + e; const int dlt = iq - j; p[4 * t + e] = (dlt >= 0) ? s[e] * 0.125f * dm[dlt & 63] : 0.f; } }
            pf[ks] = __builtin_bit_cast(bf16x8, pack8(p));
        }
        f32x4 o[2] = {(f32x4){0.f, 0.f, 0.f, 0.f}, (f32x4){0.f, 0.f, 0.f, 0.f}};
#pragma unroll
        for (int c2 = 0; c2 < 2; ++c2) { const int c = 2 * eh + c2;
#pragma unroll
            for (int ks = 0; ks < 2; ++ks) { LAS unsigned char* vb = lds + VT + (32 * ks + 16 * (g >> 1) + 4 * (g & 1) + (q16 >> 2)) * VSTR + (16 * c + 4 * (lane & 3)) * 2;
                const s16x4 v0 = tr_read(vb), v1 = tr_read(vb + 8 * VSTR); const bf16x8 vf = (bf16x8){v0[0], v0[1], v0[2], v0[3], v1[0], v1[1], v1[2], v1[3]};
                o[c2] = __builtin_amdgcn_mfma_f32_16x16x32_bf16(vf, pf[ks], o[c2], 0, 0, 0); }
#pragma unroll
            for (int kd = 0; kd < 2; ++kd) { LAS unsigned char* sb = lds + SB + (32 * kd + 8 * g + (q16 >> 2)) * VSTR + (16 * c + 4 * (lane & 3)) * 2;
                const s16x4 v0 = tr_read(sb), v1 = tr_read(sb + 4 * VSTR); const bf16x8 sf = (bf16x8){v0[0], v0[1], v0[2], v0[3], v1[0], v1[1], v1[2], v1[3]};
                o[c2] = __builtin_amdgcn_mfma_f32_16x16x32_bf16(sf, qs[kd], o[c2], 0, 0, 0); }
        }
        {
            const int n = dir ? N - 1 - (t0 + iq) : t0 + iq; bf16* op = OD + (size_t)(R0 + n) * 512 + h * 64 + 4 * g;
#pragma unroll
            for (int c2 = 0; c2 < 2; ++c2) { v2u w; w.x = pg8::cvt_pk_bf16(o[c2][0], o[c2][1]); w.y = pg8::cvt_pk_bf16(o[c2][2], o[c2][3]); *(v2u*)(op + 16 * (2 * eh + c2)) = w; }
        }
        f32x4 U[2] = {(f32x4){0.f, 0.f, 0.f, 0.f}, (f32x4){0.f, 0.f, 0.f, 0.f}};
#pragma unroll
        for (int ks = 0; ks < 2; ++ks) { LAS unsigned char* ka = lds + KW + (32 * ks + 8 * g + (q16 >> 2)) * VSTR + (16 * cd + 4 * (lane & 3)) * 2;
            const s16x4 a0 = tr_read(ka), a1 = tr_read(ka + 4 * VSTR); const bf16x8 af = (bf16x8){a0[0], a0[1], a0[2], a0[3], a1[0], a1[1], a1[2], a1[3]};
#pragma unroll
            for (int c2 = 0; c2 < 2; ++c2) { LAS unsigned char* vb = lds + VT + (32 * ks + 8 * g + (q16 >> 2)) * VSTR + (16 * (ce0 + c2) + 4 * (lane & 3)) * 2;
                const s16x4 b0 = tr_read(vb), b1 = tr_read(vb + 4 * VSTR); const bf16x8 bfr = (bf16x8){b0[0], b0[1], b0[2], b0[3], b1[0], b1[1], b1[2], b1[3]};
                U[c2] = __builtin_amdgcn_mfma_f32_16x16x32_bf16(af, bfr, U[c2], 0, 0, 0); } }
        __syncthreads();
#pragma unroll
        for (int c2 = 0; c2 < 2; ++c2)
#pragma unroll
            for (int e = 0; e < 4; ++e) { Sreg[c2][e] = gC * Sreg[c2][e] + U[c2][e];
                *(LAS bf16*)(lds + SB + (16 * cd + 4 * g + e) * VSTR + (16 * (ce0 + c2) + q16) * 2) = (bf16)f2bf(Sreg[c2][e]); }
    }
    if (!lat) {
#pragma unroll
        for (int c2 = 0; c2 < 2; ++c2)
#pragma unroll
            for (int e = 0; e < 4; ++e) F.out[O_SRET + (size_t)((b * 2 + dir) * 8 + h) * 4096 + (16 * cd + 4 * g + e) * 64 + 16 * (ce0 + c2) + q16] = Sreg[c2][e];
    }
}
__device__ __forceinline__ void scan_phase2(Frame& F) {
    if (F.G == 256) {
        if (F.bid < 64) { const int job = F.bid >> 1; rwkv_job2<16>(F, 32 + (job >> 4), (job >> 1) & 7, job & 1, 32 * (F.bid & 1)); }
        else if (F.bid < 96) { const int u = F.bid - 64; ret_job2(F, 32 + (u >> 4), (u >> 1) & 7, u & 1); }
        else for (int it = F.bid - 96; it < 1024; it += 160) { const int q = it & 511; if (it < 512) rwkv_job2<8>(F, q >> 4, (q >> 1) & 7, q & 1, 0); else ret_job2(F, q >> 4, (q >> 1) & 7, q & 1); }
    } else {
        for (int it = F.bid; it < 1088 + 32; it += F.G) {
            if (it < 64) { const int job = it >> 1; rwkv_job2<16>(F, 32 + (job >> 4), (job >> 1) & 7, job & 1, 32 * (it & 1)); }
            else if (it < 96) { const int u = it - 64; ret_job2(F, 32 + (u >> 4), (u >> 1) & 7, u & 1); }
            else { const int r = it - 96, q = r & 511; if (r < 512) rwkv_job2<8>(F, q >> 4, (q >> 1) & 7, q & 1, 0); else ret_job2(F, q >> 4, (q >> 1) & 7, q & 1); }
        }
    }
}

template <int NSL> __device__ __forceinline__ float row_reduce2(float v) {
    v += DPP_F(v, 0xB1); v += DPP_F(v, 0x4E); if (NSL >= 8) v += DPP_F(v, 0x141); if (NSL >= 16) v += DPP_F(v, 0x140); return v;
}
template <int NSL>
__device__ __forceinline__ void rwkv_job3(Frame& F, int seq, int h, int dir, int row0) {
    constexpr int KPT = 64 / NSL, TCH = 32, NV = KPT / 4;
    constexpr int WUPT = 0, AUPT = 9216, BUF0 = 18432, BUFSZ = 49152;
    LAS unsigned char* lds = F.lds;
    const int tid = F.tid, lane = F.lane, wave = F.wave, q16 = lane & 15, g = lane >> 4;
    const bool lat = seq >= 32; const int b = lat ? seq - 32 : seq, N = lat ? 2048 : 256, R0 = lat ? TCX + b * 2048 : b * 256;
    const bf16* PROJ = F.P; bf16* YD = (bf16*)F.S + (size_t)dir * T * 512; LAS float* Ly = (LAS float*)(lds + 116736);
    __syncthreads();
    for (int idx = tid; idx < 4096; idx += NTHR) { const int j = idx >> 6, k = idx & 63;
        *(LAS bf16*)(lds + WUPT + k * 144 + j * 2) = (bf16)f2bf(F.in[26][(size_t)(dir * 64 + j) * 512 + h * 64 + k]);
        *(LAS bf16*)(lds + AUPT + k * 144 + j * 2) = (bf16)f2bf(F.in[28][(size_t)(dir * 64 + j) * 512 + h * 64 + k]); }
    const bool scanw = wave < 4;
    const int rowl = (tid & 255) / NSL, sl = tid % NSL, irow = row0 + rowl;
    float S[KPT];
    {
        const float* st = F.in[7] + (size_t)((b * 2 + dir) * 8 + h) * 4096 + irow * 64 + KPT * sl;
#pragma unroll
        for (int kk = 0; kk < KPT; ++kk) S[kk] = (lat && scanw) ? st[kk] : 0.f;
    }
    const int pw = wave - 4;
    LAS float* Lasc = (LAS float*)(lds + 124928) + (pw & 1) * 1024;
    const int nch = N / TCH;
#define RW_PREP(c_) do { \
        LAS float* B_ = (LAS float*)(lds + BUF0 + ((c_) & 1) * BUFSZ); const int t0_ = (c_) * TCH; \
        float cw0[4], ca0[4], ckk8[8], cka8[8]; \
        _Pragma("unroll") for (int ct = 0; ct < 4; ++ct) { const int kc = h * 64 + 16 * ct + q16; cw0[ct] = F.in[25][dir * 512 + kc]; ca0[ct] = F.in[27][dir * 512 + kc]; } \
        { const f32x4 k0_ = *(const f32x4*)(F.in[30] + h * 64 + 8 * (lane & 7)), k1_ = *(const f32x4*)(F.in[30] + h * 64 + 8 * (lane & 7) + 4), a0_ = *(const f32x4*)(F.in[31] + h * 64 + 8 * (lane & 7)), a1_ = *(const f32x4*)(F.in[31] + h * 64 + 8 * (lane & 7) + 4); \
          _Pragma("unroll") for (int e = 0; e < 4; ++e) { ckk8[e] = k0_[e]; ckk8[4 + e] = k1_[e]; cka8[e] = a0_[e]; cka8[4 + e] = a1_[e]; } } \
        v4u raw_[6]; \
        _Pragma("unroll") for (int rep = 0; rep < 6; ++rep) { const int tk_ = t0_ + 16 * pw + (rep & 1) * 8 + (lane >> 3); const int n_ = dir ? N - 1 - tk_ : tk_; \
            raw_[rep] = *(const v4u*)(PROJ + (size_t)(R0 + n_) * NREC + 2048 + 512 * (rep >> 1) + h * 64 + 8 * (lane & 7)); } \
        bf16x8 aw_[2], aa_[2]; \
        { const int tk_ = t0_ + 16 * pw + q16; const int n_ = dir ? N - 1 - tk_ : tk_; const bf16* pa_ = PROJ + (size_t)(R0 + n_) * NREC + 8 * g; \
          _Pragma("unroll") for (int kd = 0; kd < 2; ++kd) { const v4u rw_ = *(const v4u*)(pa_ + 3584 + 32 * kd); aa_[kd] = *(const bf16x8*)(pa_ + 3648 + 32 * kd); float f_[8]; unpack8(rw_, f_); \
              _Pragma("unroll") for (int e = 0; e < 8; ++e) f_[e] = 1.f - 2.f / (1.f + __expf(2.f * f_[e])); aw_[kd] = __builtin_bit_cast(bf16x8, pack8(f_)); } } \
        f32x4 zw_[4], za_[4]; \
        _Pragma("unroll") for (int ct = 0; ct < 4; ++ct) { zw_[ct] = (f32x4){0.f, 0.f, 0.f, 0.f}; za_[ct] = (f32x4){0.f, 0.f, 0.f, 0.f}; \
            _Pragma("unroll") for (int kd = 0; kd < 2; ++kd) { \
                const bf16x8 bw_ = *(const LAS bf16x8*)(lds + WUPT + (16 * ct + q16) * 144 + 64 * kd + 16 * g), ba_ = *(const LAS bf16x8*)(lds + AUPT + (16 * ct + q16) * 144 + 64 * kd + 16 * g); \
                zw_[ct] = __builtin_amdgcn_mfma_f32_16x16x32_bf16(aw_[kd], bw_, zw_[ct], 0, 0, 0); za_[ct] = __builtin_amdgcn_mfma_f32_16x16x32_bf16(aa_[kd], ba_, za_[ct], 0, 0, 0); } } \
        _Pragma("unroll") for (int e = 0; e < 4; ++e) _Pragma("unroll") for (int ct = 0; ct < 4; ++ct) { const int tl16_ = 4 * g + e; \
            B_[2048 + (16 * pw + tl16_) * 64 + 16 * ct + q16] = __expf(-0.6065306597f * sigmoidf_(zw_[ct][e] + cw0[ct])); Lasc[tl16_ * 64 + 16 * ct + q16] = sigmoidf_(za_[ct][e] + ca0[ct]); } \
        _Pragma("unroll") for (int rep = 0; rep < 2; ++rep) { const int tl_ = 16 * pw + rep * 8 + (lane >> 3); float f_[8]; \
            unpack8(raw_[rep], f_); *(LAS f32x4*)(B_ + 8192 + tl_ * 64 + 8 * (lane & 7)) = (f32x4){f_[0], f_[1], f_[2], f_[3]}; *(LAS f32x4*)(B_ + 8192 + tl_ * 64 + 8 * (lane & 7) + 4) = (f32x4){f_[4], f_[5], f_[6], f_[7]}; \
            unpack8(raw_[4 + rep], f_); *(LAS f32x4*)(B_ + 10240 + tl_ * 64 + 8 * (lane & 7)) = (f32x4){f_[0], f_[1], f_[2], f_[3]}; *(LAS f32x4*)(B_ + 10240 + tl_ * 64 + 8 * (lane & 7) + 4) = (f32x4){f_[4], f_[5], f_[6], f_[7]}; \
            float k_[8], a_[8], kr_[8]; unpack8(raw_[2 + rep], k_); \
            { const f32x4 a0_ = *(const LAS f32x4*)(Lasc + (rep * 8 + (lane >> 3)) * 64 + 8 * (lane & 7)), a1_ = *(const LAS f32x4*)(Lasc + (rep * 8 + (lane >> 3)) * 64 + 8 * (lane & 7) + 4); \
              _Pragma("unroll") for (int e = 0; e < 4; ++e) { a_[e] = a0_[e]; a_[4 + e] = a1_[e]; } } \
            float ss_ = 0.f; \
            _Pragma("unroll") for (int e = 0; e < 8; ++e) { kr_[e] = k_[e] * ckk8[e]; ss_ += kr_[e] * kr_[e]; } \
            ss_ = row_reduce2<8>(ss_); const float rs_ = rsqrtf(ss_ + 1e-12f); \
            float o0_[8], o1_[8], o2_[8]; \
            _Pragma("unroll") for (int e = 0; e < 8; ++e) { const float kk_ = kr_[e] * rs_; o0_[e] = -kk_; o1_[e] = kk_ * a_[e]; o2_[e] = k_[e] * (1.f + (a_[e] - 1.f) * cka8[e]); } \
            LAS float* d_ = B_ + tl_ * 64 + 8 * (lane & 7); \
            *(LAS f32x4*)(d_) = (f32x4){o0_[0], o0_[1], o0_[2], o0_[3]}; *(LAS f32x4*)(d_ + 4) = (f32x4){o0_[4], o0_[5], o0_[6], o0_[7]}; \
            *(LAS f32x4*)(d_ + 4096) = (f32x4){o1_[0], o1_[1], o1_[2], o1_[3]}; *(LAS f32x4*)(d_ + 4100) = (f32x4){o1_[4], o1_[5], o1_[6], o1_[7]}; \
            *(LAS f32x4*)(d_ + 6144) = (f32x4){o2_[0], o2_[1], o2_[2], o2_[3]}; *(LAS f32x4*)(d_ + 6148) = (f32x4){o2_[4], o2_[5], o2_[6], o2_[7]}; } \
    } while (0)
    __syncthreads();
    if (wave == 4 || wave == 5) RW_PREP(0);
    __syncthreads();
    for (int c = 0; c < nch; ++c) {
        if (scanw) {
            const LAS float* B = (const LAS float*)(lds + BUF0 + (c & 1) * BUFSZ) + KPT * sl;
            const LAS float* Bv = (const LAS float*)(lds + BUF0 + (c & 1) * BUFSZ) + 10240 + irow;
            f32x4 nkA[NV], nkB[NV];
#define RW_LOADNK(nk, j_) do { _Pragma("unroll") for (int q_ = 0; q_ < NV; ++q_) nk[q_] = *(const LAS f32x4*)(B + (j_) * 64 + 4 * q_); } while (0)
#define RW_STEP(nk, nknext, j_) do { \
                f32x4 op_[4][NV]; \
                _Pragma("unroll") for (int a_ = 0; a_ < 4; ++a_) _Pragma("unroll") for (int q_ = 0; q_ < NV; ++q_) op_[a_][q_] = *(const LAS f32x4*)(B + (a_ + 1) * 2048 + (j_) * 64 + 4 * q_); \
                const float vv_ = Bv[(j_) * 64]; \
                if ((j_) + 1 < TCH) RW_LOADNK(nknext, (j_) + 1); \
                float sa_ = 0.f; \
                _Pragma("unroll") for (int q_ = 0; q_ < NV; ++q_) _Pragma("unroll") for (int e = 0; e < 4; ++e) sa_ += S[4 * q_ + e] * nk[q_][e]; \
                sa_ = row_reduce2<NSL>(sa_); \
                float y_ = 0.f; \
                _Pragma("unroll") for (int q_ = 0; q_ < NV; ++q_) _Pragma("unroll") for (int e = 0; e < 4; ++e) { S[4 * q_ + e] = S[4 * q_ + e] * op_[0][q_][e] + (sa_ * op_[1][q_][e] + vv_ * op_[2][q_][e]); y_ += S[4 * q_ + e] * op_[3][q_][e]; } \
                y_ = row_reduce2<NSL>(y_); \
                if (sl == 0) Ly[(j_) * 64 + rowl] = y_; \
            } while (0)
            RW_LOADNK(nkA, 0);
            for (int j = 0; j < TCH; j += 2) { RW_STEP(nkA, nkB, j); RW_STEP(nkB, nkA, j + 1); }
            {
                constexpr int RPW = 64 / NSL;
#pragma unroll 1
                for (int idx = lane; idx < TCH * RPW; idx += 64) { const int tok = idx / RPW, rl = wave * RPW + idx % RPW; const int tk_ = c * TCH + tok; const int n_ = dir ? N - 1 - tk_ : tk_;
                    YD[(size_t)(R0 + n_) * 512 + h * 64 + row0 + rl] = (bf16)f2bf(Ly[tok * 64 + rl]); }
            }
#undef RW_LOADNK
#undef RW_STEP
        } else if (wave < 6 && c + 1 < nch) { RW_PREP(c + 1); }
        __syncthreads();
    }
#undef RW_PREP
    if (!lat && scanw) { float* so = F.out + O_SRW + (size_t)((b * 2 + dir) * 8 + h) * 4096 + irow * 64 + KPT * sl;
#pragma unroll
        for (int kk = 0; kk < KPT; ++kk) so[kk] = S[kk]; }
}
__device__ __forceinline__ void scan_phase3(Frame& F) {
    unsigned* qctr = (unsigned*)(F.ws + WS_CTL) + 2048;
    LAS int* qslot = (LAS int*)(F.lds + LDS_BYTES - 128);
    const int nheavy = 96;
    for (int it = F.bid; it < nheavy; it += F.G) {
        if (it < 64) { const int job = it >> 1; rwkv_job3<8>(F, 32 + (job >> 4), (job >> 1) & 7, job & 1, 32 * (it & 1)); }
        else { const int u = it - 64; ret_job2(F, 32 + (u >> 4), (u >> 1) & 7, u & 1); }
    }
    for (;;) {
        __syncthreads();
        if (F.tid == 0) *qslot = (int)atomicAdd(qctr, 1u);
        __syncthreads();
        const int it = *qslot;
        if (it >= 1024) break;
        const int q = it & 511;
        if (it < 512) rwkv_job3<4>(F, q >> 4, (q >> 1) & 7, q & 1, 0); else ret_job2(F, q >> 4, (q >> 1) & 7, q & 1);
    }
}

__device__ __forceinline__ void rec_post_phase2(Frame& F) {
    const int lane = F.lane, q16 = lane & 15, g = lane >> 4;
    const bf16* PROJ = F.P; const bf16* YD = (const bf16*)F.S; const bf16* OD = (const bf16*)F.S + (size_t)2 * T * 512; const bf16* GUPT = (const bf16*)(F.ws + WS_MOD + MOD_GUPT);
    for (int it = F.wave * F.G + F.bid; it < T / 16; it += F.G * NWAVES) {
        const int tk0 = 16 * it;
        bf16x8 af[4];
#pragma unroll
        for (int kd = 0; kd < 4; ++kd) { const v4u raw = *(const v4u*)(PROJ + (size_t)(tk0 + q16) * NREC + 3712 + 32 * kd + 8 * g); float f[8]; unpack8(raw, f);
#pragma unroll
            for (int e = 0; e < 8; ++e) f[e] = sigmoidf_(f[e]);
            af[kd] = __builtin_bit_cast(bf16x8, pack8(f)); }
        for (int h = 0; h < 8; ++h) {
            f32x4 ga[4];
#pragma unroll
            for (int ct = 0; ct < 4; ++ct) { ga[ct] = (f32x4){0.f, 0.f, 0.f, 0.f};
#pragma unroll
                for (int kd = 0; kd < 4; ++kd) { const bf16x8 bfr = *(const bf16x8*)(GUPT + (size_t)(h * 64 + 16 * ct + q16) * 128 + 32 * kd + 8 * g); ga[ct] = __builtin_amdgcn_mfma_f32_16x16x32_bf16(af[kd], bfr, ga[ct], 0, 0, 0); } }
            float lng[4], lnb[4], rk_[4];
#pragma unroll
            for (int ct = 0; ct < 4; ++ct) { const int c = h * 64 + 16 * ct + q16; lng[ct] = F.in[33][c]; lnb[ct] = F.in[34][c]; rk_[ct] = F.in[32][c]; }
#pragma unroll
            for (int e = 0; e < 4; ++e) { const int tk = tk0 + 4 * g + e; const bf16* pr = PROJ + (size_t)tk * NREC + h * 64 + q16;
                float y[4], v[4]; float s1 = 0.f, s3 = 0.f;
#pragma unroll
                for (int ct = 0; ct < 4; ++ct) { { const size_t ix_ = (size_t)tk * 512 + h * 64 + 16 * ct + q16; y[ct] = bf1(YD[ix_]) + bf1(YD[ix_ + (size_t)T * 512]); } const float r = bf1(pr[2048 + 16 * ct]), k = bf1(pr[2560 + 16 * ct]); v[ct] = bf1(pr[3072 + 16 * ct]); s1 += y[ct]; s3 += r * rk_[ct] * k; }
                s1 = row_reduce<16>(s1); s3 = row_reduce<16>(s3);
                const float mu = s1 * (1.f / 64.f); float s2 = 0.f;
#pragma unroll
                for (int ct = 0; ct < 4; ++ct) { y[ct] -= mu; s2 += y[ct] * y[ct]; }
                s2 = row_reduce<16>(s2);
                const float rstd = rsqrtf(s2 * (1.f / 64.f) + 64e-5f);
#pragma unroll
                for (int ct = 0; ct < 4; ++ct) F.MIX[(size_t)tk * D + 512 + h * 64 + 16 * ct + q16] = (bf16)f2bf((y[ct] * rstd * lng[ct] + lnb[ct] + s3 * v[ct]) * ga[ct][e]);
            }
        }
        for (int h = 0; h < 8; ++h) {
#pragma unroll
            for (int e = 0; e < 4; ++e) { const int tk = tk0 + 4 * g + e; const bf16* pr = PROJ + (size_t)tk * NREC + 1536 + h * 64 + q16;
                float o[4]; float ms = 0.f;
#pragma unroll
                for (int ct = 0; ct < 4; ++ct) { { const size_t ix_ = (size_t)tk * 512 + h * 64 + 16 * ct + q16; o[ct] = bf1(OD[ix_]) + bf1(OD[ix_ + (size_t)T * 512]); } ms += o[ct] * o[ct]; }
                ms = row_reduce<16>(ms);
                const float rn = rsqrtf(ms * (1.f / 64.f) + 1e-6f);
#pragma unroll
                for (int ct = 0; ct < 4; ++ct) { const float xg = bf1(pr[16 * ct]); F.MIX[(size_t)tk * D + h * 64 + 16 * ct + q16] = (bf16)f2bf(xg * sigmoidf_(xg) * o[ct] * rn); }
            }
        }
    }
}

typedef GAS unsigned gu32;
#define XB_TMO      128
#define XB_XCNT(j)  (256  + 64 * (j))
#define XB_XSUB(j)  (1280 + 64 * (j))
#define XB_XGEN(j)  (2304 + 64 * (j))
#define XB_TOP      3328
#define XB_TOPGEN   3392
#define XCD_BAR_WORDS 3456
#define XB_SPIN_CAP (1u << 18)

__device__ __forceinline__ unsigned xb_ld(unsigned* p)              { return __hip_atomic_load(p, __ATOMIC_RELAXED, __HIP_MEMORY_SCOPE_AGENT); }
__device__ __forceinline__ unsigned xb_add(unsigned* p, unsigned v) { return __hip_atomic_fetch_add(p, v, __ATOMIC_RELAXED, __HIP_MEMORY_SCOPE_AGENT); }
__device__ __forceinline__ unsigned xb_xcc_id() { return (unsigned)__builtin_amdgcn_s_getreg((3 << 11) | 20) & 0xFu; }
#define XB_SPIN(cond, bar) do { unsigned _sp = 0; while (cond) { __builtin_amdgcn_s_sleep(1); \
    if ((++_sp & 255u) == 0u) { if (xb_ld(&(bar)[XB_TMO])) break; if (_sp > XB_SPIN_CAP) { atomicAdd(&(bar)[XB_TMO], 1u); break; } } } } while (0)

struct XcdBarrier {
    unsigned* bar; unsigned x;
    volatile LAS unsigned* st;
};

__device__ __forceinline__ XcdBarrier xcd_barrier_post(unsigned* bar, volatile LAS unsigned* st) {
    XcdBarrier b; b.bar = bar; b.x = xb_xcc_id(); b.st = st;
    if (threadIdx.x == 0) (void)xb_add(&bar[XB_XCNT(b.x)], 1u);
    return b;
}
__device__ __forceinline__ void xcd_barrier_complete(unsigned* bar, unsigned x, unsigned& nloc, unsigned& nx) {
    const unsigned G = gridDim.x * gridDim.y * gridDim.z;
    unsigned sum, cnt, mine, sp = 0u;
    for (;;) {
        sum = 0u; cnt = 0u; mine = 0u;
#pragma unroll
        for (unsigned j = 0; j < 16; ++j) { const unsigned c = xb_ld(&bar[XB_XCNT(j)]); sum += c; cnt += (c > 0u) ? 1u : 0u; mine = (j == x) ? c : mine; }
        if (sum == G) break;
        __builtin_amdgcn_s_sleep(1);
        if ((++sp & 255u) == 0u) { if (xb_ld(&bar[XB_TMO])) break; if (sp > XB_SPIN_CAP) { atomicAdd(&bar[XB_TMO], 1u); break; } }
    }
    nloc = mine > 0u ? mine : 1u; nx = cnt > 0u ? cnt : 1u;
}

__device__ __forceinline__ void xcd_barrier(const XcdBarrier& b) {
    asm volatile("s_waitcnt vmcnt(0)" ::: "memory");
    __syncthreads();
    if (threadIdx.x == 0) {
        unsigned* bar = b.bar;
        __builtin_amdgcn_s_waitcnt(0);
        unsigned nloc = b.st[0], nx = b.st[1];
        if (nloc == 0u) { xcd_barrier_complete(bar, b.x, nloc, nx); b.st[0] = nloc; b.st[1] = nx; }
        const unsigned old = xb_add(&bar[XB_XSUB(b.x)], 1u);
        const unsigned gen = old / nloc;
        if (old + 1u == (gen + 1u) * nloc) {
            __builtin_amdgcn_fence(__ATOMIC_RELEASE, "agent");
            asm volatile("s_waitcnt vmcnt(0)" ::: "memory");
            const unsigned og = xb_add(&bar[XB_TOP], 1u);
            const unsigned tg = og / nx;
            if (og + 1u == (tg + 1u) * nx) xb_add(&bar[XB_TOPGEN], 1u);
            else XB_SPIN(xb_ld(&bar[XB_TOPGEN]) == tg, bar);
            __builtin_amdgcn_fence(__ATOMIC_ACQUIRE, "agent");
            xb_add(&bar[XB_XGEN(b.x)], 1u);
            asm volatile("s_waitcnt vmcnt(0)" ::: "memory");
        } else {
            XB_SPIN(xb_ld(&bar[XB_XGEN(b.x)]) == gen, bar);
            __builtin_amdgcn_fence(__ATOMIC_ACQUIRE, "agent");
            asm volatile("s_waitcnt vmcnt(0)" ::: "memory");
        }
    }
    __syncthreads();
}

#ifndef PROBE_DUP
#define PROBE_DUP 0
#endif
#ifndef ATTN_MFMA
#define ATTN_MFMA 1
#endif
enum { PH_BASE = __COUNTER__ };
struct Args { const float* in[37]; float* out; unsigned char* ws; int ph_lo, ph_hi; };

template <bool COOP>
__global__ void __launch_bounds__(NTHR, 2) mk_fwd(Args args) {
    extern __shared__ __attribute__((aligned(16))) unsigned char lds[];
    Frame F;
    F.lds = (LAS unsigned char*)lds;
    F.tid = threadIdx.x; F.lane = F.tid & 63; F.wave = __builtin_amdgcn_readfirstlane(F.tid >> 6); F.G = gridDim.x; F.bid = blockIdx.x;
#pragma unroll
    for (int i = 0; i < 37; ++i) F.in[i] = args.in[i];
    F.out = args.out; F.ws = args.ws;
    unsigned char* ws = args.ws;
    F.Watt = (bf16*)(ws + WS_WATT); F.Woa = (bf16*)(ws + WS_WOA); F.Wrec = (bf16*)(ws + WS_WREC); F.Wor = (bf16*)(ws + WS_WOR); F.Wf1 = (bf16*)(ws + WS_WF1); F.Wf2 = (bf16*)(ws + WS_WF2);
    F.H = (bf16*)(ws + WS_H); F.MIX = (bf16*)(ws + WS_MIX); F.P = (bf16*)(ws + WS_P); F.MOD = (float*)(ws + WS_MOD); F.S = (float*)(ws + WS_S);
    volatile LAS unsigned* MISC = (volatile LAS unsigned*)(F.lds + LDS_BYTES - 256);
    if (F.tid < 16) MISC[F.tid] = 0u;
    __syncthreads();
    XcdBarrier bar; bar.bar = (unsigned*)(ws + WS_CTL) + 4096; bar.x = 0; bar.st = nullptr;
    if (COOP) bar = xcd_barrier_post((unsigned*)(ws + WS_CTL) + 4096, MISC + 8);
    const int lo = args.ph_lo, hi = args.ph_hi;
#define IN(k) (lo <= (k) && (k) < hi)
#define SEAM(k) do { if (COOP && IN((k) + 1)) { if ((k) == 0) cooperative_groups::this_grid().sync(); else xcd_barrier(bar); } } while (0)
    const f32x2v* rope = (const f32x2v*)((unsigned char*)F.MOD + MOD_ROPE);

#define PHASE(...) { constexpr int k_ = __COUNTER__ - PH_BASE - 1; if (IN(k_)) { __VA_ARGS__; SEAM(k_); } }
    PHASE(p0_prologue(F))
#if PROBE_DUP == 3
    PHASE(p0_prologue(F))
#endif
    PHASE(norm_phase(F, F.in[0], F.in[1], F.in[10], F.MOD, 0, 1, false))
    PHASE(pg8::Gemm g{F.H, F.Watt, T, NATT, D}; pg8::StaticOrder S; S.init(T, NATT, F.G, F.bid); EpiAttnIn E{F.P, F.out, rope};
          pg8::gemm_phase<EpiAttnIn, pg8::StaticOrder, true, true>(F.lds, g, S, E))
#if ATTN_MFMA
    PHASE(attn_mfma_phase(F))
#if PROBE_DUP == 1
    PHASE(attn_mfma_phase(F))
#endif
#else
    PHASE(attn_naive_phase(F))
    PHASE(diff_post_phase(F))
#endif
    PHASE(pg8::Gemm g{F.MIX, F.Woa, T, D, D}; pg8::StaticOrder S; S.init(T, D, F.G, F.bid); EpiResid E{F.in[0], F.in[1], F.out, F.MOD, 2};
          pg8::gemm_phase<EpiResid, pg8::StaticOrder, true, true>(F.lds, g, S, E))
    PHASE(norm_phase(F, F.out, F.out + (size_t)TCX * D, F.in[11], F.MOD, 3, 4, false))
    PHASE(pg8::Gemm g{F.H, F.Wf1, T, NFF, D}; pg8::StaticOrder S; S.init(T, NFF, F.G, F.bid); EpiSwiglu E{F.P};
          pg8::gemm_phase<EpiSwiglu, pg8::StaticOrder, true, true>(F.lds, g, S, E))
#if PROBE_DUP == 5
    PHASE(pg8::Gemm g{F.H, F.Wf1, T, NFF, D}; pg8::StaticOrder S; S.init(T, NFF, F.G, F.bid); EpiSwiglu E{F.P};
          pg8::gemm_phase<EpiSwiglu, pg8::StaticOrder, true, true>(F.lds, g, S, E))
#endif
    PHASE(pg8::Gemm g{F.P, F.Wf2, T, D, DFF}; pg8::StaticOrder S; S.init(T, D, F.G, F.bid); EpiResid E{F.out, F.out + (size_t)TCX * D, F.out, F.MOD, 5};
          pg8::gemm_phase<EpiResid, pg8::StaticOrder, true, true>(F.lds, g, S, E))
    PHASE(norm_phase(F, F.out, F.out + (size_t)TCX * D, F.in[10] + D, F.MOD + 3 * 6144, 0, 1, false))
    PHASE(pg8::Gemm g{F.H, F.Wrec, T, NREC, D}; pg8::StaticOrder S; S.init(T, NREC, F.G, F.bid); EpiBf16Plain E{F.P, NREC};
          pg8::gemm_phase<EpiBf16Plain, pg8::StaticOrder, true, true>(F.lds, g, S, E))
    PHASE(scan_phase3(F))
#if PROBE_DUP == 2
    PHASE(scan_phase3(F))
#endif
    PHASE(rec_post_phase2(F))
#if PROBE_DUP == 4
    PHASE(rec_post_phase2(F))
#endif
    PHASE(pg8::Gemm g{F.MIX, F.Wor, T, D, D}; pg8::StaticOrder S; S.init(T, D, F.G, F.bid); EpiResid E{F.out, F.out + (size_t)TCX * D, F.out, F.MOD + 3 * 6144, 2};
          pg8::gemm_phase<EpiResid, pg8::StaticOrder, true, true>(F.lds, g, S, E))
    PHASE(norm_phase(F, F.out, F.out + (size_t)TCX * D, F.in[11] + D, F.MOD + 3 * 6144, 3, 4, false))
    PHASE(pg8::Gemm g{F.H, F.Wf1 + WF1_STRIDE, T, NFF, D}; pg8::StaticOrder S; S.init(T, NFF, F.G, F.bid); EpiSwiglu E{F.P};
          pg8::gemm_phase<EpiSwiglu, pg8::StaticOrder, true, true>(F.lds, g, S, E))
    PHASE(pg8::Gemm g{F.P, F.Wf2 + WF2_STRIDE, T, D, DFF}; pg8::StaticOrder S; S.init(T, D, F.G, F.bid); EpiResid E{F.out, F.out + (size_t)TCX * D, F.out, F.MOD + 3 * 6144, 5};
          pg8::gemm_phase<EpiResid, pg8::StaticOrder, true, true>(F.lds, g, S, E))
    PHASE(final_norm_phase(F))
#undef PHASE
#undef IN
#undef SEAM
}

constexpr int NPHASE = __COUNTER__ - PH_BASE - 1;
#ifndef MK_N_LAUNCHES
#define MK_N_LAUNCHES 1
#endif
extern "C" void kernel_launch(void* const* d_in, const int* in_sizes, int n_in, void* d_out, int out_size, void* d_ws, size_t ws_size, hipStream_t stream) {
    static int grid = 0;
    if (grid == 0) {
        if (n_in != 37 || out_size != 33554432 || ws_size < WS_END) { fprintf(stderr, "kernel_launch: unexpected problem (n_in %d out %d ws %zu)\n", n_in, out_size, ws_size); grid = -1; return; }
        int dev = 0, cus = 0, per_cu = 0;
        if (hipGetDevice(&dev) != hipSuccess || hipDeviceGetAttribute(&cus, hipDeviceAttributeMultiprocessorCount, dev) != hipSuccess) { grid = -1; return; }
        (void)hipFuncSetAttribute((const void*)mk_fwd<false>, hipFuncAttributeMaxDynamicSharedMemorySize, LDS_BYTES);
        (void)hipFuncSetAttribute((const void*)mk_fwd<true>, hipFuncAttributeMaxDynamicSharedMemorySize, LDS_BYTES);
        if (hipOccupancyMaxActiveBlocksPerMultiprocessor(&per_cu, (const void*)mk_fwd<true>, NTHR, LDS_BYTES) != hipSuccess || per_cu < 1) per_cu = 1;
        (void)hipGetLastError();
        grid = cus;
    }
    if (grid < 0) return;
    if (hipMemsetAsync((char*)d_ws + WS_CTL, 0, 65536, stream) != hipSuccess) { fprintf(stderr, "memset failed\n"); return; }
    Args a{};
    for (int i = 0; i < 37; ++i) a.in[i] = (const float*)d_in[i];
    a.out = (float*)d_out; a.ws = (unsigned char*)d_ws;
#if MK_N_LAUNCHES == 1
    a.ph_lo = 0; a.ph_hi = NPHASE;
    void* kargs[] = {&a};
    hipError_t e = hipLaunchCooperativeKernel((const void*)mk_fwd<true>, dim3(grid), dim3(NTHR), kargs, LDS_BYTES, stream);
    if (e != hipSuccess) fprintf(stderr, "cooperative launch failed: %s (grid %d)\n", hipGetErrorString(e), grid);
#else
    for (int ph = 0; ph < NPHASE; ++ph) { a.ph_lo = ph; a.ph_hi = ph + 1; hipLaunchKernelGGL(mk_fwd<false>, dim3(grid), dim3(NTHR), LDS_BYTES, stream, a); }
#endif
}
```

```cpp
#include <hip/hip_runtime.h>
#include <hip/hip_cooperative_groups.h>
#include <cstdio>
#include <cstdint>
namespace pg8 {
#define PG8_LAS __attribute__((address_space(3)))
typedef unsigned short bf16_t;
typedef short bf16x8 __attribute__((ext_vector_type(8)));
typedef float f32x4 __attribute__((ext_vector_type(4)));
typedef unsigned u32x4 __attribute__((ext_vector_type(4)));
constexpr int BM = 256, BK = 64, HALF = 128, HTB = HALF * BK * 2  , STAGE_BYTES = 8 * HTB, NXCD = 8, WGM = 8;

__host__ __device__ __forceinline__ int lds_byte(int r, int c) { const int st = (r >> 4) * 2 + (c >> 5), rr = r & 15, cc = c & 31, ob = rr * 64 + cc * 2; return st * 1024 + (ob ^ (((ob >> 9) & 1) << 5)); }
__host__ __device__ __forceinline__ void stage_rc(int b, int& R, int& C) { const int st = b / 1024, sb = b % 1024, swz = sb ^ (((sb >> 9) & 1) << 5); R = (st >> 1) * 16 + swz / 64; C = (st & 1) * 32 + (swz % 64) / 2; }
__host__ __device__ __forceinline__ int perm32(int rho) { const int n = rho >> 4, i = rho & 15; return 8 * (i >> 2) + 4 * n + (i & 3); }

struct Unit { int pm, pn; };
struct Gemm { const bf16_t* A; const bf16_t* Bt; int M, N, K; };

struct StaticOrder {
    int nM, nN, nwg, G, c;
    __host__ __device__ void init(int M, int N, int G_, int c_) { nM = M / BM; nN = N / BM; nwg = nM * nN; G = G_; c = c_; }
    __host__ __device__ bool next(int i, Unit& u) const {
        const long L = (long)i * G + c; if (L >= nwg) return false;
        int wgid = (int)L; { const int q = nwg / NXCD, r = nwg % NXCD, xcd = wgid % NXCD, off = wgid / NXCD; wgid = (xcd < r ? xcd * (q + 1) : r * (q + 1) + (xcd - r) * q) + off; }
        const int nig = WGM * nN, gid = wgid / nig, fm = gid * WGM, gsz = (nM - fm) < WGM ? (nM - fm) : WGM;
        u.pm = fm + ((wgid % nig) % gsz); u.pn = (wgid % nig) / gsz; return true;
    }
    __device__ __forceinline__ void a_ready(const Unit&) const {}
    __device__ __forceinline__ void done(const Unit&) const {}
};
__device__ __forceinline__ unsigned cvt_pk_bf16(float lo, float hi) { unsigned r; asm volatile("v_cvt_pk_bf16_f32 %0, %1, %2" : "=v"(r) : "v"(lo), "v"(hi)); return r; }
typedef float f32x2 __attribute__((ext_vector_type(2)));
template <class Epi, class Sched, bool ALIGN_EPI = false, bool SP2 = false>
__device__ __forceinline__ void gemm_phase(PG8_LAS unsigned char* lds, const Gemm g, const Sched& S, const Epi& E) {
    const int tid = threadIdx.x, wid = __builtin_amdgcn_readfirstlane(tid >> 6), lane = tid & 63, wr = wid >> 2, wc = wid & 3, fr = lane & 15, fq = lane >> 4;
    const int K = g.K, nt = K / BK;
    unsigned voffA[2], voffB[2];
#pragma unroll
    for (int i = 0; i < 2; ++i) { int R, C; stage_rc(tid * 16 + i * 8192, R, C); const int Rb = Epi::PERM ? ((R & ~31) + perm32(R & 31)) : R;
        voffA[i] = (unsigned)(R * K + C) * 2u; voffB[i] = (unsigned)(Rb * K + C) * 2u; }
    const size_t kstep = (size_t)(BK * 2);
    const size_t hstep = (size_t)HALF * K * 2;
    const size_t tstep = 2 * hstep;
    const unsigned ldsw = (unsigned)wid * 1024u;
    const int aoff = lds_byte(wr * 64 + fr, fq * 8), boff = lds_byte(wc * 32 + fr, fq * 8);
#define PG8_SA(b, h) (((b) * 2 + (h)) * HTB)
#define PG8_SB(b, h) ((4 + (b) * 2 + (h)) * HTB)
#define PG8_STAGE(bufoff, gbase, voff) do { _Pragma("unroll") for (int _i = 0; _i < 2; ++_i) \
        __builtin_amdgcn_global_load_lds((const unsigned*)((const char*)(gbase) + (voff)[_i]), (PG8_LAS unsigned*)(lds + (bufoff) + ldsw + _i * 8192), 16, 0, 0); } while (0)
#define PG8_LDA(dst, b, h) do { _Pragma("unroll") for (int m = 0; m < 4; ++m) _Pragma("unroll") for (int k = 0; k < 2; ++k) dst[m][k] = *(const PG8_LAS bf16x8*)(lds + PG8_SA(b, h) + aoff + m * 2048 + k * 1024); } while (0)
#define PG8_LDB(dst, b, h) do { _Pragma("unroll") for (int n = 0; n < 2; ++n) _Pragma("unroll") for (int k = 0; k < 2; ++k) dst[n][k] = *(const PG8_LAS bf16x8*)(lds + PG8_SB(b, h) + boff + n * 2048 + k * 1024); } while (0)
#define PG8_MMA(ai, bj, At, Bt) do { __builtin_amdgcn_s_setprio(1); _Pragma("unroll") for (int m = 0; m < 4; ++m) _Pragma("unroll") for (int n = 0; n < 2; ++n) _Pragma("unroll") for (int k = 0; k < 2; ++k) \
        acc[ai][bj][m][n] = __builtin_amdgcn_mfma_f32_16x16x32_bf16(Bt[n][k], At[m][k], acc[ai][bj][m][n], 0, 0, 0); __builtin_amdgcn_s_setprio(0); } while (0)
#define PG8_WAIT_V(n) asm volatile("s_waitcnt vmcnt(" #n ")" ::: "memory")
#define PG8_WAIT_L(n) asm volatile("s_waitcnt lgkmcnt(" #n ")" ::: "memory")
#define PG8_BAR __builtin_amdgcn_s_barrier()
#define PG8_SCHED __builtin_amdgcn_sched_barrier(0)
    Unit cur, nxt; int ui = 0;
    if (!S.next(0, cur)) return;
    f32x4 acc[2][2][4][2];
#pragma unroll
    for (int a = 0; a < 2; ++a)
#pragma unroll
        for (int b = 0; b < 2; ++b)
#pragma unroll
            for (int m = 0; m < 4; ++m)
#pragma unroll
                for (int n = 0; n < 2; ++n) acc[a][b][m][n] = (f32x4){0.f, 0.f, 0.f, 0.f};
    bf16x8 At[4][2], B0[2][2], B1[2][2];
    const char* cA = (const char*)g.A + (size_t)cur.pm * tstep; const char* cB = (const char*)g.Bt + (size_t)cur.pn * tstep;
    S.a_ready(cur);
    if constexpr (SP2) {
        PG8_STAGE(PG8_SB(0, 0), cB, voffB); PG8_STAGE(PG8_SB(0, 1), cB + hstep, voffB); PG8_STAGE(PG8_SA(0, 0), cA, voffA); PG8_STAGE(PG8_SA(0, 1), cA + hstep, voffA);
        if (wr == 1) PG8_BAR;
        PG8_WAIT_V(2); PG8_BAR;
        PG8_STAGE(PG8_SB(1, 0), cB + kstep, voffB); PG8_STAGE(PG8_SA(1, 0), cA + kstep, voffA); PG8_STAGE(PG8_SB(1, 1), cB + hstep + kstep, voffB);
        PG8_WAIT_V(6); PG8_BAR;
    } else {
        PG8_STAGE(PG8_SB(0, 0), cB, voffB); PG8_STAGE(PG8_SA(0, 0), cA, voffA); PG8_STAGE(PG8_SB(0, 1), cB + hstep, voffB); PG8_STAGE(PG8_SA(0, 1), cA + hstep, voffA);
        if (wr == 1) PG8_BAR;
        PG8_WAIT_V(4); PG8_BAR;
        PG8_STAGE(PG8_SB(1, 0), cB + kstep, voffB); PG8_STAGE(PG8_SA(1, 0), cA + kstep, voffA); PG8_STAGE(PG8_SB(1, 1), cB + hstep + kstep, voffB);
        PG8_WAIT_V(6); PG8_BAR;
    }
    for (;;) {
        const bool has_next = S.next(ui + 1, nxt);
        const char* nA = has_next ? (const char*)g.A + (size_t)nxt.pm * tstep : cA; const char* nB = has_next ? (const char*)g.Bt + (size_t)nxt.pn * tstep : cB;
        for (int t = 0; t < nt; t += 2) {
            const bool last = (t == nt - 2);
            const char* a1 = cA + (size_t)(t + 1) * kstep;
            const char* a2 = last ? nA : cA + (size_t)(t + 2) * kstep; const char* b2 = last ? nB : cB + (size_t)(t + 2) * kstep;
            const char* a3 = a2 + kstep; const char* b3 = b2 + kstep;
            if (last && has_next) S.a_ready(nxt);
            if constexpr (SP2) {
            PG8_LDB(B0, 0, 0); PG8_LDB(B1, 0, 1); PG8_SCHED; PG8_LDA(At, 0, 0); PG8_STAGE(PG8_SA(1, 1), a1 + hstep, voffA);
            PG8_WAIT_V(8); PG8_WAIT_L(0); PG8_BAR; PG8_MMA(0, 0, At, B0); PG8_MMA(0, 1, At, B1); PG8_BAR; PG8_SCHED;
            PG8_LDA(At, 0, 1); PG8_STAGE(PG8_SB(0, 0), b2, voffB); PG8_STAGE(PG8_SB(0, 1), b2 + hstep, voffB); PG8_STAGE(PG8_SA(0, 0), a2, voffA);
            PG8_WAIT_V(8); PG8_WAIT_L(0); PG8_BAR; PG8_MMA(1, 0, At, B0); PG8_MMA(1, 1, At, B1); PG8_BAR; PG8_SCHED;
            PG8_LDB(B0, 1, 0); PG8_LDB(B1, 1, 1); PG8_SCHED; PG8_LDA(At, 1, 0); PG8_STAGE(PG8_SA(0, 1), a2 + hstep, voffA);
            PG8_WAIT_V(8); PG8_WAIT_L(0); PG8_BAR; PG8_MMA(0, 0, At, B0); PG8_MMA(0, 1, At, B1); PG8_BAR; PG8_SCHED;
            PG8_LDA(At, 1, 1); PG8_STAGE(PG8_SB(1, 0), b3, voffB); PG8_STAGE(PG8_SB(1, 1), b3 + hstep, voffB); PG8_STAGE(PG8_SA(1, 0), a3, voffA);
            PG8_WAIT_V(8); PG8_WAIT_L(0); PG8_BAR; PG8_MMA(1, 0, At, B0); PG8_MMA(1, 1, At, B1); PG8_BAR; PG8_SCHED;
            } else {
            PG8_LDB(B0, 0, 0); PG8_SCHED; PG8_LDA(At, 0, 0); PG8_STAGE(PG8_SA(1, 1), a1 + hstep, voffA);
            PG8_WAIT_L(8); PG8_BAR; PG8_WAIT_L(0); PG8_MMA(0, 0, At, B0); PG8_BAR; PG8_SCHED;
            PG8_LDB(B1, 0, 1); PG8_STAGE(PG8_SB(0, 0), b2, voffB);
            PG8_BAR; PG8_WAIT_L(0); PG8_MMA(0, 1, At, B1); PG8_BAR;
            PG8_LDA(At, 0, 1); PG8_STAGE(PG8_SA(0, 0), a2, voffA);
            PG8_BAR; PG8_WAIT_L(0); PG8_MMA(1, 0, At, B0); PG8_BAR; PG8_SCHED;
            PG8_STAGE(PG8_SB(0, 1), b2 + hstep, voffB);
            PG8_WAIT_V(6); PG8_BAR; PG8_MMA(1, 1, At, B1); PG8_BAR;
            PG8_LDB(B0, 1, 0); PG8_SCHED; PG8_LDA(At, 1, 0); PG8_STAGE(PG8_SA(0, 1), a2 + hstep, voffA);
            PG8_WAIT_L(8); PG8_BAR; PG8_WAIT_L(0); PG8_MMA(0, 0, At, B0); PG8_BAR; PG8_SCHED;
            PG8_LDB(B1, 1, 1); PG8_STAGE(PG8_SB(1, 0), b3, voffB);
            PG8_BAR; PG8_WAIT_L(0); PG8_MMA(0, 1, At, B1); PG8_BAR;
            PG8_LDA(At, 1, 1); PG8_STAGE(PG8_SA(1, 0), a3, voffA);
            PG8_BAR; PG8_WAIT_L(0); PG8_MMA(1, 0, At, B0); PG8_BAR; PG8_SCHED;
            PG8_STAGE(PG8_SB(1, 1), b3 + hstep, voffB);
            PG8_WAIT_V(6); PG8_BAR; PG8_MMA(1, 1, At, B1); PG8_BAR;
            }
        }
        if constexpr (ALIGN_EPI) { if (wr == 0) PG8_BAR; }
        if constexpr (!Epi::AFTER_DRAIN) { E(acc, cur, wr, wc, fr, fq); S.done(cur); }
        if (!has_next) break;
#pragma unroll
        for (int a = 0; a < 2; ++a)
#pragma unroll
            for (int b = 0; b < 2; ++b)
#pragma unroll
                for (int m = 0; m < 4; ++m)
#pragma unroll
                    for (int n = 0; n < 2; ++n) acc[a][b][m][n] = (f32x4){0.f, 0.f, 0.f, 0.f};
        cur = nxt; cA = nA; cB = nB; ++ui;
        if constexpr (ALIGN_EPI) { if (wr == 1) PG8_BAR; }
    }
    PG8_WAIT_V(0);
    if constexpr (!ALIGN_EPI) { if (wr == 0) PG8_BAR; }
    PG8_BAR;
    if constexpr (Epi::AFTER_DRAIN) { E.fused(acc, cur, wr, wc, fr, fq, lds, wid, lane); S.done(cur); }
#undef PG8_SA
#undef PG8_SB
#undef PG8_STAGE
#undef PG8_LDA
#undef PG8_LDB
#undef PG8_MMA
#undef PG8_WAIT_V
#undef PG8_WAIT_L
#undef PG8_BAR
#undef PG8_SCHED
}
}

#define GAS __attribute__((address_space(1)))
#define LAS __attribute__((address_space(3)))
typedef unsigned short bf16;
typedef unsigned v4u __attribute__((ext_vector_type(4)));
typedef unsigned v2u __attribute__((ext_vector_type(2)));
typedef float f32x4 __attribute__((ext_vector_type(4)));
typedef float f32x2v __attribute__((ext_vector_type(2)));

constexpr int NWAVES = 8, NTHR = 512;
constexpr int D = 1024, TCX = 8192, TLT = 4096, T = 12288;
constexpr int NATT = 3072, NREC = 3840, DFF = 2816, NFF = 5632;
constexpr int QLD = NATT;
constexpr size_t MiB = 1u << 20;
constexpr size_t WS_CTL = 0, WS_MOD = 1 * MiB, WS_WATT = 2 * MiB, WS_WOA = 8 * MiB, WS_WREC = 10 * MiB, WS_WOR = 18 * MiB, WS_WF1 = 20 * MiB, WS_WF2 = 42 * MiB,
                 WS_H = 54 * MiB, WS_MIX = 78 * MiB, WS_P = 102 * MiB, WS_S = 192 * MiB, WS_END = 256 * MiB;
constexpr size_t MOD_ROPE = 160 * 1024, MOD_LAM = 176 * 1024, MOD_GUPT = 256 * 1024;
constexpr size_t WF1_STRIDE = (size_t)NFF * D;
constexpr size_t WF2_STRIDE = (size_t)D * DFF;
constexpr size_t O_YP = 0, O_YS = 8388608, O_NAK = 12582912, O_NAV = 16777216, O_DFK = 20971520, O_DFV = 25165824, O_SRET = 29360128, O_SRW = 31457280;
constexpr int LDS_BYTES = 147456;

__device__ __forceinline__ float bflo(unsigned u) { return __uint_as_float(u << 16); }
__device__ __forceinline__ float bfhi(unsigned u) { return __uint_as_float(u & 0xffff0000u); }
__device__ __forceinline__ float bf1(bf16 b) { return __uint_as_float(((unsigned)b) << 16); }
__device__ __forceinline__ unsigned f2bf(float f) { unsigned u = __float_as_uint(f); return (u + 0x7fffu + ((u >> 16) & 1u)) >> 16; }
__device__ __forceinline__ unsigned pk2(float lo, float hi) { return f2bf(lo) | (f2bf(hi) << 16); }
__device__ __forceinline__ float wave_sum(float v) {
#pragma unroll
    for (int o = 1; o < 64; o <<= 1) v += __shfl_xor(v, o);
    return v;
}
__device__ __forceinline__ float sigmoidf_(float x) { return 1.f / (1.f + __expf(-x)); }
__device__ __forceinline__ float opaque_one() { float one = 1.0f; asm volatile("" : "+v"(one)); return one; }

struct Frame {
    LAS unsigned char* lds;
    int tid, lane, wave, G, bid;
    const float* in[37];
    float* out; unsigned char* ws;
    bf16 *Watt, *Woa, *Wrec, *Wor, *Wf1, *Wf2, *H, *MIX, *P;
    float *MOD, *S;
};

__device__ __forceinline__ void transpose_item(const float* W, int K, int N, bf16* WT, int k0, int n0, int drow0, LAS float* scr, int lane) {
#pragma unroll 8
    for (int i = 0; i < 32; ++i) { const int kk = 2 * i + (lane >> 5); scr[kk * 33 + (lane & 31)] = W[(size_t)(k0 + kk) * N + n0 + (lane & 31)]; }
    asm volatile("s_waitcnt lgkmcnt(0)" ::: "memory");
    const int c = lane & 7;
#pragma unroll
    for (int j = 0; j < 4; ++j) { const int n = (lane >> 3) + 8 * j; const LAS float* s = scr + (8 * c) * 33 + n;
        v4u o; o.x = pk2(s[0 * 33], s[1 * 33]); o.y = pk2(s[2 * 33], s[3 * 33]); o.z = pk2(s[4 * 33], s[5 * 33]); o.w = pk2(s[6 * 33], s[7 * 33]);
        *(v4u*)(WT + (size_t)(drow0 + n) * K + k0 + 8 * c) = o; }
    asm volatile("s_waitcnt lgkmcnt(0)" ::: "memory");
}

__device__ __forceinline__ void p0_prologue(Frame& F) {
    {
        LAS float* sc = (LAS float*)F.lds;
        LAS float* red = sc + 3072;
        for (int idx = F.tid; idx < 3072; idx += NTHR) { const int j = idx >> 10, k = idx & 1023; const float c = (j == 0) ? F.in[9][k] : F.in[8][(j - 1) * 1024 + k]; sc[idx] = c * sigmoidf_(c); }
        __syncthreads();
        for (int item = F.bid; item < 192; item += F.G) {
            const int layer = item / 96, col = (item % 96) * 64 + (F.tid & 63), kg = F.tid >> 6;
            const float* w = F.in[13] + (size_t)layer * 1024 * 6144 + col;
            float a0 = 0.f, a1 = 0.f, a2 = 0.f;
#pragma unroll 8
            for (int k = kg * 128; k < kg * 128 + 128; ++k) { const float wv = w[(size_t)k * 6144]; a0 += sc[k] * wv; a1 += sc[1024 + k] * wv; a2 += sc[2048 + k] * wv; }
            red[(kg * 3 + 0) * 64 + (F.tid & 63)] = a0; red[(kg * 3 + 1) * 64 + (F.tid & 63)] = a1; red[(kg * 3 + 2) * 64 + (F.tid & 63)] = a2;
            __syncthreads();
            if (F.tid < 192) { const int j = F.tid >> 6, c = F.tid & 63; float s = 0.f;
#pragma unroll
                for (int g = 0; g < 8; ++g) s += red[(g * 3 + j) * 64 + c];
                const int cc = (item % 96) * 64 + c; F.MOD[(layer * 3 + j) * 6144 + cc] = s + F.in[14][layer * 6144 + cc]; }
            __syncthreads();
        }
    }
    if (F.bid == F.G - 1) {
        f32x2v* rope = (f32x2v*)((unsigned char*)F.MOD + MOD_ROPE);
        for (int idx = F.tid; idx < 1024; idx += NTHR) { const int pos = idx >> 4, i = idx & 15; const float inv = powf(10000.0f, -(float)i / 16.0f); const float ang = (float)pos * inv; rope[idx] = (f32x2v){cosf(ang), sinf(ang)}; }
        if (F.wave == 0) { const float s1 = wave_sum(F.in[18][F.lane] * F.in[19][F.lane]), s2 = wave_sum(F.in[20][F.lane] * F.in[21][F.lane]);
            if (F.lane == 0) *(float*)((unsigned char*)F.MOD + MOD_LAM) = expf(s1) - expf(s2) + 0.2f; }
    }
    { bf16* GUPT = (bf16*)(F.ws + WS_MOD + MOD_GUPT);
      for (int idx = F.bid * NTHR + F.tid; idx < 65536; idx += F.G * NTHR) { const int n = idx >> 7, k = idx & 127; GUPT[idx] = (bf16)f2bf(F.in[29][(size_t)k * 512 + n]); } }
    {
        const int gt = F.bid * NTHR + F.tid, NG = F.G * NTHR;
        for (int idx = gt; idx < 4 * 512 * 64; idx += NG) { const int t = idx / (512 * 64), r = (idx / 64) % 512, c8 = idx % 64;
            const float* srcb = (t == 0) ? F.in[2] : (t == 1) ? F.in[3] : (t == 2) ? F.in[4] : F.in[5]; const float* src = srcb + (size_t)r * 512 + c8 * 8; const int colb = (t == 0) ? 512 : (t == 1) ? 1024 : (t == 2) ? 2048 : 2560;
            const f32x4 a = *(const f32x4*)src, b = *(const f32x4*)(src + 4);
            v4u o; o.x = pk2(a[0], a[1]); o.y = pk2(a[2], a[3]); o.z = pk2(b[0], b[1]); o.w = pk2(b[2], b[3]);
            *(v4u*)(F.P + (size_t)(T + r) * QLD + colb + c8 * 8) = o; }
    }
    {
        LAS float* scr = (LAS float*)(F.lds + 20480 + F.wave * 8448);
        __syncthreads();
        const int gw = F.bid * NWAVES + F.wave, NGW = F.G * NWAVES;
        constexpr int I0 = 16 * 96, I1 = 16 * 32, I2 = 16 * 120, I3 = 16 * 32, I4 = 16 * 176, I6 = 44 * 32;
        constexpr int NIT = I0 + I1 + I2 + I3 + 2 * I4 + 2 * I6;
        for (int it = gw; it < NIT; it += NGW) {
            int r = it;
            if (r < I0) { const int nb = 96; transpose_item(F.in[15], 1024, 3072, F.Watt, 64 * (r / nb), 32 * (r % nb), 32 * (r % nb), scr, F.lane); continue; } r -= I0;
            if (r < I1) { const int nb = 32; transpose_item(F.in[16], 1024, 1024, F.Woa, 64 * (r / nb), 32 * (r % nb), 32 * (r % nb), scr, F.lane); continue; } r -= I1;
            if (r < I2) { const int nb = 120; transpose_item(F.in[22], 1024, 3840, F.Wrec, 64 * (r / nb), 32 * (r % nb), 32 * (r % nb), scr, F.lane); continue; } r -= I2;
            if (r < I3) { const int nb = 32; transpose_item(F.in[23], 1024, 1024, F.Wor, 64 * (r / nb), 32 * (r % nb), 32 * (r % nb), scr, F.lane); continue; } r -= I3;
            if (r < 2 * I4) { const int l = r / I4; r -= l * I4; const int nb = 176, n0 = 32 * (r % nb);
                const int drow = (n0 < DFF) ? ((n0 / 128) * 256 + (n0 % 128)) : (((n0 - DFF) / 128) * 256 + 128 + ((n0 - DFF) % 128));
                transpose_item(F.in[35] + (size_t)l * 1024 * NFF, 1024, NFF, F.Wf1 + (size_t)l * WF1_STRIDE, 64 * (r / nb), n0, drow, scr, F.lane); continue; } r -= 2 * I4;
            { const int l = r / I6; r -= l * I6; const int nb = 32;
                transpose_item(F.in[36] + (size_t)l * DFF * 1024, DFF, 1024, F.Wf2 + (size_t)l * WF2_STRIDE, 64 * (r / nb), 32 * (r % nb), 32 * (r % nb), scr, F.lane); }
        }
    }
}

__device__ __forceinline__ void norm_phase(Frame& F, const float* xc, const float* xl, const float* g, const float* mod  , int shift_i, int scale_i, bool zero_s) {
    const int gw = F.bid * NWAVES + F.wave, NGW = F.G * NWAVES;
    for (int row = gw; row < T; row += NGW) {
        const float* xr = (row < TCX) ? xc + (size_t)row * D : xl + (size_t)(row - TCX) * D;
        const int cond = (row < TCX) ? 0 : 1 + ((row - TCX) >> 11);
        const float* sh = mod + cond * 6144 + shift_i * 1024; const float* sc = mod + cond * 6144 + scale_i * 1024;
        f32x4 v[4]; float ss = 0.f;
#pragma unroll
        for (int j = 0; j < 4; ++j) { v[j] = *(const f32x4*)(xr + 4 * F.lane + 256 * j); ss += (v[j][0] * v[j][0] + v[j][1] * v[j][1]) + (v[j][2] * v[j][2] + v[j][3] * v[j][3]); }
        const float rstd = rsqrtf(wave_sum(ss) * (1.f / D) + 1e-6f);
#pragma unroll
        for (int j = 0; j < 4; ++j) { const int c = 4 * F.lane + 256 * j; const f32x4 gg = *(const f32x4*)(g + c), s1 = *(const f32x4*)(sc + c), s0 = *(const f32x4*)(sh + c);
            f32x4 h;
#pragma unroll
            for (int e = 0; e < 4; ++e) h[e] = v[j][e] * rstd * gg[e] * (1.f + s1[e]) + s0[e];
            v2u o; o.x = pk2(h[0], h[1]); o.y = pk2(h[2], h[3]); *(v2u*)(F.H + (size_t)row * D + c) = o; }
    }
    if (zero_s) {
        const size_t n16 = (size_t)48 * MiB / 16; f32x4* p = (f32x4*)F.S;
        for (size_t i = (size_t)F.bid * NTHR + F.tid; i < n16; i += (size_t)F.G * NTHR) p[i] = (f32x4){0.f, 0.f, 0.f, 0.f};
    }
}
__device__ __forceinline__ void zero_s_phase(Frame& F) {
    const size_t n16 = (size_t)48 * MiB / 16; f32x4* p = (f32x4*)F.S;
    for (size_t i = (size_t)F.bid * NTHR + F.tid; i < n16; i += (size_t)F.G * NTHR) p[i] = (f32x4){0.f, 0.f, 0.f, 0.f};
}
__device__ __forceinline__ void final_norm_phase(Frame& F) {
    const int gw = F.bid * NWAVES + F.wave, NGW = F.G * NWAVES; const float* g = F.in[12];
    for (int row = gw; row < T; row += NGW) {
        float* xr = F.out + (size_t)row * D;
        f32x4 v[4]; float ss = 0.f;
#pragma unroll
        for (int j = 0; j < 4; ++j) { v[j] = *(const f32x4*)(xr + 4 * F.lane + 256 * j); ss += (v[j][0] * v[j][0] + v[j][1] * v[j][1]) + (v[j][2] * v[j][2] + v[j][3] * v[j][3]); }
        const float rstd = rsqrtf(wave_sum(ss) * (1.f / D) + 1e-6f);
#pragma unroll
        for (int j = 0; j < 4; ++j) { const int c = 4 * F.lane + 256 * j; const f32x4 gg = *(const f32x4*)(g + c); *(f32x4*)(xr + c) = v[j] * rstd * gg; }
    }
}

struct EpiAttnIn {
    static constexpr bool PERM = true, AFTER_DRAIN = false;
    bf16* QKV; float* out; const f32x2v* rope;
    __device__ __forceinline__ void operator()(const f32x4 (&acc)[2][2][4][2], const pg8::Unit& u, int wr, int wc, int fr, int fq) const {
        const int pn = u.pn; const bool ctx = u.pm < 32;
        float* cdst = nullptr; int cbase = 0;
        if (ctx) { if (pn == 2 || pn == 3) { cdst = out + O_NAK; cbase = 512; } else if (pn == 4 || pn == 5) { cdst = out + O_NAV; cbase = 1024; }
                   else if (pn == 8 || pn == 9) { cdst = out + O_DFK; cbase = 2048; } else if (pn == 10 || pn == 11) { cdst = out + O_DFV; cbase = 2560; } }
        const bool rope_on = (!ctx) && pn >= 6 && pn <= 9;
        const float sgn = (fq < 2) ? -1.f : 1.f;
        const float one_ = opaque_one();
#pragma unroll
        for (int ai = 0; ai < 2; ++ai)
#pragma unroll
            for (int m = 0; m < 4; ++m) { const int row = u.pm * 256 + ai * 128 + wr * 64 + m * 16 + fr;
#pragma unroll
                for (int bj = 0; bj < 2; ++bj) { const int col = pn * 256 + bj * 128 + wc * 32 + 8 * fq;
                    f32x4 v0 = acc[ai][bj][m][0] * one_, v1 = acc[ai][bj][m][1] * one_;
                    if (rope_on) { const int n = (row - TCX) & 2047; const int p = (wc & 1) ? (n & 63) : (n >> 6); const f32x2v* tb = rope + p * 16 + 8 * (fq & 1);
#pragma unroll
                        for (int e = 0; e < 4; ++e) { const float p0 = __shfl_xor(v0[e], 32), p1 = __shfl_xor(v1[e], 32); const f32x2v c0 = tb[e], c1 = tb[4 + e];
                            v0[e] = v0[e] * c0.x + sgn * p0 * c0.y; v1[e] = v1[e] * c1.x + sgn * p1 * c1.y; } }
                    v4u w; w.x = pg8::cvt_pk_bf16(v0[0], v0[1]); w.y = pg8::cvt_pk_bf16(v0[2], v0[3]); w.z = pg8::cvt_pk_bf16(v1[0], v1[1]); w.w = pg8::cvt_pk_bf16(v1[2], v1[3]);
                    *(v4u*)(QKV + (size_t)row * QLD + col) = w;
                    if (cdst) { float* cp = cdst + (size_t)row * 512 + (col - cbase); *(f32x4*)cp = v0; *(f32x4*)(cp + 4) = v1; } } }
    }
};
struct EpiBf16Plain {
    static constexpr bool PERM = true, AFTER_DRAIN = false;
    bf16* O; int ldc;
    __device__ __forceinline__ void operator()(const f32x4 (&acc)[2][2][4][2], const pg8::Unit& u, int wr, int wc, int fr, int fq) const {
        const float one_ = opaque_one();
#pragma unroll
        for (int ai = 0; ai < 2; ++ai)
#pragma unroll
            for (int m = 0; m < 4; ++m) { const int row = u.pm * 256 + ai * 128 + wr * 64 + m * 16 + fr;
#pragma unroll
                for (int bj = 0; bj < 2; ++bj) { const int col = u.pn * 256 + bj * 128 + wc * 32 + 8 * fq; const f32x4 v0 = acc[ai][bj][m][0] * one_, v1 = acc[ai][bj][m][1] * one_;
                    v4u w; w.x = pg8::cvt_pk_bf16(v0[0], v0[1]); w.y = pg8::cvt_pk_bf16(v0[2], v0[3]); w.z = pg8::cvt_pk_bf16(v1[0], v1[1]); w.w = pg8::cvt_pk_bf16(v1[2], v1[3]);
                    *(v4u*)(O + (size_t)row * ldc + col) = w; } }
    }
};
struct EpiSwiglu {
    static constexpr bool PERM = true, AFTER_DRAIN = false;
    bf16* O;
    __device__ __forceinline__ void operator()(const f32x4 (&acc)[2][2][4][2], const pg8::Unit& u, int wr, int wc, int fr, int fq) const {
#pragma unroll
        for (int ai = 0; ai < 2; ++ai)
#pragma unroll
            for (int m = 0; m < 4; ++m) { const int row = u.pm * 256 + ai * 128 + wr * 64 + m * 16 + fr; const int col = u.pn * 128 + wc * 32 + 8 * fq;
                float r[8];
#pragma unroll
                for (int n = 0; n < 2; ++n)
#pragma unroll
                    for (int e = 0; e < 4; ++e) { const float g = acc[ai][0][m][n][e], up = acc[ai][1][m][n][e]; r[4 * n + e] = g * __builtin_amdgcn_rcpf(1.f + __expf(-g)) * up; }
                v4u w; w.x = pg8::cvt_pk_bf16(r[0], r[1]); w.y = pg8::cvt_pk_bf16(r[2], r[3]); w.z = pg8::cvt_pk_bf16(r[4], r[5]); w.w = pg8::cvt_pk_bf16(r[6], r[7]);
                *(v4u*)(O + (size_t)row * DFF + col) = w; }
    }
};
struct EpiResid {
    static constexpr bool PERM = false, AFTER_DRAIN = false;
    const float* bc; const float* bl; float* X; const float* mod; int gate_i;
    __device__ __forceinline__ void operator()(const f32x4 (&acc)[2][2][4][2], const pg8::Unit& u, int wr, int wc, int fr, int fq) const {
        const int cond = (u.pm < 32) ? 0 : ((u.pm < 40) ? 1 : 2);
        const float* gate = mod + cond * 6144 + gate_i * 1024;
        const float* base = (u.pm < 32) ? bc : bl - (size_t)TCX * D;
        const int col0 = u.pn * 256 + wc * 32 + 4 * fq;
        f32x4 gv[2][2];
#pragma unroll
        for (int bj = 0; bj < 2; ++bj)
#pragma unroll
            for (int n = 0; n < 2; ++n) gv[bj][n] = *(const f32x4*)(gate + col0 + bj * 128 + n * 16);
#pragma unroll
        for (int ai = 0; ai < 2; ++ai)
#pragma unroll
            for (int m = 0; m < 4; ++m) { const size_t off = (size_t)(u.pm * 256 + ai * 128 + wr * 64 + m * 16 + fr) * D + col0;
#pragma unroll
                for (int bj = 0; bj < 2; ++bj)
#pragma unroll
                    for (int n = 0; n < 2; ++n) { const f32x4 b = *(const f32x4*)(base + off + bj * 128 + n * 16); *(f32x4*)(X + off + bj * 128 + n * 16) = b + gv[bj][n] * acc[ai][bj][m][n]; } }
    }
};

#define KEY_STEP(kp, vp, biasv) do { \
    float s_ = 0.f; \
    _Pragma("unroll") for (int c_ = 0; c_ < 8; ++c_) { const v4u kv_ = *(const v4u*)((kp) + 8 * c_); \
        s_ += q[8 * c_ + 0] * bflo(kv_.x) + q[8 * c_ + 1] * bfhi(kv_.x) + q[8 * c_ + 2] * bflo(kv_.y) + q[8 * c_ + 3] * bfhi(kv_.y) \
            + q[8 * c_ + 4] * bflo(kv_.z) + q[8 * c_ + 5] * bfhi(kv_.z) + q[8 * c_ + 6] * bflo(kv_.w) + q[8 * c_ + 7] * bfhi(kv_.w); } \
    s_ = s_ * 0.125f + (biasv); \
    const float mn_ = fmaxf(m, s_), al_ = __expf(m - mn_), p_ = __expf(s_ - mn_); l = l * al_ + p_; m = mn_; \
    _Pragma("unroll") for (int c_ = 0; c_ < 8; ++c_) { const v4u vv_ = *(const v4u*)((vp) + 8 * c_); \
        o[8 * c_ + 0] = o[8 * c_ + 0] * al_ + p_ * bflo(vv_.x); o[8 * c_ + 1] = o[8 * c_ + 1] * al_ + p_ * bfhi(vv_.x); \
        o[8 * c_ + 2] = o[8 * c_ + 2] * al_ + p_ * bflo(vv_.y); o[8 * c_ + 3] = o[8 * c_ + 3] * al_ + p_ * bfhi(vv_.y); \
        o[8 * c_ + 4] = o[8 * c_ + 4] * al_ + p_ * bflo(vv_.z); o[8 * c_ + 5] = o[8 * c_ + 5] * al_ + p_ * bfhi(vv_.z); \
        o[8 * c_ + 6] = o[8 * c_ + 6] * al_ + p_ * bflo(vv_.w); o[8 * c_ + 7] = o[8 * c_ + 7] * al_ + p_ * bfhi(vv_.w); } } while (0)
#define LOAD_Q(qp) do { _Pragma("unroll") for (int c_ = 0; c_ < 8; ++c_) { const v4u qv_ = *(const v4u*)((qp) + 8 * c_); \
        q[8 * c_ + 0] = bflo(qv_.x); q[8 * c_ + 1] = bfhi(qv_.x); q[8 * c_ + 2] = bflo(qv_.y); q[8 * c_ + 3] = bfhi(qv_.y); \
        q[8 * c_ + 4] = bflo(qv_.z); q[8 * c_ + 5] = bfhi(qv_.z); q[8 * c_ + 6] = bflo(qv_.w); q[8 * c_ + 7] = bfhi(qv_.w); } } while (0)

__device__ __forceinline__ void attn_naive_phase(Frame& F) {
    const bf16* QKV = F.P; const float lam = *(const float*)((unsigned char*)F.MOD + MOD_LAM);
    float* DIFFO = F.S; const float* rpb = F.in[17];
    constexpr int ND = 32768, NC = 32768, NB = 65536, NA = 65536, NTASK = ND + NC + NB + NA;
    for (int task = F.bid * NTHR + F.tid; task < NTASK; task += F.G * NTHR) {
        float q[64], o[64]; float m, l;
        if (task < ND || (task >= ND + NC && task < ND + NC + NB)) {
            const bool lat = task < ND; int idx = lat ? task : task - ND - NC;
            int n, b, h, vh;
            if (lat) { n = idx & 2047; idx >>= 11; b = idx & 1; idx >>= 1; h = idx & 3; vh = idx >> 2; }
            else { n = idx & 255; idx >>= 8; b = idx & 31; idx >>= 5; h = idx & 3; vh = idx >> 2; }
            const int row = lat ? TCX + b * 2048 + n : b * 256 + n;
            const int krow0 = lat ? TCX + b * 2048 : b * 256, nk0 = lat ? 2048 : 256, krow1 = T + b * 256, nk1 = lat ? 256 : 0;
            const int vcol = 2560 + h * 128 + vh * 64;
            float o1[64];
#pragma unroll
            for (int c = 0; c < 2; ++c) {
                const int qcol = 1536 + h * 128 + c * 64, kcol = 2048 + h * 128 + c * 64;
                LOAD_Q(QKV + (size_t)row * QLD + qcol);
#pragma unroll
                for (int d = 0; d < 64; ++d) o[d] = 0.f;
                m = -INFINITY; l = 0.f;
                for (int j = 0; j < nk0; ++j) { const bf16* kr = QKV + (size_t)(krow0 + j) * QLD; KEY_STEP(kr + kcol, kr + vcol, 0.f); }
                for (int j = 0; j < nk1; ++j) { const bf16* kr = QKV + (size_t)(krow1 + j) * QLD; KEY_STEP(kr + kcol, kr + vcol, 0.f); }
                const float il = 1.f / l;
                if (c == 0) {
#pragma unroll
                    for (int d = 0; d < 64; ++d) o1[d] = o[d] * il;
                } else {
                    float* dst = DIFFO + (size_t)row * 512 + h * 128 + vh * 64;
#pragma unroll
                    for (int d = 0; d < 64; d += 4) *(f32x4*)(dst + d) = (f32x4){o1[d] - lam * o[d] * il, o1[d + 1] - lam * o[d + 1] * il, o1[d + 2] - lam * o[d + 2] * il, o1[d + 3] - lam * o[d + 3] * il};
                }
            }
        } else {
            const bool lat = task < ND + NC; int idx = lat ? task - ND : task - ND - NC - NB;
            int n, b, h;
            if (lat) { n = idx & 2047; idx >>= 11; b = idx & 1; h = idx >> 1; } else { n = idx & 255; idx >>= 8; b = idx & 31; h = idx >> 5; }
            const int row = lat ? TCX + b * 2048 + n : b * 256 + n;
            const int kcol = 512 + h * 64, vcol = 1024 + h * 64;
            LOAD_Q(QKV + (size_t)row * QLD + h * 64);
#pragma unroll
            for (int d = 0; d < 64; ++d) o[d] = 0.f;
            m = -INFINITY; l = 0.f;
            if (lat) {
                const int r = n >> 6, qc = n & 63; const int rs = min(max(r - 4, 0), 24), cs = min(max(qc - 8, 0), 48);
                for (int i = 0; i < 8; ++i) for (int cc = 0; cc < 16; ++cc) { const int kr_ = rs + i, kc = cs + cc;
                    const bf16* kr = QKV + (size_t)(TCX + b * 2048 + kr_ * 64 + kc) * QLD; const float bias = rpb[h * 465 + (kr_ - r + 7) * 31 + (kc - qc + 15)];
                    KEY_STEP(kr + kcol, kr + vcol, bias); }
                for (int j = 0; j < 256; ++j) { const bf16* kr = QKV + (size_t)(T + b * 256 + j) * QLD; KEY_STEP(kr + kcol, kr + vcol, 0.f); }
            } else {
                for (int j = 0; j < 256; ++j) { const bf16* kr = QKV + (size_t)(b * 256 + j) * QLD; KEY_STEP(kr + kcol, kr + vcol, 0.f); }
            }
            const float il = 1.f / l; bf16* dst = F.MIX + (size_t)row * D + h * 64;
#pragma unroll
            for (int d = 0; d < 64; d += 8) { v4u w; w.x = pk2(o[d] * il, o[d + 1] * il); w.y = pk2(o[d + 2] * il, o[d + 3] * il); w.z = pk2(o[d + 4] * il, o[d + 5] * il); w.w = pk2(o[d + 6] * il, o[d + 7] * il); *(v4u*)(dst + d) = w; }
        }
    }
}
__device__ __forceinline__ void diff_post_phase(Frame& F) {
    const int gw = F.bid * NWAVES + F.wave, NGW = F.G * NWAVES; const float* DIFFO = F.S;
    for (int it = gw; it < T * 4; it += NGW) { const int row = it >> 2, h = it & 3;
        const f32x2v v = *(const f32x2v*)(DIFFO + (size_t)row * 512 + h * 128 + 2 * F.lane);
        const float r = rsqrtf(wave_sum(v.x * v.x + v.y * v.y) * (1.f / 128.f) + 1e-6f) * 0.8f;
        *(unsigned*)(F.MIX + (size_t)row * D + 512 + h * 128 + 2 * F.lane) = pk2(v.x * r, v.y * r); }
}

typedef short bf16x8 __attribute__((ext_vector_type(8)));
typedef short s16x4 __attribute__((ext_vector_type(4)));
constexpr float LOG2E = 1.4426950408889634f;
__device__ __forceinline__ s16x4 tr_read(LAS unsigned char* p) { return __builtin_bit_cast(s16x4, __builtin_amdgcn_ds_read_tr16_b64_v4i16((LAS s16x4*)p)); }

template <int KIND>
__device__ __forceinline__ void attn_unit(Frame& F, int u) {
    constexpr bool DIFF = (KIND & 1) != 0;
    constexpr int DV = DIFF ? 128 : 64, NC = DV / 16, VSTR = DIFF ? 288 : 160, KSTR = 144;
    constexpr int K0_OFF = 0, K1_OFF = 9216, V_OFF = 18432, X_OFF = 40960, XSTR = 132, RPB_OFF = 110592;
    const int tid = F.tid, lane = F.lane, wave = F.wave, q16 = lane & 15, g = lane >> 4;
    LAS unsigned char* lds = F.lds;
    const bf16* QKV = F.P;
    int b, h, qrow0, ntiles, nW = 0, R0k = 0;
    if (KIND == 0) { b = u >> 3; h = u & 7; qrow0 = b * 256; ntiles = 4; }
    else if (KIND == 1) { const int half = u & 1; h = (u >> 1) & 3; b = u >> 3; qrow0 = b * 256 + half * 128; ntiles = 4; }
    else if (KIND == 2) { const int R = u & 7; h = (u >> 3) & 7; b = u >> 6; qrow0 = TCX + b * 2048 + R * 256; R0k = min(max(4 * R - 4, 0), 24); nW = min(max(4 * R - 1, 0), 24) + 8 - R0k; ntiles = nW + 4; }
    else { const int qb = u & 15; h = (u >> 4) & 3; b = u >> 6; qrow0 = TCX + b * 2048 + qb * 128; ntiles = 36; }
    const int sidx = DIFF ? (wave >> 2) : 0;
    const int wq = DIFF ? (wave & 3) * 32 : wave * 32;
    const int qcol = DIFF ? 1536 + h * 128 + sidx * 64 : h * 64;
    const int kcol0 = DIFF ? 2048 + h * 128 : 512 + h * 64;
    const int vcol = DIFF ? 2560 + h * 128 : 1024 + h * 64;
#define KROW(ti) ((KIND <= 1) ? (b * 256 + 64 * (ti)) : (KIND == 2) ? (((ti) < nW) ? (TCX + b * 2048 + (R0k + (ti)) * 64) : (T + b * 256 + 64 * ((ti) - nW))) : (((ti) < 32) ? (TCX + b * 2048 + 64 * (ti)) : (T + b * 256 + 64 * ((ti) - 32))))
    v4u rk0, rk1, rv0, rv1;
#define LOAD_TILE(ti) do { const bf16* rp_ = QKV + (size_t)(KROW(ti) + (tid >> 3)) * QLD + 8 * (tid & 7); rk0 = *(const v4u*)(rp_ + kcol0); rv0 = *(const v4u*)(rp_ + vcol); \
        if (DIFF) { rk1 = *(const v4u*)(rp_ + kcol0 + 64); rv1 = *(const v4u*)(rp_ + vcol + 64); } } while (0)
#define STORE_TILE() do { const int row_ = tid >> 3, ch_ = tid & 7; const int prow_ = (row_ & 39) | ((row_ & 8) << 1) | ((row_ & 16) >> 1); \
        *(LAS v4u*)(lds + K0_OFF + prow_ * KSTR + ch_ * 16) = rk0; *(LAS v4u*)(lds + V_OFF + row_ * VSTR + ch_ * 16) = rv0; \
        if (DIFF) { *(LAS v4u*)(lds + K1_OFF + prow_ * KSTR + ch_ * 16) = rk1; *(LAS v4u*)(lds + V_OFF + row_ * VSTR + 128 + ch_ * 16) = rv1; } } while (0)
    LAS float* rpbL = (LAS float*)(lds + RPB_OFF);
    if (KIND == 2) { __syncthreads(); if (tid < 465) rpbL[tid] = F.in[17][h * 465 + tid] * LOG2E; }
    bf16x8 qf[2][2];
#pragma unroll
    for (int grp = 0; grp < 2; ++grp)
#pragma unroll
        for (int kd = 0; kd < 2; ++kd) qf[grp][kd] = *(const bf16x8*)(QKV + (size_t)(qrow0 + wq + 16 * grp + q16) * QLD + qcol + 32 * kd + 8 * g);
    f32x4 o[2][NC];
#pragma unroll
    for (int grp = 0; grp < 2; ++grp)
#pragma unroll
        for (int c = 0; c < NC; ++c) o[grp][c] = (f32x4){0.f, 0.f, 0.f, 0.f};
    float mrun[2] = {-1e30f, -1e30f}, lsum[2] = {0.f, 0.f};
    const int wr_ = (KIND == 2) ? (((qrow0 - TCX) & 2047) >> 6) + (wave >> 1) : 0;
    const int wrs = min(max(wr_ - 4, 0), 24);
    const int koff = (DIFF && sidx) ? K1_OFF : K0_OFF;
    constexpr float C1 = 0.125f * LOG2E;
    LOAD_TILE(0);
    for (int ti = 0; ti < ntiles; ++ti) {
        __syncthreads();
        STORE_TILE();
        __syncthreads();
        if (ti + 1 < ntiles) LOAD_TILE(ti + 1);
        bool active = true; int krow_g = 0; bool win = false;
        if (KIND == 2) { win = ti < nW; krow_g = R0k + ti; active = (!win) || (krow_g >= wrs && krow_g < wrs + 8); }
        if (active) {
            f32x4 s[2][2][2];
#pragma unroll
            for (int ks = 0; ks < 2; ++ks)
#pragma unroll
                for (int t = 0; t < 2; ++t) {
                    s[0][ks][t] = (f32x4){0.f, 0.f, 0.f, 0.f}; s[1][ks][t] = (f32x4){0.f, 0.f, 0.f, 0.f};
#pragma unroll
                    for (int kd = 0; kd < 2; ++kd) { const bf16x8 kf = *(const LAS bf16x8*)(lds + koff + (32 * ks + 16 * t + q16) * KSTR + 64 * kd + 16 * g);
                        s[0][ks][t] = __builtin_amdgcn_mfma_f32_16x16x32_bf16(kf, qf[0][kd], s[0][ks][t], 0, 0, 0);
                        s[1][ks][t] = __builtin_amdgcn_mfma_f32_16x16x32_bf16(kf, qf[1][kd], s[1][ks][t], 0, 0, 0); }
                }
            bf16x8 pf[2][2];
#pragma unroll
            for (int grp = 0; grp < 2; ++grp) {
                float tv[2][2][4];
                if (KIND == 2 && win) {
                    const int qc = (wave & 1) * 32 + 16 * grp + q16, cs = min(max(qc - 8, 0), 48); const LAS float* brow = rpbL + (krow_g - wr_ + 7) * 31 + 15 - qc;
#pragma unroll
                    for (int ks = 0; ks < 2; ++ks)
#pragma unroll
                        for (int t = 0; t < 2; ++t)
#pragma unroll
                            for (int e = 0; e < 4; ++e) { const int kc = 32 * ks + 16 * (g >> 1) + 8 * t + 4 * (g & 1) + e; const bool ok = (unsigned)(kc - cs) < 16u; const float bv_ = brow[ok ? kc : qc];
                                tv[ks][t][e] = ok ? s[grp][ks][t][e] * C1 + bv_ : -1e30f; }
                } else {
#pragma unroll
                    for (int ks = 0; ks < 2; ++ks)
#pragma unroll
                        for (int t = 0; t < 2; ++t)
#pragma unroll
                            for (int e = 0; e < 4; ++e) tv[ks][t][e] = s[grp][ks][t][e] * C1;
                }
                float tmax = -1e30f;
#pragma unroll
                for (int ks = 0; ks < 2; ++ks)
#pragma unroll
                    for (int t = 0; t < 2; ++t)
#pragma unroll
                        for (int e = 0; e < 4; ++e) tmax = fmaxf(tmax, tv[ks][t][e]);
                tmax = fmaxf(tmax, __shfl_xor(tmax, 16)); tmax = fmaxf(tmax, __shfl_xor(tmax, 32));
                const float mn = fmaxf(mrun[grp], tmax), al = __builtin_amdgcn_exp2f(mrun[grp] - mn); mrun[grp] = mn;
                float ps = 0.f;
#pragma unroll
                for (int ks = 0; ks < 2; ++ks) {
                    float p[8];
#pragma unroll
                    for (int t = 0; t < 2; ++t)
#pragma unroll
                        for (int e = 0; e < 4; ++e) { p[4 * t + e] = __builtin_amdgcn_exp2f(tv[ks][t][e] - mn); ps += p[4 * t + e]; }
                    v4u w; w.x = pg8::cvt_pk_bf16(p[0], p[1]); w.y = pg8::cvt_pk_bf16(p[2], p[3]); w.z = pg8::cvt_pk_bf16(p[4], p[5]); w.w = pg8::cvt_pk_bf16(p[6], p[7]);
                    pf[grp][ks] = __builtin_bit_cast(bf16x8, w);
                }
                lsum[grp] = lsum[grp] * al + ps;
#pragma unroll
                for (int c = 0; c < NC; ++c) o[grp][c] = o[grp][c] * al;
            }
#pragma unroll
            for (int ks = 0; ks < 2; ++ks)
#pragma unroll
                for (int c = 0; c < NC; ++c) {
                    LAS unsigned char* vb = lds + V_OFF + (32 * ks + 16 * (g >> 1) + 4 * (g & 1) + (q16 >> 2)) * VSTR + (16 * c + 4 * (lane & 3)) * 2;
                    const s16x4 v0 = tr_read(vb), v1 = tr_read(vb + 8 * VSTR);
                    const bf16x8 vf = (bf16x8){v0[0], v0[1], v0[2], v0[3], v1[0], v1[1], v1[2], v1[3]};
                    o[0][c] = __builtin_amdgcn_mfma_f32_16x16x32_bf16(vf, pf[0][ks], o[0][c], 0, 0, 0);
                    o[1][c] = __builtin_amdgcn_mfma_f32_16x16x32_bf16(vf, pf[1][ks], o[1][c], 0, 0, 0);
                }
        }
    }
    float inv[2];
#pragma unroll
    for (int grp = 0; grp < 2; ++grp) { float l = lsum[grp]; l += __shfl_xor(l, 16); l += __shfl_xor(l, 32); inv[grp] = 1.f / l; }
    if (!DIFF) {
#pragma unroll
        for (int grp = 0; grp < 2; ++grp) { bf16* dst = F.MIX + (size_t)(qrow0 + wq + 16 * grp + q16) * D + h * 64 + 4 * g;
#pragma unroll
            for (int c = 0; c < NC; ++c) { const f32x4 v = o[grp][c] * inv[grp]; v2u w; w.x = pg8::cvt_pk_bf16(v[0], v[1]); w.y = pg8::cvt_pk_bf16(v[2], v[3]); *(v2u*)(dst + 16 * c) = w; } }
    } else {
        const float lam = *(const float*)((unsigned char*)F.MOD + MOD_LAM);
        LAS float* X = (LAS float*)(lds + X_OFF);
        if (sidx == 1) {
#pragma unroll
            for (int grp = 0; grp < 2; ++grp)
#pragma unroll
                for (int c = 0; c < NC; ++c) *(LAS f32x4*)(X + (wq + 16 * grp + q16) * XSTR + 16 * c + 4 * g) = o[grp][c] * inv[grp];
        }
        __syncthreads();
        if (sidx == 0) {
#pragma unroll
            for (int grp = 0; grp < 2; ++grp) {
                float ss = 0.f;
#pragma unroll
                for (int c = 0; c < NC; ++c) { const f32x4 x2 = *(const LAS f32x4*)(X + (wq + 16 * grp + q16) * XSTR + 16 * c + 4 * g); o[grp][c] = o[grp][c] * inv[grp] - x2 * lam;
                    ss += (o[grp][c][0] * o[grp][c][0] + o[grp][c][1] * o[grp][c][1]) + (o[grp][c][2] * o[grp][c][2] + o[grp][c][3] * o[grp][c][3]); }
                ss += __shfl_xor(ss, 16); ss += __shfl_xor(ss, 32);
                const float r = rsqrtf(ss * (1.f / 128.f) + 1e-6f) * 0.8f;
                bf16* dst = F.MIX + (size_t)(qrow0 + wq + 16 * grp + q16) * D + 512 + h * 128 + 4 * g;
#pragma unroll
                for (int c = 0; c < NC; ++c) { const f32x4 v = o[grp][c] * r; v2u w; w.x = pg8::cvt_pk_bf16(v[0], v[1]); w.y = pg8::cvt_pk_bf16(v[2], v[3]); *(v2u*)(dst + 16 * c) = w; }
            }
        }
    }
#undef KROW
#undef LOAD_TILE
#undef STORE_TILE
}
__device__ __forceinline__ void attn_mfma_phase(Frame& F) {
    if (F.G == 256) {
        if (F.bid < 128) attn_unit<3>(F, F.bid);
        else { const int i = F.bid - 128; attn_unit<2>(F, i); attn_unit<1>(F, 2 * i); attn_unit<1>(F, 2 * i + 1); attn_unit<0>(F, 2 * i); attn_unit<0>(F, 2 * i + 1); }
    } else {
        for (int i = F.bid; i < 768; i += F.G) { if (i < 128) attn_unit<3>(F, i); else if (i < 256) attn_unit<2>(F, i - 128); else if (i < 512) attn_unit<1>(F, i - 256); else attn_unit<0>(F, i - 512); }
    }
}

__device__ __forceinline__ void rwkv_job(Frame& F, int seq, int h, int dir) {
    LAS float* L = (LAS float*)F.lds;
    LAS float *WUP = L, *AUP = L + 4096, *Lr = L + 8192, *Lk = Lr + 1024, *Lv = Lk + 1024, *Lwd = Lv + 1024, *Lad = Lwd + 1024, *Lw = Lad + 1024, *La = Lw + 1024, *Lkk = La + 1024, *Lkef = Lkk + 1024, *Lb = Lkef + 1024, *Ly = Lb + 1024;
    const int tid = F.tid, lane = F.lane, w = F.wave;
    const bool lat = seq >= 32; const int b = lat ? seq - 32 : seq, N = lat ? 2048 : 256, R0 = lat ? TCX + b * 2048 : b * 256;
    const bf16* PROJ = F.P; float* Y = F.S;
    __syncthreads();
    for (int idx = tid; idx < 4096; idx += NTHR) { const int j = idx >> 6, k = idx & 63; WUP[idx] = F.in[26][(size_t)(dir * 64 + j) * 512 + h * 64 + k]; AUP[idx] = F.in[28][(size_t)(dir * 64 + j) * 512 + h * 64 + k]; }
    const int i = 8 * w + (lane >> 3), s = lane & 7;
    float S[8];
    {
        const float* st = F.in[7] + (size_t)((b * 2 + dir) * 8 + h) * 4096 + i * 64 + 8 * s;
#pragma unroll
        for (int kk = 0; kk < 8; ++kk) S[kk] = lat ? st[kk] : 0.f;
    }
    for (int t0 = 0; t0 < N; t0 += 16) {
#pragma unroll
        for (int rep = 0; rep < 2; ++rep) { const int idx = tid + NTHR * rep, j = idx >> 6, k = idx & 63; const int n = dir ? N - 1 - (t0 + j) : t0 + j;
            const bf16* pr = PROJ + (size_t)(R0 + n) * NREC;
            Lr[idx] = bf1(pr[2048 + h * 64 + k]); Lk[idx] = bf1(pr[2560 + h * 64 + k]); Lv[idx] = bf1(pr[3072 + h * 64 + k]); Lwd[idx] = tanhf(bf1(pr[3584 + k])); Lad[idx] = bf1(pr[3648 + k]); }
        __syncthreads();
#pragma unroll
        for (int rep = 0; rep < 2; ++rep) { const int idx = tid + NTHR * rep, j = idx >> 6, k = idx & 63;
            float zw = F.in[25][dir * 512 + h * 64 + k], za = F.in[27][dir * 512 + h * 64 + k];
#pragma unroll 8
            for (int jj = 0; jj < 64; ++jj) { zw += Lwd[j * 64 + jj] * WUP[jj * 64 + k]; za += Lad[j * 64 + jj] * AUP[jj * 64 + k]; }
            Lw[idx] = __expf(-0.6065306597f * sigmoidf_(zw)); La[idx] = sigmoidf_(za); }
        if (tid < 256) { const int j = tid >> 4, p = tid & 15; float v[4]; float ss = 0.f;
#pragma unroll
            for (int e = 0; e < 4; ++e) { v[e] = Lk[j * 64 + 4 * p + e] * F.in[30][h * 64 + 4 * p + e]; ss += v[e] * v[e]; }
            ss += __shfl_xor(ss, 1); ss += __shfl_xor(ss, 2); ss += __shfl_xor(ss, 4); ss += __shfl_xor(ss, 8);
            const float rs = rsqrtf(ss + 1e-12f);
#pragma unroll
            for (int e = 0; e < 4; ++e) Lkk[j * 64 + 4 * p + e] = v[e] * rs; }
        __syncthreads();
#pragma unroll
        for (int rep = 0; rep < 2; ++rep) { const int idx = tid + NTHR * rep, k = idx & 63; const float a = La[idx];
            Lkef[idx] = Lk[idx] * (1.f + (a - 1.f) * F.in[31][h * 64 + k]); Lb[idx] = Lkk[idx] * a; }
        __syncthreads();
        for (int j = 0; j < 16; ++j) {
            const int o8 = j * 64 + 8 * s;
            float sa = 0.f;
#pragma unroll
            for (int kk = 0; kk < 8; ++kk) sa -= S[kk] * Lkk[o8 + kk];
            sa += __shfl_xor(sa, 1); sa += __shfl_xor(sa, 2); sa += __shfl_xor(sa, 4);
            const float vi = Lv[j * 64 + i];
            float y = 0.f;
#pragma unroll
            for (int kk = 0; kk < 8; ++kk) { S[kk] = S[kk] * Lw[o8 + kk] + sa * Lb[o8 + kk] + vi * Lkef[o8 + kk]; y += S[kk] * Lr[o8 + kk]; }
            y += __shfl_xor(y, 1); y += __shfl_xor(y, 2); y += __shfl_xor(y, 4);
            if (s == 0) Ly[j * 64 + i] = y;
        }
        __syncthreads();
#pragma unroll
        for (int rep = 0; rep < 2; ++rep) { const int idx = tid + NTHR * rep, j = idx >> 6, k = idx & 63; const int n = dir ? N - 1 - (t0 + j) : t0 + j;
            atomicAdd(Y + (size_t)(R0 + n) * 512 + h * 64 + k, Ly[idx]); }
    }
    if (!lat) { float* so = F.out + O_SRW + (size_t)((b * 2 + dir) * 8 + h) * 4096 + i * 64 + 8 * s;
#pragma unroll
        for (int kk = 0; kk < 8; ++kk) so[kk] = S[kk]; }
}
__device__ __forceinline__ void ret_job(Frame& F, int seq, int h, int dir) {
    LAS float* L = (LAS float*)F.lds;
    LAS float *Lq = L, *Lk = L + 1024, *Lv = L + 2048, *Lo = L + 3072;
    const int tid = F.tid, lane = F.lane, w = F.wave;
    const bool lat = seq >= 32; const int b = lat ? seq - 32 : seq, N = lat ? 2048 : 256, R0 = lat ? TCX + b * 2048 : b * 256;
    const bf16* PROJ = F.P; float* O = F.S + (size_t)T * 512;
    const float g = sigmoidf_(F.in[24][dir * 8 + h]);
    const int e = 8 * w + (lane >> 3), s = lane & 7;
    float S[8];
    {
        const float* st = F.in[6] + (size_t)((b * 2 + dir) * 8 + h) * 4096;
#pragma unroll
        for (int dd = 0; dd < 8; ++dd) S[dd] = lat ? st[(8 * s + dd) * 64 + e] : 0.f;
    }
    __syncthreads();
    for (int t0 = 0; t0 < N; t0 += 16) {
#pragma unroll
        for (int rep = 0; rep < 2; ++rep) { const int idx = tid + NTHR * rep, j = idx >> 6, k = idx & 63; const int n = dir ? N - 1 - (t0 + j) : t0 + j;
            const bf16* pr = PROJ + (size_t)(R0 + n) * NREC;
            Lq[idx] = bf1(pr[h * 64 + k]); Lk[idx] = bf1(pr[512 + h * 64 + k]) * 0.125f; Lv[idx] = bf1(pr[1024 + h * 64 + k]); }
        __syncthreads();
        for (int j = 0; j < 16; ++j) {
            const int o8 = j * 64 + 8 * s; const float ve = Lv[j * 64 + e];
            float o = 0.f;
#pragma unroll
            for (int dd = 0; dd < 8; ++dd) { S[dd] = g * S[dd] + Lk[o8 + dd] * ve; o += Lq[o8 + dd] * S[dd]; }
            o += __shfl_xor(o, 1); o += __shfl_xor(o, 2); o += __shfl_xor(o, 4);
            if (s == 0) Lo[j * 64 + e] = o;
        }
        __syncthreads();
#pragma unroll
        for (int rep = 0; rep < 2; ++rep) { const int idx = tid + NTHR * rep, j = idx >> 6, k = idx & 63; const int n = dir ? N - 1 - (t0 + j) : t0 + j;
            atomicAdd(O + (size_t)(R0 + n) * 512 + h * 64 + k, Lo[idx]); }
        __syncthreads();
    }
    if (!lat) { float* so = F.out + O_SRET + (size_t)((b * 2 + dir) * 8 + h) * 4096;
#pragma unroll
        for (int dd = 0; dd < 8; ++dd) so[(8 * s + dd) * 64 + e] = S[dd]; }
}
__device__ __forceinline__ void run_job(Frame& F, int J) {
    int type, seq, h, dir;
    if (J < 64) { type = J >> 5; const int r = J & 31; seq = 32 + (r >> 4); h = (r >> 1) & 7; dir = r & 1; }
    else { const int r = J - 64; type = r >> 9; const int q = r & 511; seq = q >> 4; h = (q >> 1) & 7; dir = q & 1; }
    if (type == 0) rwkv_job(F, seq, h, dir); else ret_job(F, seq, h, dir);
}
__device__ __forceinline__ void scan_phase(Frame& F) {
    if (F.G > 128) { if (F.bid < 64) run_job(F, F.bid); else for (int J = 64 + (F.bid - 64); J < 1088; J += F.G - 64) run_job(F, J); }
    else for (int J = F.bid; J < 1088; J += F.G) run_job(F, J);
}
__device__ __forceinline__ void rec_post_phase(Frame& F) {
    LAS float* sg = (LAS float*)F.lds + F.wave * 128;
    const int gw = F.bid * NWAVES + F.wave, NGW = F.G * NWAVES, lane = F.lane;
    const bf16* PROJ = F.P; const float* Y = F.S; const float* O = F.S + (size_t)T * 512;
    for (int row = gw; row < T; row += NGW) {
        const bf16* pr = PROJ + (size_t)row * NREC;
        sg[lane] = sigmoidf_(bf1(pr[3712 + lane])); sg[64 + lane] = sigmoidf_(bf1(pr[3776 + lane]));
        asm volatile("s_waitcnt lgkmcnt(0)" ::: "memory");
        for (int h = 0; h < 8; ++h) {
            const int c = h * 64 + lane;
            const float y = Y[(size_t)row * 512 + c];
            const float mu = wave_sum(y) * (1.f / 64.f), dl = y - mu, var = wave_sum(dl * dl) * (1.f / 64.f);
            const float yn = dl * rsqrtf(var + 64e-5f) * F.in[33][c] + F.in[34][c];
            const float r = bf1(pr[2048 + c]), k = bf1(pr[2560 + c]), v = bf1(pr[3072 + c]);
            const float bonus = wave_sum(r * F.in[32][c] * k) * v;
            float g = 0.f;
#pragma unroll 8
            for (int j = 0; j < 128; ++j) g += sg[j] * F.in[29][(size_t)j * 512 + c];
            F.MIX[(size_t)row * D + 512 + c] = (bf16)f2bf((yn + bonus) * g);
        }
        for (int h = 0; h < 8; ++h) {
            const int c = h * 64 + lane;
            const float o = O[(size_t)row * 512 + c];
            const float on = o * rsqrtf(wave_sum(o * o) * (1.f / 64.f) + 1e-6f);
            const float xg = bf1(pr[1536 + c]);
            F.MIX[(size_t)row * D + c] = (bf16)f2bf(xg * sigmoidf_(xg) * on);
        }
        asm volatile("s_waitcnt lgkmcnt(0)" ::: "memory");
    }
}

#define DPP_F(v, ctrl) __int_as_float(__builtin_amdgcn_mov_dpp(__float_as_int(v), (ctrl), 0xf, 0xf, true))
template <int NSL> __device__ __forceinline__ float row_reduce(float v) {
    v += DPP_F(v, 0xB1); v += DPP_F(v, 0x4E); v += DPP_F(v, 0x141); if (NSL == 16) v += DPP_F(v, 0x140); return v;
}
__device__ __forceinline__ void unpack8(const v4u r, float (&f)[8]) { f[0] = bflo(r.x); f[1] = bfhi(r.x); f[2] = bflo(r.y); f[3] = bfhi(r.y); f[4] = bflo(r.z); f[5] = bfhi(r.z); f[6] = bflo(r.w); f[7] = bfhi(r.w); }
__device__ __forceinline__ v4u pack8(const float (&f)[8]) { v4u w; w.x = pg8::cvt_pk_bf16(f[0], f[1]); w.y = pg8::cvt_pk_bf16(f[2], f[3]); w.z = pg8::cvt_pk_bf16(f[4], f[5]); w.w = pg8::cvt_pk_bf16(f[6], f[7]); return w; }

template <int NSL>
__device__ __forceinline__ void rwkv_job2(Frame& F, int seq, int h, int dir, int row0) {
    constexpr int KPT = 64 / NSL, ROWS = 512 / NSL, TCH = 32;
    constexpr int WUPT = 0, AUPT = 9216, TWO = 18432, TAO = 23040, F0 = 27648;
    LAS unsigned char* lds = F.lds;
    LAS float *Lr = (LAS float*)(lds + F0), *Lk = Lr + 2048, *Lv = Lk + 2048, *Lw = Lv + 2048, *La = Lw + 2048, *Lnk = La + 2048, *Lkef = Lnk + 2048, *Lb = Lkef + 2048, *Ly = Lb + 2048;
    const int tid = F.tid, lane = F.lane, wave = F.wave, q16 = lane & 15, g = lane >> 4;
    const bool lat = seq >= 32; const int b = lat ? seq - 32 : seq, N = lat ? 2048 : 256, R0 = lat ? TCX + b * 2048 : b * 256;
    const bf16* PROJ = F.P; float* Y = F.S;
    __syncthreads();
    for (int idx = tid; idx < 4096; idx += NTHR) { const int j = idx >> 6, k = idx & 63;
        *(LAS bf16*)(lds + WUPT + k * 144 + j * 2) = (bf16)f2bf(F.in[26][(size_t)(dir * 64 + j) * 512 + h * 64 + k]);
        *(LAS bf16*)(lds + AUPT + k * 144 + j * 2) = (bf16)f2bf(F.in[28][(size_t)(dir * 64 + j) * 512 + h * 64 + k]); }
    const int rowl = tid / NSL, sl = tid % NSL, irow = row0 + rowl;
    float S[KPT];
    {
        const float* st = F.in[7] + (size_t)((b * 2 + dir) * 8 + h) * 4096 + irow * 64 + KPT * sl;
#pragma unroll
        for (int kk = 0; kk < KPT; ++kk) S[kk] = lat ? st[kk] : 0.f;
    }
    const int ep = tid & 15, etok = tid >> 4;
    f32x4 ckk, cka;
#pragma unroll
    for (int e = 0; e < 4; ++e) { ckk[e] = F.in[30][h * 64 + 4 * ep + e]; cka[e] = F.in[31][h * 64 + 4 * ep + e]; }
    const int mat = wave >> 2, ct = wave & 3;
    const float zbias = (mat ? F.in[27] : F.in[25])[dir * 512 + h * 64 + 16 * ct + q16];
    for (int t0 = 0; t0 < N; t0 += TCH) {
        for (int idx = tid; idx < 1280; idx += NTHR) { const int tok = idx / 40, rem = idx - tok * 40, seg = rem >> 3, ch = rem & 7; const int n = dir ? N - 1 - (t0 + tok) : t0 + tok;
            const int col = (seg == 0) ? 2048 + h * 64 : (seg == 1) ? 2560 + h * 64 : (seg == 2) ? 3072 + h * 64 : (seg == 3) ? 3584 : 3648;
            const v4u raw = *(const v4u*)(PROJ + (size_t)(R0 + n) * NREC + col + 8 * ch);
            if (seg < 3) { float f[8]; unpack8(raw, f); LAS float* dst = ((seg == 0) ? Lr : (seg == 1) ? Lk : Lv) + tok * 64 + 8 * ch; *(LAS f32x4*)dst = (f32x4){f[0], f[1], f[2], f[3]}; *(LAS f32x4*)(dst + 4) = (f32x4){f[4], f[5], f[6], f[7]}; }
            else if (seg == 3) { float f[8]; unpack8(raw, f);
#pragma unroll
                for (int e = 0; e < 8; ++e) f[e] = 1.f - 2.f / (1.f + __expf(2.f * f[e]));
                *(LAS v4u*)(lds + TWO + tok * 144 + ch * 16) = pack8(f); }
            else *(LAS v4u*)(lds + TAO + tok * 144 + ch * 16) = raw; }
        __syncthreads();
        {
            f32x4 z[2] = {(f32x4){0.f, 0.f, 0.f, 0.f}, (f32x4){0.f, 0.f, 0.f, 0.f}};
#pragma unroll
            for (int kd = 0; kd < 2; ++kd) { const bf16x8 bfr = *(const LAS bf16x8*)(lds + (mat ? AUPT : WUPT) + (16 * ct + q16) * 144 + 64 * kd + 16 * g);
#pragma unroll
                for (int rt = 0; rt < 2; ++rt) { const bf16x8 afr = *(const LAS bf16x8*)(lds + (mat ? TAO : TWO) + (16 * rt + q16) * 144 + 64 * kd + 16 * g);
                    z[rt] = __builtin_amdgcn_mfma_f32_16x16x32_bf16(afr, bfr, z[rt], 0, 0, 0); } }
#pragma unroll
            for (int rt = 0; rt < 2; ++rt)
#pragma unroll
                for (int e = 0; e < 4; ++e) { const int tok = 16 * rt + 4 * g + e; const float sg = sigmoidf_(z[rt][e] + zbias);
                    if (mat) La[tok * 64 + 16 * ct + q16] = sg; else Lw[tok * 64 + 16 * ct + q16] = __expf(-0.6065306597f * sg); }
        }
        __syncthreads();
        {
            const f32x4 kv = *(const LAS f32x4*)(Lk + etok * 64 + 4 * ep), av = *(const LAS f32x4*)(La + etok * 64 + 4 * ep);
            const f32x4 kr = kv * ckk; float ss = (kr[0] * kr[0] + kr[1] * kr[1]) + (kr[2] * kr[2] + kr[3] * kr[3]);
            ss = row_reduce<16>(ss);
            const float rs = rsqrtf(ss + 1e-12f);
            const f32x4 kkv = kr * rs;
            *(LAS f32x4*)(Lnk + etok * 64 + 4 * ep) = -kkv;
            *(LAS f32x4*)(Lb + etok * 64 + 4 * ep) = kkv * av;
            *(LAS f32x4*)(Lkef + etok * 64 + 4 * ep) = kv * (1.f + (av - 1.f) * cka);
        }
        __syncthreads();
#pragma unroll 2
        for (int j = 0; j < TCH; ++j) {
            const int o8 = j * 64 + KPT * sl;
            float nk[KPT], wv[KPT], bv[KPT], ke[KPT], rv[KPT];
#pragma unroll
            for (int q4 = 0; q4 < KPT; q4 += 4) { const f32x4 a0 = *(const LAS f32x4*)(Lnk + o8 + q4), a1 = *(const LAS f32x4*)(Lw + o8 + q4), a2 = *(const LAS f32x4*)(Lb + o8 + q4), a3 = *(const LAS f32x4*)(Lkef + o8 + q4), a4 = *(const LAS f32x4*)(Lr + o8 + q4);
#pragma unroll
                for (int e = 0; e < 4; ++e) { nk[q4 + e] = a0[e]; wv[q4 + e] = a1[e]; bv[q4 + e] = a2[e]; ke[q4 + e] = a3[e]; rv[q4 + e] = a4[e]; } }
            const float vi = Lv[j * 64 + irow];
            float sa = 0.f;
#pragma unroll
            for (int kk = 0; kk < KPT; ++kk) sa += S[kk] * nk[kk];
            sa = row_reduce<NSL>(sa);
            float y = 0.f;
#pragma unroll
            for (int kk = 0; kk < KPT; ++kk) { S[kk] = S[kk] * wv[kk] + (sa * bv[kk] + vi * ke[kk]); y += S[kk] * rv[kk]; }
            y = row_reduce<NSL>(y);
            if (sl == 0) Ly[j * 64 + rowl] = y;
        }
        __syncthreads();
        for (int idx = tid; idx < TCH * ROWS; idx += NTHR) { const int tok = idx / ROWS, i = idx % ROWS; const int n = dir ? N - 1 - (t0 + tok) : t0 + tok;
            atomicAdd(Y + (size_t)(R0 + n) * 512 + h * 64 + row0 + i, Ly[tok * 64 + i]); }
    }
    if (!lat) { float* so = F.out + O_SRW + (size_t)((b * 2 + dir) * 8 + h) * 4096 + irow * 64 + KPT * sl;
#pragma unroll
        for (int kk = 0; kk < KPT; ++kk) so[kk] = S[kk]; }
}

__device__ __forceinline__ void ret_job2(Frame& F, int seq, int h, int dir, long odoff = 0) {
    constexpr int KP = 0, VT = 9216, KW = 19456, SB = 29696, DM = 39936, KSTR = 144, VSTR = 160;
    LAS unsigned char* lds = F.lds;
    LAS float* dm = (LAS float*)(lds + DM);
    const int tid = F.tid, lane = F.lane, wave = F.wave, q16 = lane & 15, g = lane >> 4;
    const bool lat = seq >= 32; const int b = lat ? seq - 32 : seq, N = lat ? 2048 : 256, R0 = lat ? TCX + b * 2048 : b * 256;
    const bf16* PROJ = F.P; bf16* OD = (bf16*)F.S + (size_t)(2 + dir) * T * 512 + odoff;
    const float lg2 = log2f(sigmoidf_(F.in[24][dir * 8 + h]));
    __syncthreads();
    if (tid < 65) dm[tid] = exp2f(lg2 * (float)tid);
    const float gC = exp2f(lg2 * 64.f);
    const int cd = wave >> 1, ce0 = 2 * (wave & 1);
    f32x4 Sreg[2];
#pragma unroll
    for (int c2 = 0; c2 < 2; ++c2)
#pragma unroll
        for (int e = 0; e < 4; ++e) { const int d_ = 16 * cd + 4 * g + e, e_ = 16 * (ce0 + c2) + q16;
            Sreg[c2][e] = lat ? F.in[6][(size_t)((b * 2 + dir) * 8 + h) * 4096 + d_ * 64 + e_] : 0.f;
            *(LAS bf16*)(lds + SB + d_ * VSTR + e_ * 2) = (bf16)f2bf(Sreg[c2][e]); }
    const int qg = wave & 3, eh = wave >> 2, iq = 16 * qg + q16;
    const int srow = tid >> 3, sch = tid & 7, sprow = (srow & 39) | ((srow & 8) << 1) | ((srow & 16) >> 1);
    for (int t0 = 0; t0 < N; t0 += 64) {
        {
            const int n = dir ? N - 1 - (t0 + srow) : t0 + srow; const bf16* rp = PROJ + (size_t)(R0 + n) * NREC + h * 64 + 8 * sch;
            const v4u rk = *(const v4u*)(rp + 512), rv = *(const v4u*)(rp + 1024);
            *(LAS v4u*)(lds + KP + sprow * KSTR + sch * 16) = rk; *(LAS v4u*)(lds + VT + srow * VSTR + sch * 16) = rv;
            float f[8]; unpack8(rk, f); const float wsc = 0.125f * exp2f(lg2 * (float)(63 - srow));
#pragma unroll
            for (int e = 0; e < 8; ++e) f[e] *= wsc;
            *(LAS v4u*)(lds + KW + srow * VSTR + sch * 16) = pack8(f);
        }
        bf16x8 qf[2], qs[2];
        {
            const int n = dir ? N - 1 - (t0 + iq) : t0 + iq; const bf16* qp = PROJ + (size_t)(R0 + n) * NREC + h * 64 + 8 * g; const float sc = exp2f(lg2 * (float)(iq + 1));
#pragma unroll
            for (int kd = 0; kd < 2; ++kd) { const v4u raw = *(const v4u*)(qp + 32 * kd); qf[kd] = __builtin_bit_cast(bf16x8, raw); float f[8]; unpack8(raw, f);
#pragma unroll
                for (int e = 0; e < 8; ++e) f[e] *= sc;
                qs[kd] = __builtin_bit_cast(bf16x8, pack8(f)); }
        }
        __syncthreads();
        bf16x8 pf[2];
#pragma unroll
        for (int ks = 0; ks < 2; ++ks) {
            float p[8];
#pragma unroll
            for (int t = 0; t < 2; ++t) { f32x4 s = (f32x4){0.f, 0.f, 0.f, 0.f};
#pragma unroll
                for (int kd = 0; kd < 2; ++kd) { const bf16x8 kf = *(const LAS bf16x8*)(lds + KP + (32 * ks + 16 * t + q16) * KSTR + 64 * kd + 16 * g); s = __builtin_amdgcn_mfma_f32_16x16x32_bf16(kf, qf[kd], s, 0, 0, 0); }
#pragma unroll
                for (int e = 0; e < 4; ++e) { const int j = 32 * ks + 16 * (g >> 1) + 8 * t + 4 * (g & 1) + e; const int dlt = iq - j; const float dv_ = dm[dlt & 63]; p[4 * t + e] = (dlt >= 0) ? s[e] * 0.125f * dv_ : 0.f; } }
            pf[ks] = __builtin_bit_cast(bf16x8, pack8(p));
        }
        f32x4 o[2] = {(f32x4){0.f, 0.f, 0.f, 0.f}, (f32x4){0.f, 0.f, 0.f, 0.f}};
#pragma unroll
        for (int c2 = 0; c2 < 2; ++c2) { const int c = 2 * eh + c2;
#pragma unroll
            for (int ks = 0; ks < 2; ++ks) { LAS unsigned char* vb = lds + VT + (32 * ks + 16 * (g >> 1) + 4 * (g & 1) + (q16 >> 2)) * VSTR + (16 * c + 4 * (lane & 3)) * 2;
                const s16x4 v0 = tr_read(vb), v1 = tr_read(vb + 8 * VSTR); const bf16x8 vf = (bf16x8){v0[0], v0[1], v0[2], v0[3], v1[0], v1[1], v1[2], v1[3]};
                o[c2] = __builtin_amdgcn_mfma_f32_16x16x32_bf16(vf, pf[ks], o[c2], 0, 0, 0); }
#pragma unroll
            for (int kd = 0; kd < 2; ++kd) { LAS unsigned char* sb = lds + SB + (32 * kd + 8 * g + (q16 >> 2)) * VSTR + (16 * c + 4 * (lane & 3)) * 2;
                const s16x4 v0 = tr_read(sb), v1 = tr_read(sb + 4 * VSTR); const bf16x8 sf = (bf16x8){v0[0], v0[1], v0[2], v0[3], v1[0], v1[1], v1[2], v1[3]};
                o[c2] = __builtin_amdgcn_mfma_f32_16x16x32_bf16(sf, qs[kd], o[c2], 0, 0, 0); }
        }
        {
            const int n = dir ? N - 1 - (t0 + iq) : t0 + iq; bf16* op = OD + (size_t)(R0 + n) * 512 + h * 64 + 4 * g;
            const float one_ = opaque_one();
#pragma unroll
            for (int c2 = 0; c2 < 2; ++c2) { const f32x4 ov = o[c2] * one_; v2u w; w.x = pg8::cvt_pk_bf16(ov[0], ov[1]); w.y = pg8::cvt_pk_bf16(ov[2], ov[3]); *(v2u*)(op + 16 * (2 * eh + c2)) = w; }
        }
        f32x4 U[2] = {(f32x4){0.f, 0.f, 0.f, 0.f}, (f32x4){0.f, 0.f, 0.f, 0.f}};
#pragma unroll
        for (int ks = 0; ks < 2; ++ks) { LAS unsigned char* ka = lds + KW + (32 * ks + 8 * g + (q16 >> 2)) * VSTR + (16 * cd + 4 * (lane & 3)) * 2;
            const s16x4 a0 = tr_read(ka), a1 = tr_read(ka + 4 * VSTR); const bf16x8 af = (bf16x8){a0[0], a0[1], a0[2], a0[3], a1[0], a1[1], a1[2], a1[3]};
#pragma unroll
            for (int c2 = 0; c2 < 2; ++c2) { LAS unsigned char* vb = lds + VT + (32 * ks + 8 * g + (q16 >> 2)) * VSTR + (16 * (ce0 + c2) + 4 * (lane & 3)) * 2;
                const s16x4 b0 = tr_read(vb), b1 = tr_read(vb + 4 * VSTR); const bf16x8 bfr = (bf16x8){b0[0], b0[1], b0[2], b0[3], b1[0], b1[1], b1[2], b1[3]};
                U[c2] = __builtin_amdgcn_mfma_f32_16x16x32_bf16(af, bfr, U[c2], 0, 0, 0); } }
        __syncthreads();
#pragma unroll
        for (int c2 = 0; c2 < 2; ++c2)
#pragma unroll
            for (int e = 0; e < 4; ++e) { Sreg[c2][e] = gC * Sreg[c2][e] + U[c2][e];
                *(LAS bf16*)(lds + SB + (16 * cd + 4 * g + e) * VSTR + (16 * (ce0 + c2) + q16) * 2) = (bf16)f2bf(Sreg[c2][e]); }
    }
    if (!lat) {
#pragma unroll
        for (int c2 = 0; c2 < 2; ++c2)
#pragma unroll
            for (int e = 0; e < 4; ++e) F.out[O_SRET + (size_t)((b * 2 + dir) * 8 + h) * 4096 + (16 * cd + 4 * g + e) * 64 + 16 * (ce0 + c2) + q16] = Sreg[c2][e];
    }
}
__device__ __forceinline__ void scan_phase2(Frame& F) {
    if (F.G == 256) {
        if (F.bid < 64) { const int job = F.bid >> 1; rwkv_job2<16>(F, 32 + (job >> 4), (job >> 1) & 7, job & 1, 32 * (F.bid & 1)); }
        else if (F.bid < 96) { const int u = F.bid - 64; ret_job2(F, 32 + (u >> 4), (u >> 1) & 7, u & 1); }
        else for (int it = F.bid - 96; it < 1024; it += 160) { const int q = it & 511; if (it < 512) rwkv_job2<8>(F, q >> 4, (q >> 1) & 7, q & 1, 0); else ret_job2(F, q >> 4, (q >> 1) & 7, q & 1); }
    } else {
        for (int it = F.bid; it < 1088 + 32; it += F.G) {
            if (it < 64) { const int job = it >> 1; rwkv_job2<16>(F, 32 + (job >> 4), (job >> 1) & 7, job & 1, 32 * (it & 1)); }
            else if (it < 96) { const int u = it - 64; ret_job2(F, 32 + (u >> 4), (u >> 1) & 7, u & 1); }
            else { const int r = it - 96, q = r & 511; if (r < 512) rwkv_job2<8>(F, q >> 4, (q >> 1) & 7, q & 1, 0); else ret_job2(F, q >> 4, (q >> 1) & 7, q & 1); }
        }
    }
}

template <int NSL> __device__ __forceinline__ float row_reduce2(float v) {
    v += DPP_F(v, 0xB1); v += DPP_F(v, 0x4E); if (NSL >= 8) v += DPP_F(v, 0x141); if (NSL >= 16) v += DPP_F(v, 0x140); return v;
}
template <int NSL>
__device__ __forceinline__ void rwkv_job3(Frame& F, int seq, int h, int dir, int row0) {
    constexpr int KPT = 64 / NSL, TCH = 32, NV = KPT / 4;
    constexpr int WUPT = 0, AUPT = 9216, BUF0 = 18432, BUFSZ = 49152;
    LAS unsigned char* lds = F.lds;
    const int tid = F.tid, lane = F.lane, wave = F.wave, q16 = lane & 15, g = lane >> 4;
    const bool lat = seq >= 32; const int b = lat ? seq - 32 : seq, N = lat ? 2048 : 256, R0 = lat ? TCX + b * 2048 : b * 256;
    const bf16* PROJ = F.P; bf16* YD = (bf16*)F.S + (size_t)dir * T * 512; LAS float* Ly = (LAS float*)(lds + 116736);
    __syncthreads();
    for (int idx = tid; idx < 4096; idx += NTHR) { const int j = idx >> 6, k = idx & 63;
        *(LAS bf16*)(lds + WUPT + k * 144 + j * 2) = (bf16)f2bf(F.in[26][(size_t)(dir * 64 + j) * 512 + h * 64 + k]);
        *(LAS bf16*)(lds + AUPT + k * 144 + j * 2) = (bf16)f2bf(F.in[28][(size_t)(dir * 64 + j) * 512 + h * 64 + k]); }
    const bool scanw = wave < 4;
    const int rowl = (tid & 255) / NSL, sl = tid % NSL, irow = row0 + rowl;
    float S[KPT];
    {
        const float* st = F.in[7] + (size_t)((b * 2 + dir) * 8 + h) * 4096 + irow * 64 + KPT * sl;
#pragma unroll
        for (int kk = 0; kk < KPT; ++kk) S[kk] = (lat && scanw) ? st[kk] : 0.f;
    }
    const int pw = wave - 4;
    LAS float* Lasc = (LAS float*)(lds + 124928) + (pw & 1) * 1024;
    const int nch = N / TCH;
#define RW_PREP(c_) do { \
        LAS float* B_ = (LAS float*)(lds + BUF0 + ((c_) & 1) * BUFSZ); const int t0_ = (c_) * TCH; \
        float cw0[4], ca0[4], ckk8[8], cka8[8]; \
        _Pragma("unroll") for (int ct = 0; ct < 4; ++ct) { const int kc = h * 64 + 16 * ct + q16; cw0[ct] = F.in[25][dir * 512 + kc]; ca0[ct] = F.in[27][dir * 512 + kc]; } \
        { const f32x4 k0_ = *(const f32x4*)(F.in[30] + h * 64 + 8 * (lane & 7)), k1_ = *(const f32x4*)(F.in[30] + h * 64 + 8 * (lane & 7) + 4), a0_ = *(const f32x4*)(F.in[31] + h * 64 + 8 * (lane & 7)), a1_ = *(const f32x4*)(F.in[31] + h * 64 + 8 * (lane & 7) + 4); \
          _Pragma("unroll") for (int e = 0; e < 4; ++e) { ckk8[e] = k0_[e]; ckk8[4 + e] = k1_[e]; cka8[e] = a0_[e]; cka8[4 + e] = a1_[e]; } } \
        v4u raw_[6]; \
        _Pragma("unroll") for (int rep = 0; rep < 6; ++rep) { const int tk_ = t0_ + 16 * pw + (rep & 1) * 8 + (lane >> 3); const int n_ = dir ? N - 1 - tk_ : tk_; \
            raw_[rep] = *(const v4u*)(PROJ + (size_t)(R0 + n_) * NREC + 2048 + 512 * (rep >> 1) + h * 64 + 8 * (lane & 7)); } \
        bf16x8 aw_[2], aa_[2]; \
        { const int tk_ = t0_ + 16 * pw + q16; const int n_ = dir ? N - 1 - tk_ : tk_; const bf16* pa_ = PROJ + (size_t)(R0 + n_) * NREC + 8 * g; \
          _Pragma("unroll") for (int kd = 0; kd < 2; ++kd) { const v4u rw_ = *(const v4u*)(pa_ + 3584 + 32 * kd); aa_[kd] = *(const bf16x8*)(pa_ + 3648 + 32 * kd); float f_[8]; unpack8(rw_, f_); \
              _Pragma("unroll") for (int e = 0; e < 8; ++e) f_[e] = 1.f - 2.f / (1.f + __expf(2.f * f_[e])); aw_[kd] = __builtin_bit_cast(bf16x8, pack8(f_)); } } \
        f32x4 zw_[4], za_[4]; \
        _Pragma("unroll") for (int ct = 0; ct < 4; ++ct) { zw_[ct] = (f32x4){0.f, 0.f, 0.f, 0.f}; za_[ct] = (f32x4){0.f, 0.f, 0.f, 0.f}; \
            _Pragma("unroll") for (int kd = 0; kd < 2; ++kd) { \
                const bf16x8 bw_ = *(const LAS bf16x8*)(lds + WUPT + (16 * ct + q16) * 144 + 64 * kd + 16 * g), ba_ = *(const LAS bf16x8*)(lds + AUPT + (16 * ct + q16) * 144 + 64 * kd + 16 * g); \
                zw_[ct] = __builtin_amdgcn_mfma_f32_16x16x32_bf16(aw_[kd], bw_, zw_[ct], 0, 0, 0); za_[ct] = __builtin_amdgcn_mfma_f32_16x16x32_bf16(aa_[kd], ba_, za_[ct], 0, 0, 0); } } \
        _Pragma("unroll") for (int e = 0; e < 4; ++e) _Pragma("unroll") for (int ct = 0; ct < 4; ++ct) { const int tl16_ = 4 * g + e; \
            B_[2048 + (16 * pw + tl16_) * 64 + 16 * ct + q16] = __expf(-0.6065306597f * sigmoidf_(zw_[ct][e] + cw0[ct])); Lasc[tl16_ * 64 + 16 * ct + q16] = sigmoidf_(za_[ct][e] + ca0[ct]); } \
        _Pragma("unroll") for (int rep = 0; rep < 2; ++rep) { const int tl_ = 16 * pw + rep * 8 + (lane >> 3); float f_[8]; \
            unpack8(raw_[rep], f_); *(LAS f32x4*)(B_ + 8192 + tl_ * 64 + 8 * (lane & 7)) = (f32x4){f_[0], f_[1], f_[2], f_[3]}; *(LAS f32x4*)(B_ + 8192 + tl_ * 64 + 8 * (lane & 7) + 4) = (f32x4){f_[4], f_[5], f_[6], f_[7]}; \
            unpack8(raw_[4 + rep], f_); *(LAS f32x4*)(B_ + 10240 + tl_ * 64 + 8 * (lane & 7)) = (f32x4){f_[0], f_[1], f_[2], f_[3]}; *(LAS f32x4*)(B_ + 10240 + tl_ * 64 + 8 * (lane & 7) + 4) = (f32x4){f_[4], f_[5], f_[6], f_[7]}; \
            float k_[8], a_[8], kr_[8]; unpack8(raw_[2 + rep], k_); \
            { const f32x4 a0_ = *(const LAS f32x4*)(Lasc + (rep * 8 + (lane >> 3)) * 64 + 8 * (lane & 7)), a1_ = *(const LAS f32x4*)(Lasc + (rep * 8 + (lane >> 3)) * 64 + 8 * (lane & 7) + 4); \
              _Pragma("unroll") for (int e = 0; e < 4; ++e) { a_[e] = a0_[e]; a_[4 + e] = a1_[e]; } } \
            float ss_ = 0.f; \
            _Pragma("unroll") for (int e = 0; e < 8; ++e) { kr_[e] = k_[e] * ckk8[e]; ss_ += kr_[e] * kr_[e]; } \
            ss_ = row_reduce2<8>(ss_); const float rs_ = rsqrtf(ss_ + 1e-12f); \
            float o0_[8], o1_[8], o2_[8]; \
            _Pragma("unroll") for (int e = 0; e < 8; ++e) { const float kk_ = kr_[e] * rs_; o0_[e] = -kk_; o1_[e] = kk_ * a_[e]; o2_[e] = k_[e] * (1.f + (a_[e] - 1.f) * cka8[e]); } \
            LAS float* d_ = B_ + tl_ * 64 + 8 * (lane & 7); \
            *(LAS f32x4*)(d_) = (f32x4){o0_[0], o0_[1], o0_[2], o0_[3]}; *(LAS f32x4*)(d_ + 4) = (f32x4){o0_[4], o0_[5], o0_[6], o0_[7]}; \
            *(LAS f32x4*)(d_ + 4096) = (f32x4){o1_[0], o1_[1], o1_[2], o1_[3]}; *(LAS f32x4*)(d_ + 4100) = (f32x4){o1_[4], o1_[5], o1_[6], o1_[7]}; \
            *(LAS f32x4*)(d_ + 6144) = (f32x4){o2_[0], o2_[1], o2_[2], o2_[3]}; *(LAS f32x4*)(d_ + 6148) = (f32x4){o2_[4], o2_[5], o2_[6], o2_[7]}; } \
    } while (0)
    __syncthreads();
    if (wave == 4 || wave == 5) RW_PREP(0);
    __syncthreads();
    for (int c = 0; c < nch; ++c) {
        if (scanw) {
            const LAS float* B = (const LAS float*)(lds + BUF0 + (c & 1) * BUFSZ) + KPT * sl;
            const LAS float* Bv = (const LAS float*)(lds + BUF0 + (c & 1) * BUFSZ) + 10240 + irow;
            f32x4 nkA[NV], nkB[NV];
#define RW_LOADNK(nk, j_) do { _Pragma("unroll") for (int q_ = 0; q_ < NV; ++q_) nk[q_] = *(const LAS f32x4*)(B + (j_) * 64 + 4 * q_); } while (0)
#define RW_STEP(nk, nknext, j_) do { \
                f32x4 op_[4][NV]; \
                _Pragma("unroll") for (int a_ = 0; a_ < 4; ++a_) _Pragma("unroll") for (int q_ = 0; q_ < NV; ++q_) op_[a_][q_] = *(const LAS f32x4*)(B + (a_ + 1) * 2048 + (j_) * 64 + 4 * q_); \
                const float vv_ = Bv[(j_) * 64]; \
                if ((j_) + 1 < TCH) RW_LOADNK(nknext, (j_) + 1); \
                float sa_ = 0.f; \
                _Pragma("unroll") for (int q_ = 0; q_ < NV; ++q_) _Pragma("unroll") for (int e = 0; e < 4; ++e) sa_ += S[4 * q_ + e] * nk[q_][e]; \
                sa_ = row_reduce2<NSL>(sa_); \
                float y_ = 0.f; \
                _Pragma("unroll") for (int q_ = 0; q_ < NV; ++q_) _Pragma("unroll") for (int e = 0; e < 4; ++e) { S[4 * q_ + e] = S[4 * q_ + e] * op_[0][q_][e] + (sa_ * op_[1][q_][e] + vv_ * op_[2][q_][e]); y_ += S[4 * q_ + e] * op_[3][q_][e]; } \
                y_ = row_reduce2<NSL>(y_); \
                if (sl == 0) Ly[(j_) * 64 + rowl] = y_; \
            } while (0)
            RW_LOADNK(nkA, 0);
            for (int j = 0; j < TCH; j += 2) { RW_STEP(nkA, nkB, j); RW_STEP(nkB, nkA, j + 1); }
            {
                constexpr int RPW = 64 / NSL;
#pragma unroll 1
                for (int idx = lane; idx < TCH * RPW; idx += 64) { const int tok = idx / RPW, rl = wave * RPW + idx % RPW; const int tk_ = c * TCH + tok; const int n_ = dir ? N - 1 - tk_ : tk_;
                    YD[(size_t)(R0 + n_) * 512 + h * 64 + row0 + rl] = (bf16)f2bf(Ly[tok * 64 + rl]); }
            }
#undef RW_LOADNK
#undef RW_STEP
        } else if (wave < 6 && c + 1 < nch) { RW_PREP(c + 1); }
        __syncthreads();
    }
#undef RW_PREP
    if (!lat && scanw) { float* so = F.out + O_SRW + (size_t)((b * 2 + dir) * 8 + h) * 4096 + irow * 64 + KPT * sl;
#pragma unroll
        for (int kk = 0; kk < KPT; ++kk) so[kk] = S[kk]; }
}
__device__ __forceinline__ void scan_phase3(Frame& F, int mode = 0) {
    unsigned* qctr = (unsigned*)(F.ws + WS_CTL) + 2048;
    LAS int* qslot = (LAS int*)(F.lds + LDS_BYTES - 128);
    const int nheavy = 96;
    for (int it = F.bid; it < nheavy; it += F.G) {
        if (it < 64) { if (mode != 2 && mode != 4) { const int job = it >> 1; rwkv_job3<8>(F, 32 + (job >> 4), (job >> 1) & 7, job & 1, 32 * (it & 1)); } }
        else if (mode != 1 && mode != 3) { const int u = it - 64; ret_job2(F, 32 + (u >> 4), (u >> 1) & 7, u & 1, (mode == 4) ? (long)(8 * MiB) : 0); }
    }
    if (mode == 1 || mode == 2 || mode == 4) return;
    for (;;) {
        __syncthreads();
        if (F.tid == 0) *qslot = (int)atomicAdd(qctr, 1u);
        __syncthreads();
        const int it = *qslot;
        if (it >= 1024) break;
        const int q = it & 511;
        if (it < 512) rwkv_job3<4>(F, q >> 4, (q >> 1) & 7, q & 1, 0); else ret_job2(F, q >> 4, (q >> 1) & 7, q & 1);
    }
}

__device__ __forceinline__ void rec_post_phase2(Frame& F) {
    const int lane = F.lane, q16 = lane & 15, g = lane >> 4;
    const bf16* PROJ = F.P; const bf16* YD = (const bf16*)F.S; const bf16* OD = (const bf16*)F.S + (size_t)2 * T * 512; const bf16* GUPT = (const bf16*)(F.ws + WS_MOD + MOD_GUPT);
    for (int it = F.wave * F.G + F.bid; it < T / 16; it += F.G * NWAVES) {
        const int tk0 = 16 * it;
        bf16x8 af[4];
#pragma unroll
        for (int kd = 0; kd < 4; ++kd) { const v4u raw = *(const v4u*)(PROJ + (size_t)(tk0 + q16) * NREC + 3712 + 32 * kd + 8 * g); float f[8]; unpack8(raw, f);
#pragma unroll
            for (int e = 0; e < 8; ++e) f[e] = sigmoidf_(f[e]);
            af[kd] = __builtin_bit_cast(bf16x8, pack8(f)); }
        for (int h = 0; h < 8; ++h) {
            f32x4 ga[4];
#pragma unroll
            for (int ct = 0; ct < 4; ++ct) { ga[ct] = (f32x4){0.f, 0.f, 0.f, 0.f};
#pragma unroll
                for (int kd = 0; kd < 4; ++kd) { const bf16x8 bfr = *(const bf16x8*)(GUPT + (size_t)(h * 64 + 16 * ct + q16) * 128 + 32 * kd + 8 * g); ga[ct] = __builtin_amdgcn_mfma_f32_16x16x32_bf16(af[kd], bfr, ga[ct], 0, 0, 0); } }
            float lng[4], lnb[4], rk_[4];
#pragma unroll
            for (int ct = 0; ct < 4; ++ct) { const int c = h * 64 + 16 * ct + q16; lng[ct] = F.in[33][c]; lnb[ct] = F.in[34][c]; rk_[ct] = F.in[32][c]; }
#pragma unroll
            for (int e = 0; e < 4; ++e) { const int tk = tk0 + 4 * g + e; const bf16* pr = PROJ + (size_t)tk * NREC + h * 64 + q16;
                float y[4], v[4]; float s1 = 0.f, s3 = 0.f;
#pragma unroll
                for (int ct = 0; ct < 4; ++ct) { { const size_t ix_ = (size_t)tk * 512 + h * 64 + 16 * ct + q16; y[ct] = bf1(YD[ix_]) + bf1(YD[ix_ + (size_t)T * 512]); } const float r = bf1(pr[2048 + 16 * ct]), k = bf1(pr[2560 + 16 * ct]); v[ct] = bf1(pr[3072 + 16 * ct]); s1 += y[ct]; s3 += r * rk_[ct] * k; }
                s1 = row_reduce<16>(s1); s3 = row_reduce<16>(s3);
                const float mu = s1 * (1.f / 64.f); float s2 = 0.f;
#pragma unroll
                for (int ct = 0; ct < 4; ++ct) { y[ct] -= mu; s2 += y[ct] * y[ct]; }
                s2 = row_reduce<16>(s2);
                const float rstd = rsqrtf(s2 * (1.f / 64.f) + 64e-5f);
#pragma unroll
                for (int ct = 0; ct < 4; ++ct) F.MIX[(size_t)tk * D + 512 + h * 64 + 16 * ct + q16] = (bf16)f2bf((y[ct] * rstd * lng[ct] + lnb[ct] + s3 * v[ct]) * ga[ct][e]);
            }
        }
        for (int h = 0; h < 8; ++h) {
#pragma unroll
            for (int e = 0; e < 4; ++e) { const int tk = tk0 + 4 * g + e; const bf16* pr = PROJ + (size_t)tk * NREC + 1536 + h * 64 + q16;
                float o[4]; float ms = 0.f;
#pragma unroll
                for (int ct = 0; ct < 4; ++ct) { { const size_t ix_ = (size_t)tk * 512 + h * 64 + 16 * ct + q16; o[ct] = bf1(OD[ix_]) + bf1(OD[ix_ + (size_t)T * 512]); } ms += o[ct] * o[ct]; }
                ms = row_reduce<16>(ms);
                const float rn = rsqrtf(ms * (1.f / 64.f) + 1e-6f);
#pragma unroll
                for (int ct = 0; ct < 4; ++ct) { const float xg = bf1(pr[16 * ct]); F.MIX[(size_t)tk * D + h * 64 + 16 * ct + q16] = (bf16)f2bf(xg * sigmoidf_(xg) * o[ct] * rn); }
            }
        }
    }
}

typedef GAS unsigned gu32;
#define XB_TMO      128
#define XB_XCNT(j)  (256  + 64 * (j))
#define XB_XSUB(j)  (1280 + 64 * (j))
#define XB_XGEN(j)  (2304 + 64 * (j))
#define XB_TOP      3328
#define XB_TOPGEN   3392
#define XCD_BAR_WORDS 3456
#define XB_SPIN_CAP (1u << 18)

__device__ __forceinline__ unsigned xb_ld(unsigned* p)              { return __hip_atomic_load(p, __ATOMIC_RELAXED, __HIP_MEMORY_SCOPE_AGENT); }
__device__ __forceinline__ unsigned xb_add(unsigned* p, unsigned v) { return __hip_atomic_fetch_add(p, v, __ATOMIC_RELAXED, __HIP_MEMORY_SCOPE_AGENT); }
__device__ __forceinline__ unsigned xb_xcc_id() { return (unsigned)__builtin_amdgcn_s_getreg((3 << 11) | 20) & 0xFu; }
#define XB_SPIN(cond, bar) do { unsigned _sp = 0; while (cond) { __builtin_amdgcn_s_sleep(1); \
    if ((++_sp & 255u) == 0u) { if (xb_ld(&(bar)[XB_TMO])) break; if (_sp > XB_SPIN_CAP) { atomicAdd(&(bar)[XB_TMO], 1u); break; } } } } while (0)

struct XcdBarrier {
    unsigned* bar; unsigned x;
    volatile LAS unsigned* st;
};

__device__ __forceinline__ XcdBarrier xcd_barrier_post(unsigned* bar, volatile LAS unsigned* st) {
    XcdBarrier b; b.bar = bar; b.x = xb_xcc_id(); b.st = st;
    if (threadIdx.x == 0) (void)xb_add(&bar[XB_XCNT(b.x)], 1u);
    return b;
}
__device__ __forceinline__ void xcd_barrier_complete(unsigned* bar, unsigned x, unsigned& nloc, unsigned& nx) {
    const unsigned G = gridDim.x * gridDim.y * gridDim.z;
    unsigned sum, cnt, mine, sp = 0u;
    for (;;) {
        sum = 0u; cnt = 0u; mine = 0u;
#pragma unroll
        for (unsigned j = 0; j < 16; ++j) { const unsigned c = xb_ld(&bar[XB_XCNT(j)]); sum += c; cnt += (c > 0u) ? 1u : 0u; mine = (j == x) ? c : mine; }
        if (sum == G) break;
        __builtin_amdgcn_s_sleep(1);
        if ((++sp & 255u) == 0u) { if (xb_ld(&bar[XB_TMO])) break; if (sp > XB_SPIN_CAP) { atomicAdd(&bar[XB_TMO], 1u); break; } }
    }
    nloc = mine > 0u ? mine : 1u; nx = cnt > 0u ? cnt : 1u;
}

__device__ __forceinline__ void xcd_barrier(const XcdBarrier& b) {
    asm volatile("s_waitcnt vmcnt(0)" ::: "memory");
    __syncthreads();
    if (threadIdx.x == 0) {
        unsigned* bar = b.bar;
        __builtin_amdgcn_s_waitcnt(0);
        unsigned nloc = b.st[0], nx = b.st[1];
        if (nloc == 0u) { xcd_barrier_complete(bar, b.x, nloc, nx); b.st[0] = nloc; b.st[1] = nx; }
        const unsigned old = xb_add(&bar[XB_XSUB(b.x)], 1u);
        const unsigned gen = old / nloc;
        if (old + 1u == (gen + 1u) * nloc) {
            __builtin_amdgcn_fence(__ATOMIC_RELEASE, "agent");
            asm volatile("s_waitcnt vmcnt(0)" ::: "memory");
            const unsigned og = xb_add(&bar[XB_TOP], 1u);
            const unsigned tg = og / nx;
            if (og + 1u == (tg + 1u) * nx) xb_add(&bar[XB_TOPGEN], 1u);
            else XB_SPIN(xb_ld(&bar[XB_TOPGEN]) == tg, bar);
            __builtin_amdgcn_fence(__ATOMIC_ACQUIRE, "agent");
            xb_add(&bar[XB_XGEN(b.x)], 1u);
            asm volatile("s_waitcnt vmcnt(0)" ::: "memory");
        } else {
            XB_SPIN(xb_ld(&bar[XB_XGEN(b.x)]) == gen, bar);
            __builtin_amdgcn_fence(__ATOMIC_ACQUIRE, "agent");
            asm volatile("s_waitcnt vmcnt(0)" ::: "memory");
        }
    }
    __syncthreads();
}

#ifndef PROBE_DUP
#define PROBE_DUP 0
#endif
#ifndef ATTN_MFMA
#define ATTN_MFMA 1
#endif
enum { PH_BASE = __COUNTER__ };
struct Args { const float* in[37]; float* out; unsigned char* ws; int ph_lo, ph_hi; };

template <bool COOP>
__global__ void __launch_bounds__(NTHR, 2) mk_fwd(Args args) {
    extern __shared__ __attribute__((aligned(16))) unsigned char lds[];
    Frame F;
    F.lds = (LAS unsigned char*)lds;
    F.tid = threadIdx.x; F.lane = F.tid & 63; F.wave = __builtin_amdgcn_readfirstlane(F.tid >> 6); F.G = gridDim.x; F.bid = blockIdx.x;
#pragma unroll
    for (int i = 0; i < 37; ++i) F.in[i] = args.in[i];
    F.out = args.out; F.ws = args.ws;
    unsigned char* ws = args.ws;
    F.Watt = (bf16*)(ws + WS_WATT); F.Woa = (bf16*)(ws + WS_WOA); F.Wrec = (bf16*)(ws + WS_WREC); F.Wor = (bf16*)(ws + WS_WOR); F.Wf1 = (bf16*)(ws + WS_WF1); F.Wf2 = (bf16*)(ws + WS_WF2);
    F.H = (bf16*)(ws + WS_H); F.MIX = (bf16*)(ws + WS_MIX); F.P = (bf16*)(ws + WS_P); F.MOD = (float*)(ws + WS_MOD); F.S = (float*)(ws + WS_S);
    volatile LAS unsigned* MISC = (volatile LAS unsigned*)(F.lds + LDS_BYTES - 256);
    if (F.tid < 16) MISC[F.tid] = 0u;
    __syncthreads();
    XcdBarrier bar; bar.bar = (unsigned*)(ws + WS_CTL) + 4096; bar.x = 0; bar.st = nullptr;
    if (COOP) bar = xcd_barrier_post((unsigned*)(ws + WS_CTL) + 4096, MISC + 8);
    const int lo = args.ph_lo, hi = args.ph_hi;
#define IN(k) (lo <= (k) && (k) < hi)
#define SEAM(k) do { if (COOP && IN((k) + 1)) { if ((k) == 0) cooperative_groups::this_grid().sync(); else xcd_barrier(bar); } } while (0)
    const f32x2v* rope = (const f32x2v*)((unsigned char*)F.MOD + MOD_ROPE);

#define PHASE(...) { constexpr int k_ = __COUNTER__ - PH_BASE - 1; if (IN(k_)) { __VA_ARGS__; SEAM(k_); } }
    PHASE(p0_prologue(F))
#if PROBE_DUP == 3
    PHASE(p0_prologue(F))
#endif
    PHASE(norm_phase(F, F.in[0], F.in[1], F.in[10], F.MOD, 0, 1, false))
    PHASE(pg8::Gemm g{F.H, F.Watt, T, NATT, D}; pg8::StaticOrder S; S.init(T, NATT, F.G, F.bid); EpiAttnIn E{F.P, F.out, rope};
          pg8::gemm_phase<EpiAttnIn, pg8::StaticOrder, true, true>(F.lds, g, S, E))
#if ATTN_MFMA
    PHASE(attn_mfma_phase(F))
#if PROBE_DUP == 1
    PHASE(attn_mfma_phase(F))
#endif
#else
    PHASE(attn_naive_phase(F))
    PHASE(diff_post_phase(F))
#endif
    PHASE(pg8::Gemm g{F.MIX, F.Woa, T, D, D}; pg8::StaticOrder S; S.init(T, D, F.G, F.bid); EpiResid E{F.in[0], F.in[1], F.out, F.MOD, 2};
          pg8::gemm_phase<EpiResid, pg8::StaticOrder, true, true>(F.lds, g, S, E))
    PHASE(norm_phase(F, F.out, F.out + (size_t)TCX * D, F.in[11], F.MOD, 3, 4, false))
    PHASE(pg8::Gemm g{F.H, F.Wf1, T, NFF, D}; pg8::StaticOrder S; S.init(T, NFF, F.G, F.bid); EpiSwiglu E{F.P};
          pg8::gemm_phase<EpiSwiglu, pg8::StaticOrder, true, true>(F.lds, g, S, E))
#if PROBE_DUP == 5
    PHASE(pg8::Gemm g{F.H, F.Wf1, T, NFF, D}; pg8::StaticOrder S; S.init(T, NFF, F.G, F.bid); EpiSwiglu E{F.P};
          pg8::gemm_phase<EpiSwiglu, pg8::StaticOrder, true, true>(F.lds, g, S, E))
#endif
    PHASE(pg8::Gemm g{F.P, F.Wf2, T, D, DFF}; pg8::StaticOrder S; S.init(T, D, F.G, F.bid); EpiResid E{F.out, F.out + (size_t)TCX * D, F.out, F.MOD, 5};
          pg8::gemm_phase<EpiResid, pg8::StaticOrder, true, true>(F.lds, g, S, E))
    PHASE(norm_phase(F, F.out, F.out + (size_t)TCX * D, F.in[10] + D, F.MOD + 3 * 6144, 0, 1, false))
    PHASE(pg8::Gemm g{F.H, F.Wrec, T, NREC, D}; pg8::StaticOrder S; S.init(T, NREC, F.G, F.bid); EpiBf16Plain E{F.P, NREC};
          pg8::gemm_phase<EpiBf16Plain, pg8::StaticOrder, true, true>(F.lds, g, S, E))
#if PROBE_DUP == 8
    PHASE(scan_phase3(F, 2))
#endif
#if PROBE_DUP == 9
    PHASE(scan_phase3(F, 2))
    PHASE(scan_phase3(F, 3))
#else
    PHASE(scan_phase3(F))
#endif
#if PROBE_DUP == 2
    PHASE(scan_phase3(F))
#endif
#if PROBE_DUP == 6
    PHASE(scan_phase3(F, 1))
#endif
#if PROBE_DUP == 7
    PHASE(scan_phase3(F, 2))
#endif
#if PROBE_DUP == 11
    PHASE(scan_phase3(F, 4))
#endif
#if PROBE_DUP == 10
    PHASE(for (int i_ = F.tid; i_ < 36000; i_ += NTHR) ((LAS unsigned*)F.lds)[i_] = 0u; scan_phase3(F, 2))
#endif
    PHASE(rec_post_phase2(F))
#if PROBE_DUP == 4
    PHASE(rec_post_phase2(F))
#endif
    PHASE(pg8::Gemm g{F.MIX, F.Wor, T, D, D}; pg8::StaticOrder S; S.init(T, D, F.G, F.bid); EpiResid E{F.out, F.out + (size_t)TCX * D, F.out, F.MOD + 3 * 6144, 2};
          pg8::gemm_phase<EpiResid, pg8::StaticOrder, true, true>(F.lds, g, S, E))
    PHASE(norm_phase(F, F.out, F.out + (size_t)TCX * D, F.in[11] + D, F.MOD + 3 * 6144, 3, 4, false))
    PHASE(pg8::Gemm g{F.H, F.Wf1 + WF1_STRIDE, T, NFF, D}; pg8::StaticOrder S; S.init(T, NFF, F.G, F.bid); EpiSwiglu E{F.P};
          pg8::gemm_phase<EpiSwiglu, pg8::StaticOrder, true, true>(F.lds, g, S, E))
    PHASE(pg8::Gemm g{F.P, F.Wf2 + WF2_STRIDE, T, D, DFF}; pg8::StaticOrder S; S.init(T, D, F.G, F.bid); EpiResid E{F.out, F.out + (size_t)TCX * D, F.out, F.MOD + 3 * 6144, 5};
          pg8::gemm_phase<EpiResid, pg8::StaticOrder, true, true>(F.lds, g, S, E))
    PHASE(final_norm_phase(F))
#undef PHASE
#undef IN
#undef SEAM
}

constexpr int NPHASE = __COUNTER__ - PH_BASE - 1;
#ifndef MK_N_LAUNCHES
#define MK_N_LAUNCHES 1
#endif
extern "C" void kernel_launch(void* const* d_in, const int* in_sizes, int n_in, void* d_out, int out_size, void* d_ws, size_t ws_size, hipStream_t stream) {
    static int grid = 0;
    if (grid == 0) {
        if (n_in != 37 || out_size != 33554432 || ws_size < WS_END) { fprintf(stderr, "kernel_launch: unexpected problem (n_in %d out %d ws %zu)\n", n_in, out_size, ws_size); grid = -1; return; }
        int dev = 0, cus = 0, per_cu = 0;
        if (hipGetDevice(&dev) != hipSuccess || hipDeviceGetAttribute(&cus, hipDeviceAttributeMultiprocessorCount, dev) != hipSuccess) { grid = -1; return; }
        (void)hipFuncSetAttribute((const void*)mk_fwd<false>, hipFuncAttributeMaxDynamicSharedMemorySize, LDS_BYTES);
        (void)hipFuncSetAttribute((const void*)mk_fwd<true>, hipFuncAttributeMaxDynamicSharedMemorySize, LDS_BYTES);
        if (hipOccupancyMaxActiveBlocksPerMultiprocessor(&per_cu, (const void*)mk_fwd<true>, NTHR, LDS_BYTES) != hipSuccess || per_cu < 1) per_cu = 1;
        (void)hipGetLastError();
        grid = cus;
    }
    if (grid < 0) return;
    if (hipMemsetAsync((char*)d_ws + WS_CTL, 0, 65536, stream) != hipSuccess) { fprintf(stderr, "memset failed\n"); return; }
    Args a{};
    for (int i = 0; i < 37; ++i) a.in[i] = (const float*)d_in[i];
    a.out = (float*)d_out; a.ws = (unsigned char*)d_ws;
#if MK_N_LAUNCHES == 1
    a.ph_lo = 0; a.ph_hi = NPHASE;
    void* kargs[] = {&a};
    hipError_t e = hipLaunchCooperativeKernel((const void*)mk_fwd<true>, dim3(grid), dim3(NTHR), kargs, LDS_BYTES, stream);
    if (e != hipSuccess) fprintf(stderr, "cooperative launch failed: %s (grid %d)\n", hipGetErrorString(e), grid);
#else
    for (int ph = 0; ph < NPHASE; ++ph) { a.ph_lo = ph; a.ph_hi = ph + 1; hipLaunchKernelGGL(mk_fwd<false>, dim3(grid), dim3(NTHR), LDS_BYTES, stream, a); }
#endif
}
```

```cpp
#include <hip/hip_runtime.h>
#include <hip/hip_cooperative_groups.h>
#include <cstdio>
#include <cstdint>
namespace pg8 {
#define PG8_LAS __attribute__((address_space(3)))
typedef unsigned short bf16_t;
typedef short bf16x8 __attribute__((ext_vector_type(8)));
typedef float f32x4 __attribute__((ext_vector_type(4)));
typedef unsigned u32x4 __attribute__((ext_vector_type(4)));
constexpr int BM = 256, BK = 64, HALF = 128, HTB = HALF * BK * 2  , STAGE_BYTES = 8 * HTB, NXCD = 8, WGM = 8;

__host__ __device__ __forceinline__ int lds_byte(int r, int c) { const int st = (r >> 4) * 2 + (c >> 5), rr = r & 15, cc = c & 31, ob = rr * 64 + cc * 2; return st * 1024 + (ob ^ (((ob >> 9) & 1) << 5)); }
__host__ __device__ __forceinline__ void stage_rc(int b, int& R, int& C) { const int st = b / 1024, sb = b % 1024, swz = sb ^ (((sb >> 9) & 1) << 5); R = (st >> 1) * 16 + swz / 64; C = (st & 1) * 32 + (swz % 64) / 2; }
__host__ __device__ __forceinline__ int perm32(int rho) { const int n = rho >> 4, i = rho & 15; return 8 * (i >> 2) + 4 * n + (i & 3); }

struct Unit { int pm, pn; };
struct Gemm { const bf16_t* A; const bf16_t* Bt; int M, N, K; };

struct StaticOrder {
    int nM, nN, nwg, G, c;
    __host__ __device__ void init(int M, int N, int G_, int c_) { nM = M / BM; nN = N / BM; nwg = nM * nN; G = G_; c = c_; }
    __host__ __device__ bool next(int i, Unit& u) const {
        const long L = (long)i * G + c; if (L >= nwg) return false;
        int wgid = (int)L; { const int q = nwg / NXCD, r = nwg % NXCD, xcd = wgid % NXCD, off = wgid / NXCD; wgid = (xcd < r ? xcd * (q + 1) : r * (q + 1) + (xcd - r) * q) + off; }
        const int nig = WGM * nN, gid = wgid / nig, fm = gid * WGM, gsz = (nM - fm) < WGM ? (nM - fm) : WGM;
        u.pm = fm + ((wgid % nig) % gsz); u.pn = (wgid % nig) / gsz; return true;
    }
    __device__ __forceinline__ void a_ready(const Unit&) const {}
    __device__ __forceinline__ void done(const Unit&) const {}
};
__device__ __forceinline__ unsigned cvt_pk_bf16(float lo, float hi) { typedef __bf16 b2_t __attribute__((ext_vector_type(2))); typedef float f2_t __attribute__((ext_vector_type(2))); const f2_t v = {lo, hi}; return __builtin_bit_cast(unsigned, __builtin_convertvector(v, b2_t)); }
typedef float f32x2 __attribute__((ext_vector_type(2)));
template <class Epi, class Sched, bool ALIGN_EPI = false, bool SP2 = false>
__device__ __forceinline__ void gemm_phase(PG8_LAS unsigned char* lds, const Gemm g, const Sched& S, const Epi& E) {
    const int tid = threadIdx.x, wid = __builtin_amdgcn_readfirstlane(tid >> 6), lane = tid & 63, wr = wid >> 2, wc = wid & 3, fr = lane & 15, fq = lane >> 4;
    const int K = g.K, nt = K / BK;
    unsigned voffA[2], voffB[2];
#pragma unroll
    for (int i = 0; i < 2; ++i) { int R, C; stage_rc(tid * 16 + i * 8192, R, C); const int Rb = Epi::PERM ? ((R & ~31) + perm32(R & 31)) : R;
        voffA[i] = (unsigned)(R * K + C) * 2u; voffB[i] = (unsigned)(Rb * K + C) * 2u; }
    const size_t kstep = (size_t)(BK * 2);
    const size_t hstep = (size_t)HALF * K * 2;
    const size_t tstep = 2 * hstep;
    const unsigned ldsw = (unsigned)wid * 1024u;
    const int aoff = lds_byte(wr * 64 + fr, fq * 8), boff = lds_byte(wc * 32 + fr, fq * 8);
#define PG8_SA(b, h) (((b) * 2 + (h)) * HTB)
#define PG8_SB(b, h) ((4 + (b) * 2 + (h)) * HTB)
#define PG8_STAGE(bufoff, gbase, voff) do { _Pragma("unroll") for (int _i = 0; _i < 2; ++_i) \
        __builtin_amdgcn_global_load_lds((const unsigned*)((const char*)(gbase) + (voff)[_i]), (PG8_LAS unsigned*)(lds + (bufoff) + ldsw + _i * 8192), 16, 0, 0); } while (0)
#define PG8_LDA(dst, b, h) do { _Pragma("unroll") for (int m = 0; m < 4; ++m) _Pragma("unroll") for (int k = 0; k < 2; ++k) dst[m][k] = *(const PG8_LAS bf16x8*)(lds + PG8_SA(b, h) + aoff + m * 2048 + k * 1024); } while (0)
#define PG8_LDB(dst, b, h) do { _Pragma("unroll") for (int n = 0; n < 2; ++n) _Pragma("unroll") for (int k = 0; k < 2; ++k) dst[n][k] = *(const PG8_LAS bf16x8*)(lds + PG8_SB(b, h) + boff + n * 2048 + k * 1024); } while (0)
#define PG8_MMA(ai, bj, At, Bt) do { __builtin_amdgcn_s_setprio(1); _Pragma("unroll") for (int m = 0; m < 4; ++m) _Pragma("unroll") for (int n = 0; n < 2; ++n) _Pragma("unroll") for (int k = 0; k < 2; ++k) \
        acc[ai][bj][m][n] = __builtin_amdgcn_mfma_f32_16x16x32_bf16(Bt[n][k], At[m][k], acc[ai][bj][m][n], 0, 0, 0); __builtin_amdgcn_s_setprio(0); } while (0)
#define PG8_WAIT_V(n) asm volatile("s_waitcnt vmcnt(" #n ")" ::: "memory")
#define PG8_WAIT_L(n) asm volatile("s_waitcnt lgkmcnt(" #n ")" ::: "memory")
#define PG8_BAR __builtin_amdgcn_s_barrier()
#define PG8_SCHED __builtin_amdgcn_sched_barrier(0)
    Unit cur, nxt; int ui = 0;
    if (!S.next(0, cur)) return;
    f32x4 acc[2][2][4][2];
#pragma unroll
    for (int a = 0; a < 2; ++a)
#pragma unroll
        for (int b = 0; b < 2; ++b)
#pragma unroll
            for (int m = 0; m < 4; ++m)
#pragma unroll
                for (int n = 0; n < 2; ++n) acc[a][b][m][n] = (f32x4){0.f, 0.f, 0.f, 0.f};
    bf16x8 At[4][2], B0[2][2], B1[2][2];
    const char* cA = (const char*)g.A + (size_t)cur.pm * tstep; const char* cB = (const char*)g.Bt + (size_t)cur.pn * tstep;
    S.a_ready(cur);
    if constexpr (SP2) {
        PG8_STAGE(PG8_SB(0, 0), cB, voffB); PG8_STAGE(PG8_SB(0, 1), cB + hstep, voffB); PG8_STAGE(PG8_SA(0, 0), cA, voffA); PG8_STAGE(PG8_SA(0, 1), cA + hstep, voffA);
        if (wr == 1) PG8_BAR;
        PG8_WAIT_V(2); PG8_BAR;
        PG8_STAGE(PG8_SB(1, 0), cB + kstep, voffB); PG8_STAGE(PG8_SA(1, 0), cA + kstep, voffA); PG8_STAGE(PG8_SB(1, 1), cB + hstep + kstep, voffB);
        PG8_WAIT_V(6); PG8_BAR;
    } else {
        PG8_STAGE(PG8_SB(0, 0), cB, voffB); PG8_STAGE(PG8_SA(0, 0), cA, voffA); PG8_STAGE(PG8_SB(0, 1), cB + hstep, voffB); PG8_STAGE(PG8_SA(0, 1), cA + hstep, voffA);
        if (wr == 1) PG8_BAR;
        PG8_WAIT_V(4); PG8_BAR;
        PG8_STAGE(PG8_SB(1, 0), cB + kstep, voffB); PG8_STAGE(PG8_SA(1, 0), cA + kstep, voffA); PG8_STAGE(PG8_SB(1, 1), cB + hstep + kstep, voffB);
        PG8_WAIT_V(6); PG8_BAR;
    }
    for (;;) {
        const bool has_next = S.next(ui + 1, nxt);
        const char* nA = has_next ? (const char*)g.A + (size_t)nxt.pm * tstep : cA; const char* nB = has_next ? (const char*)g.Bt + (size_t)nxt.pn * tstep : cB;
        for (int t = 0; t < nt; t += 2) {
            const bool last = (t == nt - 2);
            const char* a1 = cA + (size_t)(t + 1) * kstep;
            const char* a2 = last ? nA : cA + (size_t)(t + 2) * kstep; const char* b2 = last ? nB : cB + (size_t)(t + 2) * kstep;
            const char* a3 = a2 + kstep; const char* b3 = b2 + kstep;
            if (last && has_next) S.a_ready(nxt);
            if constexpr (SP2) {
            PG8_LDB(B0, 0, 0); PG8_LDB(B1, 0, 1); PG8_SCHED; PG8_LDA(At, 0, 0); PG8_STAGE(PG8_SA(1, 1), a1 + hstep, voffA);
            PG8_WAIT_V(8); PG8_WAIT_L(0); PG8_BAR; PG8_MMA(0, 0, At, B0); PG8_MMA(0, 1, At, B1); PG8_BAR; PG8_SCHED;
            PG8_LDA(At, 0, 1); PG8_STAGE(PG8_SB(0, 0), b2, voffB); PG8_STAGE(PG8_SB(0, 1), b2 + hstep, voffB); PG8_STAGE(PG8_SA(0, 0), a2, voffA);
            PG8_WAIT_V(8); PG8_WAIT_L(0); PG8_BAR; PG8_MMA(1, 0, At, B0); PG8_MMA(1, 1, At, B1); PG8_BAR; PG8_SCHED;
            PG8_LDB(B0, 1, 0); PG8_LDB(B1, 1, 1); PG8_SCHED; PG8_LDA(At, 1, 0); PG8_STAGE(PG8_SA(0, 1), a2 + hstep, voffA);
            PG8_WAIT_V(8); PG8_WAIT_L(0); PG8_BAR; PG8_MMA(0, 0, At, B0); PG8_MMA(0, 1, At, B1); PG8_BAR; PG8_SCHED;
            PG8_LDA(At, 1, 1); PG8_STAGE(PG8_SB(1, 0), b3, voffB); PG8_STAGE(PG8_SB(1, 1), b3 + hstep, voffB); PG8_STAGE(PG8_SA(1, 0), a3, voffA);
            PG8_WAIT_V(8); PG8_WAIT_L(0); PG8_BAR; PG8_MMA(1, 0, At, B0); PG8_MMA(1, 1, At, B1); PG8_BAR; PG8_SCHED;
            } else {
            PG8_LDB(B0, 0, 0); PG8_SCHED; PG8_LDA(At, 0, 0); PG8_STAGE(PG8_SA(1, 1), a1 + hstep, voffA);
            PG8_WAIT_L(8); PG8_BAR; PG8_WAIT_L(0); PG8_MMA(0, 0, At, B0); PG8_BAR; PG8_SCHED;
            PG8_LDB(B1, 0, 1); PG8_STAGE(PG8_SB(0, 0), b2, voffB);
            PG8_BAR; PG8_WAIT_L(0); PG8_MMA(0, 1, At, B1); PG8_BAR;
            PG8_LDA(At, 0, 1); PG8_STAGE(PG8_SA(0, 0), a2, voffA);
            PG8_BAR; PG8_WAIT_L(0); PG8_MMA(1, 0, At, B0); PG8_BAR; PG8_SCHED;
            PG8_STAGE(PG8_SB(0, 1), b2 + hstep, voffB);
            PG8_WAIT_V(6); PG8_BAR; PG8_MMA(1, 1, At, B1); PG8_BAR;
            PG8_LDB(B0, 1, 0); PG8_SCHED; PG8_LDA(At, 1, 0); PG8_STAGE(PG8_SA(0, 1), a2 + hstep, voffA);
            PG8_WAIT_L(8); PG8_BAR; PG8_WAIT_L(0); PG8_MMA(0, 0, At, B0); PG8_BAR; PG8_SCHED;
            PG8_LDB(B1, 1, 1); PG8_STAGE(PG8_SB(1, 0), b3, voffB);
            PG8_BAR; PG8_WAIT_L(0); PG8_MMA(0, 1, At, B1); PG8_BAR;
            PG8_LDA(At, 1, 1); PG8_STAGE(PG8_SA(1, 0), a3, voffA);
            PG8_BAR; PG8_WAIT_L(0); PG8_MMA(1, 0, At, B0); PG8_BAR; PG8_SCHED;
            PG8_STAGE(PG8_SB(1, 1), b3 + hstep, voffB);
            PG8_WAIT_V(6); PG8_BAR; PG8_MMA(1, 1, At, B1); PG8_BAR;
            }
        }
        if constexpr (ALIGN_EPI) { if (wr == 0) PG8_BAR; }
        if constexpr (!Epi::AFTER_DRAIN) { E(acc, cur, wr, wc, fr, fq); S.done(cur); }
        if (!has_next) break;
#pragma unroll
        for (int a = 0; a < 2; ++a)
#pragma unroll
            for (int b = 0; b < 2; ++b)
#pragma unroll
                for (int m = 0; m < 4; ++m)
#pragma unroll
                    for (int n = 0; n < 2; ++n) acc[a][b][m][n] = (f32x4){0.f, 0.f, 0.f, 0.f};
        cur = nxt; cA = nA; cB = nB; ++ui;
        if constexpr (ALIGN_EPI) { if (wr == 1) PG8_BAR; }
    }
    PG8_WAIT_V(0);
    if constexpr (!ALIGN_EPI) { if (wr == 0) PG8_BAR; }
    PG8_BAR;
    if constexpr (Epi::AFTER_DRAIN) { E.fused(acc, cur, wr, wc, fr, fq, lds, wid, lane); S.done(cur); }
#undef PG8_SA
#undef PG8_SB
#undef PG8_STAGE
#undef PG8_LDA
#undef PG8_LDB
#undef PG8_MMA
#undef PG8_WAIT_V
#undef PG8_WAIT_L
#undef PG8_BAR
#undef PG8_SCHED
}
}

#define GAS __attribute__((address_space(1)))
#define LAS __attribute__((address_space(3)))
typedef unsigned short bf16;
typedef unsigned v4u __attribute__((ext_vector_type(4)));
typedef unsigned v2u __attribute__((ext_vector_type(2)));
typedef float f32x4 __attribute__((ext_vector_type(4)));
typedef float f32x2v __attribute__((ext_vector_type(2)));

constexpr int NWAVES = 8, NTHR = 512;
constexpr int D = 1024, TCX = 8192, TLT = 4096, T = 12288;
constexpr int NATT = 3072, NREC = 3840, DFF = 2816, NFF = 5632;
constexpr int QLD = NATT;
constexpr size_t MiB = 1u << 20;
constexpr size_t WS_CTL = 0, WS_MOD = 1 * MiB, WS_WATT = 2 * MiB, WS_WOA = 8 * MiB, WS_WREC = 10 * MiB, WS_WOR = 18 * MiB, WS_WF1 = 20 * MiB, WS_WF2 = 42 * MiB,
                 WS_H = 54 * MiB, WS_MIX = 78 * MiB, WS_P = 102 * MiB, WS_S = 192 * MiB, WS_END = 256 * MiB;
constexpr size_t MOD_ROPE = 160 * 1024, MOD_LAM = 176 * 1024, MOD_GUPT = 256 * 1024;
constexpr size_t WF1_STRIDE = (size_t)NFF * D;
constexpr size_t WF2_STRIDE = (size_t)D * DFF;
constexpr size_t O_YP = 0, O_YS = 8388608, O_NAK = 12582912, O_NAV = 16777216, O_DFK = 20971520, O_DFV = 25165824, O_SRET = 29360128, O_SRW = 31457280;
constexpr int LDS_BYTES = 147456;

__device__ __forceinline__ float bflo(unsigned u) { return __uint_as_float(u << 16); }
__device__ __forceinline__ float bfhi(unsigned u) { return __uint_as_float(u & 0xffff0000u); }
__device__ __forceinline__ float bf1(bf16 b) { return __uint_as_float(((unsigned)b) << 16); }
__device__ __forceinline__ unsigned f2bf(float f) { unsigned u = __float_as_uint(f); return (u + 0x7fffu + ((u >> 16) & 1u)) >> 16; }
__device__ __forceinline__ unsigned cvtpk(float lo, float hi) { typedef __bf16 b2_t __attribute__((ext_vector_type(2))); const f32x2v v = {lo, hi}; return __builtin_bit_cast(unsigned, __builtin_convertvector(v, b2_t)); }
__device__ __forceinline__ unsigned pk2(float lo, float hi) { return f2bf(lo) | (f2bf(hi) << 16); }
__device__ __forceinline__ float wave_sum(float v) {
#pragma unroll
    for (int o = 1; o < 64; o <<= 1) v += __shfl_xor(v, o);
    return v;
}
__device__ __forceinline__ float sigmoidf_(float x) { return 1.f / (1.f + __expf(-x)); }
__device__ __forceinline__ float opaque_one() { float one = 1.0f; asm volatile("" : "+v"(one)); return one; }

struct Frame {
    LAS unsigned char* lds;
    int tid, lane, wave, G, bid;
    const float* in[37];
    float* out; unsigned char* ws;
    bf16 *Watt, *Woa, *Wrec, *Wor, *Wf1, *Wf2, *H, *MIX, *P;
    float *MOD, *S;
};

__device__ __forceinline__ void transpose_item(const float* W, int K, int N, bf16* WT, int k0, int n0, int drow0, LAS float* scr, int lane) {
#pragma unroll 8
    for (int i = 0; i < 32; ++i) { const int kk = 2 * i + (lane >> 5); scr[kk * 33 + (lane & 31)] = W[(size_t)(k0 + kk) * N + n0 + (lane & 31)]; }
    asm volatile("s_waitcnt lgkmcnt(0)" ::: "memory");
    const int c = lane & 7;
#pragma unroll
    for (int j = 0; j < 4; ++j) { const int n = (lane >> 3) + 8 * j; const LAS float* s = scr + (8 * c) * 33 + n;
        v4u o; o.x = pk2(s[0 * 33], s[1 * 33]); o.y = pk2(s[2 * 33], s[3 * 33]); o.z = pk2(s[4 * 33], s[5 * 33]); o.w = pk2(s[6 * 33], s[7 * 33]);
        *(v4u*)(WT + (size_t)(drow0 + n) * K + k0 + 8 * c) = o; }
    asm volatile("s_waitcnt lgkmcnt(0)" ::: "memory");
}

__device__ __forceinline__ void p0_prologue(Frame& F) {
    {
        LAS float* sc = (LAS float*)F.lds;
        LAS float* red = sc + 3072;
        for (int idx = F.tid; idx < 3072; idx += NTHR) { const int j = idx >> 10, k = idx & 1023; const float c = (j == 0) ? F.in[9][k] : F.in[8][(j - 1) * 1024 + k]; sc[idx] = c * sigmoidf_(c); }
        __syncthreads();
        for (int item = F.bid; item < 192; item += F.G) {
            const int layer = item / 96, col = (item % 96) * 64 + (F.tid & 63), kg = F.tid >> 6;
            const float* w = F.in[13] + (size_t)layer * 1024 * 6144 + col;
            float a0 = 0.f, a1 = 0.f, a2 = 0.f;
#pragma unroll 8
            for (int k = kg * 128; k < kg * 128 + 128; ++k) { const float wv = w[(size_t)k * 6144]; a0 += sc[k] * wv; a1 += sc[1024 + k] * wv; a2 += sc[2048 + k] * wv; }
            red[(kg * 3 + 0) * 64 + (F.tid & 63)] = a0; red[(kg * 3 + 1) * 64 + (F.tid & 63)] = a1; red[(kg * 3 + 2) * 64 + (F.tid & 63)] = a2;
            __syncthreads();
            if (F.tid < 192) { const int j = F.tid >> 6, c = F.tid & 63; float s = 0.f;
#pragma unroll
                for (int g = 0; g < 8; ++g) s += red[(g * 3 + j) * 64 + c];
                const int cc = (item % 96) * 64 + c; F.MOD[(layer * 3 + j) * 6144 + cc] = s + F.in[14][layer * 6144 + cc]; }
            __syncthreads();
        }
    }
    if (F.bid == F.G - 1) {
        f32x2v* rope = (f32x2v*)((unsigned char*)F.MOD + MOD_ROPE);
        for (int idx = F.tid; idx < 1024; idx += NTHR) { const int pos = idx >> 4, i = idx & 15; const float inv = powf(10000.0f, -(float)i / 16.0f); const float ang = (float)pos * inv; rope[idx] = (f32x2v){cosf(ang), sinf(ang)}; }
        if (F.wave == 0) { const float s1 = wave_sum(F.in[18][F.lane] * F.in[19][F.lane]), s2 = wave_sum(F.in[20][F.lane] * F.in[21][F.lane]);
            if (F.lane == 0) *(float*)((unsigned char*)F.MOD + MOD_LAM) = expf(s1) - expf(s2) + 0.2f; }
    }
    { bf16* GUPT = (bf16*)(F.ws + WS_MOD + MOD_GUPT);
      for (int idx = F.bid * NTHR + F.tid; idx < 65536; idx += F.G * NTHR) { const int n = idx >> 7, k = idx & 127; GUPT[idx] = (bf16)f2bf(F.in[29][(size_t)k * 512 + n]); } }
    {
        const int gt = F.bid * NTHR + F.tid, NG = F.G * NTHR;
        for (int idx = gt; idx < 4 * 512 * 64; idx += NG) { const int t = idx / (512 * 64), r = (idx / 64) % 512, c8 = idx % 64;
            const float* srcb = (t == 0) ? F.in[2] : (t == 1) ? F.in[3] : (t == 2) ? F.in[4] : F.in[5]; const float* src = srcb + (size_t)r * 512 + c8 * 8; const int colb = (t == 0) ? 512 : (t == 1) ? 1024 : (t == 2) ? 2048 : 2560;
            const f32x4 a = *(const f32x4*)src, b = *(const f32x4*)(src + 4);
            v4u o; o.x = pk2(a[0], a[1]); o.y = pk2(a[2], a[3]); o.z = pk2(b[0], b[1]); o.w = pk2(b[2], b[3]);
            *(v4u*)(F.P + (size_t)(T + r) * QLD + colb + c8 * 8) = o; }
    }
    {
        LAS float* scr = (LAS float*)(F.lds + 20480 + F.wave * 8448);
        __syncthreads();
        const int gw = F.bid * NWAVES + F.wave, NGW = F.G * NWAVES;
        constexpr int I0 = 16 * 96, I1 = 16 * 32, I2 = 16 * 120, I3 = 16 * 32, I4 = 16 * 176, I6 = 44 * 32;
        constexpr int NIT = I0 + I1 + I2 + I3 + 2 * I4 + 2 * I6;
        for (int it = gw; it < NIT; it += NGW) {
            int r = it;
            if (r < I0) { const int nb = 96; transpose_item(F.in[15], 1024, 3072, F.Watt, 64 * (r / nb), 32 * (r % nb), 32 * (r % nb), scr, F.lane); continue; } r -= I0;
            if (r < I1) { const int nb = 32; transpose_item(F.in[16], 1024, 1024, F.Woa, 64 * (r / nb), 32 * (r % nb), 32 * (r % nb), scr, F.lane); continue; } r -= I1;
            if (r < I2) { const int nb = 120; transpose_item(F.in[22], 1024, 3840, F.Wrec, 64 * (r / nb), 32 * (r % nb), 32 * (r % nb), scr, F.lane); continue; } r -= I2;
            if (r < I3) { const int nb = 32; transpose_item(F.in[23], 1024, 1024, F.Wor, 64 * (r / nb), 32 * (r % nb), 32 * (r % nb), scr, F.lane); continue; } r -= I3;
            if (r < 2 * I4) { const int l = r / I4; r -= l * I4; const int nb = 176, n0 = 32 * (r % nb);
                const int drow = (n0 < DFF) ? ((n0 / 128) * 256 + (n0 % 128)) : (((n0 - DFF) / 128) * 256 + 128 + ((n0 - DFF) % 128));
                transpose_item(F.in[35] + (size_t)l * 1024 * NFF, 1024, NFF, F.Wf1 + (size_t)l * WF1_STRIDE, 64 * (r / nb), n0, drow, scr, F.lane); continue; } r -= 2 * I4;
            { const int l = r / I6; r -= l * I6; const int nb = 32;
                transpose_item(F.in[36] + (size_t)l * DFF * 1024, DFF, 1024, F.Wf2 + (size_t)l * WF2_STRIDE, 64 * (r / nb), 32 * (r % nb), 32 * (r % nb), scr, F.lane); }
        }
    }
}

__device__ __forceinline__ void norm_phase(Frame& F, const float* xc, const float* xl, const float* g, const float* mod  , int shift_i, int scale_i, bool zero_s) {
    const int gw = F.bid * NWAVES + F.wave, NGW = F.G * NWAVES;
    for (int row = gw; row < T; row += NGW) {
        const float* xr = (row < TCX) ? xc + (size_t)row * D : xl + (size_t)(row - TCX) * D;
        const int cond = (row < TCX) ? 0 : 1 + ((row - TCX) >> 11);
        const float* sh = mod + cond * 6144 + shift_i * 1024; const float* sc = mod + cond * 6144 + scale_i * 1024;
        f32x4 v[4]; float ss = 0.f;
#pragma unroll
        for (int j = 0; j < 4; ++j) { v[j] = *(const f32x4*)(xr + 4 * F.lane + 256 * j); ss += (v[j][0] * v[j][0] + v[j][1] * v[j][1]) + (v[j][2] * v[j][2] + v[j][3] * v[j][3]); }
        const float rstd = rsqrtf(wave_sum(ss) * (1.f / D) + 1e-6f);
#pragma unroll
        for (int j = 0; j < 4; ++j) { const int c = 4 * F.lane + 256 * j; const f32x4 gg = *(const f32x4*)(g + c), s1 = *(const f32x4*)(sc + c), s0 = *(const f32x4*)(sh + c);
            f32x4 h;
#pragma unroll
            for (int e = 0; e < 4; ++e) h[e] = v[j][e] * rstd * gg[e] * (1.f + s1[e]) + s0[e];
            v2u o; o.x = pk2(h[0], h[1]); o.y = pk2(h[2], h[3]); *(v2u*)(F.H + (size_t)row * D + c) = o; }
    }
    if (zero_s) {
        const size_t n16 = (size_t)48 * MiB / 16; f32x4* p = (f32x4*)F.S;
        for (size_t i = (size_t)F.bid * NTHR + F.tid; i < n16; i += (size_t)F.G * NTHR) p[i] = (f32x4){0.f, 0.f, 0.f, 0.f};
    }
}
__device__ __forceinline__ void zero_s_phase(Frame& F) {
    const size_t n16 = (size_t)48 * MiB / 16; f32x4* p = (f32x4*)F.S;
    for (size_t i = (size_t)F.bid * NTHR + F.tid; i < n16; i += (size_t)F.G * NTHR) p[i] = (f32x4){0.f, 0.f, 0.f, 0.f};
}
__device__ __forceinline__ void final_norm_phase(Frame& F) {
    const int gw = F.bid * NWAVES + F.wave, NGW = F.G * NWAVES; const float* g = F.in[12];
    for (int row = gw; row < T; row += NGW) {
        float* xr = F.out + (size_t)row * D;
        f32x4 v[4]; float ss = 0.f;
#pragma unroll
        for (int j = 0; j < 4; ++j) { v[j] = *(const f32x4*)(xr + 4 * F.lane + 256 * j); ss += (v[j][0] * v[j][0] + v[j][1] * v[j][1]) + (v[j][2] * v[j][2] + v[j][3] * v[j][3]); }
        const float rstd = rsqrtf(wave_sum(ss) * (1.f / D) + 1e-6f);
#pragma unroll
        for (int j = 0; j < 4; ++j) { const int c = 4 * F.lane + 256 * j; const f32x4 gg = *(const f32x4*)(g + c); *(f32x4*)(xr + c) = v[j] * rstd * gg; }
    }
}

struct EpiAttnIn {
    static constexpr bool PERM = true, AFTER_DRAIN = false;
    bf16* QKV; float* out; const f32x2v* rope;
    __device__ __forceinline__ void operator()(const f32x4 (&acc)[2][2][4][2], const pg8::Unit& u, int wr, int wc, int fr, int fq) const {
        const int pn = u.pn; const bool ctx = u.pm < 32;
        float* cdst = nullptr; int cbase = 0;
        if (ctx) { if (pn == 2 || pn == 3) { cdst = out + O_NAK; cbase = 512; } else if (pn == 4 || pn == 5) { cdst = out + O_NAV; cbase = 1024; }
                   else if (pn == 8 || pn == 9) { cdst = out + O_DFK; cbase = 2048; } else if (pn == 10 || pn == 11) { cdst = out + O_DFV; cbase = 2560; } }
        const bool rope_on = (!ctx) && pn >= 6 && pn <= 9;
        const float sgn = (fq < 2) ? -1.f : 1.f;
        const float one_ = opaque_one();
#pragma unroll
        for (int ai = 0; ai < 2; ++ai)
#pragma unroll
            for (int m = 0; m < 4; ++m) { const int row = u.pm * 256 + ai * 128 + wr * 64 + m * 16 + fr;
#pragma unroll
                for (int bj = 0; bj < 2; ++bj) { const int col = pn * 256 + bj * 128 + wc * 32 + 8 * fq;
                    f32x4 v0 = acc[ai][bj][m][0] * one_, v1 = acc[ai][bj][m][1] * one_;
                    if (rope_on) { const int n = (row - TCX) & 2047; const int p = (wc & 1) ? (n & 63) : (n >> 6); const f32x2v* tb = rope + p * 16 + 8 * (fq & 1);
#pragma unroll
                        for (int e = 0; e < 4; ++e) { const float p0 = __shfl_xor(v0[e], 32), p1 = __shfl_xor(v1[e], 32); const f32x2v c0 = tb[e], c1 = tb[4 + e];
                            v0[e] = v0[e] * c0.x + sgn * p0 * c0.y; v1[e] = v1[e] * c1.x + sgn * p1 * c1.y; } }
                    v4u w; w.x = pg8::cvt_pk_bf16(v0[0], v0[1]); w.y = pg8::cvt_pk_bf16(v0[2], v0[3]); w.z = pg8::cvt_pk_bf16(v1[0], v1[1]); w.w = pg8::cvt_pk_bf16(v1[2], v1[3]);
                    *(v4u*)(QKV + (size_t)row * QLD + col) = w;
                    if (cdst) { float* cp = cdst + (size_t)row * 512 + (col - cbase); *(f32x4*)cp = v0; *(f32x4*)(cp + 4) = v1; } } }
    }
};
struct EpiBf16Plain {
    static constexpr bool PERM = true, AFTER_DRAIN = false;
    bf16* O; int ldc;
    __device__ __forceinline__ void operator()(const f32x4 (&acc)[2][2][4][2], const pg8::Unit& u, int wr, int wc, int fr, int fq) const {
        const float one_ = opaque_one();
#pragma unroll
        for (int ai = 0; ai < 2; ++ai)
#pragma unroll
            for (int m = 0; m < 4; ++m) { const int row = u.pm * 256 + ai * 128 + wr * 64 + m * 16 + fr;
#pragma unroll
                for (int bj = 0; bj < 2; ++bj) { const int col = u.pn * 256 + bj * 128 + wc * 32 + 8 * fq; const f32x4 v0 = acc[ai][bj][m][0] * one_, v1 = acc[ai][bj][m][1] * one_;
                    v4u w; w.x = pg8::cvt_pk_bf16(v0[0], v0[1]); w.y = pg8::cvt_pk_bf16(v0[2], v0[3]); w.z = pg8::cvt_pk_bf16(v1[0], v1[1]); w.w = pg8::cvt_pk_bf16(v1[2], v1[3]);
                    *(v4u*)(O + (size_t)row * ldc + col) = w; } }
    }
};
struct EpiSwiglu {
    static constexpr bool PERM = true, AFTER_DRAIN = false;
    bf16* O;
    __device__ __forceinline__ void operator()(const f32x4 (&acc)[2][2][4][2], const pg8::Unit& u, int wr, int wc, int fr, int fq) const {
#pragma unroll
        for (int ai = 0; ai < 2; ++ai)
#pragma unroll
            for (int m = 0; m < 4; ++m) { const int row = u.pm * 256 + ai * 128 + wr * 64 + m * 16 + fr; const int col = u.pn * 128 + wc * 32 + 8 * fq;
                float r[8];
#pragma unroll
                for (int n = 0; n < 2; ++n)
#pragma unroll
                    for (int e = 0; e < 4; ++e) { const float g = acc[ai][0][m][n][e], up = acc[ai][1][m][n][e]; r[4 * n + e] = g * __builtin_amdgcn_rcpf(1.f + __expf(-g)) * up; }
                v4u w; w.x = pg8::cvt_pk_bf16(r[0], r[1]); w.y = pg8::cvt_pk_bf16(r[2], r[3]); w.z = pg8::cvt_pk_bf16(r[4], r[5]); w.w = pg8::cvt_pk_bf16(r[6], r[7]);
                *(v4u*)(O + (size_t)row * DFF + col) = w; }
    }
};
struct EpiResid {
    static constexpr bool PERM = false, AFTER_DRAIN = false;
    const float* bc; const float* bl; float* X; const float* mod; int gate_i;
    __device__ __forceinline__ void operator()(const f32x4 (&acc)[2][2][4][2], const pg8::Unit& u, int wr, int wc, int fr, int fq) const {
        const int cond = (u.pm < 32) ? 0 : ((u.pm < 40) ? 1 : 2);
        const float* gate = mod + cond * 6144 + gate_i * 1024;
        const float* base = (u.pm < 32) ? bc : bl - (size_t)TCX * D;
        const int col0 = u.pn * 256 + wc * 32 + 4 * fq;
        f32x4 gv[2][2];
#pragma unroll
        for (int bj = 0; bj < 2; ++bj)
#pragma unroll
            for (int n = 0; n < 2; ++n) gv[bj][n] = *(const f32x4*)(gate + col0 + bj * 128 + n * 16);
#pragma unroll
        for (int ai = 0; ai < 2; ++ai)
#pragma unroll
            for (int m = 0; m < 4; ++m) { const size_t off = (size_t)(u.pm * 256 + ai * 128 + wr * 64 + m * 16 + fr) * D + col0;
#pragma unroll
                for (int bj = 0; bj < 2; ++bj)
#pragma unroll
                    for (int n = 0; n < 2; ++n) { const f32x4 b = *(const f32x4*)(base + off + bj * 128 + n * 16); *(f32x4*)(X + off + bj * 128 + n * 16) = b + gv[bj][n] * acc[ai][bj][m][n]; } }
    }
};

#define KEY_STEP(kp, vp, biasv) do { \
    float s_ = 0.f; \
    _Pragma("unroll") for (int c_ = 0; c_ < 8; ++c_) { const v4u kv_ = *(const v4u*)((kp) + 8 * c_); \
        s_ += q[8 * c_ + 0] * bflo(kv_.x) + q[8 * c_ + 1] * bfhi(kv_.x) + q[8 * c_ + 2] * bflo(kv_.y) + q[8 * c_ + 3] * bfhi(kv_.y) \
            + q[8 * c_ + 4] * bflo(kv_.z) + q[8 * c_ + 5] * bfhi(kv_.z) + q[8 * c_ + 6] * bflo(kv_.w) + q[8 * c_ + 7] * bfhi(kv_.w); } \
    s_ = s_ * 0.125f + (biasv); \
    const float mn_ = fmaxf(m, s_), al_ = __expf(m - mn_), p_ = __expf(s_ - mn_); l = l * al_ + p_; m = mn_; \
    _Pragma("unroll") for (int c_ = 0; c_ < 8; ++c_) { const v4u vv_ = *(const v4u*)((vp) + 8 * c_); \
        o[8 * c_ + 0] = o[8 * c_ + 0] * al_ + p_ * bflo(vv_.x); o[8 * c_ + 1] = o[8 * c_ + 1] * al_ + p_ * bfhi(vv_.x); \
        o[8 * c_ + 2] = o[8 * c_ + 2] * al_ + p_ * bflo(vv_.y); o[8 * c_ + 3] = o[8 * c_ + 3] * al_ + p_ * bfhi(vv_.y); \
        o[8 * c_ + 4] = o[8 * c_ + 4] * al_ + p_ * bflo(vv_.z); o[8 * c_ + 5] = o[8 * c_ + 5] * al_ + p_ * bfhi(vv_.z); \
        o[8 * c_ + 6] = o[8 * c_ + 6] * al_ + p_ * bflo(vv_.w); o[8 * c_ + 7] = o[8 * c_ + 7] * al_ + p_ * bfhi(vv_.w); } } while (0)
#define LOAD_Q(qp) do { _Pragma("unroll") for (int c_ = 0; c_ < 8; ++c_) { const v4u qv_ = *(const v4u*)((qp) + 8 * c_); \
        q[8 * c_ + 0] = bflo(qv_.x); q[8 * c_ + 1] = bfhi(qv_.x); q[8 * c_ + 2] = bflo(qv_.y); q[8 * c_ + 3] = bfhi(qv_.y); \
        q[8 * c_ + 4] = bflo(qv_.z); q[8 * c_ + 5] = bfhi(qv_.z); q[8 * c_ + 6] = bflo(qv_.w); q[8 * c_ + 7] = bfhi(qv_.w); } } while (0)

__device__ __forceinline__ void attn_naive_phase(Frame& F) {
    const bf16* QKV = F.P; const float lam = *(const float*)((unsigned char*)F.MOD + MOD_LAM);
    float* DIFFO = F.S; const float* rpb = F.in[17];
    constexpr int ND = 32768, NC = 32768, NB = 65536, NA = 65536, NTASK = ND + NC + NB + NA;
    for (int task = F.bid * NTHR + F.tid; task < NTASK; task += F.G * NTHR) {
        float q[64], o[64]; float m, l;
        if (task < ND || (task >= ND + NC && task < ND + NC + NB)) {
            const bool lat = task < ND; int idx = lat ? task : task - ND - NC;
            int n, b, h, vh;
            if (lat) { n = idx & 2047; idx >>= 11; b = idx & 1; idx >>= 1; h = idx & 3; vh = idx >> 2; }
            else { n = idx & 255; idx >>= 8; b = idx & 31; idx >>= 5; h = idx & 3; vh = idx >> 2; }
            const int row = lat ? TCX + b * 2048 + n : b * 256 + n;
            const int krow0 = lat ? TCX + b * 2048 : b * 256, nk0 = lat ? 2048 : 256, krow1 = T + b * 256, nk1 = lat ? 256 : 0;
            const int vcol = 2560 + h * 128 + vh * 64;
            float o1[64];
#pragma unroll
            for (int c = 0; c < 2; ++c) {
                const int qcol = 1536 + h * 128 + c * 64, kcol = 2048 + h * 128 + c * 64;
                LOAD_Q(QKV + (size_t)row * QLD + qcol);
#pragma unroll
                for (int d = 0; d < 64; ++d) o[d] = 0.f;
                m = -INFINITY; l = 0.f;
                for (int j = 0; j < nk0; ++j) { const bf16* kr = QKV + (size_t)(krow0 + j) * QLD; KEY_STEP(kr + kcol, kr + vcol, 0.f); }
                for (int j = 0; j < nk1; ++j) { const bf16* kr = QKV + (size_t)(krow1 + j) * QLD; KEY_STEP(kr + kcol, kr + vcol, 0.f); }
                const float il = 1.f / l;
                if (c == 0) {
#pragma unroll
                    for (int d = 0; d < 64; ++d) o1[d] = o[d] * il;
                } else {
                    float* dst = DIFFO + (size_t)row * 512 + h * 128 + vh * 64;
#pragma unroll
                    for (int d = 0; d < 64; d += 4) *(f32x4*)(dst + d) = (f32x4){o1[d] - lam * o[d] * il, o1[d + 1] - lam * o[d + 1] * il, o1[d + 2] - lam * o[d + 2] * il, o1[d + 3] - lam * o[d + 3] * il};
                }
            }
        } else {
            const bool lat = task < ND + NC; int idx = lat ? task - ND : task - ND - NC - NB;
            int n, b, h;
            if (lat) { n = idx & 2047; idx >>= 11; b = idx & 1; h = idx >> 1; } else { n = idx & 255; idx >>= 8; b = idx & 31; h = idx >> 5; }
            const int row = lat ? TCX + b * 2048 + n : b * 256 + n;
            const int kcol = 512 + h * 64, vcol = 1024 + h * 64;
            LOAD_Q(QKV + (size_t)row * QLD + h * 64);
#pragma unroll
            for (int d = 0; d < 64; ++d) o[d] = 0.f;
            m = -INFINITY; l = 0.f;
            if (lat) {
                const int r = n >> 6, qc = n & 63; const int rs = min(max(r - 4, 0), 24), cs = min(max(qc - 8, 0), 48);
                for (int i = 0; i < 8; ++i) for (int cc = 0; cc < 16; ++cc) { const int kr_ = rs + i, kc = cs + cc;
                    const bf16* kr = QKV + (size_t)(TCX + b * 2048 + kr_ * 64 + kc) * QLD; const float bias = rpb[h * 465 + (kr_ - r + 7) * 31 + (kc - qc + 15)];
                    KEY_STEP(kr + kcol, kr + vcol, bias); }
                for (int j = 0; j < 256; ++j) { const bf16* kr = QKV + (size_t)(T + b * 256 + j) * QLD; KEY_STEP(kr + kcol, kr + vcol, 0.f); }
            } else {
                for (int j = 0; j < 256; ++j) { const bf16* kr = QKV + (size_t)(b * 256 + j) * QLD; KEY_STEP(kr + kcol, kr + vcol, 0.f); }
            }
            const float il = 1.f / l; bf16* dst = F.MIX + (size_t)row * D + h * 64;
#pragma unroll
            for (int d = 0; d < 64; d += 8) { v4u w; w.x = pk2(o[d] * il, o[d + 1] * il); w.y = pk2(o[d + 2] * il, o[d + 3] * il); w.z = pk2(o[d + 4] * il, o[d + 5] * il); w.w = pk2(o[d + 6] * il, o[d + 7] * il); *(v4u*)(dst + d) = w; }
        }
    }
}
__device__ __forceinline__ void diff_post_phase(Frame& F) {
    const int gw = F.bid * NWAVES + F.wave, NGW = F.G * NWAVES; const float* DIFFO = F.S;
    for (int it = gw; it < T * 4; it += NGW) { const int row = it >> 2, h = it & 3;
        const f32x2v v = *(const f32x2v*)(DIFFO + (size_t)row * 512 + h * 128 + 2 * F.lane);
        const float r = rsqrtf(wave_sum(v.x * v.x + v.y * v.y) * (1.f / 128.f) + 1e-6f) * 0.8f;
        *(unsigned*)(F.MIX + (size_t)row * D + 512 + h * 128 + 2 * F.lane) = pk2(v.x * r, v.y * r); }
}

typedef short bf16x8 __attribute__((ext_vector_type(8)));
typedef short s16x4 __attribute__((ext_vector_type(4)));
constexpr float LOG2E = 1.4426950408889634f;
__device__ __forceinline__ s16x4 tr_read(LAS unsigned char* p) { return __builtin_bit_cast(s16x4, __builtin_amdgcn_ds_read_tr16_b64_v4i16((LAS s16x4*)p)); }

template <int KIND>
__device__ __forceinline__ void attn_unit(Frame& F, int u) {
    constexpr bool DIFF = (KIND & 1) != 0;
    constexpr int DV = DIFF ? 128 : 64, NC = DV / 16, VSTR = DIFF ? 288 : 160, KSTR = 144;
    constexpr int K0_OFF = 0, K1_OFF = 9216, V_OFF = 18432, X_OFF = 40960, XSTR = 132, RPB_OFF = 110592;
    const int tid = F.tid, lane = F.lane, wave = F.wave, q16 = lane & 15, g = lane >> 4;
    LAS unsigned char* lds = F.lds;
    const bf16* QKV = F.P;
    int b, h, qrow0, ntiles, nW = 0, R0k = 0;
    if (KIND == 0) { b = u >> 3; h = u & 7; qrow0 = b * 256; ntiles = 4; }
    else if (KIND == 1) { const int half = u & 1; h = (u >> 1) & 3; b = u >> 3; qrow0 = b * 256 + half * 128; ntiles = 4; }
    else if (KIND == 2) { const int R = u & 7; h = (u >> 3) & 7; b = u >> 6; qrow0 = TCX + b * 2048 + R * 256; R0k = min(max(4 * R - 4, 0), 24); nW = min(max(4 * R - 1, 0), 24) + 8 - R0k; ntiles = nW + 4; }
    else { const int qb = u & 15; h = (u >> 4) & 3; b = u >> 6; qrow0 = TCX + b * 2048 + qb * 128; ntiles = 36; }
    const int sidx = DIFF ? (wave >> 2) : 0;
    const int wq = DIFF ? (wave & 3) * 32 : wave * 32;
    const int qcol = DIFF ? 1536 + h * 128 + sidx * 64 : h * 64;
    const int kcol0 = DIFF ? 2048 + h * 128 : 512 + h * 64;
    const int vcol = DIFF ? 2560 + h * 128 : 1024 + h * 64;
#define KROW(ti) ((KIND <= 1) ? (b * 256 + 64 * (ti)) : (KIND == 2) ? (((ti) < nW) ? (TCX + b * 2048 + (R0k + (ti)) * 64) : (T + b * 256 + 64 * ((ti) - nW))) : (((ti) < 32) ? (TCX + b * 2048 + 64 * (ti)) : (T + b * 256 + 64 * ((ti) - 32))))
    v4u rk0, rk1, rv0, rv1;
#define LOAD_TILE(ti) do { const bf16* rp_ = QKV + (size_t)(KROW(ti) + (tid >> 3)) * QLD + 8 * (tid & 7); rk0 = *(const v4u*)(rp_ + kcol0); rv0 = *(const v4u*)(rp_ + vcol); \
        if (DIFF) { rk1 = *(const v4u*)(rp_ + kcol0 + 64); rv1 = *(const v4u*)(rp_ + vcol + 64); } } while (0)
#define STORE_TILE() do { const int row_ = tid >> 3, ch_ = tid & 7; const int prow_ = (row_ & 39) | ((row_ & 8) << 1) | ((row_ & 16) >> 1); \
        *(LAS v4u*)(lds + K0_OFF + prow_ * KSTR + ch_ * 16) = rk0; *(LAS v4u*)(lds + V_OFF + row_ * VSTR + ch_ * 16) = rv0; \
        if (DIFF) { *(LAS v4u*)(lds + K1_OFF + prow_ * KSTR + ch_ * 16) = rk1; *(LAS v4u*)(lds + V_OFF + row_ * VSTR + 128 + ch_ * 16) = rv1; } } while (0)
    LAS float* rpbL = (LAS float*)(lds + RPB_OFF);
    if (KIND == 2) { __syncthreads(); if (tid < 465) rpbL[tid] = F.in[17][h * 465 + tid] * LOG2E; }
    bf16x8 qf[2][2];
#pragma unroll
    for (int grp = 0; grp < 2; ++grp)
#pragma unroll
        for (int kd = 0; kd < 2; ++kd) qf[grp][kd] = *(const bf16x8*)(QKV + (size_t)(qrow0 + wq + 16 * grp + q16) * QLD + qcol + 32 * kd + 8 * g);
    f32x4 o[2][NC];
#pragma unroll
    for (int grp = 0; grp < 2; ++grp)
#pragma unroll
        for (int c = 0; c < NC; ++c) o[grp][c] = (f32x4){0.f, 0.f, 0.f, 0.f};
    float mrun[2] = {-1e30f, -1e30f}, lsum[2] = {0.f, 0.f};
    const int wr_ = (KIND == 2) ? (((qrow0 - TCX) & 2047) >> 6) + (wave >> 1) : 0;
    const int wrs = min(max(wr_ - 4, 0), 24);
    const int koff = (DIFF && sidx) ? K1_OFF : K0_OFF;
    constexpr float C1 = 0.125f * LOG2E;
    LOAD_TILE(0);
    for (int ti = 0; ti < ntiles; ++ti) {
        __syncthreads();
        STORE_TILE();
        __syncthreads();
        if (ti + 1 < ntiles) LOAD_TILE(ti + 1);
        bool active = true; int krow_g = 0; bool win = false;
        if (KIND == 2) { win = ti < nW; krow_g = R0k + ti; active = (!win) || (krow_g >= wrs && krow_g < wrs + 8); }
        if (active) {
            f32x4 s[2][2][2];
#pragma unroll
            for (int ks = 0; ks < 2; ++ks)
#pragma unroll
                for (int t = 0; t < 2; ++t) {
                    s[0][ks][t] = (f32x4){0.f, 0.f, 0.f, 0.f}; s[1][ks][t] = (f32x4){0.f, 0.f, 0.f, 0.f};
#pragma unroll
                    for (int kd = 0; kd < 2; ++kd) { const bf16x8 kf = *(const LAS bf16x8*)(lds + koff + (32 * ks + 16 * t + q16) * KSTR + 64 * kd + 16 * g);
                        s[0][ks][t] = __builtin_amdgcn_mfma_f32_16x16x32_bf16(kf, qf[0][kd], s[0][ks][t], 0, 0, 0);
                        s[1][ks][t] = __builtin_amdgcn_mfma_f32_16x16x32_bf16(kf, qf[1][kd], s[1][ks][t], 0, 0, 0); }
                }
            bf16x8 pf[2][2];
#pragma unroll
            for (int grp = 0; grp < 2; ++grp) {
                float tv[2][2][4];
                if (KIND == 2 && win) {
                    const int qc = (wave & 1) * 32 + 16 * grp + q16, cs = min(max(qc - 8, 0), 48); const LAS float* brow = rpbL + (krow_g - wr_ + 7) * 31 + 15 - qc;
#pragma unroll
                    for (int ks = 0; ks < 2; ++ks)
#pragma unroll
                        for (int t = 0; t < 2; ++t)
#pragma unroll
                            for (int e = 0; e < 4; ++e) { const int kc = 32 * ks + 16 * (g >> 1) + 8 * t + 4 * (g & 1) + e; const bool ok = (unsigned)(kc - cs) < 16u; const float bv_ = brow[ok ? kc : qc];
                                tv[ks][t][e] = ok ? s[grp][ks][t][e] * C1 + bv_ : -1e30f; }
                } else {
#pragma unroll
                    for (int ks = 0; ks < 2; ++ks)
#pragma unroll
                        for (int t = 0; t < 2; ++t)
#pragma unroll
                            for (int e = 0; e < 4; ++e) tv[ks][t][e] = s[grp][ks][t][e] * C1;
                }
                float tmax = -1e30f;
#pragma unroll
                for (int ks = 0; ks < 2; ++ks)
#pragma unroll
                    for (int t = 0; t < 2; ++t)
#pragma unroll
                        for (int e = 0; e < 4; ++e) tmax = fmaxf(tmax, tv[ks][t][e]);
                tmax = fmaxf(tmax, __shfl_xor(tmax, 16)); tmax = fmaxf(tmax, __shfl_xor(tmax, 32));
                const float mn = fmaxf(mrun[grp], tmax), al = __builtin_amdgcn_exp2f(mrun[grp] - mn); mrun[grp] = mn;
                float ps = 0.f;
#pragma unroll
                for (int ks = 0; ks < 2; ++ks) {
                    float p[8];
#pragma unroll
                    for (int t = 0; t < 2; ++t)
#pragma unroll
                        for (int e = 0; e < 4; ++e) { p[4 * t + e] = __builtin_amdgcn_exp2f(tv[ks][t][e] - mn); ps += p[4 * t + e]; }
                    v4u w; w.x = pg8::cvt_pk_bf16(p[0], p[1]); w.y = pg8::cvt_pk_bf16(p[2], p[3]); w.z = pg8::cvt_pk_bf16(p[4], p[5]); w.w = pg8::cvt_pk_bf16(p[6], p[7]);
                    pf[grp][ks] = __builtin_bit_cast(bf16x8, w);
                }
                lsum[grp] = lsum[grp] * al + ps;
#pragma unroll
                for (int c = 0; c < NC; ++c) o[grp][c] = o[grp][c] * al;
            }
#pragma unroll
            for (int ks = 0; ks < 2; ++ks)
#pragma unroll
                for (int c = 0; c < NC; ++c) {
                    LAS unsigned char* vb = lds + V_OFF + (32 * ks + 16 * (g >> 1) + 4 * (g & 1) + (q16 >> 2)) * VSTR + (16 * c + 4 * (lane & 3)) * 2;
                    const s16x4 v0 = tr_read(vb), v1 = tr_read(vb + 8 * VSTR);
                    const bf16x8 vf = (bf16x8){v0[0], v0[1], v0[2], v0[3], v1[0], v1[1], v1[2], v1[3]};
                    o[0][c] = __builtin_amdgcn_mfma_f32_16x16x32_bf16(vf, pf[0][ks], o[0][c], 0, 0, 0);
                    o[1][c] = __builtin_amdgcn_mfma_f32_16x16x32_bf16(vf, pf[1][ks], o[1][c], 0, 0, 0);
                }
        }
    }
    float inv[2];
#pragma unroll
    for (int grp = 0; grp < 2; ++grp) { float l = lsum[grp]; l += __shfl_xor(l, 16); l += __shfl_xor(l, 32); inv[grp] = 1.f / l; }
    if (!DIFF) {
#pragma unroll
        for (int grp = 0; grp < 2; ++grp) { bf16* dst = F.MIX + (size_t)(qrow0 + wq + 16 * grp + q16) * D + h * 64 + 4 * g;
#pragma unroll
            for (int c = 0; c < NC; ++c) { const f32x4 v = o[grp][c] * inv[grp]; v2u w; w.x = pg8::cvt_pk_bf16(v[0], v[1]); w.y = pg8::cvt_pk_bf16(v[2], v[3]); *(v2u*)(dst + 16 * c) = w; } }
    } else {
        const float lam = *(const float*)((unsigned char*)F.MOD + MOD_LAM);
        LAS float* X = (LAS float*)(lds + X_OFF);
        if (sidx == 1) {
#pragma unroll
            for (int grp = 0; grp < 2; ++grp)
#pragma unroll
                for (int c = 0; c < NC; ++c) *(LAS f32x4*)(X + (wq + 16 * grp + q16) * XSTR + 16 * c + 4 * g) = o[grp][c] * inv[grp];
        }
        __syncthreads();
        if (sidx == 0) {
#pragma unroll
            for (int grp = 0; grp < 2; ++grp) {
                float ss = 0.f;
#pragma unroll
                for (int c = 0; c < NC; ++c) { const f32x4 x2 = *(const LAS f32x4*)(X + (wq + 16 * grp + q16) * XSTR + 16 * c + 4 * g); o[grp][c] = o[grp][c] * inv[grp] - x2 * lam;
                    ss += (o[grp][c][0] * o[grp][c][0] + o[grp][c][1] * o[grp][c][1]) + (o[grp][c][2] * o[grp][c][2] + o[grp][c][3] * o[grp][c][3]); }
                ss += __shfl_xor(ss, 16); ss += __shfl_xor(ss, 32);
                const float r = rsqrtf(ss * (1.f / 128.f) + 1e-6f) * 0.8f;
                bf16* dst = F.MIX + (size_t)(qrow0 + wq + 16 * grp + q16) * D + 512 + h * 128 + 4 * g;
#pragma unroll
                for (int c = 0; c < NC; ++c) { const f32x4 v = o[grp][c] * r; v2u w; w.x = pg8::cvt_pk_bf16(v[0], v[1]); w.y = pg8::cvt_pk_bf16(v[2], v[3]); *(v2u*)(dst + 16 * c) = w; }
            }
        }
    }
#undef KROW
#undef LOAD_TILE
#undef STORE_TILE
}
__device__ __forceinline__ void attn_mfma_phase(Frame& F) {
    if (F.G == 256) {
        if (F.bid < 128) attn_unit<3>(F, F.bid);
        else { const int i = F.bid - 128; attn_unit<2>(F, i); attn_unit<1>(F, 2 * i); attn_unit<1>(F, 2 * i + 1); attn_unit<0>(F, 2 * i); attn_unit<0>(F, 2 * i + 1); }
    } else {
        for (int i = F.bid; i < 768; i += F.G) { if (i < 128) attn_unit<3>(F, i); else if (i < 256) attn_unit<2>(F, i - 128); else if (i < 512) attn_unit<1>(F, i - 256); else attn_unit<0>(F, i - 512); }
    }
}

__device__ __forceinline__ void rwkv_job(Frame& F, int seq, int h, int dir) {
    LAS float* L = (LAS float*)F.lds;
    LAS float *WUP = L, *AUP = L + 4096, *Lr = L + 8192, *Lk = Lr + 1024, *Lv = Lk + 1024, *Lwd = Lv + 1024, *Lad = Lwd + 1024, *Lw = Lad + 1024, *La = Lw + 1024, *Lkk = La + 1024, *Lkef = Lkk + 1024, *Lb = Lkef + 1024, *Ly = Lb + 1024;
    const int tid = F.tid, lane = F.lane, w = F.wave;
    const bool lat = seq >= 32; const int b = lat ? seq - 32 : seq, N = lat ? 2048 : 256, R0 = lat ? TCX + b * 2048 : b * 256;
    const bf16* PROJ = F.P; float* Y = F.S;
    __syncthreads();
    for (int idx = tid; idx < 4096; idx += NTHR) { const int j = idx >> 6, k = idx & 63; WUP[idx] = F.in[26][(size_t)(dir * 64 + j) * 512 + h * 64 + k]; AUP[idx] = F.in[28][(size_t)(dir * 64 + j) * 512 + h * 64 + k]; }
    const int i = 8 * w + (lane >> 3), s = lane & 7;
    float S[8];
    {
        const float* st = F.in[7] + (size_t)((b * 2 + dir) * 8 + h) * 4096 + i * 64 + 8 * s;
#pragma unroll
        for (int kk = 0; kk < 8; ++kk) S[kk] = lat ? st[kk] : 0.f;
    }
    for (int t0 = 0; t0 < N; t0 += 16) {
#pragma unroll
        for (int rep = 0; rep < 2; ++rep) { const int idx = tid + NTHR * rep, j = idx >> 6, k = idx & 63; const int n = dir ? N - 1 - (t0 + j) : t0 + j;
            const bf16* pr = PROJ + (size_t)(R0 + n) * NREC;
            Lr[idx] = bf1(pr[2048 + h * 64 + k]); Lk[idx] = bf1(pr[2560 + h * 64 + k]); Lv[idx] = bf1(pr[3072 + h * 64 + k]); Lwd[idx] = tanhf(bf1(pr[3584 + k])); Lad[idx] = bf1(pr[3648 + k]); }
        __syncthreads();
#pragma unroll
        for (int rep = 0; rep < 2; ++rep) { const int idx = tid + NTHR * rep, j = idx >> 6, k = idx & 63;
            float zw = F.in[25][dir * 512 + h * 64 + k], za = F.in[27][dir * 512 + h * 64 + k];
#pragma unroll 8
            for (int jj = 0; jj < 64; ++jj) { zw += Lwd[j * 64 + jj] * WUP[jj * 64 + k]; za += Lad[j * 64 + jj] * AUP[jj * 64 + k]; }
            Lw[idx] = __expf(-0.6065306597f * sigmoidf_(zw)); La[idx] = sigmoidf_(za); }
        if (tid < 256) { const int j = tid >> 4, p = tid & 15; float v[4]; float ss = 0.f;
#pragma unroll
            for (int e = 0; e < 4; ++e) { v[e] = Lk[j * 64 + 4 * p + e] * F.in[30][h * 64 + 4 * p + e]; ss += v[e] * v[e]; }
            ss += __shfl_xor(ss, 1); ss += __shfl_xor(ss, 2); ss += __shfl_xor(ss, 4); ss += __shfl_xor(ss, 8);
            const float rs = rsqrtf(ss + 1e-12f);
#pragma unroll
            for (int e = 0; e < 4; ++e) Lkk[j * 64 + 4 * p + e] = v[e] * rs; }
        __syncthreads();
#pragma unroll
        for (int rep = 0; rep < 2; ++rep) { const int idx = tid + NTHR * rep, k = idx & 63; const float a = La[idx];
            Lkef[idx] = Lk[idx] * (1.f + (a - 1.f) * F.in[31][h * 64 + k]); Lb[idx] = Lkk[idx] * a; }
        __syncthreads();
        for (int j = 0; j < 16; ++j) {
            const int o8 = j * 64 + 8 * s;
            float sa = 0.f;
#pragma unroll
            for (int kk = 0; kk < 8; ++kk) sa -= S[kk] * Lkk[o8 + kk];
            sa += __shfl_xor(sa, 1); sa += __shfl_xor(sa, 2); sa += __shfl_xor(sa, 4);
            const float vi = Lv[j * 64 + i];
            float y = 0.f;
#pragma unroll
            for (int kk = 0; kk < 8; ++kk) { S[kk] = S[kk] * Lw[o8 + kk] + sa * Lb[o8 + kk] + vi * Lkef[o8 + kk]; y += S[kk] * Lr[o8 + kk]; }
            y += __shfl_xor(y, 1); y += __shfl_xor(y, 2); y += __shfl_xor(y, 4);
            if (s == 0) Ly[j * 64 + i] = y;
        }
        __syncthreads();
#pragma unroll
        for (int rep = 0; rep < 2; ++rep) { const int idx = tid + NTHR * rep, j = idx >> 6, k = idx & 63; const int n = dir ? N - 1 - (t0 + j) : t0 + j;
            atomicAdd(Y + (size_t)(R0 + n) * 512 + h * 64 + k, Ly[idx]); }
    }
    if (!lat) { float* so = F.out + O_SRW + (size_t)((b * 2 + dir) * 8 + h) * 4096 + i * 64 + 8 * s;
#pragma unroll
        for (int kk = 0; kk < 8; ++kk) so[kk] = S[kk]; }
}
__device__ __forceinline__ void ret_job(Frame& F, int seq, int h, int dir) {
    LAS float* L = (LAS float*)F.lds;
    LAS float *Lq = L, *Lk = L + 1024, *Lv = L + 2048, *Lo = L + 3072;
    const int tid = F.tid, lane = F.lane, w = F.wave;
    const bool lat = seq >= 32; const int b = lat ? seq - 32 : seq, N = lat ? 2048 : 256, R0 = lat ? TCX + b * 2048 : b * 256;
    const bf16* PROJ = F.P; float* O = F.S + (size_t)T * 512;
    const float g = sigmoidf_(F.in[24][dir * 8 + h]);
    const int e = 8 * w + (lane >> 3), s = lane & 7;
    float S[8];
    {
        const float* st = F.in[6] + (size_t)((b * 2 + dir) * 8 + h) * 4096;
#pragma unroll
        for (int dd = 0; dd < 8; ++dd) S[dd] = lat ? st[(8 * s + dd) * 64 + e] : 0.f;
    }
    __syncthreads();
    for (int t0 = 0; t0 < N; t0 += 16) {
#pragma unroll
        for (int rep = 0; rep < 2; ++rep) { const int idx = tid + NTHR * rep, j = idx >> 6, k = idx & 63; const int n = dir ? N - 1 - (t0 + j) : t0 + j;
            const bf16* pr = PROJ + (size_t)(R0 + n) * NREC;
            Lq[idx] = bf1(pr[h * 64 + k]); Lk[idx] = bf1(pr[512 + h * 64 + k]) * 0.125f; Lv[idx] = bf1(pr[1024 + h * 64 + k]); }
        __syncthreads();
        for (int j = 0; j < 16; ++j) {
            const int o8 = j * 64 + 8 * s; const float ve = Lv[j * 64 + e];
            float o = 0.f;
#pragma unroll
            for (int dd = 0; dd < 8; ++dd) { S[dd] = g * S[dd] + Lk[o8 + dd] * ve; o += Lq[o8 + dd] * S[dd]; }
            o += __shfl_xor(o, 1); o += __shfl_xor(o, 2); o += __shfl_xor(o, 4);
            if (s == 0) Lo[j * 64 + e] = o;
        }
        __syncthreads();
#pragma unroll
        for (int rep = 0; rep < 2; ++rep) { const int idx = tid + NTHR * rep, j = idx >> 6, k = idx & 63; const int n = dir ? N - 1 - (t0 + j) : t0 + j;
            atomicAdd(O + (size_t)(R0 + n) * 512 + h * 64 + k, Lo[idx]); }
        __syncthreads();
    }
    if (!lat) { float* so = F.out + O_SRET + (size_t)((b * 2 + dir) * 8 + h) * 4096;
#pragma unroll
        for (int dd = 0; dd < 8; ++dd) so[(8 * s + dd) * 64 + e] = S[dd]; }
}
__device__ __forceinline__ void run_job(Frame& F, int J) {
    int type, seq, h, dir;
    if (J < 64) { type = J >> 5; const int r = J & 31; seq = 32 + (r >> 4); h = (r >> 1) & 7; dir = r & 1; }
    else { const int r = J - 64; type = r >> 9; const int q = r & 511; seq = q >> 4; h = (q >> 1) & 7; dir = q & 1; }
    if (type == 0) rwkv_job(F, seq, h, dir); else ret_job(F, seq, h, dir);
}
__device__ __forceinline__ void scan_phase(Frame& F) {
    if (F.G > 128) { if (F.bid < 64) run_job(F, F.bid); else for (int J = 64 + (F.bid - 64); J < 1088; J += F.G - 64) run_job(F, J); }
    else for (int J = F.bid; J < 1088; J += F.G) run_job(F, J);
}
__device__ __forceinline__ void rec_post_phase(Frame& F) {
    LAS float* sg = (LAS float*)F.lds + F.wave * 128;
    const int gw = F.bid * NWAVES + F.wave, NGW = F.G * NWAVES, lane = F.lane;
    const bf16* PROJ = F.P; const float* Y = F.S; const float* O = F.S + (size_t)T * 512;
    for (int row = gw; row < T; row += NGW) {
        const bf16* pr = PROJ + (size_t)row * NREC;
        sg[lane] = sigmoidf_(bf1(pr[3712 + lane])); sg[64 + lane] = sigmoidf_(bf1(pr[3776 + lane]));
        asm volatile("s_waitcnt lgkmcnt(0)" ::: "memory");
        for (int h = 0; h < 8; ++h) {
            const int c = h * 64 + lane;
            const float y = Y[(size_t)row * 512 + c];
            const float mu = wave_sum(y) * (1.f / 64.f), dl = y - mu, var = wave_sum(dl * dl) * (1.f / 64.f);
            const float yn = dl * rsqrtf(var + 64e-5f) * F.in[33][c] + F.in[34][c];
            const float r = bf1(pr[2048 + c]), k = bf1(pr[2560 + c]), v = bf1(pr[3072 + c]);
            const float bonus = wave_sum(r * F.in[32][c] * k) * v;
            float g = 0.f;
#pragma unroll 8
            for (int j = 0; j < 128; ++j) g += sg[j] * F.in[29][(size_t)j * 512 + c];
            F.MIX[(size_t)row * D + 512 + c] = (bf16)f2bf((yn + bonus) * g);
        }
        for (int h = 0; h < 8; ++h) {
            const int c = h * 64 + lane;
            const float o = O[(size_t)row * 512 + c];
            const float on = o * rsqrtf(wave_sum(o * o) * (1.f / 64.f) + 1e-6f);
            const float xg = bf1(pr[1536 + c]);
            F.MIX[(size_t)row * D + c] = (bf16)f2bf(xg * sigmoidf_(xg) * on);
        }
        asm volatile("s_waitcnt lgkmcnt(0)" ::: "memory");
    }
}

#define DPP_F(v, ctrl) __int_as_float(__builtin_amdgcn_mov_dpp(__float_as_int(v), (ctrl), 0xf, 0xf, true))
template <int NSL> __device__ __forceinline__ float row_reduce(float v) {
    v += DPP_F(v, 0xB1); v += DPP_F(v, 0x4E); v += DPP_F(v, 0x141); if (NSL == 16) v += DPP_F(v, 0x140); return v;
}
__device__ __forceinline__ void unpack8(const v4u r, float (&f)[8]) { f[0] = bflo(r.x); f[1] = bfhi(r.x); f[2] = bflo(r.y); f[3] = bfhi(r.y); f[4] = bflo(r.z); f[5] = bfhi(r.z); f[6] = bflo(r.w); f[7] = bfhi(r.w); }
__device__ __forceinline__ v4u pack8(const float (&f)[8]) { v4u w; w.x = pg8::cvt_pk_bf16(f[0], f[1]); w.y = pg8::cvt_pk_bf16(f[2], f[3]); w.z = pg8::cvt_pk_bf16(f[4], f[5]); w.w = pg8::cvt_pk_bf16(f[6], f[7]); return w; }

template <int NSL>
__device__ __forceinline__ void rwkv_job2(Frame& F, int seq, int h, int dir, int row0) {
    constexpr int KPT = 64 / NSL, ROWS = 512 / NSL, TCH = 32;
    constexpr int WUPT = 0, AUPT = 9216, TWO = 18432, TAO = 23040, F0 = 27648;
    LAS unsigned char* lds = F.lds;
    LAS float *Lr = (LAS float*)(lds + F0), *Lk = Lr + 2048, *Lv = Lk + 2048, *Lw = Lv + 2048, *La = Lw + 2048, *Lnk = La + 2048, *Lkef = Lnk + 2048, *Lb = Lkef + 2048, *Ly = Lb + 2048;
    const int tid = F.tid, lane = F.lane, wave = F.wave, q16 = lane & 15, g = lane >> 4;
    const bool lat = seq >= 32; const int b = lat ? seq - 32 : seq, N = lat ? 2048 : 256, R0 = lat ? TCX + b * 2048 : b * 256;
    const bf16* PROJ = F.P; float* Y = F.S;
    __syncthreads();
    for (int idx = tid; idx < 4096; idx += NTHR) { const int j = idx >> 6, k = idx & 63;
        *(LAS bf16*)(lds + WUPT + k * 144 + j * 2) = (bf16)f2bf(F.in[26][(size_t)(dir * 64 + j) * 512 + h * 64 + k]);
        *(LAS bf16*)(lds + AUPT + k * 144 + j * 2) = (bf16)f2bf(F.in[28][(size_t)(dir * 64 + j) * 512 + h * 64 + k]); }
    const int rowl = tid / NSL, sl = tid % NSL, irow = row0 + rowl;
    float S[KPT];
    {
        const float* st = F.in[7] + (size_t)((b * 2 + dir) * 8 + h) * 4096 + irow * 64 + KPT * sl;
#pragma unroll
        for (int kk = 0; kk < KPT; ++kk) S[kk] = lat ? st[kk] : 0.f;
    }
    const int ep = tid & 15, etok = tid >> 4;
    f32x4 ckk, cka;
#pragma unroll
    for (int e = 0; e < 4; ++e) { ckk[e] = F.in[30][h * 64 + 4 * ep + e]; cka[e] = F.in[31][h * 64 + 4 * ep + e]; }
    const int mat = wave >> 2, ct = wave & 3;
    const float zbias = (mat ? F.in[27] : F.in[25])[dir * 512 + h * 64 + 16 * ct + q16];
    for (int t0 = 0; t0 < N; t0 += TCH) {
        for (int idx = tid; idx < 1280; idx += NTHR) { const int tok = idx / 40, rem = idx - tok * 40, seg = rem >> 3, ch = rem & 7; const int n = dir ? N - 1 - (t0 + tok) : t0 + tok;
            const int col = (seg == 0) ? 2048 + h * 64 : (seg == 1) ? 2560 + h * 64 : (seg == 2) ? 3072 + h * 64 : (seg == 3) ? 3584 : 3648;
            const v4u raw = *(const v4u*)(PROJ + (size_t)(R0 + n) * NREC + col + 8 * ch);
            if (seg < 3) { float f[8]; unpack8(raw, f); LAS float* dst = ((seg == 0) ? Lr : (seg == 1) ? Lk : Lv) + tok * 64 + 8 * ch; *(LAS f32x4*)dst = (f32x4){f[0], f[1], f[2], f[3]}; *(LAS f32x4*)(dst + 4) = (f32x4){f[4], f[5], f[6], f[7]}; }
            else if (seg == 3) { float f[8]; unpack8(raw, f);
#pragma unroll
                for (int e = 0; e < 8; ++e) f[e] = 1.f - 2.f / (1.f + __expf(2.f * f[e]));
                *(LAS v4u*)(lds + TWO + tok * 144 + ch * 16) = pack8(f); }
            else *(LAS v4u*)(lds + TAO + tok * 144 + ch * 16) = raw; }
        __syncthreads();
        {
            f32x4 z[2] = {(f32x4){0.f, 0.f, 0.f, 0.f}, (f32x4){0.f, 0.f, 0.f, 0.f}};
#pragma unroll
            for (int kd = 0; kd < 2; ++kd) { const bf16x8 bfr = *(const LAS bf16x8*)(lds + (mat ? AUPT : WUPT) + (16 * ct + q16) * 144 + 64 * kd + 16 * g);
#pragma unroll
                for (int rt = 0; rt < 2; ++rt) { const bf16x8 afr = *(const LAS bf16x8*)(lds + (mat ? TAO : TWO) + (16 * rt + q16) * 144 + 64 * kd + 16 * g);
                    z[rt] = __builtin_amdgcn_mfma_f32_16x16x32_bf16(afr, bfr, z[rt], 0, 0, 0); } }
#pragma unroll
            for (int rt = 0; rt < 2; ++rt)
#pragma unroll
                for (int e = 0; e < 4; ++e) { const int tok = 16 * rt + 4 * g + e; const float sg = sigmoidf_(z[rt][e] + zbias);
                    if (mat) La[tok * 64 + 16 * ct + q16] = sg; else Lw[tok * 64 + 16 * ct + q16] = __expf(-0.6065306597f * sg); }
        }
        __syncthreads();
        {
            const f32x4 kv = *(const LAS f32x4*)(Lk + etok * 64 + 4 * ep), av = *(const LAS f32x4*)(La + etok * 64 + 4 * ep);
            const f32x4 kr = kv * ckk; float ss = (kr[0] * kr[0] + kr[1] * kr[1]) + (kr[2] * kr[2] + kr[3] * kr[3]);
            ss = row_reduce<16>(ss);
            const float rs = rsqrtf(ss + 1e-12f);
            const f32x4 kkv = kr * rs;
            *(LAS f32x4*)(Lnk + etok * 64 + 4 * ep) = -kkv;
            *(LAS f32x4*)(Lb + etok * 64 + 4 * ep) = kkv * av;
            *(LAS f32x4*)(Lkef + etok * 64 + 4 * ep) = kv * (1.f + (av - 1.f) * cka);
        }
        __syncthreads();
#pragma unroll 2
        for (int j = 0; j < TCH; ++j) {
            const int o8 = j * 64 + KPT * sl;
            float nk[KPT], wv[KPT], bv[KPT], ke[KPT], rv[KPT];
#pragma unroll
            for (int q4 = 0; q4 < KPT; q4 += 4) { const f32x4 a0 = *(const LAS f32x4*)(Lnk + o8 + q4), a1 = *(const LAS f32x4*)(Lw + o8 + q4), a2 = *(const LAS f32x4*)(Lb + o8 + q4), a3 = *(const LAS f32x4*)(Lkef + o8 + q4), a4 = *(const LAS f32x4*)(Lr + o8 + q4);
#pragma unroll
                for (int e = 0; e < 4; ++e) { nk[q4 + e] = a0[e]; wv[q4 + e] = a1[e]; bv[q4 + e] = a2[e]; ke[q4 + e] = a3[e]; rv[q4 + e] = a4[e]; } }
            const float vi = Lv[j * 64 + irow];
            float sa = 0.f;
#pragma unroll
            for (int kk = 0; kk < KPT; ++kk) sa += S[kk] * nk[kk];
            sa = row_reduce<NSL>(sa);
            float y = 0.f;
#pragma unroll
            for (int kk = 0; kk < KPT; ++kk) { S[kk] = S[kk] * wv[kk] + (sa * bv[kk] + vi * ke[kk]); y += S[kk] * rv[kk]; }
            y = row_reduce<NSL>(y);
            if (sl == 0) Ly[j * 64 + rowl] = y;
        }
        __syncthreads();
        for (int idx = tid; idx < TCH * ROWS; idx += NTHR) { const int tok = idx / ROWS, i = idx % ROWS; const int n = dir ? N - 1 - (t0 + tok) : t0 + tok;
            atomicAdd(Y + (size_t)(R0 + n) * 512 + h * 64 + row0 + i, Ly[tok * 64 + i]); }
    }
    if (!lat) { float* so = F.out + O_SRW + (size_t)((b * 2 + dir) * 8 + h) * 4096 + irow * 64 + KPT * sl;
#pragma unroll
        for (int kk = 0; kk < KPT; ++kk) so[kk] = S[kk]; }
}

__device__ __forceinline__ void ret_job2(Frame& F, int seq, int h, int dir, long odoff = 0) {
    constexpr int KP = 0, VT = 9216, KW = 19456, SB = 29696, DM = 39936, KSTR = 144, VSTR = 160;
    LAS unsigned char* lds = F.lds;
    LAS float* dm = (LAS float*)(lds + DM);
    const int tid = F.tid, lane = F.lane, wave = F.wave, q16 = lane & 15, g = lane >> 4;
    const bool lat = seq >= 32; const int b = lat ? seq - 32 : seq, N = lat ? 2048 : 256, R0 = lat ? TCX + b * 2048 : b * 256;
    const bf16* PROJ = F.P; bf16* OD = (bf16*)F.S + (size_t)(2 + dir) * T * 512 + odoff;
    const float lg2 = log2f(sigmoidf_(F.in[24][dir * 8 + h]));
    __syncthreads();
    { int t_ = tid; asm volatile("" : "+v"(t_)); if (t_ < 65) dm[t_] = exp2f(lg2 * (float)t_); }
    const float gC = exp2f(lg2 * 64.f);
    const int cd = wave >> 1, ce0 = 2 * (wave & 1);
    f32x4 Sreg[2];
#pragma unroll
    for (int c2 = 0; c2 < 2; ++c2)
#pragma unroll
        for (int e = 0; e < 4; ++e) { const int d_ = 16 * cd + 4 * g + e, e_ = 16 * (ce0 + c2) + q16;
            Sreg[c2][e] = lat ? F.in[6][(size_t)((b * 2 + dir) * 8 + h) * 4096 + d_ * 64 + e_] : 0.f;
            *(LAS bf16*)(lds + SB + d_ * VSTR + e_ * 2) = (bf16)f2bf(Sreg[c2][e]); }
    const int qg = wave & 3, eh = wave >> 2, iq = 16 * qg + q16;
    const int srow = tid >> 3, sch = tid & 7, sprow = (srow & 39) | ((srow & 8) << 1) | ((srow & 16) >> 1);
    for (int t0 = 0; t0 < N; t0 += 64) {
        {
            const int n = dir ? N - 1 - (t0 + srow) : t0 + srow; const bf16* rp = PROJ + (size_t)(R0 + n) * NREC + h * 64 + 8 * sch;
            const v4u rk = *(const v4u*)(rp + 512), rv = *(const v4u*)(rp + 1024);
            *(LAS v4u*)(lds + KP + sprow * KSTR + sch * 16) = rk; *(LAS v4u*)(lds + VT + srow * VSTR + sch * 16) = rv;
            float f[8]; unpack8(rk, f); const float wsc = 0.125f * exp2f(lg2 * (float)(63 - srow));
#pragma unroll
            for (int e = 0; e < 8; ++e) f[e] *= wsc;
            *(LAS v4u*)(lds + KW + srow * VSTR + sch * 16) = pack8(f);
        }
        bf16x8 qf[2], qs[2];
        {
            const int n = dir ? N - 1 - (t0 + iq) : t0 + iq; const bf16* qp = PROJ + (size_t)(R0 + n) * NREC + h * 64 + 8 * g; const float sc = exp2f(lg2 * (float)(iq + 1));
#pragma unroll
            for (int kd = 0; kd < 2; ++kd) { const v4u raw = *(const v4u*)(qp + 32 * kd); qf[kd] = __builtin_bit_cast(bf16x8, raw); float f[8]; unpack8(raw, f);
#pragma unroll
                for (int e = 0; e < 8; ++e) f[e] *= sc;
                qs[kd] = __builtin_bit_cast(bf16x8, pack8(f)); }
        }
        __syncthreads();
        bf16x8 pf[2];
#pragma unroll
        for (int ks = 0; ks < 2; ++ks) {
            float p[8];
#pragma unroll
            for (int t = 0; t < 2; ++t) { f32x4 s = (f32x4){0.f, 0.f, 0.f, 0.f};
#pragma unroll
                for (int kd = 0; kd < 2; ++kd) { const bf16x8 kf = *(const LAS bf16x8*)(lds + KP + (32 * ks + 16 * t + q16) * KSTR + 64 * kd + 16 * g); s = __builtin_amdgcn_mfma_f32_16x16x32_bf16(kf, qf[kd], s, 0, 0, 0); }
#pragma unroll
                for (int e = 0; e < 4; ++e) { const int j = 32 * ks + 16 * (g >> 1) + 8 * t + 4 * (g & 1) + e; const int dlt = iq - j; const float dv_ = dm[dlt & 63]; p[4 * t + e] = (dlt >= 0) ? s[e] * 0.125f * dv_ : 0.f; } }
            pf[ks] = __builtin_bit_cast(bf16x8, pack8(p));
        }
        f32x4 o[2] = {(f32x4){0.f, 0.f, 0.f, 0.f}, (f32x4){0.f, 0.f, 0.f, 0.f}};
#pragma unroll
        for (int c2 = 0; c2 < 2; ++c2) { const int c = 2 * eh + c2;
#pragma unroll
            for (int ks = 0; ks < 2; ++ks) { LAS unsigned char* vb = lds + VT + (32 * ks + 16 * (g >> 1) + 4 * (g & 1) + (q16 >> 2)) * VSTR + (16 * c + 4 * (lane & 3)) * 2;
                const s16x4 v0 = tr_read(vb), v1 = tr_read(vb + 8 * VSTR); const bf16x8 vf = (bf16x8){v0[0], v0[1], v0[2], v0[3], v1[0], v1[1], v1[2], v1[3]};
                o[c2] = __builtin_amdgcn_mfma_f32_16x16x32_bf16(vf, pf[ks], o[c2], 0, 0, 0); }
#pragma unroll
            for (int kd = 0; kd < 2; ++kd) { LAS unsigned char* sb = lds + SB + (32 * kd + 8 * g + (q16 >> 2)) * VSTR + (16 * c + 4 * (lane & 3)) * 2;
                const s16x4 v0 = tr_read(sb), v1 = tr_read(sb + 4 * VSTR); const bf16x8 sf = (bf16x8){v0[0], v0[1], v0[2], v0[3], v1[0], v1[1], v1[2], v1[3]};
                o[c2] = __builtin_amdgcn_mfma_f32_16x16x32_bf16(sf, qs[kd], o[c2], 0, 0, 0); }
        }
        {
            const int n = dir ? N - 1 - (t0 + iq) : t0 + iq; bf16* op = OD + (size_t)(R0 + n) * 512 + h * 64 + 4 * g;
            const float one_ = opaque_one();
#pragma unroll
            for (int c2 = 0; c2 < 2; ++c2) { const f32x4 ov = o[c2] * one_; v2u w; w.x = pg8::cvt_pk_bf16(ov[0], ov[1]); w.y = pg8::cvt_pk_bf16(ov[2], ov[3]); *(v2u*)(op + 16 * (2 * eh + c2)) = w; }
        }
        f32x4 U[2] = {(f32x4){0.f, 0.f, 0.f, 0.f}, (f32x4){0.f, 0.f, 0.f, 0.f}};
#pragma unroll
        for (int ks = 0; ks < 2; ++ks) { LAS unsigned char* ka = lds + KW + (32 * ks + 8 * g + (q16 >> 2)) * VSTR + (16 * cd + 4 * (lane & 3)) * 2;
            const s16x4 a0 = tr_read(ka), a1 = tr_read(ka + 4 * VSTR); const bf16x8 af = (bf16x8){a0[0], a0[1], a0[2], a0[3], a1[0], a1[1], a1[2], a1[3]};
#pragma unroll
            for (int c2 = 0; c2 < 2; ++c2) { LAS unsigned char* vb = lds + VT + (32 * ks + 8 * g + (q16 >> 2)) * VSTR + (16 * (ce0 + c2) + 4 * (lane & 3)) * 2;
                const s16x4 b0 = tr_read(vb), b1 = tr_read(vb + 4 * VSTR); const bf16x8 bfr = (bf16x8){b0[0], b0[1], b0[2], b0[3], b1[0], b1[1], b1[2], b1[3]};
                U[c2] = __builtin_amdgcn_mfma_f32_16x16x32_bf16(af, bfr, U[c2], 0, 0, 0); } }
        __syncthreads();
#pragma unroll
        for (int c2 = 0; c2 < 2; ++c2)
#pragma unroll
            for (int e = 0; e < 4; ++e) { Sreg[c2][e] = gC * Sreg[c2][e] + U[c2][e];
                *(LAS bf16*)(lds + SB + (16 * cd + 4 * g + e) * VSTR + (16 * (ce0 + c2) + q16) * 2) = (bf16)f2bf(Sreg[c2][e]); }
    }
    if (!lat) {
#pragma unroll
        for (int c2 = 0; c2 < 2; ++c2)
#pragma unroll
            for (int e = 0; e < 4; ++e) F.out[O_SRET + (size_t)((b * 2 + dir) * 8 + h) * 4096 + (16 * cd + 4 * g + e) * 64 + 16 * (ce0 + c2) + q16] = Sreg[c2][e];
    }
}
__device__ __forceinline__ void scan_phase2(Frame& F) {
    if (F.G == 256) {
        if (F.bid < 64) { const int job = F.bid >> 1; rwkv_job2<16>(F, 32 + (job >> 4), (job >> 1) & 7, job & 1, 32 * (F.bid & 1)); }
        else if (F.bid < 96) { const int u = F.bid - 64; ret_job2(F, 32 + (u >> 4), (u >> 1) & 7, u & 1); }
        else for (int it = F.bid - 96; it < 1024; it += 160) { const int q = it & 511; if (it < 512) rwkv_job2<8>(F, q >> 4, (q >> 1) & 7, q & 1, 0); else ret_job2(F, q >> 4, (q >> 1) & 7, q & 1); }
    } else {
        for (int it = F.bid; it < 1088 + 32; it += F.G) {
            if (it < 64) { const int job = it >> 1; rwkv_job2<16>(F, 32 + (job >> 4), (job >> 1) & 7, job & 1, 32 * (it & 1)); }
            else if (it < 96) { const int u = it - 64; ret_job2(F, 32 + (u >> 4), (u >> 1) & 7, u & 1); }
            else { const int r = it - 96, q = r & 511; if (r < 512) rwkv_job2<8>(F, q >> 4, (q >> 1) & 7, q & 1, 0); else ret_job2(F, q >> 4, (q >> 1) & 7, q & 1); }
        }
    }
}

template <int NSL> __device__ __forceinline__ float row_reduce2(float v) {
    v += DPP_F(v, 0xB1); v += DPP_F(v, 0x4E); if (NSL >= 8) v += DPP_F(v, 0x141); if (NSL >= 16) v += DPP_F(v, 0x140); return v;
}
template <int NSL>
__device__ __forceinline__ void rwkv_job3(Frame& F, int seq, int h, int dir, int row0) {
    constexpr int KPT = 64 / NSL, TCH = 32, NV = KPT / 4;
    constexpr int WUPT = 0, AUPT = 9216, BUF0 = 18432, BUFSZ = 49152;
    LAS unsigned char* lds = F.lds;
    const int tid = F.tid, lane = F.lane, wave = F.wave, q16 = lane & 15, g = lane >> 4;
    const bool lat = seq >= 32; const int b = lat ? seq - 32 : seq, N = lat ? 2048 : 256, R0 = lat ? TCX + b * 2048 : b * 256;
    const bf16* PROJ = F.P; bf16* YD = (bf16*)F.S + (size_t)dir * T * 512; LAS float* Ly = (LAS float*)(lds + 116736);
    __syncthreads();
    for (int idx = tid; idx < 4096; idx += NTHR) { const int j = idx >> 6, k = idx & 63;
        *(LAS bf16*)(lds + WUPT + k * 144 + j * 2) = (bf16)f2bf(F.in[26][(size_t)(dir * 64 + j) * 512 + h * 64 + k]);
        *(LAS bf16*)(lds + AUPT + k * 144 + j * 2) = (bf16)f2bf(F.in[28][(size_t)(dir * 64 + j) * 512 + h * 64 + k]); }
    const bool scanw = wave < 4;
    const int rowl = (tid & 255) / NSL, sl = tid % NSL, irow = row0 + rowl;
    float S[KPT];
    {
        const float* st = F.in[7] + (size_t)((b * 2 + dir) * 8 + h) * 4096 + irow * 64 + KPT * sl;
#pragma unroll
        for (int kk = 0; kk < KPT; ++kk) S[kk] = (lat && scanw) ? st[kk] : 0.f;
    }
    const int pw = wave - 4;
    LAS float* Lasc = (LAS float*)(lds + 124928) + (pw & 1) * 1024;
    const int nch = N / TCH;
#define RW_PREP(c_) do { \
        LAS float* B_ = (LAS float*)(lds + BUF0 + ((c_) & 1) * BUFSZ); const int t0_ = (c_) * TCH; \
        float cw0[4], ca0[4], ckk8[8], cka8[8]; \
        _Pragma("unroll") for (int ct = 0; ct < 4; ++ct) { const int kc = h * 64 + 16 * ct + q16; cw0[ct] = F.in[25][dir * 512 + kc]; ca0[ct] = F.in[27][dir * 512 + kc]; } \
        { const f32x4 k0_ = *(const f32x4*)(F.in[30] + h * 64 + 8 * (lane & 7)), k1_ = *(const f32x4*)(F.in[30] + h * 64 + 8 * (lane & 7) + 4), a0_ = *(const f32x4*)(F.in[31] + h * 64 + 8 * (lane & 7)), a1_ = *(const f32x4*)(F.in[31] + h * 64 + 8 * (lane & 7) + 4); \
          _Pragma("unroll") for (int e = 0; e < 4; ++e) { ckk8[e] = k0_[e]; ckk8[4 + e] = k1_[e]; cka8[e] = a0_[e]; cka8[4 + e] = a1_[e]; } } \
        v4u raw_[6]; \
        _Pragma("unroll") for (int rep = 0; rep < 6; ++rep) { const int tk_ = t0_ + 16 * pw + (rep & 1) * 8 + (lane >> 3); const int n_ = dir ? N - 1 - tk_ : tk_; \
            raw_[rep] = *(const v4u*)(PROJ + (size_t)(R0 + n_) * NREC + 2048 + 512 * (rep >> 1) + h * 64 + 8 * (lane & 7)); } \
        bf16x8 aw_[2], aa_[2]; \
        { const int tk_ = t0_ + 16 * pw + q16; const int n_ = dir ? N - 1 - tk_ : tk_; const bf16* pa_ = PROJ + (size_t)(R0 + n_) * NREC + 8 * g; \
          _Pragma("unroll") for (int kd = 0; kd < 2; ++kd) { const v4u rw_ = *(const v4u*)(pa_ + 3584 + 32 * kd); aa_[kd] = *(const bf16x8*)(pa_ + 3648 + 32 * kd); float f_[8]; unpack8(rw_, f_); \
              _Pragma("unroll") for (int e = 0; e < 8; ++e) f_[e] = 1.f - 2.f / (1.f + __expf(2.f * f_[e])); aw_[kd] = __builtin_bit_cast(bf16x8, pack8(f_)); } } \
        f32x4 zw_[4], za_[4]; unsigned pbW_ = WUPT + q16 * 144 + 16 * g; asm volatile("" : "+v"(pbW_)); \
        _Pragma("unroll") for (int ct = 0; ct < 4; ++ct) { zw_[ct] = (f32x4){0.f, 0.f, 0.f, 0.f}; za_[ct] = (f32x4){0.f, 0.f, 0.f, 0.f}; \
            _Pragma("unroll") for (int kd = 0; kd < 2; ++kd) { \
                const bf16x8 bw_ = *(const LAS bf16x8*)(lds + pbW_ + ct * 2304 + 64 * kd), ba_ = *(const LAS bf16x8*)(lds + pbW_ + 9216 + ct * 2304 + 64 * kd); \
                zw_[ct] = __builtin_amdgcn_mfma_f32_16x16x32_bf16(aw_[kd], bw_, zw_[ct], 0, 0, 0); za_[ct] = __builtin_amdgcn_mfma_f32_16x16x32_bf16(aa_[kd], ba_, za_[ct], 0, 0, 0); } } \
        _Pragma("unroll") for (int e = 0; e < 4; ++e) _Pragma("unroll") for (int ct = 0; ct < 4; ++ct) { const int tl16_ = 4 * g + e; \
            B_[2048 + (16 * pw + tl16_) * 64 + 16 * ct + q16] = __expf(-0.6065306597f * sigmoidf_(zw_[ct][e] + cw0[ct])); Lasc[tl16_ * 64 + 16 * ct + q16] = sigmoidf_(za_[ct][e] + ca0[ct]); } \
        _Pragma("unroll") for (int rep = 0; rep < 2; ++rep) { const int tl_ = 16 * pw + rep * 8 + (lane >> 3); float f_[8]; \
            unpack8(raw_[rep], f_); *(LAS f32x4*)(B_ + 8192 + tl_ * 64 + 8 * (lane & 7)) = (f32x4){f_[0], f_[1], f_[2], f_[3]}; *(LAS f32x4*)(B_ + 8192 + tl_ * 64 + 8 * (lane & 7) + 4) = (f32x4){f_[4], f_[5], f_[6], f_[7]}; \
            unpack8(raw_[4 + rep], f_); *(LAS f32x4*)(B_ + 10240 + tl_ * 64 + 8 * (lane & 7)) = (f32x4){f_[0], f_[1], f_[2], f_[3]}; *(LAS f32x4*)(B_ + 10240 + tl_ * 64 + 8 * (lane & 7) + 4) = (f32x4){f_[4], f_[5], f_[6], f_[7]}; \
            float k_[8], a_[8], kr_[8]; unpack8(raw_[2 + rep], k_); \
            { const f32x4 a0_ = *(const LAS f32x4*)(Lasc + (rep * 8 + (lane >> 3)) * 64 + 8 * (lane & 7)), a1_ = *(const LAS f32x4*)(Lasc + (rep * 8 + (lane >> 3)) * 64 + 8 * (lane & 7) + 4); \
              _Pragma("unroll") for (int e = 0; e < 4; ++e) { a_[e] = a0_[e]; a_[4 + e] = a1_[e]; } } \
            float ss_ = 0.f; \
            _Pragma("unroll") for (int e = 0; e < 8; ++e) { kr_[e] = k_[e] * ckk8[e]; ss_ += kr_[e] * kr_[e]; } \
            ss_ = row_reduce2<8>(ss_); const float rs_ = rsqrtf(ss_ + 1e-12f); \
            float o0_[8], o1_[8], o2_[8]; \
            _Pragma("unroll") for (int e = 0; e < 8; ++e) { const float kk_ = kr_[e] * rs_; o0_[e] = -kk_; o1_[e] = kk_ * a_[e]; o2_[e] = k_[e] * (1.f + (a_[e] - 1.f) * cka8[e]); } \
            LAS float* d_ = B_ + tl_ * 64 + 8 * (lane & 7); \
            *(LAS f32x4*)(d_) = (f32x4){o0_[0], o0_[1], o0_[2], o0_[3]}; *(LAS f32x4*)(d_ + 4) = (f32x4){o0_[4], o0_[5], o0_[6], o0_[7]}; \
            *(LAS f32x4*)(d_ + 4096) = (f32x4){o1_[0], o1_[1], o1_[2], o1_[3]}; *(LAS f32x4*)(d_ + 4100) = (f32x4){o1_[4], o1_[5], o1_[6], o1_[7]}; \
            *(LAS f32x4*)(d_ + 6144) = (f32x4){o2_[0], o2_[1], o2_[2], o2_[3]}; *(LAS f32x4*)(d_ + 6148) = (f32x4){o2_[4], o2_[5], o2_[6], o2_[7]}; } \
    } while (0)
    __syncthreads();
    if (wave == 4 || wave == 5) RW_PREP(0);
    __syncthreads();
    for (int c = 0; c < nch; ++c) {
        if (scanw) {
            const LAS float* B = (const LAS float*)(lds + BUF0 + (c & 1) * BUFSZ) + KPT * sl;
            const LAS float* Bv = (const LAS float*)(lds + BUF0 + (c & 1) * BUFSZ) + 10240 + irow;
            f32x4 nkA[NV], nkB[NV];
#define RW_LOADNK(nk, j_) do { _Pragma("unroll") for (int q_ = 0; q_ < NV; ++q_) nk[q_] = *(const LAS f32x4*)(B + (j_) * 64 + 4 * q_); } while (0)
#define RW_STEP(nk, nknext, j_) do { \
                f32x4 op_[4][NV]; \
                _Pragma("unroll") for (int a_ = 0; a_ < 4; ++a_) _Pragma("unroll") for (int q_ = 0; q_ < NV; ++q_) op_[a_][q_] = *(const LAS f32x4*)(B + (a_ + 1) * 2048 + (j_) * 64 + 4 * q_); \
                const float vv_ = Bv[(j_) * 64]; \
                if ((j_) + 1 < TCH) RW_LOADNK(nknext, (j_) + 1); \
                float sa_ = 0.f; \
                _Pragma("unroll") for (int q_ = 0; q_ < NV; ++q_) _Pragma("unroll") for (int e = 0; e < 4; ++e) sa_ += S[4 * q_ + e] * nk[q_][e]; \
                sa_ = row_reduce2<NSL>(sa_); \
                float y_ = 0.f; \
                _Pragma("unroll") for (int q_ = 0; q_ < NV; ++q_) _Pragma("unroll") for (int e = 0; e < 4; ++e) { S[4 * q_ + e] = S[4 * q_ + e] * op_[0][q_][e] + (sa_ * op_[1][q_][e] + vv_ * op_[2][q_][e]); y_ += S[4 * q_ + e] * op_[3][q_][e]; } \
                y_ = row_reduce2<NSL>(y_); \
                if (sl == 0) Ly[(j_) * 64 + rowl] = y_; \
            } while (0)
            RW_LOADNK(nkA, 0);
            for (int j = 0; j < TCH; j += 2) { RW_STEP(nkA, nkB, j); RW_STEP(nkB, nkA, j + 1); }
            {
                constexpr int RPW = 64 / NSL;
#pragma unroll 1
                for (int idx = lane; idx < TCH * RPW; idx += 64) { const int tok = idx / RPW, rl = wave * RPW + idx % RPW; const int tk_ = c * TCH + tok; const int n_ = dir ? N - 1 - tk_ : tk_;
                    YD[(size_t)(R0 + n_) * 512 + h * 64 + row0 + rl] = (bf16)f2bf(Ly[tok * 64 + rl]); }
            }
#undef RW_LOADNK
#undef RW_STEP
        } else if (wave < 6 && c + 1 < nch) { RW_PREP(c + 1); }
        __syncthreads();
    }
#undef RW_PREP
    if (!lat && scanw) { float* so = F.out + O_SRW + (size_t)((b * 2 + dir) * 8 + h) * 4096 + irow * 64 + KPT * sl;
#pragma unroll
        for (int kk = 0; kk < KPT; ++kk) so[kk] = S[kk]; }
}
__device__ __forceinline__ void scan_phase3(Frame& F, int mode = 0) {
    unsigned* qctr = (unsigned*)(F.ws + WS_CTL) + 2048;
    LAS int* qslot = (LAS int*)(F.lds + LDS_BYTES - 128);
    const int nheavy = 96;
    for (int it = F.bid; it < nheavy; it += F.G) {
        if (it < 64) { if (mode != 2 && mode != 4) { const int job = it >> 1; rwkv_job3<8>(F, 32 + (job >> 4), (job >> 1) & 7, job & 1, 32 * (it & 1)); } }
        else if (mode != 1 && mode != 3) { const int u = it - 64; ret_job2(F, 32 + (u >> 4), (u >> 1) & 7, u & 1, (mode == 4) ? (long)(8 * MiB) : 0); }
    }
    if (mode == 1 || mode == 2 || mode == 4) return;
    for (;;) {
        __syncthreads();
        if (F.tid == 0) *qslot = (int)atomicAdd(qctr, 1u);
        __syncthreads();
        const int it = *qslot;
        if (it >= 1024) break;
        const int q = it & 511;
        if (it < 512) rwkv_job3<4>(F, q >> 4, (q >> 1) & 7, q & 1, 0); else ret_job2(F, q >> 4, (q >> 1) & 7, q & 1);
    }
}

template <int DUMMY>
__device__ __forceinline__ void rwkv_job4(Frame& F, int seq, int h, int dir) {
    constexpr int TCH = 32;
    constexpr int WUPT = 0, AUPT = 9216, BUF0 = 18432, BUFSZ = 33280, O_A1 = 0, O_BK = 8192, O_W = 16384, O_V = 24576, O_SC = 32768, ZROW = BUF0 + 2 * BUFSZ, LYO = ZROW + 256, LASC = LYO + 8192;
    LAS unsigned char* lds = F.lds;
    const int tid = F.tid, lane = F.lane, wave = F.wave, q16 = lane & 15, g = lane >> 4;
    const bool lat = seq >= 32; const int b = lat ? seq - 32 : seq, N = lat ? 2048 : 256, R0 = lat ? TCX + b * 2048 : b * 256;
    const bf16* PROJ = F.P; bf16* YD = (bf16*)F.S + (size_t)dir * T * 512; LAS float* Ly = (LAS float*)(lds + LYO);
    __syncthreads();
    for (int idx = tid; idx < 4096; idx += NTHR) { const int j = idx >> 6, k = idx & 63;
        *(LAS bf16*)(lds + WUPT + k * 144 + j * 2) = (bf16)f2bf(F.in[26][(size_t)(dir * 64 + j) * 512 + h * 64 + k]);
        *(LAS bf16*)(lds + AUPT + k * 144 + j * 2) = (bf16)f2bf(F.in[28][(size_t)(dir * 64 + j) * 512 + h * 64 + k]); }
    if (tid < 32) ((LAS unsigned*)(lds + ZROW))[tid] = 0u;
    const bool scanw = wave < 4;
    const int qi = wave & 3, irow = 16 * qi + q16;
    f32x4 X[4];
    {
        const float* st = F.in[7] + (size_t)((b * 2 + dir) * 8 + h) * 4096 + irow * 64 + 4 * g;
#pragma unroll
        for (int kt = 0; kt < 4; ++kt) X[kt] = (lat && scanw) ? *(const f32x4*)(st + 16 * kt) : (f32x4){0.f, 0.f, 0.f, 0.f};
    }
    const int pw = wave - 4;
    LAS float* Lasc = (LAS float*)(lds + LASC) + (pw & 1) * 1024;
    const int nch = N / TCH;
#define RW_PREP4(c_) do { \
        LAS unsigned char* Bb_ = lds + BUF0 + ((c_) & 1) * BUFSZ; LAS float* Wb_ = (LAS float*)(Bb_ + O_W); const int t0_ = (c_) * TCH; \
        float cw0[4], ca0[4]; \
        _Pragma("unroll") for (int ct = 0; ct < 4; ++ct) { const int kc = h * 64 + 16 * ct + q16; cw0[ct] = F.in[25][dir * 512 + kc]; ca0[ct] = F.in[27][dir * 512 + kc]; } \
        bf16x8 aw_[2], aa_[2]; \
        { const int tk_ = t0_ + 16 * pw + q16; const int n_ = dir ? N - 1 - tk_ : tk_; const bf16* pa_ = PROJ + (size_t)(R0 + n_) * NREC + 8 * g; \
          _Pragma("unroll") for (int kd = 0; kd < 2; ++kd) { const v4u rw_ = *(const v4u*)(pa_ + 3584 + 32 * kd); aa_[kd] = *(const bf16x8*)(pa_ + 3648 + 32 * kd); float f_[8]; unpack8(rw_, f_); \
              _Pragma("unroll") for (int e = 0; e < 8; ++e) f_[e] = 1.f - 2.f / (1.f + __expf(2.f * f_[e])); aw_[kd] = __builtin_bit_cast(bf16x8, pack8(f_)); } } \
        f32x4 zw_[4], za_[4]; unsigned pbW_ = WUPT + q16 * 144 + 16 * g; asm volatile("" : "+v"(pbW_)); \
        _Pragma("unroll") for (int ct = 0; ct < 4; ++ct) { zw_[ct] = (f32x4){0.f, 0.f, 0.f, 0.f}; za_[ct] = (f32x4){0.f, 0.f, 0.f, 0.f}; \
            _Pragma("unroll") for (int kd = 0; kd < 2; ++kd) { \
                const bf16x8 bw_ = *(const LAS bf16x8*)(lds + pbW_ + ct * 2304 + 64 * kd), ba_ = *(const LAS bf16x8*)(lds + pbW_ + 9216 + ct * 2304 + 64 * kd); \
                zw_[ct] = __builtin_amdgcn_mfma_f32_16x16x32_bf16(aw_[kd], bw_, zw_[ct], 0, 0, 0); za_[ct] = __builtin_amdgcn_mfma_f32_16x16x32_bf16(aa_[kd], ba_, za_[ct], 0, 0, 0); } } \
        _Pragma("unroll") for (int e = 0; e < 4; ++e) _Pragma("unroll") for (int ct = 0; ct < 4; ++ct) { const int tl16_ = 4 * g + e; \
            Wb_[(16 * pw + tl16_) * 64 + 16 * ct + q16] = __expf(-0.6065306597f * sigmoidf_(zw_[ct][e] + cw0[ct])); Lasc[tl16_ * 64 + 16 * ct + q16] = sigmoidf_(za_[ct][e] + ca0[ct]); } \
        __builtin_amdgcn_sched_barrier(0); \
        float ckk8[8], cka8[8]; \
        { const f32x4 k0_ = *(const f32x4*)(F.in[30] + h * 64 + 8 * (lane & 7)), k1_ = *(const f32x4*)(F.in[30] + h * 64 + 8 * (lane & 7) + 4), a0_ = *(const f32x4*)(F.in[31] + h * 64 + 8 * (lane & 7)), a1_ = *(const f32x4*)(F.in[31] + h * 64 + 8 * (lane & 7) + 4); \
          _Pragma("unroll") for (int e = 0; e < 4; ++e) { ckk8[e] = k0_[e]; ckk8[4 + e] = k1_[e]; cka8[e] = a0_[e]; cka8[4 + e] = a1_[e]; } } \
        _Pragma("unroll") for (int rep = 0; rep < 2; ++rep) { const int tl_ = 16 * pw + rep * 8 + (lane >> 3); const int c8_ = 8 * (lane & 7); \
            v4u rr_, rk_; { const int tk_ = t0_ + tl_; const int n_ = dir ? N - 1 - tk_ : tk_; const bf16* pp_ = PROJ + (size_t)(R0 + n_) * NREC + 2048 + h * 64 + c8_; rr_ = *(const v4u*)pp_; rk_ = *(const v4u*)(pp_ + 512); const v4u rv_ = *(const v4u*)(pp_ + 1024); \
              float f_[8]; unpack8(rv_, f_); *(LAS f32x4*)(Bb_ + O_V + (tl_ * 64 + c8_) * 4) = (f32x4){f_[0], f_[1], f_[2], f_[3]}; *(LAS f32x4*)(Bb_ + O_V + (tl_ * 64 + c8_ + 4) * 4) = (f32x4){f_[4], f_[5], f_[6], f_[7]}; } \
            float kr_[8]; float ss_ = 0.f; \
            { float k_[8]; unpack8(rk_, k_); _Pragma("unroll") for (int e = 0; e < 8; ++e) { kr_[e] = k_[e] * ckk8[e]; ss_ += kr_[e] * kr_[e]; } } \
            ss_ = row_reduce2<8>(ss_); const float rs_ = rsqrtf(ss_ + 1e-12f); \
            float br_ = 0.f, kfr_ = 0.f; \
            _Pragma("unroll") for (int hf = 0; hf < 2; ++hf) { \
                __builtin_amdgcn_sched_barrier(0); \
                const f32x4 a4_ = *(const LAS f32x4*)(Lasc + (rep * 8 + (lane >> 3)) * 64 + c8_ + 4 * hf), w4_ = *(const LAS f32x4*)(Wb_ + tl_ * 64 + c8_ + 4 * hf); \
                const unsigned rw0_ = hf ? rr_.z : rr_.x, rw1_ = hf ? rr_.w : rr_.y, kw0_ = hf ? rk_.z : rk_.x, kw1_ = hf ? rk_.w : rk_.y; \
                const float r4_[4] = {bflo(rw0_), bfhi(rw0_), bflo(rw1_), bfhi(rw1_)}, k4_[4] = {bflo(kw0_), bfhi(kw0_), bflo(kw1_), bfhi(kw1_)}; \
                float nk4_[4], wr4_[4]; unsigned bk4_[4]; \
                _Pragma("unroll") for (int e = 0; e < 4; ++e) { const float kk_ = kr_[4 * hf + e] * rs_, bb_ = kk_ * a4_[e], ke_ = k4_[e] * (1.f + (a4_[e] - 1.f) * cka8[4 * hf + e]); \
                    nk4_[e] = -kk_; wr4_[e] = w4_[e] * r4_[e]; bk4_[e] = cvtpk(bb_, ke_); br_ += bb_ * r4_[e]; kfr_ += ke_ * r4_[e]; } \
                *(LAS v2u*)(Bb_ + O_A1 + (tl_ * 2 + 0) * 128 + (c8_ + 4 * hf) * 2) = (v2u){cvtpk(nk4_[0], nk4_[1]), cvtpk(nk4_[2], nk4_[3])}; \
                *(LAS v2u*)(Bb_ + O_A1 + (tl_ * 2 + 1) * 128 + (c8_ + 4 * hf) * 2) = (v2u){cvtpk(wr4_[0], wr4_[1]), cvtpk(wr4_[2], wr4_[3])}; \
                *(LAS v4u*)(Bb_ + O_BK + (tl_ * 64 + c8_ + 4 * hf) * 4) = (v4u){bk4_[0], bk4_[1], bk4_[2], bk4_[3]}; } \
            br_ = row_reduce2<8>(br_); kfr_ = row_reduce2<8>(kfr_); \
            if ((lane & 7) == 0) *(LAS f32x2v*)(Bb_ + O_SC + tl_ * 8) = (f32x2v){br_, kfr_}; __builtin_amdgcn_sched_barrier(0); } \
    } while (0)
    __syncthreads();
    if (wave == 4 || wave == 5) RW_PREP4(0);
    __syncthreads();
    for (int c = 0; c < nch; ++c) {
        if (scanw) {
            LAS unsigned char* Bb = lds + BUF0 + (c & 1) * BUFSZ;
            LAS unsigned char* a1p = (q16 < 2) ? (Bb + O_A1 + q16 * 128 + 8 * g) : (lds + ZROW + 8 * g); const int a1s = (q16 < 2) ? 256 : 0;
            const LAS unsigned char* wp = Bb + O_W + 16 * g; const LAS unsigned char* bkp = Bb + O_BK + 4 * q16; const LAS float* vp = (const LAS float*)(Bb + O_V) + irow; const LAS unsigned char* scp = Bb + O_SC;
            struct Ops { v2u a1w[2][2]; f32x4 wv[4]; unsigned bk[4]; float vi; f32x2v sc; };
#define RW4_LOAD(o_, t_) do { \
                _Pragma("unroll") for (int ks = 0; ks < 2; ++ks) { o_.a1w[ks][0] = *(const LAS v2u*)(a1p + (t_) * a1s + 64 * ks); o_.a1w[ks][1] = *(const LAS v2u*)(a1p + (t_) * a1s + 64 * ks + 32); } \
                _Pragma("unroll") for (int kt = 0; kt < 4; ++kt) { o_.wv[kt] = *(const LAS f32x4*)(wp + (t_) * 256 + 64 * kt); o_.bk[kt] = *(const LAS unsigned*)(bkp + (t_) * 256 + 64 * kt); } \
                o_.vi = vp[(t_) * 64]; o_.sc = *(const LAS f32x2v*)(scp + 8 * (t_)); } while (0)
#define RW4_STEP(o_, t_) do { \
                f32x4 Xw_[4]; \
                _Pragma("unroll") for (int kt = 0; kt < 4; ++kt) Xw_[kt] = X[kt] * o_.wv[kt]; \
                f32x4 Y_ = (f32x4){0.f, 0.f, 0.f, 0.f}; \
                _Pragma("unroll") for (int ks = 0; ks < 2; ++ks) { v4u xb_; xb_.x = cvtpk(X[2 * ks][0], X[2 * ks][1]); xb_.y = cvtpk(X[2 * ks][2], X[2 * ks][3]); xb_.z = cvtpk(X[2 * ks + 1][0], X[2 * ks + 1][1]); xb_.w = cvtpk(X[2 * ks + 1][2], X[2 * ks + 1][3]); \
                    const v4u af_ = (v4u){o_.a1w[ks][0].x, o_.a1w[ks][0].y, o_.a1w[ks][1].x, o_.a1w[ks][1].y}; \
                    Y_ = __builtin_amdgcn_mfma_f32_16x16x32_bf16(__builtin_bit_cast(bf16x8, af_), __builtin_bit_cast(bf16x8, xb_), Y_, 0, 0, 0); } \
                const float sa_ = Y_[0], yy_ = Y_[1]; \
                const unsigned b2w_ = (g == 0) ? cvtpk(sa_, o_.vi) : 0u; \
                const bf16x8 B2_ = __builtin_bit_cast(bf16x8, (v4u){b2w_, 0u, 0u, 0u}); \
                _Pragma("unroll") for (int kt = 0; kt < 4; ++kt) { const bf16x8 A2_ = __builtin_bit_cast(bf16x8, (v4u){(g == 0) ? o_.bk[kt] : 0u, 0u, 0u, 0u}); \
                    X[kt] = __builtin_amdgcn_mfma_f32_16x16x32_bf16(A2_, B2_, Xw_[kt], 0, 0, 0); } \
                if (g == 0) Ly[(t_) * 64 + irow] = yy_ + sa_ * o_.sc.x + o_.vi * o_.sc.y; } while (0)
            Ops oA, oB;
            RW4_LOAD(oA, 0);
#pragma unroll 1
            for (int t = 0; t < TCH; t += 2) {
                RW4_LOAD(oB, t + 1);
                RW4_STEP(oA, t);
                if (t + 2 < TCH) RW4_LOAD(oA, t + 2);
                RW4_STEP(oB, t + 1);
            }
#undef RW4_LOAD
#undef RW4_STEP
            {
#pragma unroll 1
                for (int idx = lane; idx < TCH * 16; idx += 64) { const int tok = idx >> 4, rl = 16 * qi + (idx & 15); const int tk_ = c * TCH + tok; const int n_ = dir ? N - 1 - tk_ : tk_;
                    YD[(size_t)(R0 + n_) * 512 + h * 64 + rl] = (bf16)f2bf(Ly[tok * 64 + rl]); }
            }
        } else if (wave < 6 && c + 1 < nch) { RW_PREP4(c + 1); }
        __syncthreads();
    }
#undef RW_PREP4
    if (!lat && scanw) { float* so = F.out + O_SRW + (size_t)((b * 2 + dir) * 8 + h) * 4096 + irow * 64 + 4 * g;
#pragma unroll
        for (int kt = 0; kt < 4; ++kt) *(f32x4*)(so + 16 * kt) = X[kt]; }
}
__device__ __forceinline__ void scan_phase4(Frame& F, int mode = 0) {
    unsigned* qctr = (unsigned*)(F.ws + WS_CTL) + 2048;
    LAS int* qslot = (LAS int*)(F.lds + LDS_BYTES - 128);
    int heavy = F.bid;
    for (;;) {
        int type, seq, h, dir, row0 = 0;
        if (heavy < 160) {
            if (heavy < 128) { type = 2; const int u = heavy >> 2; seq = 32 + (u >> 4); h = (u >> 1) & 7; dir = u & 1; row0 = 16 * (heavy & 3); }
            else { type = 1; const int u = heavy - 128; seq = 32 + (u >> 4); h = (u >> 1) & 7; dir = u & 1; }
            heavy += F.G;
            if ((mode == 2 && type == 2) || (mode == 1 && type == 1)) continue;
        } else {
            if (mode) break;
            __syncthreads();
            if (F.tid == 0) *qslot = (int)atomicAdd(qctr, 1u);
            __syncthreads();
            const int it = *qslot;
            if (it >= 1024) break;
            type = it >> 9; const int q = it & 511; seq = q >> 4; h = (q >> 1) & 7; dir = q & 1;
        }
        if (type == 0) rwkv_job4<0>(F, seq, h, dir); else if (type == 1) ret_job2(F, seq, h, dir); else rwkv_job3<16>(F, seq, h, dir, row0);
    }
}
__device__ __forceinline__ void rec_post_phase2(Frame& F) {
    const int lane = F.lane, q16 = lane & 15, g = lane >> 4;
    const bf16* PROJ = F.P; const bf16* YD = (const bf16*)F.S; const bf16* OD = (const bf16*)F.S + (size_t)2 * T * 512; const bf16* GUPT = (const bf16*)(F.ws + WS_MOD + MOD_GUPT);
    for (int it = F.wave * F.G + F.bid; it < T / 16; it += F.G * NWAVES) {
        const int tk0 = 16 * it;
        bf16x8 af[4];
#pragma unroll
        for (int kd = 0; kd < 4; ++kd) { const v4u raw = *(const v4u*)(PROJ + (size_t)(tk0 + q16) * NREC + 3712 + 32 * kd + 8 * g); float f[8]; unpack8(raw, f);
#pragma unroll
            for (int e = 0; e < 8; ++e) f[e] = sigmoidf_(f[e]);
            af[kd] = __builtin_bit_cast(bf16x8, pack8(f)); }
        for (int h = 0; h < 8; ++h) {
            f32x4 ga[4];
#pragma unroll
            for (int ct = 0; ct < 4; ++ct) { ga[ct] = (f32x4){0.f, 0.f, 0.f, 0.f};
#pragma unroll
                for (int kd = 0; kd < 4; ++kd) { const bf16x8 bfr = *(const bf16x8*)(GUPT + (size_t)(h * 64 + 16 * ct + q16) * 128 + 32 * kd + 8 * g); ga[ct] = __builtin_amdgcn_mfma_f32_16x16x32_bf16(af[kd], bfr, ga[ct], 0, 0, 0); } }
            float lng[4], lnb[4], rk_[4];
#pragma unroll
            for (int ct = 0; ct < 4; ++ct) { const int c = h * 64 + 16 * ct + q16; lng[ct] = F.in[33][c]; lnb[ct] = F.in[34][c]; rk_[ct] = F.in[32][c]; }
#pragma unroll
            for (int e = 0; e < 4; ++e) { const int tk = tk0 + 4 * g + e; const bf16* pr = PROJ + (size_t)tk * NREC + h * 64 + q16;
                float y[4], v[4]; float s1 = 0.f, s3 = 0.f;
#pragma unroll
                for (int ct = 0; ct < 4; ++ct) { { const size_t ix_ = (size_t)tk * 512 + h * 64 + 16 * ct + q16; y[ct] = bf1(YD[ix_]) + bf1(YD[ix_ + (size_t)T * 512]); } const float r = bf1(pr[2048 + 16 * ct]), k = bf1(pr[2560 + 16 * ct]); v[ct] = bf1(pr[3072 + 16 * ct]); s1 += y[ct]; s3 += r * rk_[ct] * k; }
                s1 = row_reduce<16>(s1); s3 = row_reduce<16>(s3);
                const float mu = s1 * (1.f / 64.f); float s2 = 0.f;
#pragma unroll
                for (int ct = 0; ct < 4; ++ct) { y[ct] -= mu; s2 += y[ct] * y[ct]; }
                s2 = row_reduce<16>(s2);
                const float rstd = rsqrtf(s2 * (1.f / 64.f) + 64e-5f);
#pragma unroll
                for (int ct = 0; ct < 4; ++ct) F.MIX[(size_t)tk * D + 512 + h * 64 + 16 * ct + q16] = (bf16)f2bf((y[ct] * rstd * lng[ct] + lnb[ct] + s3 * v[ct]) * ga[ct][e]);
            }
        }
        for (int h = 0; h < 8; ++h) {
#pragma unroll
            for (int e = 0; e < 4; ++e) { const int tk = tk0 + 4 * g + e; const bf16* pr = PROJ + (size_t)tk * NREC + 1536 + h * 64 + q16;
                float o[4]; float ms = 0.f;
#pragma unroll
                for (int ct = 0; ct < 4; ++ct) { { const size_t ix_ = (size_t)tk * 512 + h * 64 + 16 * ct + q16; o[ct] = bf1(OD[ix_]) + bf1(OD[ix_ + (size_t)T * 512]); } ms += o[ct] * o[ct]; }
                ms = row_reduce<16>(ms);
                const float rn = rsqrtf(ms * (1.f / 64.f) + 1e-6f);
#pragma unroll
                for (int ct = 0; ct < 4; ++ct) { const float xg = bf1(pr[16 * ct]); F.MIX[(size_t)tk * D + h * 64 + 16 * ct + q16] = (bf16)f2bf(xg * sigmoidf_(xg) * o[ct] * rn); }
            }
        }
    }
}

typedef GAS unsigned gu32;
#define XB_TMO      128
#define XB_XCNT(j)  (256  + 64 * (j))
#define XB_XSUB(j)  (1280 + 64 * (j))
#define XB_XGEN(j)  (2304 + 64 * (j))
#define XB_TOP      3328
#define XB_TOPGEN   3392
#define XCD_BAR_WORDS 3456
#define XB_SPIN_CAP (1u << 18)

__device__ __forceinline__ unsigned xb_ld(unsigned* p)              { return __hip_atomic_load(p, __ATOMIC_RELAXED, __HIP_MEMORY_SCOPE_AGENT); }
__device__ __forceinline__ unsigned xb_add(unsigned* p, unsigned v) { return __hip_atomic_fetch_add(p, v, __ATOMIC_RELAXED, __HIP_MEMORY_SCOPE_AGENT); }
__device__ __forceinline__ unsigned xb_xcc_id() { return (unsigned)__builtin_amdgcn_s_getreg((3 << 11) | 20) & 0xFu; }
#define XB_SPIN(cond, bar) do { unsigned _sp = 0; while (cond) { __builtin_amdgcn_s_sleep(1); \
    if ((++_sp & 255u) == 0u) { if (xb_ld(&(bar)[XB_TMO])) break; if (_sp > XB_SPIN_CAP) { atomicAdd(&(bar)[XB_TMO], 1u); break; } } } } while (0)

struct XcdBarrier {
    unsigned* bar; unsigned x;
    volatile LAS unsigned* st;
};

__device__ __forceinline__ XcdBarrier xcd_barrier_post(unsigned* bar, volatile LAS unsigned* st) {
    XcdBarrier b; b.bar = bar; b.x = xb_xcc_id(); b.st = st;
    if (threadIdx.x == 0) (void)xb_add(&bar[XB_XCNT(b.x)], 1u);
    return b;
}
__device__ __forceinline__ void xcd_barrier_complete(unsigned* bar, unsigned x, unsigned& nloc, unsigned& nx) {
    const unsigned G = gridDim.x * gridDim.y * gridDim.z;
    unsigned sum, cnt, mine, sp = 0u;
    for (;;) {
        sum = 0u; cnt = 0u; mine = 0u;
#pragma unroll
        for (unsigned j = 0; j < 16; ++j) { const unsigned c = xb_ld(&bar[XB_XCNT(j)]); sum += c; cnt += (c > 0u) ? 1u : 0u; mine = (j == x) ? c : mine; }
        if (sum == G) break;
        __builtin_amdgcn_s_sleep(1);
        if ((++sp & 255u) == 0u) { if (xb_ld(&bar[XB_TMO])) break; if (sp > XB_SPIN_CAP) { atomicAdd(&bar[XB_TMO], 1u); break; } }
    }
    nloc = mine > 0u ? mine : 1u; nx = cnt > 0u ? cnt : 1u;
}

__device__ __forceinline__ void xcd_barrier(const XcdBarrier& b) {
    asm volatile("s_waitcnt vmcnt(0)" ::: "memory");
    __syncthreads();
    if (threadIdx.x == 0) {
        unsigned* bar = b.bar;
        __builtin_amdgcn_s_waitcnt(0);
        unsigned nloc = b.st[0], nx = b.st[1];
        if (nloc == 0u) { xcd_barrier_complete(bar, b.x, nloc, nx); b.st[0] = nloc; b.st[1] = nx; }
        const unsigned old = xb_add(&bar[XB_XSUB(b.x)], 1u);
        const unsigned gen = old / nloc;
        if (old + 1u == (gen + 1u) * nloc) {
            __builtin_amdgcn_fence(__ATOMIC_RELEASE, "agent");
            asm volatile("s_waitcnt vmcnt(0)" ::: "memory");
            const unsigned og = xb_add(&bar[XB_TOP], 1u);
            const unsigned tg = og / nx;
            if (og + 1u == (tg + 1u) * nx) xb_add(&bar[XB_TOPGEN], 1u);
            else XB_SPIN(xb_ld(&bar[XB_TOPGEN]) == tg, bar);
            __builtin_amdgcn_fence(__ATOMIC_ACQUIRE, "agent");
            xb_add(&bar[XB_XGEN(b.x)], 1u);
            asm volatile("s_waitcnt vmcnt(0)" ::: "memory");
        } else {
            XB_SPIN(xb_ld(&bar[XB_XGEN(b.x)]) == gen, bar);
            __builtin_amdgcn_fence(__ATOMIC_ACQUIRE, "agent");
            asm volatile("s_waitcnt vmcnt(0)" ::: "memory");
        }
    }
    __syncthreads();
}

#ifndef PROBE_DUP
#define PROBE_DUP 0
#endif
#ifndef ATTN_MFMA
#define ATTN_MFMA 1
#endif
enum { PH_BASE = __COUNTER__ };
struct Args { const float* in[37]; float* out; unsigned char* ws; int ph_lo, ph_hi; };

template <bool COOP>
__global__ void __launch_bounds__(NTHR, 2) mk_fwd(Args args) {
    extern __shared__ __attribute__((aligned(16))) unsigned char lds[];
    Frame F;
    F.lds = (LAS unsigned char*)lds;
    F.tid = threadIdx.x; F.lane = F.tid & 63; F.wave = __builtin_amdgcn_readfirstlane(F.tid >> 6); F.G = gridDim.x; F.bid = blockIdx.x;
#pragma unroll
    for (int i = 0; i < 37; ++i) F.in[i] = args.in[i];
    F.out = args.out; F.ws = args.ws;
    unsigned char* ws = args.ws;
    F.Watt = (bf16*)(ws + WS_WATT); F.Woa = (bf16*)(ws + WS_WOA); F.Wrec = (bf16*)(ws + WS_WREC); F.Wor = (bf16*)(ws + WS_WOR); F.Wf1 = (bf16*)(ws + WS_WF1); F.Wf2 = (bf16*)(ws + WS_WF2);
    F.H = (bf16*)(ws + WS_H); F.MIX = (bf16*)(ws + WS_MIX); F.P = (bf16*)(ws + WS_P); F.MOD = (float*)(ws + WS_MOD); F.S = (float*)(ws + WS_S);
    volatile LAS unsigned* MISC = (volatile LAS unsigned*)(F.lds + LDS_BYTES - 256);
    if (F.tid < 16) MISC[F.tid] = 0u;
    __syncthreads();
    XcdBarrier bar; bar.bar = (unsigned*)(ws + WS_CTL) + 4096; bar.x = 0; bar.st = nullptr;
    if (COOP) bar = xcd_barrier_post((unsigned*)(ws + WS_CTL) + 4096, MISC + 8);
    const int lo = args.ph_lo, hi = args.ph_hi;
#define IN(k) (lo <= (k) && (k) < hi)
#define SEAM(k) do { if (COOP && IN((k) + 1)) { if ((k) == 0) cooperative_groups::this_grid().sync(); else xcd_barrier(bar); } } while (0)
    const f32x2v* rope = (const f32x2v*)((unsigned char*)F.MOD + MOD_ROPE);

#define PHASE(...) { constexpr int k_ = __COUNTER__ - PH_BASE - 1; if (IN(k_)) { __VA_ARGS__; SEAM(k_); } }
    PHASE(p0_prologue(F))
#if PROBE_DUP == 3
    PHASE(p0_prologue(F))
#endif
    PHASE(norm_phase(F, F.in[0], F.in[1], F.in[10], F.MOD, 0, 1, false))
    PHASE(pg8::Gemm g{F.H, F.Watt, T, NATT, D}; pg8::StaticOrder S; S.init(T, NATT, F.G, F.bid); EpiAttnIn E{F.P, F.out, rope};
          pg8::gemm_phase<EpiAttnIn, pg8::StaticOrder, true, true>(F.lds, g, S, E))
#if ATTN_MFMA
    PHASE(attn_mfma_phase(F))
#if PROBE_DUP == 1
    PHASE(attn_mfma_phase(F))
#endif
#else
    PHASE(attn_naive_phase(F))
    PHASE(diff_post_phase(F))
#endif
    PHASE(pg8::Gemm g{F.MIX, F.Woa, T, D, D}; pg8::StaticOrder S; S.init(T, D, F.G, F.bid); EpiResid E{F.in[0], F.in[1], F.out, F.MOD, 2};
          pg8::gemm_phase<EpiResid, pg8::StaticOrder, true, true>(F.lds, g, S, E))
    PHASE(norm_phase(F, F.out, F.out + (size_t)TCX * D, F.in[11], F.MOD, 3, 4, false))
    PHASE(pg8::Gemm g{F.H, F.Wf1, T, NFF, D}; pg8::StaticOrder S; S.init(T, NFF, F.G, F.bid); EpiSwiglu E{F.P};
          pg8::gemm_phase<EpiSwiglu, pg8::StaticOrder, true, true>(F.lds, g, S, E))
#if PROBE_DUP == 5
    PHASE(pg8::Gemm g{F.H, F.Wf1, T, NFF, D}; pg8::StaticOrder S; S.init(T, NFF, F.G, F.bid); EpiSwiglu E{F.P};
          pg8::gemm_phase<EpiSwiglu, pg8::StaticOrder, true, true>(F.lds, g, S, E))
#endif
    PHASE(pg8::Gemm g{F.P, F.Wf2, T, D, DFF}; pg8::StaticOrder S; S.init(T, D, F.G, F.bid); EpiResid E{F.out, F.out + (size_t)TCX * D, F.out, F.MOD, 5};
          pg8::gemm_phase<EpiResid, pg8::StaticOrder, true, true>(F.lds, g, S, E))
    PHASE(norm_phase(F, F.out, F.out + (size_t)TCX * D, F.in[10] + D, F.MOD + 3 * 6144, 0, 1, false))
    PHASE(pg8::Gemm g{F.H, F.Wrec, T, NREC, D}; pg8::StaticOrder S; S.init(T, NREC, F.G, F.bid); EpiBf16Plain E{F.P, NREC};
          pg8::gemm_phase<EpiBf16Plain, pg8::StaticOrder, true, true>(F.lds, g, S, E))
#if PROBE_DUP == 8
    PHASE(scan_phase3(F, 2))
#endif
#if PROBE_DUP == 9
    PHASE(scan_phase3(F, 2))
    PHASE(scan_phase3(F, 3))
#else
    PHASE(scan_phase4(F))
#endif
#if PROBE_DUP == 2
    PHASE(scan_phase4(F))
#endif
#if PROBE_DUP == 6
    PHASE(scan_phase4(F, 1))
#endif
#if PROBE_DUP == 7
    PHASE(scan_phase4(F, 2))
#endif
#if PROBE_DUP == 11
    PHASE(scan_phase3(F, 4))
#endif
#if PROBE_DUP == 10
    PHASE(for (int i_ = F.tid; i_ < 36000; i_ += NTHR) ((LAS unsigned*)F.lds)[i_] = 0u; scan_phase3(F, 2))
#endif
    PHASE(rec_post_phase2(F))
#if PROBE_DUP == 4
    PHASE(rec_post_phase2(F))
#endif
    PHASE(pg8::Gemm g{F.MIX, F.Wor, T, D, D}; pg8::StaticOrder S; S.init(T, D, F.G, F.bid); EpiResid E{F.out, F.out + (size_t)TCX * D, F.out, F.MOD + 3 * 6144, 2};
          pg8::gemm_phase<EpiResid, pg8::StaticOrder, true, true>(F.lds, g, S, E))
    PHASE(norm_phase(F, F.out, F.out + (size_t)TCX * D, F.in[11] + D, F.MOD + 3 * 6144, 3, 4, false))
    PHASE(pg8::Gemm g{F.H, F.Wf1 + WF1_STRIDE, T, NFF, D}; pg8::StaticOrder S; S.init(T, NFF, F.G, F.bid); EpiSwiglu E{F.P};
          pg8::gemm_phase<EpiSwiglu, pg8::StaticOrder, true, true>(F.lds, g, S, E))
    PHASE(pg8::Gemm g{F.P, F.Wf2 + WF2_STRIDE, T, D, DFF}; pg8::StaticOrder S; S.init(T, D, F.G, F.bid); EpiResid E{F.out, F.out + (size_t)TCX * D, F.out, F.MOD + 3 * 6144, 5};
          pg8::gemm_phase<EpiResid, pg8::StaticOrder, true, true>(F.lds, g, S, E))
    PHASE(final_norm_phase(F))
#undef PHASE
#undef IN
#undef SEAM
}

constexpr int NPHASE = __COUNTER__ - PH_BASE - 1;
#ifndef MK_N_LAUNCHES
#define MK_N_LAUNCHES 1
#endif
extern "C" void kernel_launch(void* const* d_in, const int* in_sizes, int n_in, void* d_out, int out_size, void* d_ws, size_t ws_size, hipStream_t stream) {
    static int grid = 0;
    if (grid == 0) {
        if (n_in != 37 || out_size != 33554432 || ws_size < WS_END) { fprintf(stderr, "kernel_launch: unexpected problem (n_in %d out %d ws %zu)\n", n_in, out_size, ws_size); grid = -1; return; }
        int dev = 0, cus = 0, per_cu = 0;
        if (hipGetDevice(&dev) != hipSuccess || hipDeviceGetAttribute(&cus, hipDeviceAttributeMultiprocessorCount, dev) != hipSuccess) { grid = -1; return; }
        (void)hipFuncSetAttribute((const void*)mk_fwd<false>, hipFuncAttributeMaxDynamicSharedMemorySize, LDS_BYTES);
        (void)hipFuncSetAttribute((const void*)mk_fwd<true>, hipFuncAttributeMaxDynamicSharedMemorySize, LDS_BYTES);
        if (hipOccupancyMaxActiveBlocksPerMultiprocessor(&per_cu, (const void*)mk_fwd<true>, NTHR, LDS_BYTES) != hipSuccess || per_cu < 1) per_cu = 1;
        (void)hipGetLastError();
        grid = cus;
    }
    if (grid < 0) return;
    if (hipMemsetAsync((char*)d_ws + WS_CTL, 0, 65536, stream) != hipSuccess) { fprintf(stderr, "memset failed\n"); return; }
    Args a{};
    for (int i = 0; i < 37; ++i) a.in[i] = (const float*)d_in[i];
    a.out = (float*)d_out; a.ws = (unsigned char*)d_ws;
#if MK_N_LAUNCHES == 1
    a.ph_lo = 0; a.ph_hi = NPHASE;
    void* kargs[] = {&a};
    hipError_t e = hipLaunchCooperativeKernel((const void*)mk_fwd<true>, dim3(grid), dim3(NTHR), kargs, LDS_BYTES, stream);
    if (e != hipSuccess) fprintf(stderr, "cooperative launch failed: %s (grid %d)\n", hipGetErrorString(e), grid);
#else
    for (int ph = 0; ph < NPHASE; ++ph) { a.ph_lo = ph; a.ph_hi = ph + 1; hipLaunchKernelGGL(mk_fwd<false>, dim3(grid), dim3(NTHR), LDS_BYTES, stream, a); }
#endif
}
```
